# Optimizing an MI355X kernel written in HIP

```python
import jax
import jax.numpy as jnp
from jax import lax
import numpy as np

D_MODEL = 2048
BATCH = 2
SEQ = 4096
DEPTH = 1
DEC_BATCH = 8
DEC_SEQ = 1
PAST_LEN = 16384
PAGE_SIZE = 128

R_HEADS = 8
R_DK = 128
R_DV = 256
R_CHUNK = 128
A_HEADS = 16
A_KV_HEADS = 4
A_HEAD_DIM = 128
A_GROUP = A_HEADS // A_KV_HEADS
I_HEADS = 16
I_DIM = 128
TOPK_MAX = 256
Q_BLOCK = 128
ROPE_THETA = 10000.0
P_HEADS = 8
P_NKEYS = 128
P_DKEY = 128
P_TOPK = 16
P_NEXPERTS = P_NKEYS * P_NKEYS
P_BLOCK = 128
EPS = 1e-6
F32 = jnp.float32

IN_SPLITS = (
    ('rq', R_HEADS * R_DK), ('rk', R_HEADS * R_DK), ('rv', R_HEADS * R_DV), ('rg', R_HEADS * R_DV),
    ('aq', A_HEADS * A_HEAD_DIM), ('ak', A_KV_HEADS * A_HEAD_DIM), ('av', A_KV_HEADS * A_HEAD_DIM),
    ('iq', I_HEADS * I_DIM), ('ik', I_DIM), ('iw', I_HEADS),
    ('gr', D_MODEL), ('ga', D_MODEL),
)
IN_WIDTH = sum(w for _, w in IN_SPLITS)

kernel_name = 'retention_dsa_peer_hybrid_step'


def _rmsnorm(x, w):
    xf = x.astype(F32)
    y = xf * lax.rsqrt(jnp.mean(xf * xf, axis=-1, keepdims=True) + EPS)
    return (y * w.astype(F32)).astype(x.dtype)


def _rope(x, pos):
    half = x.shape[-1] // 2
    freqs = ROPE_THETA ** (-jnp.arange(half, dtype=F32) / half)
    ang = pos.astype(F32)[:, None] * freqs[None, :]
    cos = jnp.cos(ang)[None, :, None, :]
    sin = jnp.sin(ang)[None, :, None, :]
    xf = x.astype(F32)
    x1, x2 = xf[..., :half], xf[..., half:]
    return jnp.concatenate([x1 * cos - x2 * sin, x2 * cos + x1 * sin], axis=-1).astype(x.dtype)


def _split_proj(z):
    parts = {}
    off = 0
    for name, width in IN_SPLITS:
        parts[name] = z[..., off:off + width]
        off += width
    return parts


def _mixer_in(x, pos, norm1_w, w_in, q_norm_w, k_norm_w):
    B, T, _ = x.shape
    xn = _rmsnorm(x, norm1_w)
    p = _split_proj(xn @ w_in)
    out = {}
    out['rq'] = _rope(p['rq'].reshape(B, T, R_HEADS, R_DK), pos)
    out['rk'] = _rope(p['rk'].reshape(B, T, R_HEADS, R_DK), pos) * (R_DK ** -0.5)
    out['rv'] = p['rv'].reshape(B, T, R_HEADS, R_DV)
    out['rg'] = p['rg']
    out['aq'] = _rope(_rmsnorm(p['aq'].reshape(B, T, A_HEADS, A_HEAD_DIM), q_norm_w), pos)
    out['ak'] = _rope(_rmsnorm(p['ak'].reshape(B, T, A_KV_HEADS, A_HEAD_DIM), k_norm_w), pos)
    out['av'] = p['av'].reshape(B, T, A_KV_HEADS, A_HEAD_DIM)
    out['iq'] = _rope(p['iq'].reshape(B, T, I_HEADS, I_DIM), pos) * (I_DIM ** -0.5)
    out['ik'] = _rope(p['ik'].reshape(B, T, 1, I_DIM), pos)[:, :, 0]
    out['iw'] = p['iw'] * (I_HEADS ** -0.5)
    out['gr'] = p['gr']
    out['ga'] = p['ga']
    return out


def _ret_log_decay():
    return jnp.log1p(-jnp.exp2(-5.0 - jnp.arange(R_HEADS, dtype=F32)))


def _ret_chunk(S, q, k, v):
    log_g = _ret_log_decay()
    C = q.shape[1]
    n = jnp.arange(C, dtype=F32)
    diff = n[:, None] - n[None, :]
    causal = diff >= 0
    dmat = jnp.where(causal, jnp.exp(jnp.where(causal, diff, 0.0)[None] * log_g[:, None, None]), 0.0)
    qf, kf, vf = q.astype(F32), k.astype(F32), v.astype(F32)
    scores = jnp.einsum('bihd,bjhd->bhij', qf, kf) * dmat[None]
    intra = jnp.einsum('bhij,bjhe->bihe', scores, vf)
    q_dec = qf * jnp.exp((n + 1.0)[:, None] * log_g[None, :])[None, :, :, None]
    cross = jnp.einsum('bihd,bhde->bihe', q_dec, S)
    k_dec = kf * jnp.exp((C - 1.0 - n)[:, None] * log_g[None, :])[None, :, :, None]
    S_new = jnp.exp(C * log_g)[None, :, None, None] * S + jnp.einsum('bjhd,bjhe->bhde', k_dec, vf)
    return S_new, intra + cross


def _retention_prompt(rq, rk, rv):
    B, T = rq.shape[:2]
    nc = T // R_CHUNK
    to_c = lambda a: jnp.moveaxis(a.reshape(B, nc, R_CHUNK, *a.shape[2:]), 1, 0)
    S0 = jnp.zeros((B, R_HEADS, R_DK, R_DV), F32)
    S, o = lax.scan(lambda S, blk: _ret_chunk(S, *blk), S0, (to_c(rq), to_c(rk), to_c(rv)))
    return jnp.moveaxis(o, 0, 1).reshape(B, T, R_HEADS, R_DV), S


def _index_select(iq, iw, ik, qpos, topk):
    s = jax.nn.relu(jnp.einsum('bqhd,bld->bqhl', iq.astype(F32), ik.astype(F32)))
    score = jnp.einsum('bqhl,bqh->bql', s, iw.astype(F32))
    kpos = jnp.arange(ik.shape[1])
    admissible = kpos[None, :] <= qpos[:, None]
    score = jnp.where(admissible[None], score, -jnp.inf)
    _, idx = lax.top_k(score, topk)
    valid = idx <= qpos[None, :, None]
    return idx, valid


def _attn_core(q, ks, vs, valid):
    B, Q = q.shape[:2]
    qg = q.reshape(B, Q, A_KV_HEADS, A_GROUP, A_HEAD_DIM).astype(F32)
    logits = jnp.einsum('bqngd,bqsnd->bqngs', qg, ks.astype(F32)) * (A_HEAD_DIM ** -0.5)
    logits = jnp.where(valid[:, :, None, None, :], logits, -1e30)
    prob = jax.nn.softmax(logits, axis=-1)
    o = jnp.einsum('bqngs,bqsnd->bqngd', prob, vs.astype(F32))
    return o.reshape(B, Q, A_HEADS * A_HEAD_DIM).astype(q.dtype)


_row_gather = jax.vmap(lambda a, i: a[i])


def _dsa_prompt(aq, ak, av, iq, iw, ik):
    B, T = aq.shape[:2]
    nb = T // Q_BLOCK
    topk = min(TOPK_MAX, T // 4)

    def blk(args):
        qb, iqb, iwb, b0 = args
        qpos = b0 * Q_BLOCK + jnp.arange(Q_BLOCK)
        idx, valid = _index_select(iqb, iwb, ik, qpos, topk)
        return _attn_core(qb, _row_gather(ak, idx), _row_gather(av, idx), valid)

    to_b = lambda a: jnp.moveaxis(a.reshape(B, nb, Q_BLOCK, *a.shape[2:]), 1, 0)
    out = lax.map(blk, (to_b(aq), to_b(iq), to_b(iw), jnp.arange(nb)))
    return jnp.moveaxis(out, 0, 1).reshape(B, T, A_HEADS * A_HEAD_DIM)


def _dsa_sample(aq, ak, av, iq, iw, ik, pool_k, pool_v, pool_kidx, page_table):
    Bd, Ts = aq.shape[:2]
    past = page_table.shape[1] * PAGE_SIZE
    L = past + Ts
    ik_past = pool_kidx[page_table].reshape(Bd, past, I_DIM)
    ik_all = jnp.concatenate([ik_past, ik.astype(ik_past.dtype)], axis=1)
    qpos = past + jnp.arange(Ts)
    idx, valid = _index_select(iq, iw, ik_all, qpos, min(TOPK_MAX, L // 4))
    is_past = idx < past
    pidx = jnp.minimum(idx, past - 1)
    phys = jnp.take_along_axis(page_table, (pidx // PAGE_SIZE).reshape(Bd, -1), axis=1).reshape(pidx.shape)
    rows = phys * PAGE_SIZE + pidx % PAGE_SIZE
    nidx = jnp.clip(idx - past, 0, Ts - 1)

    def select(pool, new):
        flat = pool.reshape(-1, *pool.shape[2:])
        return jnp.where(is_past[..., None, None], flat[rows], _row_gather(new, nidx).astype(flat.dtype))

    return _attn_core(aq, select(pool_k, ak), select(pool_v, av), valid)


def _mixer_out(x, p, ret, att, ret_gn_w, w_ret_o, w_att_o, w_out):
    B, T = x.shape[:2]
    mu = jnp.mean(ret, axis=-1, keepdims=True)
    var = jnp.mean(jnp.square(ret - mu), axis=-1, keepdims=True)
    rn = ((ret - mu) * lax.rsqrt(var + EPS)).reshape(B, T, R_HEADS * R_DV)
    rn = (rn * ret_gn_w.astype(F32) * jax.nn.silu(p['rg'].astype(F32))).astype(x.dtype)
    mixed = jax.nn.sigmoid(p['gr']) * (rn @ w_ret_o) + jax.nn.sigmoid(p['ga']) * (att @ w_att_o)
    return x + mixed @ w_out


def _peer(xn, wq, keys1, keys2, u_tab, v_tab):
    N = xn.shape[0]
    q = (xn @ wq).reshape(N, P_HEADS, 2, P_DKEY // 2).astype(F32)
    s1 = jnp.einsum('nhd,hkd->nhk', q[:, :, 0], keys1.astype(F32))
    s2 = jnp.einsum('nhd,hkd->nhk', q[:, :, 1], keys2.astype(F32))
    v1, i1 = lax.top_k(s1, P_TOPK)
    v2, i2 = lax.top_k(s2, P_TOPK)
    cand = (v1[..., :, None] + v2[..., None, :]).reshape(N, P_HEADS, P_TOPK * P_TOPK)
    sc, ci = lax.top_k(cand, P_TOPK)
    e = (jnp.take_along_axis(i1, ci // P_TOPK, axis=-1) * P_NKEYS
         + jnp.take_along_axis(i2, ci % P_TOPK, axis=-1))
    g = jax.nn.softmax(sc, axis=-1)
    act = jax.nn.gelu(jnp.einsum('nhkd,nd->nhk', u_tab[e].astype(F32), xn.astype(F32)), approximate=False)
    out = jnp.einsum('nhk,nhkd->nd', g * act, v_tab[e].astype(F32))
    return out.astype(xn.dtype)


def _prompt_layer(x, W):
    (norm1_w, w_in, q_norm_w, k_norm_w, ret_gn_w, w_ret_o, w_att_o, w_out,
     norm2_w, peer_wq, peer_keys1, peer_keys2, peer_u, peer_v) = W
    B, T, D = x.shape
    pos = jnp.arange(T)
    p = _mixer_in(x, pos, norm1_w, w_in, q_norm_w, k_norm_w)
    ret, S = _retention_prompt(p['rq'], p['rk'], p['rv'])
    att = _dsa_prompt(p['aq'], p['ak'], p['av'], p['iq'], p['iw'], p['ik'])
    h = _mixer_out(x, p, ret, att, ret_gn_w, w_ret_o, w_att_o, w_out)
    hn = _rmsnorm(h, norm2_w).reshape(-1, P_BLOCK, D)
    f = lax.map(lambda t: _peer(t, peer_wq, peer_keys1, peer_keys2, peer_u, peer_v), hn).reshape(B, T, D)
    return h + f, p['ak'], p['av'], p['ik'], S


def _sample_layer(x, pool_k, pool_v, pool_kidx, S_in, page_table, W):
    (norm1_w, w_in, q_norm_w, k_norm_w, ret_gn_w, w_ret_o, w_att_o, w_out,
     norm2_w, peer_wq, peer_keys1, peer_keys2, peer_u, peer_v) = W
    Bd, Ts, D = x.shape
    pos = page_table.shape[1] * PAGE_SIZE + jnp.arange(Ts)
    p = _mixer_in(x, pos, norm1_w, w_in, q_norm_w, k_norm_w)
    S, ret = _ret_chunk(S_in.astype(F32), p['rq'], p['rk'], p['rv'])
    att = _dsa_sample(p['aq'], p['ak'], p['av'], p['iq'], p['iw'], p['ik'], pool_k, pool_v, pool_kidx, page_table)
    h = _mixer_out(x, p, ret, att, ret_gn_w, w_ret_o, w_att_o, w_out)
    hn = _rmsnorm(h, norm2_w).reshape(-1, D)
    f = _peer(hn, peer_wq, peer_keys1, peer_keys2, peer_u, peer_v).reshape(Bd, Ts, D)
    return h + f, p['ak'], p['av'], p['ik'], S


def setup_inputs(seed: int = 0) -> dict:
    key = jax.random.key(seed)
    ks = jax.random.split(key, 24)
    nrm = lambda k, shape, scale: jax.random.normal(k, shape, F32) * scale
    gain = lambda k, shape: 1.0 + 0.01 * jax.random.normal(k, shape, F32)
    n_pages = PAST_LEN // PAGE_SIZE
    n_used = DEC_BATCH * n_pages
    n_pool = (n_used * 5) // 4
    page_table = jax.random.permutation(ks[6], n_pool)[:n_used].reshape(DEC_BATCH, n_pages).astype(jnp.int32)
    return {
        'x_prompt': nrm(ks[0], (BATCH, SEQ, D_MODEL), 1.0),
        'x_sample': nrm(ks[1], (DEC_BATCH, DEC_SEQ, D_MODEL), 1.0),
        'cache_k': nrm(ks[2], (DEPTH, n_pool, PAGE_SIZE, A_KV_HEADS, A_HEAD_DIM), 1.0),
        'cache_v': nrm(ks[3], (DEPTH, n_pool, PAGE_SIZE, A_KV_HEADS, A_HEAD_DIM), 1.0),
        'cache_k_idx': nrm(ks[4], (DEPTH, n_pool, PAGE_SIZE, I_DIM), 1.0),
        'state_ret': nrm(ks[5], (DEPTH, DEC_BATCH, R_HEADS, R_DK, R_DV), 0.1),
        'page_table': page_table,
        'norm1_w': gain(ks[7], (DEPTH, D_MODEL)),
        'w_in': nrm(ks[8], (DEPTH, D_MODEL, IN_WIDTH), D_MODEL ** -0.5),
        'q_norm_w': gain(ks[9], (DEPTH, A_HEAD_DIM)),
        'k_norm_w': gain(ks[10], (DEPTH, A_HEAD_DIM)),
        'ret_gn_w': gain(ks[11], (DEPTH, R_HEADS * R_DV)),
        'w_ret_o': nrm(ks[12], (DEPTH, R_HEADS * R_DV, D_MODEL), (R_HEADS * R_DV) ** -0.5),
        'w_att_o': nrm(ks[13], (DEPTH, A_HEADS * A_HEAD_DIM, D_MODEL), (A_HEADS * A_HEAD_DIM) ** -0.5),
        'w_out': nrm(ks[14], (DEPTH, D_MODEL, D_MODEL), D_MODEL ** -0.5),
        'norm2_w': gain(ks[15], (DEPTH, D_MODEL)),
        'peer_wq': nrm(ks[16], (DEPTH, D_MODEL, P_HEADS * P_DKEY), D_MODEL ** -0.5),
        'peer_keys1': nrm(ks[17], (DEPTH, P_HEADS, P_NKEYS, P_DKEY // 2), (P_DKEY // 2) ** -0.5),
        'peer_keys2': nrm(ks[18], (DEPTH, P_HEADS, P_NKEYS, P_DKEY // 2), (P_DKEY // 2) ** -0.5),
        'peer_u': nrm(ks[19], (DEPTH, P_NEXPERTS, D_MODEL), D_MODEL ** -0.5),
        'peer_v': nrm(ks[20], (DEPTH, P_NEXPERTS, D_MODEL), (P_HEADS * P_TOPK) ** -0.5),
    }


def reference(x_prompt, x_sample, cache_k, cache_v, cache_k_idx, state_ret, page_table,
              norm1_w, w_in, q_norm_w, k_norm_w, ret_gn_w, w_ret_o, w_att_o, w_out,
              norm2_w, peer_wq, peer_keys1, peer_keys2, peer_u, peer_v):
    yp, ys = x_prompt, x_sample
    kp_l, vp_l, ikp_l, sp_l, ks_l, vs_l, iks_l, ss_l = [], [], [], [], [], [], [], []
    for layer in range(DEPTH):
        W = (norm1_w[layer], w_in[layer], q_norm_w[layer], k_norm_w[layer], ret_gn_w[layer],
             w_ret_o[layer], w_att_o[layer], w_out[layer], norm2_w[layer], peer_wq[layer],
             peer_keys1[layer], peer_keys2[layer], peer_u[layer], peer_v[layer])
        yp, kp, vp, ikp, sp = _prompt_layer(yp, W)
        ys, kn, vn, ikn, sn = _sample_layer(ys, cache_k[layer], cache_v[layer], cache_k_idx[layer],
                                            state_ret[layer], page_table, W)
        kp_l.append(kp); vp_l.append(vp); ikp_l.append(ikp); sp_l.append(sp)
        ks_l.append(kn); vs_l.append(vn); iks_l.append(ikn); ss_l.append(sn)
    return (yp, ys,
            jnp.stack(kp_l), jnp.stack(vp_l), jnp.stack(ikp_l), jnp.stack(sp_l),
            jnp.stack(ks_l), jnp.stack(vs_l), jnp.stack(iks_l), jnp.stack(ss_l))
```

```cpp
#include <hip/hip_runtime.h>
#include <stdint.h>
#include <stdio.h>
#include <string.h>
#include <math.h>
#include <type_traits>

typedef _Float16 h16;
typedef _Float16 h16x8 __attribute__((ext_vector_type(8)));
typedef _Float16 h16x4 __attribute__((ext_vector_type(4)));
typedef _Float16 h16x2 __attribute__((ext_vector_type(2)));
typedef float f32x4 __attribute__((ext_vector_type(4)));
typedef float f32x2 __attribute__((ext_vector_type(2)));
typedef unsigned u32x4 __attribute__((ext_vector_type(4)));
typedef unsigned long long u64;

#define LAS __attribute__((address_space(3)))

constexpr int D = 2048, SEQ = 4096, TP = 8192, NS = 8, TT = TP + NS;
constexpr int NWP = 15616;
constexpr int NW0 = 15504;
constexpr int PAST = 16384, PAGE = 128, NPAGES = 128, LS = PAST + 1;
constexpr int NEXP = 16384;
constexpr float EPS = 1e-6f;
constexpr int C_RQ = 0, C_RK = 1024, C_RV = 2048, C_RG = 4096, C_AQ = 6144, C_AK = 8192, C_AV = 8704, C_IQ = 9216, C_IK = 11264, C_IW = 11392, C_GR = 11408, C_GA = 13456;
constexpr size_t O_YP = 0, O_YS = 16777216, O_KP = 16793600, O_VP = 20987904, O_IKP = 25182208, O_SP = 26230784,
                 O_KS = 26755072, O_VS = 26759168, O_IKS = 26763264, O_SS = 26764288;
constexpr int LDS_BYTES = 139264;
constexpr int SCS = 4112;
constexpr int SSCS = 16400;

#define XB_TMO      128
#define XB_XCNT(j)  (256  + 64 * (j))
#define XB_XSUB(j)  (1280 + 64 * (j))
#define XB_XGEN(j)  (2304 + 64 * (j))
#define XB_TOP      3328
#define XB_TOPGEN   3392
#define XCD_BAR_WORDS 3456
#define XB_SPIN_CAP (1u << 22)
__device__ __forceinline__ unsigned xb_ld(unsigned* p)              { return __hip_atomic_load(p, __ATOMIC_RELAXED, __HIP_MEMORY_SCOPE_AGENT); }
__device__ __forceinline__ unsigned xb_add(unsigned* p, unsigned v) { return __hip_atomic_fetch_add(p, v, __ATOMIC_RELAXED, __HIP_MEMORY_SCOPE_AGENT); }
__device__ __forceinline__ unsigned xb_xcc_id() { return (unsigned)__builtin_amdgcn_s_getreg((3 << 11) | 20) & 0xFu; }
#define XB_SPIN(cond, bar) do { unsigned _sp = 0; while (cond) { __builtin_amdgcn_s_sleep(1); \
    if ((++_sp & 255u) == 0u) { if (xb_ld(&(bar)[XB_TMO])) break; if (_sp > XB_SPIN_CAP) { atomicAdd(&(bar)[XB_TMO], 1u); break; } } } } while (0)
struct XcdBarrier { unsigned* bar; unsigned x; volatile LAS unsigned* st; };
__device__ __forceinline__ XcdBarrier xcd_barrier_post(unsigned* bar, volatile LAS unsigned* st) {
    XcdBarrier b; b.bar = bar; b.x = xb_xcc_id(); b.st = st;
    if (threadIdx.x == 0) (void)xb_add(&bar[XB_XCNT(b.x)], 1u);
    return b;
}
__device__ __forceinline__ void xcd_barrier_complete(unsigned* bar, unsigned x, unsigned& nloc, unsigned& nx) {
    const unsigned G = gridDim.x * gridDim.y * gridDim.z;
    unsigned sum, cnt, mine, sp = 0u;
    for (;;) {
        sum = 0u; cnt = 0u; mine = 0u;
#pragma unroll
        for (unsigned j = 0; j < 16; ++j) { const unsigned c = xb_ld(&bar[XB_XCNT(j)]); sum += c; cnt += (c > 0u) ? 1u : 0u; mine = (j == x) ? c : mine; }
        if (sum == G) break;
        __builtin_amdgcn_s_sleep(1);
        if ((++sp & 255u) == 0u) { if (xb_ld(&bar[XB_TMO])) break; if (sp > XB_SPIN_CAP) { atomicAdd(&bar[XB_TMO], 1u); break; } }
    }
    nloc = mine > 0u ? mine : 1u; nx = cnt > 0u ? cnt : 1u;
}
__device__ __forceinline__ void xcd_barrier(const XcdBarrier& b) {
    asm volatile("s_waitcnt vmcnt(0)" ::: "memory");
    __syncthreads();
    if (threadIdx.x == 0) {
        unsigned* bar = b.bar;
        __builtin_amdgcn_s_waitcnt(0);
        volatile LAS unsigned* stw = (volatile LAS unsigned*)(unsigned)(LDS_BYTES - 16);
        unsigned nloc = stw[0], nx = stw[1];
        if (nloc == 0u) { xcd_barrier_complete(bar, b.x, nloc, nx); stw[0] = nloc; stw[1] = nx; }
        const unsigned old = xb_add(&bar[XB_XSUB(b.x)], 1u);
        const unsigned gen = old / nloc;
        if (old + 1u == (gen + 1u) * nloc) {
            __builtin_amdgcn_fence(__ATOMIC_RELEASE, "agent");
            asm volatile("s_waitcnt vmcnt(0)" ::: "memory");
            const unsigned og = xb_add(&bar[XB_TOP], 1u);
            const unsigned tg = og / nx;
            if (og + 1u == (tg + 1u) * nx) xb_add(&bar[XB_TOPGEN], 1u);
            else XB_SPIN(xb_ld(&bar[XB_TOPGEN]) == tg, bar);
            __builtin_amdgcn_fence(__ATOMIC_ACQUIRE, "agent");
            xb_add(&bar[XB_XGEN(b.x)], 1u);
            asm volatile("s_waitcnt vmcnt(0)" ::: "memory");
        } else {
            XB_SPIN(xb_ld(&bar[XB_XGEN(b.x)]) == gen, bar);
            __builtin_amdgcn_fence(__ATOMIC_ACQUIRE, "agent");
            asm volatile("s_waitcnt vmcnt(0)" ::: "memory");
        }
    }
    __syncthreads();
}

struct Params {
    const float *x_prompt, *x_sample, *cache_k, *cache_v, *cache_kidx, *state_ret;
    const int* page_table;
    const float *norm1_w, *w_in, *q_norm_w, *k_norm_w, *ret_gn_w, *w_ret_o, *w_att_o, *w_out, *norm2_w, *peer_wq, *peer_k1, *peer_k2, *peer_u, *peer_v;
    float* out;
    unsigned* ctl;
    float* ROWSS;
    h16 *XN, *WinT, *WrT, *WaT, *WoT, *WqT, *PU, *PV, *K1H, *K2H;
    int2* ROUTE;
    unsigned char *AQ8, *AK8;
    h16 *RQ, *RK, *RV, *RG, *AQ, *AK, *AV, *IQ, *IK, *GR, *GA;
    float* IW;
    float* KV; h16* SPT; int* TOPI; h16 *RN, *ATT, *MIX, *HN; float* MIXF; float* PQ;
    float2* ROPE;
    float *XNS, *ZS, *SRQ, *SRK, *SRV, *SRG, *SAQ, *SAK, *SAV, *SIQ, *SIK, *SIW, *SGR, *SGA, *SSC;
    int* STOP;
    float *SRN, *SATT, *SMIX, *SHN, *SPQ;
};
struct KArgs {
    const void* in[21];
    float* out;
    char* ws;
    int ph_lo, ph_hi;
};
constexpr size_t al256(size_t x) { return (x + 255) & ~(size_t)255; }
constexpr size_t WS_CTL = 0;
constexpr size_t WS_XN = WS_CTL + 65536;
constexpr size_t WS_WINT = WS_XN + al256((size_t)TP * D * 2);
constexpr size_t WS_WRT = WS_WINT + al256((size_t)NWP * D * 2);
constexpr size_t WS_WAT = WS_WRT + al256((size_t)D * D * 2);
constexpr size_t WS_WOT = WS_WAT + al256((size_t)D * D * 2);
constexpr size_t WS_WQT = WS_WOT + al256((size_t)D * D * 2);
constexpr size_t WS_PU = WS_WQT + al256((size_t)1024 * D * 2);
constexpr size_t WS_PV = WS_PU + al256((size_t)NEXP * D * 2);
constexpr size_t WS_RQ = WS_PV + al256((size_t)NEXP * D * 2);
constexpr size_t WS_RK = WS_RQ + al256((size_t)TP * 1024 * 2);
constexpr size_t WS_RV = WS_RK + al256((size_t)TP * 1024 * 2);
constexpr size_t WS_RG = WS_RV + al256((size_t)TP * 2048 * 2);
constexpr size_t WS_AQ = WS_RG + al256((size_t)TP * 2048 * 2);
constexpr size_t WS_AK = WS_AQ + al256((size_t)TP * 2048 * 2);
constexpr size_t WS_AV = WS_AK + al256((size_t)TP * 512 * 2);
constexpr size_t WS_IQ = WS_AV + al256((size_t)TP * 512 * 2);
constexpr size_t WS_IK = WS_IQ + al256((size_t)TP * 2048 * 2);
constexpr size_t WS_GR = WS_IK + al256((size_t)TP * 128 * 2);
constexpr size_t WS_GA = WS_GR + al256((size_t)TP * 2048 * 2);
constexpr size_t WS_IW = WS_GA + al256((size_t)TP * 2048 * 2);
constexpr size_t WS_KV = WS_IW + al256((size_t)TP * 16 * 4);
constexpr size_t WS_SPT = WS_KV + al256((size_t)2 * 8 * 32 * 128 * 256 * 4);
constexpr size_t WS_TOPI = WS_SPT + al256((size_t)2 * 8 * 32 * 256 * 128 * 2);
constexpr size_t WS_RN = WS_TOPI + al256((size_t)TP * 256 * 4);
constexpr size_t WS_ATT = WS_RN + al256((size_t)TP * D * 2);
constexpr size_t WS_MIX = WS_ATT + al256((size_t)TP * D * 2);
constexpr size_t WS_HN = WS_MIX + al256((size_t)TP * D * 2);
constexpr size_t WS_MIXF = WS_HN + al256((size_t)TP * D * 2);
constexpr size_t WS_PQ = WS_MIXF + al256((size_t)TP * D * 4);
constexpr size_t WS_ROPE = WS_PQ + al256((size_t)TP * 1024 * 4);
constexpr size_t WS_XNS = WS_ROPE + al256((size_t)4097 * 64 * 8);
constexpr size_t WS_ZS = WS_XNS + al256(8 * D * 4);
constexpr size_t WS_SRQ = WS_ZS + al256((size_t)8 * NW0 * 4);
constexpr size_t WS_SRK = WS_SRQ + al256(8 * 1024 * 4);
constexpr size_t WS_SRV = WS_SRK + al256(8 * 1024 * 4);
constexpr size_t WS_SRG = WS_SRV + al256(8 * 2048 * 4);
constexpr size_t WS_SAQ = WS_SRG + al256(8 * 2048 * 4);
constexpr size_t WS_SAK = WS_SAQ + al256(8 * 2048 * 4);
constexpr size_t WS_SAV = WS_SAK + al256(8 * 512 * 4);
constexpr size_t WS_SIQ = WS_SAV + al256(8 * 512 * 4);
constexpr size_t WS_SIK = WS_SIQ + al256(8 * 2048 * 4);
constexpr size_t WS_SIW = WS_SIK + al256(8 * 128 * 4);
constexpr size_t WS_SGR = WS_SIW + al256(8 * 16 * 4);
constexpr size_t WS_SGA = WS_SGR + al256(8 * 2048 * 4);
constexpr size_t WS_SSC = WS_SGA + al256(8 * 2048 * 4);
constexpr size_t WS_STOP = WS_SSC + al256((size_t)8 * SSCS * 4);
constexpr size_t WS_SRN = WS_STOP + al256(8 * 256 * 4);
constexpr size_t WS_SATT = WS_SRN + al256(8 * 2048 * 4);
constexpr size_t WS_SMIX = WS_SATT + al256(8 * 2048 * 4);
constexpr size_t WS_SHN = WS_SMIX + al256(8 * 2048 * 4);
constexpr size_t WS_SPQ = WS_SHN + al256(8 * 2048 * 4);
constexpr size_t WS_K1H = WS_SPQ + al256(8 * 1024 * 4);
constexpr size_t WS_K2H = WS_K1H + al256(8 * 128 * 64 * 2);
constexpr size_t WS_ROUTE = WS_K2H + al256(8 * 128 * 64 * 2);
constexpr size_t WS_AQ8 = WS_ROUTE + al256((size_t)TP * 128 * 8);
constexpr size_t WS_AK8 = WS_AQ8 + al256((size_t)TP * 2048);
constexpr size_t WS_END = WS_AK8 + al256((size_t)TP * 512);
__device__ __forceinline__ Params make_params(const KArgs& a) {
    Params p;
    p.x_prompt = (const float*)a.in[0]; p.x_sample = (const float*)a.in[1]; p.cache_k = (const float*)a.in[2]; p.cache_v = (const float*)a.in[3];
    p.cache_kidx = (const float*)a.in[4]; p.state_ret = (const float*)a.in[5]; p.page_table = (const int*)a.in[6];
    p.norm1_w = (const float*)a.in[7]; p.w_in = (const float*)a.in[8]; p.q_norm_w = (const float*)a.in[9]; p.k_norm_w = (const float*)a.in[10];
    p.ret_gn_w = (const float*)a.in[11]; p.w_ret_o = (const float*)a.in[12]; p.w_att_o = (const float*)a.in[13]; p.w_out = (const float*)a.in[14];
    p.norm2_w = (const float*)a.in[15]; p.peer_wq = (const float*)a.in[16]; p.peer_k1 = (const float*)a.in[17]; p.peer_k2 = (const float*)a.in[18];
    p.peer_u = (const float*)a.in[19]; p.peer_v = (const float*)a.in[20];
    p.out = a.out;
    char* w = a.ws;
    p.ctl = (unsigned*)(w + WS_CTL); p.ROWSS = (float*)(w + WS_CTL + 32768);
    p.XN = (h16*)(w + WS_XN); p.WinT = (h16*)(w + WS_WINT); p.WrT = (h16*)(w + WS_WRT); p.WaT = (h16*)(w + WS_WAT); p.WoT = (h16*)(w + WS_WOT); p.WqT = (h16*)(w + WS_WQT);
    p.PU = (h16*)(w + WS_PU); p.PV = (h16*)(w + WS_PV); p.K1H = (h16*)(w + WS_K1H); p.K2H = (h16*)(w + WS_K2H); p.ROUTE = (int2*)(w + WS_ROUTE); p.AQ8 = (unsigned char*)(w + WS_AQ8); p.AK8 = (unsigned char*)(w + WS_AK8);
    p.RQ = (h16*)(w + WS_RQ); p.RK = (h16*)(w + WS_RK); p.RV = (h16*)(w + WS_RV); p.RG = (h16*)(w + WS_RG);
    p.AQ = (h16*)(w + WS_AQ); p.AK = (h16*)(w + WS_AK); p.AV = (h16*)(w + WS_AV); p.IQ = (h16*)(w + WS_IQ); p.IK = (h16*)(w + WS_IK);
    p.GR = (h16*)(w + WS_GR); p.GA = (h16*)(w + WS_GA); p.IW = (float*)(w + WS_IW);
    p.KV = (float*)(w + WS_KV); p.SPT = (h16*)(w + WS_SPT); p.TOPI = (int*)(w + WS_TOPI);
    p.RN = (h16*)(w + WS_RN); p.ATT = (h16*)(w + WS_ATT); p.MIX = (h16*)(w + WS_MIX); p.HN = (h16*)(w + WS_HN);
    p.MIXF = (float*)(w + WS_MIXF); p.PQ = (float*)(w + WS_PQ); p.ROPE = (float2*)(w + WS_ROPE);
    p.XNS = (float*)(w + WS_XNS); p.ZS = (float*)(w + WS_ZS);
    p.SRQ = (float*)(w + WS_SRQ); p.SRK = (float*)(w + WS_SRK); p.SRV = (float*)(w + WS_SRV); p.SRG = (float*)(w + WS_SRG);
    p.SAQ = (float*)(w + WS_SAQ); p.SAK = (float*)(w + WS_SAK); p.SAV = (float*)(w + WS_SAV);
    p.SIQ = (float*)(w + WS_SIQ); p.SIK = (float*)(w + WS_SIK); p.SIW = (float*)(w + WS_SIW);
    p.SGR = (float*)(w + WS_SGR); p.SGA = (float*)(w + WS_SGA); p.SSC = (float*)(w + WS_SSC); p.STOP = (int*)(w + WS_STOP);
    p.SRN = (float*)(w + WS_SRN); p.SATT = (float*)(w + WS_SATT); p.SMIX = (float*)(w + WS_SMIX); p.SHN = (float*)(w + WS_SHN); p.SPQ = (float*)(w + WS_SPQ);
    return p;
}

__device__ __forceinline__ float wave_sum(float v) {
#pragma unroll
    for (int o = 32; o > 0; o >>= 1) v += __shfl_xor(v, o);
    return v;
}
__device__ __forceinline__ float wave_max(float v) {
#pragma unroll
    for (int o = 32; o > 0; o >>= 1) v = fmaxf(v, __shfl_xor(v, o));
    return v;
}
__device__ __forceinline__ int otid() { int t = threadIdx.x; asm volatile("" : "+v"(t)); return t; }
__device__ __forceinline__ unsigned f2ord(float f) { unsigned b = __float_as_uint(f); return b ^ ((unsigned)((int)b >> 31) | 0x80000000u); }
__device__ __forceinline__ unsigned pkh(float lo, float hi) { h16x2 v; v.x = (h16)lo; v.y = (h16)hi; return __builtin_bit_cast(unsigned, v); }
__device__ __forceinline__ u32x4 pk8(const float* v) { u32x4 r; r.x = pkh(v[0], v[1]); r.y = pkh(v[2], v[3]); r.z = pkh(v[4], v[5]); r.w = pkh(v[6], v[7]); return r; }
__device__ __forceinline__ void unpk8(u32x4 r, float* v) {
    const unsigned rx = r.x, ry = r.y, rz = r.z, rw = r.w;
    h16x2 a = __builtin_bit_cast(h16x2, rx), b = __builtin_bit_cast(h16x2, ry), c = __builtin_bit_cast(h16x2, rz), d = __builtin_bit_cast(h16x2, rw);
    v[0] = (float)a.x; v[1] = (float)a.y; v[2] = (float)b.x; v[3] = (float)b.y; v[4] = (float)c.x; v[5] = (float)c.y; v[6] = (float)d.x; v[7] = (float)d.y;
}
__device__ __forceinline__ float sigmoidf_(float x) { return __builtin_amdgcn_rcpf(1.f + __expf(-x)); }
__device__ __forceinline__ float siluf_(float x) { return x * __builtin_amdgcn_rcpf(1.f + __expf(-x)); }
__device__ __forceinline__ float gelu_exact(float x) { return 0.5f * x * (1.f + erff(x * 0.70710678118654752f)); }
__device__ __forceinline__ float ret_log_g(int h) { return logf(1.f - exp2f(-5.f - (float)h)); }

__device__ __forceinline__ unsigned off_b(unsigned row, unsigned ch) { return 256u * row + 16u * (ch ^ (((row & 3) << 2) | ((row >> 2) & 3))); }
__device__ __forceinline__ unsigned tr_addr16(unsigned lane, unsigned c, unsigned t) {
    const unsigned g = lane >> 4, q = (lane & 15) >> 2, p = lane & 3;
    return off_b(8 * g + 4 * t + q, 2 * c + (p >> 1)) + 8 * (p & 1);
}
template <int IMM>
__device__ __forceinline__ h16x8 tr_read8o(unsigned a0, unsigned a1) {
    h16x4 r0, r1;
    asm volatile("ds_read_b64_tr_b16 %0, %2 offset:%4\n\tds_read_b64_tr_b16 %1, %3 offset:%4\n\ts_waitcnt lgkmcnt(0)" : "=&v"(r0), "=&v"(r1) : "v"(a0), "v"(a1), "n"(IMM) : "memory");
    h16x8 r; r[0] = r0[0]; r[1] = r0[1]; r[2] = r0[2]; r[3] = r0[3]; r[4] = r1[0]; r[5] = r1[1]; r[6] = r1[2]; r[7] = r1[3];
    return r;
}
__device__ __forceinline__ void tr_read8x4(unsigned z0, unsigned z1, unsigned c0, h16x8 (&out)[4]) {
    h16x4 r[8];
    const unsigned a0 = z0 ^ (32u * c0), a1 = z1 ^ (32u * c0), a2 = z0 ^ (32u * (c0 + 1)), a3 = z1 ^ (32u * (c0 + 1));
    const unsigned a4 = z0 ^ (32u * (c0 + 2)), a5 = z1 ^ (32u * (c0 + 2)), a6 = z0 ^ (32u * (c0 + 3)), a7 = z1 ^ (32u * (c0 + 3));
    asm volatile("ds_read_b64_tr_b16 %0, %8\n\tds_read_b64_tr_b16 %1, %9\n\tds_read_b64_tr_b16 %2, %10\n\tds_read_b64_tr_b16 %3, %11\n\t"
                 "ds_read_b64_tr_b16 %4, %12\n\tds_read_b64_tr_b16 %5, %13\n\tds_read_b64_tr_b16 %6, %14\n\tds_read_b64_tr_b16 %7, %15\n\ts_waitcnt lgkmcnt(0)"
                 : "=&v"(r[0]), "=&v"(r[1]), "=&v"(r[2]), "=&v"(r[3]), "=&v"(r[4]), "=&v"(r[5]), "=&v"(r[6]), "=&v"(r[7])
                 : "v"(a0), "v"(a1), "v"(a2), "v"(a3), "v"(a4), "v"(a5), "v"(a6), "v"(a7) : "memory");
#pragma unroll
    for (int i = 0; i < 4; ++i) { h16x8 v; v[0] = r[2 * i][0]; v[1] = r[2 * i][1]; v[2] = r[2 * i][2]; v[3] = r[2 * i][3]; v[4] = r[2 * i + 1][0]; v[5] = r[2 * i + 1][1]; v[6] = r[2 * i + 1][2]; v[7] = r[2 * i + 1][3]; out[i] = v; }
}
template <int I, int N, class F>
__device__ __forceinline__ void static_for(F&& f) { if constexpr (I < N) { f(std::integral_constant<int, I>{}); static_for<I + 1, N>(f); } }
__device__ __forceinline__ unsigned lds_u32(const void* p) { return (unsigned)(size_t)(const LAS char*)p; }

__device__ __forceinline__ int wave_sum_small(unsigned cnt) {
    int c = 0;
#pragma unroll
    for (int b = 0; b < 7; ++b) c += __popcll(__ballot((cnt >> b) & 1u)) << b;
    return c;
}
template <int NV>
__device__ __forceinline__ void wave_kth_r4(const unsigned (&u)[NV], int K, unsigned& tau, int& need_eq) {
    tau = 0u; bool exact = false;
    for (int bit = 30; bit >= 0; bit -= 2) {
        const unsigned c1 = tau | (1u << bit), c2 = tau | (2u << bit), c3 = tau | (3u << bit);
        int n1 = 0, n2 = 0, n3 = 0;
#pragma unroll
        for (int i = 0; i < NV; ++i) { n1 += __popcll(__ballot(u[i] >= c1)); n2 += __popcll(__ballot(u[i] >= c2)); n3 += __popcll(__ballot(u[i] >= c3)); }
        int n = -1;
        if (n3 >= K) { tau = c3; n = n3; } else if (n2 >= K) { tau = c2; n = n2; } else if (n1 >= K) { tau = c1; n = n1; }
        if (n == K) { exact = true; break; }
    }
    int cg = 0;
    if (!exact && tau != 0xFFFFFFFFu) {
#pragma unroll
        for (int i = 0; i < NV; ++i) cg += __popcll(__ballot(u[i] > tau));
    }
    need_eq = exact ? K : K - cg;
}
template <int NV>
__device__ __forceinline__ void wave_kth(const unsigned (&u)[NV], int K, unsigned& tau, int& need_eq) {
    tau = 0u; int cg = 0; bool exact = false;
    for (int bit = 31; bit >= -1; --bit) {
        const unsigned cand = (bit >= 0) ? (tau | (1u << bit)) : tau + 1u;
        int c = 0;
        if constexpr (NV >= 8) {
            unsigned cnt = 0u;
#pragma unroll
            for (int i = 0; i < NV; ++i) cnt += (u[i] >= cand) ? 1u : 0u;
            c = wave_sum_small(cnt);
        } else {
#pragma unroll
            for (int i = 0; i < NV; ++i) c += __popcll(__ballot(u[i] >= cand));
        }
        if (bit >= 0) { if (c >= K) tau = cand; if (c == K) { exact = true; break; } } else cg = (tau == 0xFFFFFFFFu) ? 0 : c;
    }
    need_eq = exact ? K : K - cg;
}

template <bool WIN>
__device__ __forceinline__ void p0_transpose_item(const float* W, int K, int N, h16* WT, float* scr, int item, int nblk, int lane, const float* kscale = nullptr) {
    const int kb = item / nblk, nb = item % nblk, k0 = 64 * kb, n0 = 32 * nb;
    float tv[32];
#pragma unroll
    for (int i = 0; i < 32; ++i) { const int kk = 2 * i + (lane >> 5), n = n0 + (lane & 31); tv[i] = (n < N) ? W[(size_t)(k0 + kk) * N + n] : 0.f; }
#pragma unroll
    for (int i = 0; i < 32; ++i) { const int kk = 2 * i + (lane >> 5); scr[kk * 33 + (lane & 31)] = tv[i]; }
    asm volatile("s_waitcnt lgkmcnt(0)" ::: "memory");
    const int c = lane & 7;
#pragma unroll
    for (int j = 0; j < 4; ++j) {
        const int nl = (lane >> 3) + 8 * j, n = n0 + nl;
        const float* s = scr + (8 * c) * 33 + nl;
        float v[8];
#pragma unroll
        for (int e = 0; e < 8; ++e) v[e] = s[e * 33];
        if (kscale) {
#pragma unroll
            for (int e = 0; e < 8; ++e) v[e] *= kscale[k0 + 8 * c + e];
        }
        int dst = n;
        if (WIN) { if (n >= C_GR) dst = n - 16; else if (n >= C_IW) dst = 15488 + (n - C_IW); }
        if (n < N) *(u32x4*)(WT + (size_t)dst * K + k0 + 8 * c) = pk8(v);
    }
    asm volatile("s_waitcnt lgkmcnt(0)" ::: "memory");
}

__device__ __forceinline__ void phase0(const Params& p, char* smem) {
    const int tid = otid(), lane = tid & 63, wave = tid >> 6;
    const int gw = blockIdx.x * 8 + wave, NGW = gridDim.x * 8;
    const int gt = blockIdx.x * 512 + tid, NGT = gridDim.x * 512;
    for (int r = gw; r < TT; r += NGW) {
        const float* x = (r < TP) ? p.x_prompt + (size_t)r * D : p.x_sample + (size_t)(r - TP) * D;
        f32x4 v[8]; float ss = 0.f;
#pragma unroll
        for (int j = 0; j < 8; ++j) { v[j] = *(const f32x4*)(x + 4 * (lane + 64 * j)); ss += v[j].x * v[j].x + v[j].y * v[j].y + v[j].z * v[j].z + v[j].w * v[j].w; }
        ss = wave_sum(ss);
        const float rs = rsqrtf(ss * (1.f / D) + EPS);
#pragma unroll
        for (int j = 0; j < 8; ++j) {
            const f32x4 w = *(const f32x4*)(p.norm1_w + 4 * (lane + 64 * j));
            const float a = v[j].x * rs * w.x, b = v[j].y * rs * w.y, c = v[j].z * rs * w.z, d = v[j].w * rs * w.w;
            if (r < TP) { f32x2 o; o.x = __uint_as_float(pkh(a, b)); o.y = __uint_as_float(pkh(c, d)); *(f32x2*)(p.XN + (size_t)r * D + 4 * (lane + 64 * j)) = o; }
            else { f32x4 o = {a, b, c, d}; *(f32x4*)(p.XNS + (size_t)(r - TP) * D + 4 * (lane + 64 * j)) = o; }
        }
    }
    {
        float* scr = (float*)smem + wave * (64 * 33);
        constexpr int NB_IN = (NW0 + 31) / 32;
        constexpr int I_IN = 32 * NB_IN;
        for (int it = gw; it < I_IN; it += NGW) p0_transpose_item<true>(p.w_in, D, NW0, p.WinT, scr, it, NB_IN, lane);
    }
    for (int i = gt; i < (NWP - NW0) * D / 8; i += NGT) { u32x4 z = {0u, 0u, 0u, 0u}; *(u32x4*)(p.WinT + (size_t)NW0 * D + (size_t)i * 8) = z; }
    for (int i = gt; i < 2 * 8 * 128 * 64 / 8; i += NGT) {
        const int half = 8 * 128 * 64 / 8;
        const float* src = (i < half) ? p.peer_k1 + (size_t)i * 8 : p.peer_k2 + (size_t)(i - half) * 8;
        h16* dst = (i < half) ? p.K1H + (size_t)i * 8 : p.K2H + (size_t)(i - half) * 8;
        const f32x4 a = *(const f32x4*)src, b = *(const f32x4*)(src + 4);
        u32x4 o; o.x = pkh(a.x, a.y); o.y = pkh(a.z, a.w); o.z = pkh(b.x, b.y); o.w = pkh(b.z, b.w);
        *(u32x4*)dst = o;
    }
    for (int i = gt; i < 4097 * 64; i += NGT) {
        const int pi = i >> 6, fi = i & 63;
        const double pos = (pi == 4096) ? 16384.0 : (double)pi;
        double fq = 1.0;
        if (fi & 1) fq *= 0.86596432336006535; if (fi & 2) fq *= 0.74989420933245583; if (fi & 4) fq *= 0.56234132519034908;
        if (fi & 8) fq *= 0.31622776601683794; if (fi & 16) fq *= 0.1; if (fi & 32) fq *= 0.01;
        const double rev = pos * fq * 0.15915494309189533577;
        const double fr = rev - __builtin_rint(rev);
        float2 cs; cs.x = __builtin_amdgcn_cosf((float)fr); cs.y = __builtin_amdgcn_sinf((float)fr);
        p.ROPE[i] = cs;
    }
}

constexpr int G_BK = 64, G_HALF = 128, G_HT = G_HALF * G_BK;
__device__ __forceinline__ int g_lds_byte(int r, int c) {
    int st = (r >> 4) * 2 + (c >> 5), rr = r & 15, cc = c & 31, ob = rr * 64 + cc * 2;
    return st * 1024 + (ob ^ (((ob >> 9) & 1) << 5));
}
__device__ __forceinline__ void g_stage_rc(int b, int& R, int& C) {
    int st = b / 1024, sb = b % 1024, swz = sb ^ (((sb >> 9) & 1) << 5);
    R = (st >> 1) * 16 + swz / 64; C = (st & 1) * 32 + (swz % 64) / 2;
}

__device__ __forceinline__ void gemm_core(const h16* A, const h16* Bt, const int brow, const int bcol, const int K, f32x4 (&acc)[2][2][4][2], h16* shm) {
  #define SA(b,h) (shm+((b)*2+(h))*G_HT)
  #define SB(b,h) (shm+(4+(b)*2+(h))*G_HT)
  #define STAGE_X(T,P,BASE,br,kt) do{const char* _ub=(const char*)(BASE)+((long)(br)*K+(long)(kt)*G_BK)*2; \
    for(int _i=0;_i<2;++_i){int _b=(T)*16+_i*8192;int _r,_c;g_stage_rc(_b,_r,_c); \
      const unsigned _vo=(unsigned)((_r*K+_c)*2); \
      __builtin_amdgcn_global_load_lds((const unsigned*)(_ub+_vo), \
        (unsigned*)((char*)(P)+_b),16,0,0);}}while(0)
  #define STAGE(P,BASE,br,kt) STAGE_X(t0,P,BASE,br,kt)
  #define LDA(dst,b,h) for(int m=0;m<4;++m)for(int k=0;k<2;++k) \
    dst[m][k]=*reinterpret_cast<const h16x8*>((char*)SA(b,h)+g_lds_byte(wr*64+m*16+fr,k*32+fq*8))
  #define LDB(dst,b,h) for(int n=0;n<2;++n)for(int k=0;k<2;++k) \
    dst[n][k]=*reinterpret_cast<const h16x8*>((char*)SB(b,h)+g_lds_byte(wc*32+n*16+fr,k*32+fq*8))
  #define MMA(ai,bj,At,Bx) do{__builtin_amdgcn_s_setprio(1); \
    for(int m=0;m<4;++m)for(int n=0;n<2;++n)for(int k=0;k<2;++k) \
      acc[ai][bj][m][n]=__builtin_amdgcn_mfma_f32_16x16x32_f16(Bx[n][k],At[m][k],acc[ai][bj][m][n],0,0,0); \
    __builtin_amdgcn_s_setprio(0);}while(0)
  #define WAIT_V(n) asm volatile("s_waitcnt vmcnt(" #n ")":::"memory")
  #define WAIT_L(n) asm volatile("s_waitcnt lgkmcnt(" #n ")":::"memory")
  #define BAR __builtin_amdgcn_s_barrier()
  #define SCHED __builtin_amdgcn_sched_barrier(0)
  const int t0=otid();
  int wid=t0>>6,lane=t0&63,wr=wid>>2,wc=wid&3,fr=lane&15,fq=lane>>4;
  h16x8 At[4][2],B0[2][2],B1[2][2];
  const int nt=K/G_BK;
  STAGE(SB(0,0),Bt,bcol,0); STAGE(SA(0,0),A,brow,0);
  STAGE(SB(0,1),Bt,bcol+G_HALF,0); STAGE(SA(0,1),A,brow+G_HALF,0);
  if(wr==1)BAR;
  WAIT_V(4); BAR;
  STAGE(SB(1,0),Bt,bcol,1); STAGE(SA(1,0),A,brow,1); STAGE(SB(1,1),Bt,bcol+G_HALF,1);
  WAIT_V(6); BAR;
  for(int t=0;t<nt-2;t+=2){
    LDB(B0,0,0); SCHED; LDA(At,0,0); STAGE(SA(1,1),A,brow+G_HALF,t+1);
    WAIT_L(8); BAR; WAIT_L(0); MMA(0,0,At,B0); BAR; SCHED;
    LDB(B1,0,1); STAGE(SB(0,0),Bt,bcol,t+2);
    BAR; WAIT_L(0); MMA(0,1,At,B1); BAR;
    LDA(At,0,1); STAGE(SA(0,0),A,brow,t+2);
    BAR; WAIT_L(0); MMA(1,0,At,B0); BAR; SCHED;
    STAGE(SB(0,1),Bt,bcol+G_HALF,t+2);
    WAIT_V(6); BAR; MMA(1,1,At,B1); BAR;
    LDB(B0,1,0); SCHED; LDA(At,1,0); STAGE(SA(0,1),A,brow+G_HALF,t+2);
    WAIT_L(8); BAR; WAIT_L(0); MMA(0,0,At,B0); BAR; SCHED;
    LDB(B1,1,1); STAGE(SB(1,0),Bt,bcol,t+3);
    BAR; WAIT_L(0); MMA(0,1,At,B1); BAR;
    LDA(At,1,1); STAGE(SA(1,0),A,brow,t+3);
    BAR; WAIT_L(0); MMA(1,0,At,B0); BAR; SCHED;
    STAGE(SB(1,1),Bt,bcol+G_HALF,t+3);
    WAIT_V(6); BAR; MMA(1,1,At,B1); BAR;
  }
  int tz=otid(); wid=tz>>6; lane=tz&63; wr=wid>>2; wc=wid&3; fr=lane&15; fq=lane>>4;
  { LDB(B0,0,0); WAIT_V(0); LDA(At,0,0); STAGE_X(tz,SA(1,1),A,brow+G_HALF,nt-1);
    BAR; WAIT_L(0); MMA(0,0,At,B0); BAR;
    LDB(B1,0,1); BAR; WAIT_L(0); MMA(0,1,At,B1); BAR;
    LDA(At,0,1); WAIT_V(4); BAR; WAIT_L(0); MMA(1,0,At,B0); MMA(1,1,At,B1); BAR; }
  { LDB(B0,1,0); LDA(At,1,0); WAIT_V(2); BAR; WAIT_L(0); MMA(0,0,At,B0); BAR;
    LDB(B1,1,1); WAIT_V(0); BAR; WAIT_L(0); MMA(0,1,At,B1); BAR;
    LDA(At,1,1); BAR; WAIT_L(0); MMA(1,0,At,B0); MMA(1,1,At,B1); BAR; }
  if(wr==0)BAR;
  #undef SA
  #undef SB
  #undef STAGE_X
  #undef STAGE
  #undef LDA
  #undef LDB
  #undef MMA
}

__device__ __forceinline__ bool unit_next(int i, int nM, int nN, int& pm, int& pn) {
    const int nwg = nM * nN; const long L = (long)i * gridDim.x + blockIdx.x; if (L >= nwg) return false;
    int wgid = (int)L; { const int q = nwg / 8, r = nwg % 8, xcd = wgid % 8, off = wgid / 8; wgid = (xcd < r ? xcd * (q + 1) : r * (q + 1) + (xcd - r) * q) + off; }
    const int nig = 8 * nN, gid = wgid / nig, fm = gid * 8, gsz = (nM - fm) < 8 ? (nM - fm) : 8;
    pm = fm + ((wgid % nig) % gsz); pn = (wgid % nig) / gsz; return true;
}

constexpr int ES = 132;
__device__ __forceinline__ void stage_quadrant(const f32x4 (&acc)[2][2][4][2], int ai, int bj, float* E, int tz) {
    const int wid = tz >> 6, lane = tz & 63, wr = wid >> 2, wc = wid & 3, fr = lane & 15, fq = lane >> 4;
#pragma unroll
    for (int m = 0; m < 4; ++m)
#pragma unroll
        for (int n = 0; n < 2; ++n) *(f32x4*)(E + (wr * 64 + m * 16 + fr) * ES + wc * 32 + n * 16 + fq * 4) = acc[ai][bj][m][n];
}
__device__ __forceinline__ void read_rowpart(const float* E, int r, int part, float* x1, float* x2) {
#pragma unroll
    for (int q = 0; q < 4; ++q) {
        const f32x4 a = *(const f32x4*)(E + r * ES + 16 * part + 4 * q), b = *(const f32x4*)(E + r * ES + 64 + 16 * part + 4 * q);
        x1[4 * q] = a.x; x1[4 * q + 1] = a.y; x1[4 * q + 2] = a.z; x1[4 * q + 3] = a.w;
        x2[4 * q] = b.x; x2[4 * q + 1] = b.y; x2[4 * q + 2] = b.z; x2[4 * q + 3] = b.w;
    }
}

constexpr int ES16 = 264;
__device__ __forceinline__ void stage_full16(const f32x4 (&acc)[2][2][4][2], h16* E16, int tz) {
    const int wid = tz >> 6, lane = tz & 63, wr = wid >> 2, wc = wid & 3, fr = lane & 15, fq = lane >> 4;
#pragma unroll
    for (int ai = 0; ai < 2; ++ai)
#pragma unroll
        for (int bj = 0; bj < 2; ++bj)
#pragma unroll
            for (int m = 0; m < 4; ++m)
#pragma unroll
                for (int n = 0; n < 2; ++n) {
                    const f32x4 a = acc[ai][bj][m][n];
                    f32x2 o; o.x = __uint_as_float(pkh(a.x, a.y)); o.y = __uint_as_float(pkh(a.z, a.w));
                    *(f32x2*)(E16 + (ai * 128 + wr * 64 + m * 16 + fr) * ES16 + bj * 128 + wc * 32 + n * 16 + fq * 4) = o;
                }
}
__device__ __forceinline__ void read_rowpart16(const h16* E16, int row, int bj, int part, float* x1, float* x2) {
    const h16* b = E16 + row * ES16 + bj * 128 + 16 * part;
    unpk8(*(const u32x4*)b, x1); unpk8(*(const u32x4*)(b + 8), x1 + 8);
    unpk8(*(const u32x4*)(b + 64), x2); unpk8(*(const u32x4*)(b + 72), x2 + 8);
}
template <class BODY>
__device__ __forceinline__ void epilogue_full(const f32x4 (&acc)[2][2][4][2], char* smem, BODY body) {
    h16* E16 = (h16*)smem;
    const int tz = otid();
    __syncthreads();
    stage_full16(acc, E16, tz);
    __syncthreads();
    const int r = tz >> 2, part = tz & 3;
#pragma unroll 1
    for (int q = 0; q < 4; ++q) {
        float x1[16], x2[16];
        read_rowpart16(E16, (q >> 1) * 128 + r, q & 1, part, x1, x2);
        body(q >> 1, q & 1, r, part, x1, x2);
    }
    __syncthreads();
}
__device__ __forceinline__ void rope32(float* x1, float* x2, const float2* rp, int part) {
#pragma unroll
    for (int i = 0; i < 16; ++i) { const float2 cs = rp[16 * part + i]; const float a = x1[i], b = x2[i]; x1[i] = a * cs.x - b * cs.y; x2[i] = b * cs.x + a * cs.y; }
}
struct RopeRegs { f32x4 v[8]; };
__device__ __forceinline__ void rope_load(RopeRegs& rr, const float2* rp, int part) {
#pragma unroll
    for (int k = 0; k < 8; ++k) rr.v[k] = *(const f32x4*)(rp + 16 * part + 2 * k);
}
__device__ __forceinline__ void rope32r(float* x1, float* x2, const RopeRegs& rr) {
#pragma unroll
    for (int k = 0; k < 8; ++k) {
        { const float c = rr.v[k].x, s = rr.v[k].y, a = x1[2 * k], b = x2[2 * k]; x1[2 * k] = a * c - b * s; x2[2 * k] = b * c + a * s; }
        { const float c = rr.v[k].z, s = rr.v[k].w, a = x1[2 * k + 1], b = x2[2 * k + 1]; x1[2 * k + 1] = a * c - b * s; x2[2 * k + 1] = b * c + a * s; }
    }
}
template <class BUF, class LD, class PR>
__device__ __forceinline__ void epilogue_pipe(const f32x4 (&acc)[2][2][4][2], float* E, int tz, LD ld, PR pr) {
    BUF b0, b1;
    const int r = tz >> 2, part = tz & 3;
    float x1[16], x2[16];
    ld(0, 0, r, part, b0);
    __syncthreads(); stage_quadrant(acc, 0, 0, E, tz); __syncthreads(); read_rowpart(E, r, part, x1, x2); ld(0, 1, r, part, b1); pr(0, 0, r, part, b0, x1, x2);
    __syncthreads(); stage_quadrant(acc, 0, 1, E, tz); __syncthreads(); read_rowpart(E, r, part, x1, x2); ld(1, 0, r, part, b0); pr(0, 1, r, part, b1, x1, x2);
    __syncthreads(); stage_quadrant(acc, 1, 0, E, tz); __syncthreads(); read_rowpart(E, r, part, x1, x2); ld(1, 1, r, part, b1); pr(1, 0, r, part, b0, x1, x2);
    __syncthreads(); stage_quadrant(acc, 1, 1, E, tz); __syncthreads(); read_rowpart(E, r, part, x1, x2); pr(1, 1, r, part, b1, x1, x2);
}
__device__ __forceinline__ void store_h16_32(h16* dst, int part, const float* x1, const float* x2) {
    *(u32x4*)(dst + 16 * part) = pk8(x1); *(u32x4*)(dst + 16 * part + 8) = pk8(x1 + 8);
    *(u32x4*)(dst + 64 + 16 * part) = pk8(x2); *(u32x4*)(dst + 64 + 16 * part + 8) = pk8(x2 + 8);
}
__device__ __forceinline__ void store_fp8_32(unsigned char* dst, int part, const float* x1, const float* x2, float sc) {
    u32x4 a, b;
#pragma unroll
    for (int q = 0; q < 4; ++q) {
        int w = __builtin_amdgcn_cvt_pk_fp8_f32(x1[4 * q] * sc, x1[4 * q + 1] * sc, 0, false);
        w = __builtin_amdgcn_cvt_pk_fp8_f32(x1[4 * q + 2] * sc, x1[4 * q + 3] * sc, w, true); a[q] = (unsigned)w;
        int v = __builtin_amdgcn_cvt_pk_fp8_f32(x2[4 * q] * sc, x2[4 * q + 1] * sc, 0, false);
        v = __builtin_amdgcn_cvt_pk_fp8_f32(x2[4 * q + 2] * sc, x2[4 * q + 3] * sc, v, true); b[q] = (unsigned)v;
    }
    *(u32x4*)(dst + 16 * part) = a; *(u32x4*)(dst + 64 + 16 * part) = b;
}
__device__ __forceinline__ void store_f32_32(float* dst, int part, const float* x1, const float* x2) {
#pragma unroll
    for (int q = 0; q < 4; ++q) {
        f32x4 a = {x1[4 * q], x1[4 * q + 1], x1[4 * q + 2], x1[4 * q + 3]}, b = {x2[4 * q], x2[4 * q + 1], x2[4 * q + 2], x2[4 * q + 3]};
        *(f32x4*)(dst + 16 * part + 4 * q) = a; *(f32x4*)(dst + 64 + 16 * part + 4 * q) = b;
    }
}
__device__ __forceinline__ float quad_sum(float v) { v += __shfl_xor(v, 1); v += __shfl_xor(v, 2); return v; }

__device__ __forceinline__ void inproj_block(const Params& p, int cb, int tok, int part, float* x1, float* x2, const RopeRegs& rr) {
    if (cb < 8) {
        rope32r(x1, x2, rr); store_h16_32(p.RQ + (size_t)tok * 1024 + cb * 128, part, x1, x2);
    } else if (cb < 16) {
        rope32r(x1, x2, rr);
#pragma unroll
        for (int i = 0; i < 16; ++i) { x1[i] *= 0.08838834764831845f; x2[i] *= 0.08838834764831845f; }
        store_h16_32(p.RK + (size_t)tok * 1024 + (cb - 8) * 128, part, x1, x2);
    } else if (cb < 32) {
        store_h16_32(p.RV + (size_t)tok * 2048 + (cb - 16) * 128, part, x1, x2);
    } else if (cb < 48) {
#pragma unroll
        for (int i = 0; i < 16; ++i) { x1[i] = siluf_(x1[i]); x2[i] = siluf_(x2[i]); }
        store_h16_32(p.RG + (size_t)tok * 2048 + (cb - 32) * 128, part, x1, x2);
    } else if (cb < 68) {
        const bool isq = cb < 64;
        float ss = 0.f;
#pragma unroll
        for (int i = 0; i < 16; ++i) ss += x1[i] * x1[i] + x2[i] * x2[i];
        ss = quad_sum(ss);
        const float rs = rsqrtf(ss * (1.f / 128.f) + EPS);
        const float* nw = isq ? p.q_norm_w : p.k_norm_w;
#pragma unroll
        for (int i = 0; i < 16; ++i) { x1[i] *= rs * nw[16 * part + i]; x2[i] *= rs * nw[64 + 16 * part + i]; }
        rope32r(x1, x2, rr);
        if (isq) {
#pragma unroll
            for (int i = 0; i < 16; ++i) { x1[i] *= 0.08838834764831845f; x2[i] *= 0.08838834764831845f; }
            store_fp8_32(p.AQ8 + (size_t)tok * 2048 + (cb - 48) * 128, part, x1, x2, 16.f);
        } else {
            store_fp8_32(p.AK8 + (size_t)tok * 512 + (cb - 64) * 128, part, x1, x2, 1.f);
            store_f32_32(p.out + O_KP + (size_t)tok * 512 + (cb - 64) * 128, part, x1, x2);
        }
    } else if (cb < 72) {
        store_h16_32(p.AV + (size_t)tok * 512 + (cb - 68) * 128, part, x1, x2);
        store_f32_32(p.out + O_VP + (size_t)tok * 512 + (cb - 68) * 128, part, x1, x2);
    } else if (cb < 88) {
        rope32r(x1, x2, rr);
#pragma unroll
        for (int i = 0; i < 16; ++i) { x1[i] *= 0.08838834764831845f; x2[i] *= 0.08838834764831845f; }
        store_h16_32(p.IQ + (size_t)tok * 2048 + (cb - 72) * 128, part, x1, x2);
    } else if (cb == 88) {
        rope32r(x1, x2, rr);
        store_h16_32(p.IK + (size_t)tok * 128, part, x1, x2);
        store_f32_32(p.out + O_IKP + (size_t)tok * 128, part, x1, x2);
    } else if (cb < 121) {
#pragma unroll
        for (int i = 0; i < 16; ++i) { x1[i] = sigmoidf_(x1[i]); x2[i] = sigmoidf_(x2[i]); }
        h16* dst = (cb < 105) ? p.GR + (size_t)tok * 2048 + (cb - 89) * 128 : p.GA + (size_t)tok * 2048 + (cb - 105) * 128;
        store_h16_32(dst, part, x1, x2);
    } else {
        if (part == 0) {
#pragma unroll
            for (int q = 0; q < 4; ++q) { f32x4 a = {x1[4 * q] * 0.25f, x1[4 * q + 1] * 0.25f, x1[4 * q + 2] * 0.25f, x1[4 * q + 3] * 0.25f}; *(f32x4*)(p.IW + (size_t)tok * 16 + 4 * q) = a; }
        }
    }
}

template <int CB, class F>
__device__ __forceinline__ void gemv8_item(const float* A, const float* W, int N, int n0, char* smem, F f, const float* normw = nullptr, float* shn_out = nullptr) {
    constexpr int C4 = CB / 4, KG = 512 / C4, NL = 2048 / KG, OUT = 8 * CB, P = 512 / OUT;
    const int tid = otid();
    float* AT = (float*)smem;
    float* red = AT + 2048 * 8;
    float* rs8 = (float*)(smem + 131072);
    __syncthreads();
    if (normw) {
        float ssl[8];
#pragma unroll
        for (int t = 0; t < 8; ++t) ssl[t] = 0.f;
#pragma unroll
        for (int j = 0; j < 32; ++j) { const int i = tid + 512 * j, t = i >> 11, k = i & 2047; const float a = A[i]; AT[k * 8 + t] = a * normw[k]; ssl[j >> 2] += a * a; }
#pragma unroll
        for (int t = 0; t < 8; ++t) { const float s = wave_sum(ssl[t]); if ((tid & 63) == 0) rs8[8 + (tid >> 6) * 8 + t] = s; }
        __syncthreads();
        if (tid < 8) { float s = 0.f; for (int w = 0; w < 8; ++w) s += rs8[8 + w * 8 + tid]; rs8[tid] = rsqrtf(s * (1.f / 2048.f) + EPS); }
        __syncthreads();
        if (shn_out) for (int i = tid; i < 8 * 2048; i += 512) { const int t = i >> 11, k = i & 2047; shn_out[i] = AT[k * 8 + t] * rs8[t]; }
    } else {
        float av32[32];
#pragma unroll
        for (int j = 0; j < 32; ++j) av32[j] = A[tid + 512 * j];
#pragma unroll
        for (int j = 0; j < 32; ++j) { const int i = tid + 512 * j, t = i >> 11, k = i & 2047; AT[k * 8 + t] = av32[j]; }
        __syncthreads();
    }
    const int c4 = tid % C4, kg = tid / C4, n = n0 + 4 * c4;
    const bool ok = (n + 3) < N;
    float acc[8][4];
#pragma unroll
    for (int t = 0; t < 8; ++t)
#pragma unroll
        for (int c = 0; c < 4; ++c) acc[t][c] = 0.f;
    const float* wp = W + (size_t)kg * N + (ok ? n : 0);
#pragma unroll 16
    for (int j = 0; j < NL; ++j) {
        const int k = kg + KG * j;
        f32x4 w = *(const f32x4*)(wp + (size_t)(KG * j) * N);
        if (!ok) w = (f32x4){0.f, 0.f, 0.f, 0.f};
        const f32x4 a0 = *(const f32x4*)(AT + k * 8), a1 = *(const f32x4*)(AT + k * 8 + 4);
        const float av[8] = {a0.x, a0.y, a0.z, a0.w, a1.x, a1.y, a1.z, a1.w};
#pragma unroll
        for (int t = 0; t < 8; ++t) { acc[t][0] += av[t] * w.x; acc[t][1] += av[t] * w.y; acc[t][2] += av[t] * w.z; acc[t][3] += av[t] * w.w; }
    }
#pragma unroll
    for (int t = 0; t < 8; ++t) { f32x4 v = {acc[t][0], acc[t][1], acc[t][2], acc[t][3]}; *(f32x4*)(red + (kg * 8 + t) * CB + 4 * c4) = v; }
    __syncthreads();
    {
        const int o = tid % OUT, part = tid / OUT, t = o / CB, col = o % CB;
        float s = 0.f;
#pragma unroll 8
        for (int q = 0; q < 32; ++q) s += red[((part * 32 + q) * 8 + t) * CB + col];
        if (P > 1) {
            AT[part * OUT + o] = s;
            __syncthreads();
            if (tid < OUT) {
                s = 0.f;
#pragma unroll
                for (int q = 0; q < P; ++q) s += AT[q * OUT + o];
            }
        }
        if (tid < OUT && (n0 + col) < N) f(t, n0 + col, normw ? s * rs8[t] : s);
    }
}

__device__ __forceinline__ void late_weight_transposes(const Params& p, char* smem, int first) {
    const int t0 = otid(), lane = t0 & 63, wave = t0 >> 6;
    const int G = gridDim.x, gw = ((int)blockIdx.x - first) * 8 + wave, NGW = (G - first) * 8;
    float* scr = (float*)smem + wave * (64 * 33);
    constexpr int I_SQ = 32 * 64, I_WQ = 32 * 32, NIT = 3 * I_SQ + I_WQ;
    __syncthreads();
    for (int it = gw; it < NIT; it += NGW) {
        int r = it;
        if (r < I_SQ) { p0_transpose_item<false>(p.w_ret_o, D, D, p.WrT, scr, r, 64, lane); continue; } r -= I_SQ;
        if (r < I_SQ) { p0_transpose_item<false>(p.w_att_o, D, D, p.WaT, scr, r, 64, lane); continue; } r -= I_SQ;
        if (r < I_SQ) { p0_transpose_item<false>(p.w_out, D, D, p.WoT, scr, r, 64, lane); continue; } r -= I_SQ;
        p0_transpose_item<false>(p.peer_wq, D, 1024, p.WqT, scr, r, 32, lane, p.norm2_w);
    }
    __syncthreads();
}

__device__ __forceinline__ void phase1(const Params& p, char* smem) {
    const int tid = otid();
    for (int i = 0;; ++i) {
        int pm, pn; if (!unit_next(i, TP / 256, NWP / 256, pm, pn)) break;
        f32x4 acc[2][2][4][2] = {};
        gemm_core(p.XN, p.WinT, pm * 256, pn * 256, D, acc, (h16*)smem);
        epilogue_full(acc, smem, [&](int ai, int bj, int r, int part, float* x1, float* x2) {
            RopeRegs rr;
            rope_load(rr, p.ROPE + (size_t)((pm * 256 + ai * 128 + r) & (SEQ - 1)) * 64, part);
            inproj_block(p, pn * 2 + bj, pm * 256 + ai * 128 + r, part, x1, x2, rr);
        });
    }
    {
        const int G = gridDim.x, first = (G > 160) ? 160 : 0, nw = G - first;
        if ((int)blockIdx.x >= first) {
            for (int it = blockIdx.x - first; it < (NW0 + 63) / 64; it += nw) {
                float* ZS = p.ZS;
                gemv8_item<64>(p.XNS, p.w_in, NW0, it * 64, smem, [=](int t, int n, float v) { ZS[(size_t)t * NW0 + n] = v; });
            }
            late_weight_transposes(p, smem, first);
        }
    }
}

__device__ __forceinline__ void indexer_item(const Params& p, int b, int g, char* smem) {
    const int tid = otid(), lane = tid & 63, wave = tid >> 6, r16 = lane & 15, kq = lane >> 4;
    float* SC = (float*)smem;
    const int t0 = 8 * g, nkeys = 8 * g + 8, ntile = (nkeys + 15) >> 4;
    const size_t tb = (size_t)b * SEQ;
    {
        h16x8 af[2][4][4];
        float* WL = (float*)(smem + 8 * SCS * 4);
        if (tid < 128) WL[tid] = p.IW[(tb + t0) * 16 + tid];
#pragma unroll
        for (int Qg = 0; Qg < 2; ++Qg)
#pragma unroll
            for (int hg = 0; hg < 4; ++hg) {
                const h16* qp = p.IQ + (tb + t0 + Qg * 4 + (r16 >> 2)) * 2048 + (hg * 4 + (r16 & 3)) * 128 + kq * 8;
#pragma unroll
                for (int kk = 0; kk < 4; ++kk) af[Qg][hg][kk] = *(const h16x8*)(qp + kk * 32);
            }
        __syncthreads();
        f32x4 wv[2][4];
#pragma unroll
        for (int Qg = 0; Qg < 2; ++Qg)
#pragma unroll
            for (int hg = 0; hg < 4; ++hg) wv[Qg][hg] = *(const f32x4*)(WL + (Qg * 4 + kq) * 16 + hg * 4);
        const h16* kbase = p.IK + (tb + r16) * 128 + kq * 8;
        const int last = ntile - 1;
        h16x8 b0[4], b1[4], b2[4];
#define IDX_LOAD(dst, tl) { const int _t = (tl) < last ? (tl) : last; const h16* _kp = kbase + (size_t)_t * 16 * 128; \
    asm volatile("global_load_dwordx4 %0, %4, off\n\tglobal_load_dwordx4 %1, %4, off offset:64\n\tglobal_load_dwordx4 %2, %4, off offset:128\n\tglobal_load_dwordx4 %3, %4, off offset:192" \
                 : "=&v"(dst[0]), "=&v"(dst[1]), "=&v"(dst[2]), "=&v"(dst[3]) : "v"(_kp) : "memory"); }
#define IDX_WAIT8(bfr) asm volatile("s_waitcnt vmcnt(8)" : "+v"(bfr[0]), "+v"(bfr[1]), "+v"(bfr[2]), "+v"(bfr[3]) :: "memory")
#define IDX_TILE(bfr, tl) { const int _t = (tl) < last ? (tl) : last; \
    _Pragma("unroll") for (int Qg = 0; Qg < 2; ++Qg) { float sc = 0.f; \
        _Pragma("unroll") for (int hg = 0; hg < 4; ++hg) { f32x4 a = {0.f, 0.f, 0.f, 0.f}; \
            _Pragma("unroll") for (int kk = 0; kk < 4; ++kk) a = __builtin_amdgcn_mfma_f32_16x16x32_f16(af[Qg][hg][kk], bfr[kk], a, 0, 0, 0); \
            sc += wv[Qg][hg].x * fmaxf(a.x, 0.f) + wv[Qg][hg].y * fmaxf(a.y, 0.f) + wv[Qg][hg].z * fmaxf(a.z, 0.f) + wv[Qg][hg].w * fmaxf(a.w, 0.f); } \
        SC[(Qg * 4 + kq) * SCS + _t * 16 + r16] = sc; } }
#pragma unroll
        for (int Qg = 0; Qg < 2; ++Qg)
#pragma unroll
            for (int hg = 0; hg < 4; ++hg) asm volatile("" : "+v"(af[Qg][hg][0]), "+v"(af[Qg][hg][1]), "+v"(af[Qg][hg][2]), "+v"(af[Qg][hg][3]));
#pragma unroll
        for (int Qg = 0; Qg < 2; ++Qg) asm volatile("" : "+v"(wv[Qg][0]), "+v"(wv[Qg][1]), "+v"(wv[Qg][2]), "+v"(wv[Qg][3]));
        IDX_LOAD(b0, wave) IDX_LOAD(b1, wave + 8) IDX_LOAD(b2, wave + 16)
        for (int tile = wave; tile < ntile; tile += 24) {
            IDX_WAIT8(b0); IDX_TILE(b0, tile) IDX_LOAD(b0, tile + 24)
            IDX_WAIT8(b1); IDX_TILE(b1, tile + 8) IDX_LOAD(b1, tile + 32)
            IDX_WAIT8(b2); IDX_TILE(b2, tile + 16) IDX_LOAD(b2, tile + 40)
        }
        asm volatile("s_waitcnt vmcnt(0)" ::: "memory");
#undef IDX_WAIT8
#undef IDX_LOAD
#undef IDX_TILE
    }
    __syncthreads();
    {
        const int t = t0 + wave, nvalid = t + 1;
        int* outp = p.TOPI + (tb + t) * 256;
        if (nvalid <= 256) {
#pragma unroll
            for (int i = 0; i < 4; ++i) { const int j = lane + 64 * i; outp[j] = (j < nvalid) ? j : -1; }
        } else {
            unsigned u[64];
#pragma unroll
            for (int i = 0; i < 64; ++i) { const int s = i * 64 + lane; const unsigned o = f2ord(SC[wave * SCS + s]); u[i] = (s <= t) ? o : 0u; }
            unsigned tau; int need_eq;
            wave_kth<64>(u, 256, tau, need_eq);
            const u64 lt = (1ull << lane) - 1ull;
            int base = 0, eqt = 0;
            unsigned tau2 = tau; asm volatile("" : "+v"(tau2));
#pragma unroll
            for (int i = 0; i < 64; ++i) {
                const bool gt = u[i] > tau2, eq = u[i] == tau2;
                const u64 meq = __ballot(eq);
                const bool sel = gt || (eq && (eqt + __popcll(meq & lt)) < need_eq);
                const u64 ms = __ballot(sel);
                if (sel) outp[base + __popcll(ms & lt)] = i * 64 + lane;
                base += __popcll(ms); eqt += __popcll(meq);
                if ((i & 3) == 3) __builtin_amdgcn_sched_barrier(0);
            }
        }
    }
    __syncthreads();
}

__device__ __forceinline__ void kv_item(const Params& p, int b, int h, int c, char* smem) {
    const int tid = otid(), lane = tid & 63, wave = tid >> 6;
    char* Kimg = smem;
    char* Vimg = smem + 32768;
    const size_t tok0 = (size_t)b * SEQ + c * 128;
    const float lg = ret_log_g(h);
#pragma unroll
    for (int i = 0; i < 4; ++i) {
        const int q = tid + 512 * i, tt = q >> 4, ch = q & 15;
        const u32x4 raw = *(const u32x4*)(p.RK + (tok0 + tt) * 1024 + h * 128 + ch * 8);
        float v[8]; unpk8(raw, v);
        const float dec = __expf((float)(127 - tt) * lg);
#pragma unroll
        for (int e = 0; e < 8; ++e) v[e] *= dec;
        *(u32x4*)(Kimg + (tt >> 5) * 8192 + off_b(tt & 31, ch)) = pk8(v);
    }
#pragma unroll
    for (int i = 0; i < 8; ++i) {
        const int q = tid + 512 * i, tt = q >> 5, c32 = q & 31;
        const u32x4 raw = *(const u32x4*)(p.RV + (tok0 + tt) * 2048 + h * 256 + c32 * 8);
        *(u32x4*)(Vimg + ((tt >> 5) * 2 + (c32 >> 4)) * 8192 + off_b(tt & 31, c32 & 15)) = raw;
    }
    __syncthreads();
    f32x4 acc[16];
#pragma unroll
    for (int nt = 0; nt < 16; ++nt) acc[nt] = (f32x4){0.f, 0.f, 0.f, 0.f};
    const unsigned z0 = lds_u32(smem) + tr_addr16(lane, 0, 0), z1 = lds_u32(smem) + tr_addr16(lane, 0, 1);
    static_for<0, 4>([&](auto KS) {
        constexpr int ks = decltype(KS)::value;
        const h16x8 af = tr_read8o<ks * 8192>(z0 ^ (32u * wave), z1 ^ (32u * wave));
        static_for<0, 16>([&](auto NT) {
            constexpr int nt = decltype(NT)::value;
            const h16x8 bf = tr_read8o<(ks * 2 + (nt >> 3)) * 8192>((z0 + 32768u) ^ (32u * (nt & 7)), (z1 + 32768u) ^ (32u * (nt & 7)));
            acc[nt] = __builtin_amdgcn_mfma_f32_16x16x32_f16(bf, af, acc[nt], 0, 0, 0);
        });
    });
    float* dst = p.KV + ((size_t)((b * 8 + h) * 32 + c) * 128) * 256;
#pragma unroll
    for (int nt = 0; nt < 16; ++nt) *(f32x4*)(dst + (size_t)(16 * wave + (lane & 15)) * 256 + 16 * nt + 4 * (lane >> 4)) = acc[nt];
    __syncthreads();
}

__device__ __forceinline__ void sample_post_item(const Params& p) {
    const int tid = otid();
    const float2* rp = p.ROPE + (size_t)4096 * 64;
    for (int q = tid; q < 8 * 122 * 4; q += 512) {
        const int part = q & 3, cb = (q >> 2) % 122, t = (q >> 2) / 122;
        const int col0 = (cb < 89) ? cb * 128 : (cb < 105) ? C_GR + (cb - 89) * 128 : (cb < 121) ? C_GA + (cb - 105) * 128 : C_IW;
        const float* z = p.ZS + (size_t)t * NW0 + col0;
        float x1[16], x2[16];
        if (cb < 121) {
#pragma unroll
            for (int i = 0; i < 16; ++i) { x1[i] = z[16 * part + i]; x2[i] = z[64 + 16 * part + i]; }
        } else {
#pragma unroll
            for (int i = 0; i < 16; ++i) { x1[i] = z[i]; x2[i] = 0.f; }
        }
        if (cb < 8) { rope32(x1, x2, rp, part); store_f32_32(p.SRQ + t * 1024 + cb * 128, part, x1, x2); }
        else if (cb < 16) {
            rope32(x1, x2, rp, part);
#pragma unroll
            for (int i = 0; i < 16; ++i) { x1[i] *= 0.08838834764831845f; x2[i] *= 0.08838834764831845f; }
            store_f32_32(p.SRK + t * 1024 + (cb - 8) * 128, part, x1, x2);
        } else if (cb < 32) store_f32_32(p.SRV + t * 2048 + (cb - 16) * 128, part, x1, x2);
        else if (cb < 48) {
#pragma unroll
            for (int i = 0; i < 16; ++i) { x1[i] = siluf_(x1[i]); x2[i] = siluf_(x2[i]); }
            store_f32_32(p.SRG + t * 2048 + (cb - 32) * 128, part, x1, x2);
        } else if (cb < 68) {
            const bool isq = cb < 64;
            float ss = 0.f;
#pragma unroll
            for (int i = 0; i < 16; ++i) ss += x1[i] * x1[i] + x2[i] * x2[i];
            ss = quad_sum(ss);
            const float rs = rsqrtf(ss * (1.f / 128.f) + EPS);
            const float* nw = isq ? p.q_norm_w : p.k_norm_w;
#pragma unroll
            for (int i = 0; i < 16; ++i) { x1[i] *= rs * nw[16 * part + i]; x2[i] *= rs * nw[64 + 16 * part + i]; }
            rope32(x1, x2, rp, part);
            if (isq) {
#pragma unroll
                for (int i = 0; i < 16; ++i) { x1[i] *= 0.08838834764831845f; x2[i] *= 0.08838834764831845f; }
                store_f32_32(p.SAQ + t * 2048 + (cb - 48) * 128, part, x1, x2);
            } else {
                store_f32_32(p.SAK + t * 512 + (cb - 64) * 128, part, x1, x2);
                store_f32_32(p.out + O_KS + t * 512 + (cb - 64) * 128, part, x1, x2);
            }
        } else if (cb < 72) {
            store_f32_32(p.SAV + t * 512 + (cb - 68) * 128, part, x1, x2);
            store_f32_32(p.out + O_VS + t * 512 + (cb - 68) * 128, part, x1, x2);
        } else if (cb < 88) {
        } else if (cb == 88) {
            rope32(x1, x2, rp, part);
            store_f32_32(p.SIK + t * 128, part, x1, x2);
            store_f32_32(p.out + O_IKS + t * 128, part, x1, x2);
        } else if (cb < 121) {
#pragma unroll
            for (int i = 0; i < 16; ++i) { x1[i] = sigmoidf_(x1[i]); x2[i] = sigmoidf_(x2[i]); }
            float* dst = (cb < 105) ? p.SGR + t * 2048 + (cb - 89) * 128 : p.SGA + t * 2048 + (cb - 105) * 128;
            store_f32_32(dst, part, x1, x2);
        }
    }
}

__device__ __forceinline__ void sample_indexer_item(const Params& p, int t, int kr, char* smem) {
    const int tid = otid();
    float* qs = (float*)smem;
    float* ws = qs + 2048;
    float* kself = ws + 16;
    float* tmp = kself + 128;
    const float2* rp = p.ROPE + (size_t)4096 * 64;
    const float* z = p.ZS + (size_t)t * NW0;
    __syncthreads();
#pragma unroll
    for (int i = 0; i < 2; ++i) {
        const int pr = tid + 512 * i, hh = pr >> 6, d = pr & 63;
        const float a = z[C_IQ + hh * 128 + d], b = z[C_IQ + hh * 128 + 64 + d];
        const float2 cs = rp[d];
        qs[hh * 128 + d] = (a * cs.x - b * cs.y) * 0.08838834764831845f;
        qs[hh * 128 + 64 + d] = (b * cs.x + a * cs.y) * 0.08838834764831845f;
    }
    if (tid < 16) ws[tid] = z[C_IW + tid] * 0.25f;
    if (tid < 64) { const float a = z[C_IK + tid], b = z[C_IK + 64 + tid]; const float2 cs = rp[tid]; kself[tid] = a * cs.x - b * cs.y; kself[64 + tid] = b * cs.x + a * cs.y; }
    __syncthreads();
    {
        const int lane = tid & 63, wave = tid >> 6, r16 = lane & 15, g = lane >> 4;
        h16x8 qhi[4], qlo[4];
#pragma unroll
        for (int kk = 0; kk < 4; ++kk) {
            const float* qp = qs + r16 * 128 + kk * 32 + g * 8;
            const f32x4 a = *(const f32x4*)qp, b = *(const f32x4*)(qp + 4);
            const float v[8] = {a.x, a.y, a.z, a.w, b.x, b.y, b.z, b.w};
#pragma unroll
            for (int e = 0; e < 8; ++e) { const h16 hv = (h16)v[e]; qhi[kk][e] = hv; qlo[kk][e] = (h16)(v[e] - (float)hv); }
        }
        f32x4 wv4 = *(const f32x4*)(ws + 4 * g);
        f32x4 kraw[4][4][2];
#pragma unroll
        for (int tl = 0; tl < 4; ++tl) {
            const int s = kr * 512 + (wave * 4 + tl) * 16 + r16;
            const int page = p.page_table[t * NPAGES + (s >> 7)];
            const float* kp = p.cache_kidx + ((size_t)page * PAGE + (s & 127)) * 128 + g * 8;
#pragma unroll
            for (int kk = 0; kk < 4; ++kk) { kraw[tl][kk][0] = *(const f32x4*)(kp + kk * 32); kraw[tl][kk][1] = *(const f32x4*)(kp + kk * 32 + 4); }
        }
#pragma unroll
        for (int tl = 0; tl < 4; ++tl) {
            f32x4 acc = {0.f, 0.f, 0.f, 0.f};
#pragma unroll
            for (int kk = 0; kk < 4; ++kk) {
                const f32x4 a = kraw[tl][kk][0], b = kraw[tl][kk][1];
                const float v[8] = {a.x, a.y, a.z, a.w, b.x, b.y, b.z, b.w};
                h16x8 khi, klo;
#pragma unroll
                for (int e = 0; e < 8; ++e) { const h16 hv = (h16)v[e]; khi[e] = hv; klo[e] = (h16)(v[e] - (float)hv); }
                acc = __builtin_amdgcn_mfma_f32_16x16x32_f16(qlo[kk], khi, acc, 0, 0, 0);
                acc = __builtin_amdgcn_mfma_f32_16x16x32_f16(qhi[kk], klo, acc, 0, 0, 0);
                acc = __builtin_amdgcn_mfma_f32_16x16x32_f16(qhi[kk], khi, acc, 0, 0, 0);
            }
            float sc = wv4.x * fmaxf(acc.x, 0.f) + wv4.y * fmaxf(acc.y, 0.f) + wv4.z * fmaxf(acc.z, 0.f) + wv4.w * fmaxf(acc.w, 0.f);
            sc += __shfl_xor(sc, 16); sc += __shfl_xor(sc, 32);
            if (g == 0) p.SSC[(size_t)t * SSCS + kr * 512 + (wave * 4 + tl) * 16 + r16] = sc;
        }
    }
    if (kr == 31) {
        if (tid < 16) { float d = 0.f;
#pragma unroll 4
            for (int i = 0; i < 128; ++i) d += qs[tid * 128 + i] * kself[i]; tmp[tid] = ws[tid] * fmaxf(d, 0.f); }
        __syncthreads();
        if (tid == 0) { float sc = 0.f; for (int i = 0; i < 16; ++i) sc += tmp[i]; p.SSC[(size_t)t * SSCS + PAST] = sc; }
    }
    __syncthreads();
}

__device__ __forceinline__ void phase2(const Params& p, char* smem) {
    const int c = blockIdx.x, G = gridDim.x;
    for (int k = 0;; ++k) {
        const int rr = (k >> 1) * 2 * G, r = (k & 1) ? rr + 2 * G - 1 - c : rr + c;
        if (rr >= 1024) break;
        if (r < 1024) indexer_item(p, r & 1, 511 - (r >> 1), smem);
    }
    for (int it = c; it < 512; it += G) kv_item(p, it >> 8, (it >> 5) & 7, it & 31, smem);
    for (int it = c; it < 256; it += G) sample_indexer_item(p, it >> 5, it & 31, smem);
    if (c == G - 1) sample_post_item(p);
}

__device__ __forceinline__ void scan_item(const Params& p, int item) {
    const int idx = item * 512 + otid();
    const int dv = idx & 255, dkb = (idx >> 8) & 15, h = (idx >> 12) & 7, b = idx >> 15;
    const float gC = __expf(128.f * ret_log_g(h));
    float S[8];
#pragma unroll
    for (int i = 0; i < 8; ++i) S[i] = 0.f;
    const size_t bh = (size_t)(b * 8 + h);
#pragma unroll 4
    for (int c = 0; c < 32; ++c) {
        *(u32x4*)(p.SPT + (((bh * 32 + c) * 256 + dv) * 128) + dkb * 8) = pk8(S);
        const float* kv = p.KV + ((bh * 32 + c) * 128 + dkb * 8) * 256 + dv;
#pragma unroll
        for (int i = 0; i < 8; ++i) S[i] = gC * S[i] + kv[(size_t)i * 256];
    }
#pragma unroll
    for (int i = 0; i < 8; ++i) p.out[O_SP + (bh * 128 + dkb * 8 + i) * 256 + dv] = S[i];
}

__device__ __forceinline__ void attn_item(const Params& p, int b, int n, int qg, char* smem) {
    const int tid = otid(), lane = tid & 63, wave = tid >> 6, r16 = lane & 15, g = lane >> 4;
    const int tt = 8 * qg + wave, t = b * SEQ + tt;
    const int cnt = (tt + 1 < 256) ? tt + 1 : 256;
    int* lidx = (int*)(smem + wave * 9216);
    char* img = smem + wave * 9216 + 1024;
    const unsigned az0 = lds_u32(img) + tr_addr16(lane, 0, 0), az1 = lds_u32(img) + tr_addr16(lane, 0, 1);
    const size_t tb = (size_t)b * SEQ;
#pragma unroll
    for (int i = 0; i < 4; ++i) { const int v = p.TOPI[(size_t)t * 256 + lane + 64 * i]; lidx[lane + 64 * i] = v < 0 ? 0 : v; }
    long qf[4];
    {
        const unsigned char* qp = p.AQ8 + (size_t)t * 2048 + (n * 4 + (r16 & 3)) * 128 + 16 * g;
        u32x4 c0 = *(const u32x4*)qp, c1 = *(const u32x4*)(qp + 64);
        if (r16 >= 4) { c0 = (u32x4){0u, 0u, 0u, 0u}; c1 = c0; }
        qf[0] = (long)(((u64)c0.y << 32) | c0.x); qf[1] = (long)(((u64)c0.w << 32) | c0.z);
        qf[2] = (long)(((u64)c1.y << 32) | c1.x); qf[3] = (long)(((u64)c1.w << 32) | c1.z);
    }
    const unsigned char* kbase = p.AK8 + tb * 512 + n * 128 + 16 * g;
    const h16* vbase = p.AV + tb * 512 + n * 128;
    f32x4 sacc[16];
    {
        u32x4 kf[16][2];
#pragma unroll
        for (int i = 0; i < 16; ++i) {
            const unsigned char* kp = kbase + (size_t)lidx[16 * i + r16] * 512;
            kf[i][0] = *(const u32x4*)kp; kf[i][1] = *(const u32x4*)(kp + 64);
        }
#pragma unroll
        for (int i = 0; i < 16; ++i) {
            const u32x4 k0 = kf[i][0], k1 = kf[i][1];
            f32x4 a = {0.f, 0.f, 0.f, 0.f};
            a = __builtin_amdgcn_mfma_f32_16x16x32_fp8_fp8((long)(((u64)k0.y << 32) | k0.x), qf[0], a, 0, 0, 0);
            a = __builtin_amdgcn_mfma_f32_16x16x32_fp8_fp8((long)(((u64)k0.w << 32) | k0.z), qf[1], a, 0, 0, 0);
            a = __builtin_amdgcn_mfma_f32_16x16x32_fp8_fp8((long)(((u64)k1.y << 32) | k1.x), qf[2], a, 0, 0, 0);
            a = __builtin_amdgcn_mfma_f32_16x16x32_fp8_fp8((long)(((u64)k1.w << 32) | k1.z), qf[3], a, 0, 0, 0);
#pragma unroll
            for (int j = 0; j < 4; ++j) sacc[i][j] = ((16 * i + 4 * g + j) < cnt) ? a[j] * (1.f / 16.f) : -3.0e38f;
        }
    }
    u32x4 vr[3][8];
#pragma unroll
    for (int b0 = 0; b0 < 3; ++b0)
#pragma unroll
        for (int i2 = 0; i2 < 8; ++i2) {
            const int q = lane + 64 * i2, s = q >> 4, ch = q & 15;
            const int slot = (2 * b0 + ((s >> 2) & 1)) * 16 + 4 * (s >> 3) + (s & 3);
            vr[b0][i2] = *(const u32x4*)(vbase + (size_t)lidx[slot] * 512 + ch * 8);
        }
    float mx = -3.0e38f;
#pragma unroll
    for (int i = 0; i < 16; ++i)
#pragma unroll
        for (int j = 0; j < 4; ++j) mx = fmaxf(mx, sacc[i][j]);
    mx = fmaxf(mx, __shfl_xor(mx, 16)); mx = fmaxf(mx, __shfl_xor(mx, 32));
    float sum = 0.f;
#pragma unroll
    for (int i = 0; i < 16; ++i)
#pragma unroll
        for (int j = 0; j < 4; ++j) { const float e = __expf(sacc[i][j] - mx); sacc[i][j] = e; sum += e; }
    sum += __shfl_xor(sum, 16); sum += __shfl_xor(sum, 32);
    f32x4 oacc[8];
#pragma unroll
    for (int c = 0; c < 8; ++c) oacc[c] = (f32x4){0.f, 0.f, 0.f, 0.f};
#pragma unroll
    for (int bI = 0; bI < 8; ++bI) {
#pragma unroll
        for (int i2 = 0; i2 < 8; ++i2) { const int q = lane + 64 * i2; *(u32x4*)(img + off_b(q >> 4, q & 15)) = vr[bI % 3][i2]; }
        if (bI + 3 < 8) {
#pragma unroll
            for (int i2 = 0; i2 < 8; ++i2) {
                const int q = lane + 64 * i2, s = q >> 4, ch = q & 15;
                const int slot = (2 * (bI + 3) + ((s >> 2) & 1)) * 16 + 4 * (s >> 3) + (s & 3);
                vr[bI % 3][i2] = *(const u32x4*)(vbase + (size_t)lidx[slot] * 512 + ch * 8);
            }
        }
        h16x8 pf;
        {
            const f32x4 a0 = sacc[2 * bI], a1 = sacc[2 * bI + 1];
            pf[0] = (h16)a0.x; pf[1] = (h16)a0.y; pf[2] = (h16)a0.z; pf[3] = (h16)a0.w;
            pf[4] = (h16)a1.x; pf[5] = (h16)a1.y; pf[6] = (h16)a1.z; pf[7] = (h16)a1.w;
        }
#pragma unroll
        for (int c0 = 0; c0 < 8; c0 += 4) {
            h16x8 vf[4];
            tr_read8x4(az0, az1, c0, vf);
#pragma unroll
            for (int c = 0; c < 4; ++c) oacc[c0 + c] = __builtin_amdgcn_mfma_f32_16x16x32_f16(pf, vf[c], oacc[c0 + c], 0, 0, 0);
        }
    }
    float inv[4];
#pragma unroll
    for (int j = 0; j < 4; ++j) inv[j] = 1.f / __shfl(sum, j);
    h16* ost = (h16*)img;
    if (g == 0) {
#pragma unroll
        for (int c = 0; c < 8; ++c)
#pragma unroll
            for (int j = 0; j < 4; ++j) ost[j * 128 + 16 * c + r16] = (h16)(oacc[c][j] * inv[j]);
    }
    asm volatile("s_waitcnt lgkmcnt(0)" ::: "memory");
    *(u32x4*)(p.ATT + (size_t)t * 2048 + n * 512 + lane * 8) = *(const u32x4*)(ost + lane * 8);
    asm volatile("s_waitcnt lgkmcnt(0)" ::: "memory");
}

__device__ __forceinline__ void sample_topk_item(const Params& p, int t, char* smem) {
    const int tid = otid(), lane = tid & 63, wave = tid >> 6;
    int* red = (int*)smem;
    int* cnts = red + 16;
    __syncthreads();
    unsigned u[33];
#pragma unroll
    for (int i = 0; i < 33; ++i) { const int s = i * 512 + tid; u[i] = (s < LS) ? f2ord(p.SSC[(size_t)t * SSCS + s]) : 0u; }
    unsigned tau = 0u;
    for (int bit = 31; bit >= 0; --bit) {
        const unsigned cand = tau | (1u << bit);
        int c = 0;
#pragma unroll
        for (int i = 0; i < 33; ++i) c += (u[i] >= cand) ? 1 : 0;
#pragma unroll
        for (int o = 32; o > 0; o >>= 1) c += __shfl_xor(c, o);
        if (lane == 0) red[wave] = c;
        __syncthreads();
        int tot = 0;
#pragma unroll
        for (int w = 0; w < 8; ++w) tot += red[w];
        __syncthreads();
        if (tot >= 256) tau = cand;
    }
    const u64 lt = (1ull << lane) - 1ull;
#pragma unroll
    for (int i = 0; i < 33; ++i) {
        const u64 mg = __ballot(u[i] > tau), me = __ballot(u[i] == tau);
        if (lane == 0) { cnts[i * 8 + wave] = __popcll(mg); cnts[264 + i * 8 + wave] = __popcll(me); }
        if ((i & 3) == 3) __builtin_amdgcn_sched_barrier(0);
    }
    __syncthreads();
    int cg_tot = 0;
#pragma unroll 8
    for (int i = 0; i < 264; ++i) cg_tot += cnts[i];
    const int need_eq = 256 - cg_tot;
    int eq_before = 0, sel_before = 0;
    int* outp = p.STOP + t * 256;
    unsigned tau2 = tau; asm volatile("" : "+v"(tau2));
#pragma unroll
    for (int i = 0; i < 33; ++i) {
        int eb = eq_before, sb = sel_before;
        for (int w = 0; w < wave; ++w) {
            const int ng = cnts[i * 8 + w], ne = cnts[264 + i * 8 + w];
            int take_e = need_eq - eb; take_e = take_e < 0 ? 0 : (take_e > ne ? ne : take_e);
            eb += ne; sb += ng + take_e;
        }
        const bool gt = u[i] > tau2, eq = u[i] == tau2;
        const u64 me = __ballot(eq);
        const bool sel = gt || (eq && (eb + __popcll(me & lt)) < need_eq);
        const u64 ms = __ballot(sel);
        if (sel) outp[sb + __popcll(ms & lt)] = i * 512 + tid;
        for (int w = 0; w < 8; ++w) {
            const int ng = cnts[i * 8 + w], ne = cnts[264 + i * 8 + w];
            int take_e = need_eq - eq_before; take_e = take_e < 0 ? 0 : (take_e > ne ? ne : take_e);
            eq_before += ne; sel_before += ng + take_e;
        }
        __builtin_amdgcn_sched_barrier(0);
    }
    __syncthreads();
}

__device__ __forceinline__ void phase3(const Params& p, char* smem, int rep) {
    const int c = blockIdx.x, G = gridDim.x;
    for (int it = c; it < 136; it += G) { if (it < 128) scan_item(p, it); else sample_topk_item(p, it - 128, smem); }
    volatile int* s_next = (volatile int*)(smem + LDS_BYTES - 64);
    const unsigned home = xb_xcc_id() & 7u;
    int dead = 0;
    for (;;) {
        __syncthreads();
        if (threadIdx.x == 0) {
            int it = -1;
            for (int qi = dead; qi < 8; ++qi) {
                const unsigned q = (home + qi) & 7u;
                const int v = (int)atomicAdd(&p.ctl[4096 + 512 * rep + 64 * q], 2u);
                if (v < 512) { it = (int)q * 512 + v; s_next[1] = qi; break; }
            }
            if (it < 0) s_next[1] = 8;
            s_next[0] = it;
        }
        __syncthreads();
        const int it = s_next[0];
        dead = s_next[1];
        if (it < 0) break;
        const int q = it >> 9;
        attn_item(p, q >> 2, q & 3, it & 511, smem);
        attn_item(p, q >> 2, q & 3, (it & 511) + 1, smem);
    }
}

__device__ __forceinline__ void retout_item(const Params& p, int b, int h, int c, char* smem) {
    const int tid = otid(), lane = tid & 63, wave = tid >> 6, r16 = lane & 15, g = lane >> 4;
    char* Vimg = smem;
    const size_t tok0 = (size_t)b * SEQ + c * 128;
    const float lg = ret_log_g(h);
#pragma unroll
    for (int i = 0; i < 8; ++i) {
        const int q = tid + 512 * i, sg = q >> 5, c32 = q & 31, bI = sg >> 5, s = sg & 31;
        const int tokl = bI * 32 + ((s >> 2) & 1) * 16 + 4 * (s >> 3) + (s & 3);
        const u32x4 raw = *(const u32x4*)(p.RV + (tok0 + tokl) * 2048 + h * 256 + c32 * 8);
        *(u32x4*)(Vimg + (bI * 2 + (c32 >> 4)) * 8192 + off_b(s, c32 & 15)) = raw;
    }
    __syncthreads();
    const int il = 16 * wave + r16;
    h16x8 qf[4], qd[4];
    {
        const h16* qp = p.RQ + (tok0 + il) * 1024 + h * 128 + g * 8;
        const float dq = __expf((float)(il + 1) * lg);
#pragma unroll
        for (int kk = 0; kk < 4; ++kk) {
            const u32x4 raw = *(const u32x4*)(qp + kk * 32);
            qf[kk] = __builtin_bit_cast(h16x8, raw);
            float v[8]; unpk8(raw, v);
#pragma unroll
            for (int e = 0; e < 8; ++e) v[e] *= dq;
            qd[kk] = __builtin_bit_cast(h16x8, pk8(v));
        }
    }
    f32x4 sacc[8];
#pragma unroll
    for (int jr = 0; jr < 2; ++jr) {
        h16x8 kf[4][4];
        if (4 * jr <= wave) {
#pragma unroll
            for (int q = 0; q < 4; ++q) {
                const int jt = 4 * jr + q, jc = jt <= wave ? jt : wave;
                const h16* kp = p.RK + (tok0 + 16 * jc + r16) * 1024 + h * 128 + g * 8;
#pragma unroll
                for (int kk = 0; kk < 4; ++kk) kf[q][kk] = *(const h16x8*)(kp + kk * 32);
            }
        }
#pragma unroll
        for (int q = 0; q < 4; ++q) {
            const int jt = 4 * jr + q;
            sacc[jt] = (f32x4){0.f, 0.f, 0.f, 0.f};
            if (jt <= wave) {
#pragma unroll
                for (int kk = 0; kk < 4; ++kk) sacc[jt] = __builtin_amdgcn_mfma_f32_16x16x32_f16(kf[q][kk], qf[kk], sacc[jt], 0, 0, 0);
#pragma unroll
                for (int j = 0; j < 4; ++j) { const int jl = 16 * jt + 4 * g + j; sacc[jt][j] = (il >= jl) ? sacc[jt][j] * __expf((float)(il - jl) * lg) : 0.f; }
            }
        }
        __builtin_amdgcn_sched_barrier(0);
    }
    f32x4 oacc[16];
    const h16* sp = p.SPT + ((size_t)((b * 8 + h) * 32 + c) * 256) * 128;
#pragma unroll
    for (int er = 0; er < 4; ++er) {
        h16x8 sf[4][4];
#pragma unroll
        for (int q = 0; q < 4; ++q) {
            const h16* sr = sp + (size_t)(16 * (4 * er + q) + r16) * 128 + g * 8;
#pragma unroll
            for (int kk = 0; kk < 4; ++kk) sf[q][kk] = *(const h16x8*)(sr + kk * 32);
        }
#pragma unroll
        for (int q = 0; q < 4; ++q) {
            const int et = 4 * er + q;
            oacc[et] = (f32x4){0.f, 0.f, 0.f, 0.f};
#pragma unroll
            for (int kk = 0; kk < 4; ++kk) oacc[et] = __builtin_amdgcn_mfma_f32_16x16x32_f16(sf[q][kk], qd[kk], oacc[et], 0, 0, 0);
        }
        __builtin_amdgcn_sched_barrier(0);
    }
    const unsigned rz0 = lds_u32(Vimg) + tr_addr16(lane, 0, 0), rz1 = lds_u32(Vimg) + tr_addr16(lane, 0, 1);
    static_for<0, 4>([&](auto BI) {
        constexpr int bI = decltype(BI)::value;
        if (2 * bI <= wave) {
            h16x8 pf;
            const f32x4 a0 = sacc[2 * bI], a1 = sacc[2 * bI + 1];
            pf[0] = (h16)a0.x; pf[1] = (h16)a0.y; pf[2] = (h16)a0.z; pf[3] = (h16)a0.w;
            pf[4] = (h16)a1.x; pf[5] = (h16)a1.y; pf[6] = (h16)a1.z; pf[7] = (h16)a1.w;
            static_for<0, 16>([&](auto ET) {
                constexpr int et = decltype(ET)::value;
                const h16x8 vf = tr_read8o<(bI * 2 + (et >> 3)) * 8192>(rz0 ^ (32u * (et & 7)), rz1 ^ (32u * (et & 7)));
                oacc[et] = __builtin_amdgcn_mfma_f32_16x16x32_f16(vf, pf, oacc[et], 0, 0, 0);
            });
        }
    });
    float s1 = 0.f;
#pragma unroll
    for (int et = 0; et < 16; ++et) s1 += oacc[et].x + oacc[et].y + oacc[et].z + oacc[et].w;
    s1 += __shfl_xor(s1, 16); s1 += __shfl_xor(s1, 32);
    const float mu = s1 * (1.f / 256.f);
    float s2 = 0.f;
#pragma unroll
    for (int et = 0; et < 16; ++et)
#pragma unroll
        for (int j = 0; j < 4; ++j) { const float d = oacc[et][j] - mu; s2 += d * d; }
    s2 += __shfl_xor(s2, 16); s2 += __shfl_xor(s2, 32);
    const float rs = rsqrtf(s2 * (1.f / 256.f) + EPS);
    const size_t tok = tok0 + il;
#pragma unroll
    for (int et = 0; et < 16; ++et) {
        const int e0 = h * 256 + 16 * et + 4 * g;
        const f32x4 gw = *(const f32x4*)(p.ret_gn_w + e0);
        const f32x2 rgraw = *(const f32x2*)(p.RG + tok * 2048 + e0);
        const float rgx = rgraw.x, rgy = rgraw.y;
        const h16x2 r0 = __builtin_bit_cast(h16x2, rgx), r1 = __builtin_bit_cast(h16x2, rgy);
        const float o0 = (oacc[et].x - mu) * rs * gw.x * (float)r0.x, o1 = (oacc[et].y - mu) * rs * gw.y * (float)r0.y;
        const float o2 = (oacc[et].z - mu) * rs * gw.z * (float)r1.x, o3 = (oacc[et].w - mu) * rs * gw.w * (float)r1.y;
        f32x2 o; o.x = __uint_as_float(pkh(o0, o1)); o.y = __uint_as_float(pkh(o2, o3));
        *(f32x2*)(p.RN + tok * 2048 + e0) = o;
    }
    __syncthreads();
}

__device__ __forceinline__ void sample_ret_item(const Params& p, int t, int h, char* smem) {
    const int tid = otid(), dv = tid & 255, half = tid >> 8;
    float* qs = (float*)smem;
    float* ks = qs + 128;
    float* part = ks + 128;
    float* red = part + 512;
    __syncthreads();
    if (tid < 128) { qs[tid] = p.SRQ[t * 1024 + h * 128 + tid]; ks[tid] = p.SRK[t * 1024 + h * 128 + tid]; }
    __syncthreads();
    const float gm = 1.f - exp2f(-5.f - (float)h);
    float qk = 0.f;
#pragma unroll 4
    for (int i = 0; i < 128; ++i) qk += qs[i] * ks[i];
    const float v = p.SRV[t * 2048 + h * 256 + dv];
    const float* Sin = p.state_ret + ((size_t)(t * 8 + h) * 128) * 256;
    float* Sout = p.out + O_SS + ((size_t)(t * 8 + h) * 128) * 256;
    float cross = 0.f;
#pragma unroll 8
    for (int i = 0; i < 64; ++i) {
        const int dk = half * 64 + i;
        const float s = Sin[(size_t)dk * 256 + dv];
        cross += qs[dk] * s;
        Sout[(size_t)dk * 256 + dv] = gm * s + ks[dk] * v;
    }
    part[half * 256 + dv] = cross;
    __syncthreads();
    float o = 0.f;
    if (tid < 256) o = qk * v + gm * (part[dv] + part[256 + dv]);
    float s1 = (tid < 256) ? o : 0.f;
    s1 = wave_sum(s1);
    if ((tid & 63) == 0) red[tid >> 6] = s1;
    __syncthreads();
    const float mu = (red[0] + red[1] + red[2] + red[3]) * (1.f / 256.f);
    float d = (tid < 256) ? (o - mu) : 0.f;
    float s2 = wave_sum(d * d);
    if ((tid & 63) == 0) red[8 + (tid >> 6)] = s2;
    __syncthreads();
    const float rs = rsqrtf((red[8] + red[9] + red[10] + red[11]) * (1.f / 256.f) + EPS);
    if (tid < 256) p.SRN[t * 2048 + h * 256 + dv] = d * rs * p.ret_gn_w[h * 256 + dv] * p.SRG[t * 2048 + h * 256 + dv];
    __syncthreads();
}

__device__ __forceinline__ void sample_attn_item(const Params& p, int t, int n, char* smem) {
    const int tid = otid(), lane = tid & 63, wave = tid >> 6;
    float* qs = (float*)smem;
    int* rowk = (int*)(smem + 2048);
    float* lg = (float*)(smem + 3072);
    float* part = (float*)(smem + 7168);
    float* sums = (float*)(smem + 23552);
    __syncthreads();
    qs[tid] = p.SAQ[t * 2048 + n * 512 + tid];
    if (tid < 256) { const int idx = p.STOP[t * 256 + tid]; rowk[tid] = (idx < PAST) ? p.page_table[t * NPAGES + (idx >> 7)] * PAGE + (idx & 127) : -1; }
    __syncthreads();
    {
        const int key = wave * 32 + (lane >> 1), dh = lane & 1, row = rowk[key];
        const float* kp = (row >= 0) ? p.cache_k + ((size_t)row * 4 + n) * 128 + dh * 64 : p.SAK + t * 512 + n * 128 + dh * 64;
        f32x4 kv[16];
#pragma unroll
        for (int i = 0; i < 16; ++i) kv[i] = *(const f32x4*)(kp + 4 * i);
#pragma unroll
        for (int h = 0; h < 4; ++h) {
            float d = 0.f;
#pragma unroll
            for (int i = 0; i < 16; ++i) { const f32x4 q = *(const f32x4*)(qs + h * 128 + dh * 64 + 4 * i); d += kv[i].x * q.x + kv[i].y * q.y + kv[i].z * q.z + kv[i].w * q.w; }
            d += __shfl_xor(d, 1);
            if (dh == 0) lg[h * 256 + key] = d;
        }
    }
    __syncthreads();
    if (wave < 4) {
        float v[4];
#pragma unroll
        for (int i = 0; i < 4; ++i) v[i] = lg[wave * 256 + lane + 64 * i];
        const float mx = wave_max(fmaxf(fmaxf(v[0], v[1]), fmaxf(v[2], v[3])));
        float s = 0.f;
#pragma unroll
        for (int i = 0; i < 4; ++i) { v[i] = __expf(v[i] - mx); s += v[i]; lg[wave * 256 + lane + 64 * i] = v[i]; }
        s = wave_sum(s);
        if (lane == 0) sums[wave] = s;
    }
    __syncthreads();
    {
        const int sub = lane >> 4, dc = lane & 15;
        float acc[4][8];
#pragma unroll
        for (int h = 0; h < 4; ++h)
#pragma unroll
            for (int e = 0; e < 8; ++e) acc[h][e] = 0.f;
        f32x4 va[8], vb[8];
#pragma unroll
        for (int j = 0; j < 8; ++j) {
            const int row = rowk[wave * 32 + sub * 8 + j];
            const float* vp = (row >= 0) ? p.cache_v + ((size_t)row * 4 + n) * 128 + dc * 8 : p.SAV + t * 512 + n * 128 + dc * 8;
            va[j] = *(const f32x4*)vp; vb[j] = *(const f32x4*)(vp + 4);
        }
#pragma unroll
        for (int j = 0; j < 8; ++j) {
            const int key = wave * 32 + sub * 8 + j;
#pragma unroll
            for (int h = 0; h < 4; ++h) {
                const float pk = lg[h * 256 + key];
                acc[h][0] += pk * va[j].x; acc[h][1] += pk * va[j].y; acc[h][2] += pk * va[j].z; acc[h][3] += pk * va[j].w;
                acc[h][4] += pk * vb[j].x; acc[h][5] += pk * vb[j].y; acc[h][6] += pk * vb[j].z; acc[h][7] += pk * vb[j].w;
            }
        }
#pragma unroll
        for (int h = 0; h < 4; ++h)
#pragma unroll
            for (int e = 0; e < 8; ++e) { float v = acc[h][e]; v += __shfl_xor(v, 16); v += __shfl_xor(v, 32); if (sub == 0) part[(wave * 4 + h) * 128 + dc * 8 + e] = v; }
    }
    __syncthreads();
    {
        const int h = tid >> 7, d = tid & 127;
        float o = 0.f;
#pragma unroll
        for (int w = 0; w < 8; ++w) o += part[(w * 4 + h) * 128 + d];
        p.SATT[t * 2048 + (n * 4 + h) * 128 + d] = o / sums[h];
    }
    __syncthreads();
}

__device__ __forceinline__ void phase4(const Params& p, char* smem) {
    const int c = blockIdx.x, G = gridDim.x;
    for (int it = G - 1 - c; it < 96; it += G) {
        if (it < 32) sample_attn_item(p, it >> 2, it & 3, smem);
        else sample_ret_item(p, (it - 32) >> 3, (it - 32) & 7, smem);
    }
    for (int it = c; it < 512; it += G) retout_item(p, it >> 8, (it >> 5) & 7, it & 31, smem);
}

__device__ __forceinline__ void phase5(const Params& p, char* smem) {
    const int tid = otid();
    for (int i = 0;; ++i) {
        int pm, pn; if (!unit_next(i, TP / 256, D / 256, pm, pn)) break;
        f32x4 acc[2][2][4][2] = {};
        gemm_core(p.RN, p.WrT, pm * 256, pn * 256, D, acc, (h16*)smem);
        {
            const int tz = otid(), wid = tz >> 6, lane = tz & 63, wr = wid >> 2, wc = wid & 3, fr = lane & 15, fq = lane >> 4;
            h16* R16 = (h16*)smem;
            __syncthreads();
#pragma unroll 4
            for (int i = 0; i < 16; ++i) {
                const int q = tz + 512 * i, row = q >> 5, ch = q & 31;
                const size_t off = (size_t)(pm * 256 + row) * D + pn * 256 + ch * 8;
                float gr[8], ga[8];
                unpk8(*(const u32x4*)(p.GR + off), gr); unpk8(*(const u32x4*)(p.GA + off), ga);
#pragma unroll
                for (int e = 0; e < 8; ++e) gr[e] *= __builtin_amdgcn_rcpf(fmaxf(ga[e], 1e-4f));
                *(u32x4*)(R16 + row * ES16 + ch * 8) = pk8(gr);
            }
            __syncthreads();
#pragma unroll
            for (int ai = 0; ai < 2; ++ai)
#pragma unroll
                for (int bj = 0; bj < 2; ++bj)
#pragma unroll
                    for (int m = 0; m < 4; ++m)
#pragma unroll
                        for (int n = 0; n < 2; ++n) {
                            const f32x2 rr = *(const f32x2*)(R16 + (ai * 128 + wr * 64 + m * 16 + fr) * ES16 + bj * 128 + wc * 32 + n * 16 + fq * 4);
                            const float rx = rr.x, ry = rr.y;
                            const h16x2 r0 = __builtin_bit_cast(h16x2, rx), r1 = __builtin_bit_cast(h16x2, ry);
                            acc[ai][bj][m][n].x *= (float)r0.x; acc[ai][bj][m][n].y *= (float)r0.y; acc[ai][bj][m][n].z *= (float)r1.x; acc[ai][bj][m][n].w *= (float)r1.y;
                        }
        }
        __syncthreads();
        gemm_core(p.ATT, p.WaT, pm * 256, pn * 256, D, acc, (h16*)smem);
        epilogue_full(acc, smem, [&](int ai, int bj, int r, int part, float* x1, float* x2) {
            const size_t rowoff = (size_t)(pm * 256 + ai * 128 + r) * D + pn * 256 + bj * 128;
            const h16* gp = p.GA + rowoff;
            float g1[16], g2[16];
            unpk8(*(const u32x4*)(gp + 16 * part), g1); unpk8(*(const u32x4*)(gp + 16 * part + 8), g1 + 8);
            unpk8(*(const u32x4*)(gp + 64 + 16 * part), g2); unpk8(*(const u32x4*)(gp + 64 + 16 * part + 8), g2 + 8);
#pragma unroll
            for (int e = 0; e < 16; ++e) { x1[e] *= fmaxf(g1[e], 1e-4f); x2[e] *= fmaxf(g2[e], 1e-4f); }
            store_h16_32(p.MIX + rowoff, part, x1, x2);
        });
    }
    for (int it = blockIdx.x; it < 256; it += gridDim.x) {
        float* SMIX = p.SMIX; const float* SGR = p.SGR; const float* SGA = p.SGA;
        gemv8_item<8>(p.SRN, p.w_ret_o, D, it * 8, smem, [=](int t, int n, float v) { SMIX[t * D + n] = SGR[t * D + n] * v; });
        gemv8_item<8>(p.SATT, p.w_att_o, D, it * 8, smem, [=](int t, int n, float v) { SMIX[t * D + n] += SGA[t * D + n] * v; });
    }
}

__device__ __forceinline__ void phase6(const Params& p, char* smem) {
    const int tid = otid();
    for (int i = 0;; ++i) {
        int pm, pn; if (!unit_next(i, TP / 256, D / 256, pm, pn)) break;
        f32x4 acc[2][2][4][2] = {};
#ifdef GEMM_TWICE
        gemm_core(p.MIX, p.WoT, pm * 256, pn * 256, D, acc, (h16*)smem);
        __syncthreads();
        for (int a = 0; a < 2; ++a) for (int b = 0; b < 2; ++b) for (int m = 0; m < 4; ++m) for (int n = 0; n < 2; ++n) acc[a][b][m][n] = acc[a][b][m][n] * 0.0f;
#endif
        gemm_core(p.MIX, p.WoT, pm * 256, pn * 256, D, acc, (h16*)smem);
        epilogue_full(acc, smem, [&](int ai, int bj, int r, int part, float* x1, float* x2) {
            const size_t rowoff = (size_t)(pm * 256 + ai * 128 + r) * D + pn * 256 + bj * 128;
            const float* xp = p.x_prompt + rowoff;
#pragma unroll
            for (int q = 0; q < 4; ++q) {
                const f32x4 a = *(const f32x4*)(xp + 16 * part + 4 * q), bq = *(const f32x4*)(xp + 64 + 16 * part + 4 * q);
                x1[4 * q] += a.x; x1[4 * q + 1] += a.y; x1[4 * q + 2] += a.z; x1[4 * q + 3] += a.w;
                x2[4 * q] += bq.x; x2[4 * q + 1] += bq.y; x2[4 * q + 2] += bq.z; x2[4 * q + 3] += bq.w;
            }
            store_h16_32(p.HN + rowoff, part, x1, x2);
            float ss = 0.f;
#pragma unroll
            for (int e = 0; e < 16; ++e) ss += x1[e] * x1[e] + x2[e] * x2[e];
            ss = quad_sum(ss);
            if (part == 0) atomicAdd(p.ROWSS + pm * 256 + ai * 128 + r, ss);
        });
    }
    for (int it = blockIdx.x; it < 256; it += gridDim.x) {
        float* out = p.out; const float* xs = p.x_sample;
        gemv8_item<8>(p.SMIX, p.w_out, D, it * 8, smem, [=](int t, int n, float v) { out[O_YS + t * D + n] = xs[t * D + n] + v; });
    }
}

__device__ __forceinline__ void phase7(const Params& p) {
    const int t0 = otid(), lane = t0 & 63, gw = blockIdx.x * 8 + (t0 >> 6), NGW = gridDim.x * 8;
    for (int r = gw; r < TT; r += NGW) {
        const float* x = (r < TP) ? p.out + O_YP + (size_t)r * D : p.out + O_YS + (size_t)(r - TP) * D;
        f32x4 v[8]; float ss = 0.f;
#pragma unroll
        for (int j = 0; j < 8; ++j) { v[j] = *(const f32x4*)(x + 4 * (lane + 64 * j)); ss += v[j].x * v[j].x + v[j].y * v[j].y + v[j].z * v[j].z + v[j].w * v[j].w; }
        ss = wave_sum(ss);
        const float rs = rsqrtf(ss * (1.f / D) + EPS);
#pragma unroll
        for (int j = 0; j < 8; ++j) {
            const f32x4 w = *(const f32x4*)(p.norm2_w + 4 * (lane + 64 * j));
            const float a = v[j].x * rs * w.x, b = v[j].y * rs * w.y, c = v[j].z * rs * w.z, d = v[j].w * rs * w.w;
            if (r < TP) { f32x2 o; o.x = __uint_as_float(pkh(a, b)); o.y = __uint_as_float(pkh(c, d)); *(f32x2*)(p.HN + (size_t)r * D + 4 * (lane + 64 * j)) = o; }
            else { f32x4 o = {a, b, c, d}; *(f32x4*)(p.SHN + (size_t)(r - TP) * D + 4 * (lane + 64 * j)) = o; }
        }
    }
}

constexpr int PCV_ITER = 4;
constexpr int PCV_UCH = (int)(((size_t)NEXP * D / 32) / (512 * PCV_ITER));
constexpr int PCV_VCH = PCV_UCH;
constexpr int PCV_CHUNKS = PCV_UCH + PCV_VCH;
__device__ __forceinline__ void peer_convert_chunk(const Params& p, int chunk) {
    const int tid = otid();
    const bool isu = chunk < PCV_UCH;
    const size_t base = (size_t)(isu ? chunk : chunk - PCV_UCH) * (512 * PCV_ITER) + tid;
    const float* tab = isu ? p.peer_u : p.peer_v;
    unsigned char* outp = (unsigned char*)(isu ? p.PU : p.PV);
    const float sc = isu ? 64.f : 16.f;
#pragma unroll 2
    for (int r = 0; r < PCV_ITER; ++r) {
        const float* src = tab + (base + (size_t)r * 512) * 32;
        f32x4 a[8];
#pragma unroll
        for (int q = 0; q < 8; ++q) a[q] = *(const f32x4*)(src + 4 * q);
        if (isu) {
            const float* wk = p.norm2_w + (int)(((base + (size_t)r * 512) & 63) * 32);
#pragma unroll
            for (int q = 0; q < 8; ++q) { const f32x4 w4 = *(const f32x4*)(wk + 4 * q); a[q].x *= w4.x; a[q].y *= w4.y; a[q].z *= w4.z; a[q].w *= w4.w; }
        }
        u32x4 o;
#pragma unroll
        for (int q = 0; q < 4; ++q) {
            unsigned w = 0u;
            w = __builtin_amdgcn_cvt_scalef32_pk_fp4_f32(w, a[2 * q].x * sc, a[2 * q].y * sc, 1.0f, 0);
            w = __builtin_amdgcn_cvt_scalef32_pk_fp4_f32(w, a[2 * q].z * sc, a[2 * q].w * sc, 1.0f, 1);
            w = __builtin_amdgcn_cvt_scalef32_pk_fp4_f32(w, a[2 * q + 1].x * sc, a[2 * q + 1].y * sc, 1.0f, 2);
            w = __builtin_amdgcn_cvt_scalef32_pk_fp4_f32(w, a[2 * q + 1].z * sc, a[2 * q + 1].w * sc, 1.0f, 3);
            o[q] = w;
        }
        *(u32x4*)(outp + (base + (size_t)r * 512) * 16) = o;
    }
}
__device__ __forceinline__ void peer_convert_pull(const Params& p, char* smem, int rep) {
    volatile int* s_next = (volatile int*)(smem + LDS_BYTES - 64);
    for (;;) {
        __syncthreads();
        if (threadIdx.x == 0) s_next[0] = (int)atomicAdd(&p.ctl[6144 + 64 * rep], 1u);
        __syncthreads();
        const int ch = s_next[0];
        if (ch >= PCV_CHUNKS) break;
        peer_convert_chunk(p, ch);
    }
}

__device__ __forceinline__ void phase8(const Params& p, char* smem, int rep) {
    const int tid = otid();
    for (int i = 0;; ++i) {
        int pm, pn; if (!unit_next(i, TP / 256, 1024 / 256, pm, pn)) break;
        f32x4 acc[2][2][4][2] = {};
        gemm_core(p.HN, p.WqT, pm * 256, pn * 256, D, acc, (h16*)smem);
        epilogue_full(acc, smem, [&](int ai, int bj, int r, int part, float* x1, float* x2) {
            const float rs = rsqrtf(p.ROWSS[pm * 256 + ai * 128 + r] * (1.f / D) + EPS);
#pragma unroll
            for (int e = 0; e < 16; ++e) { x1[e] *= rs; x2[e] *= rs; }
            store_h16_32((h16*)p.PQ + (size_t)(pm * 256 + ai * 128 + r) * 1024 + pn * 256 + bj * 128, part, x1, x2);
        });
    }
    {
        const int G = gridDim.x, first = (G > 144) ? 128 : 0;
        if ((int)blockIdx.x >= first)
            for (int it = blockIdx.x - first; it < 128; it += G - first) {
                float* SPQ = p.SPQ;
                gemv8_item<8>(p.out + O_YS, p.peer_wq, 1024, it * 8, smem, [=](int t, int n, float v) { SPQ[t * 1024 + n] = v; }, p.norm2_w, it == 0 ? p.SHN : nullptr);
            }
    }
    peer_convert_pull(p, smem, rep);
}

template <int NV, class EMIT>
__device__ __forceinline__ void wave_select(const unsigned (&u)[NV], int K, int lane, EMIT emit) {
    unsigned tau; int need_eq;
    if constexpr (NV < 8) wave_kth_r4<NV>(u, K, tau, need_eq); else wave_kth<NV>(u, K, tau, need_eq);
    const u64 lt = (1ull << lane) - 1ull;
    int base = 0, eqt = 0;
    unsigned tau2 = tau; asm volatile("" : "+v"(tau2));
#pragma unroll
    for (int i = 0; i < NV; ++i) {
        const bool gt = u[i] > tau2, eq = u[i] == tau2;
        const u64 meq = __ballot(eq);
        const bool sel = gt || (eq && (eqt + __popcll(meq & lt)) < need_eq);
        const u64 ms = __ballot(sel);
        if (sel) emit(i, base + __popcll(ms & lt));
        base += __popcll(ms); eqt += __popcll(meq);
    }
}

template <bool SAMPLE>
__device__ __forceinline__ void load_row8(const void* base, size_t row, int chunk, float* v) {
    if (SAMPLE) {
        const float* r = (const float*)base + row * D + chunk * 8;
        const f32x4 a = *(const f32x4*)r, b = *(const f32x4*)(r + 4);
        v[0] = a.x; v[1] = a.y; v[2] = a.z; v[3] = a.w; v[4] = b.x; v[5] = b.y; v[6] = b.z; v[7] = b.w;
    } else {
        unpk8(*(const u32x4*)((const h16*)base + row * D + chunk * 8), v);
    }
}

template <bool SAMPLE>
__device__ __forceinline__ void peer_item(const Params& p, int tk, char* smem) {
    const int tid = otid(), lane = tid & 63, h = tid >> 6;
    float* qsh = (float*)smem;
    int* route_e = (int*)(smem + 4096);
    float* route_g = (float*)(smem + 4608);
    float* l1v = (float*)(smem + 5120);
    int* l1i = (int*)(smem + 5632);
    float* l2v = (float*)(smem + 6144);
    int* l2i = (int*)(smem + 6656);
    float* parts = (float*)(smem + 8192);
    const int ts = tk - TP;
    __syncthreads();
    { const float* q = SAMPLE ? p.SPQ + (size_t)ts * 1024 : p.PQ + (size_t)tk * 1024; qsh[tid] = q[tid]; qsh[tid + 512] = q[tid + 512]; }
    __syncthreads();
    {
        float s1[2], s2[2];
#pragma unroll
        for (int i = 0; i < 2; ++i) {
            const int key = lane + 64 * i;
            float a = 0.f, b = 0.f;
            if constexpr (SAMPLE) {
                const float* k1 = p.peer_k1 + ((size_t)(h * 128 + key)) * 64;
                const float* k2 = p.peer_k2 + ((size_t)(h * 128 + key)) * 64;
#pragma unroll 4
                for (int c4 = 0; c4 < 16; ++c4) {
                    const f32x4 x = *(const f32x4*)(k1 + 4 * c4), y = *(const f32x4*)(k2 + 4 * c4);
                    const f32x4 q1 = *(const f32x4*)(qsh + h * 128 + 4 * c4), q2 = *(const f32x4*)(qsh + h * 128 + 64 + 4 * c4);
                    a += x.x * q1.x + x.y * q1.y + x.z * q1.z + x.w * q1.w;
                    b += y.x * q2.x + y.y * q2.y + y.z * q2.z + y.w * q2.w;
                }
            } else {
                const h16* k1 = p.K1H + ((size_t)(h * 128 + key)) * 64;
                const h16* k2 = p.K2H + ((size_t)(h * 128 + key)) * 64;
#pragma unroll 2
                for (int c8 = 0; c8 < 8; ++c8) {
                    float x[8], y[8]; unpk8(*(const u32x4*)(k1 + 8 * c8), x); unpk8(*(const u32x4*)(k2 + 8 * c8), y);
                    const f32x4 q1a = *(const f32x4*)(qsh + h * 128 + 8 * c8), q1b = *(const f32x4*)(qsh + h * 128 + 8 * c8 + 4);
                    const f32x4 q2a = *(const f32x4*)(qsh + h * 128 + 64 + 8 * c8), q2b = *(const f32x4*)(qsh + h * 128 + 64 + 8 * c8 + 4);
                    a += x[0] * q1a.x + x[1] * q1a.y + x[2] * q1a.z + x[3] * q1a.w + x[4] * q1b.x + x[5] * q1b.y + x[6] * q1b.z + x[7] * q1b.w;
                    b += y[0] * q2a.x + y[1] * q2a.y + y[2] * q2a.z + y[3] * q2a.w + y[4] * q2b.x + y[5] * q2b.y + y[6] * q2b.z + y[7] * q2b.w;
                }
            }
            s1[i] = a; s2[i] = b;
        }
        unsigned u[2];
        u[0] = f2ord(s1[0]); u[1] = f2ord(s1[1]);
        wave_select<2>(u, 16, lane, [&](int i, int pos) { l1v[h * 16 + pos] = s1[i]; l1i[h * 16 + pos] = lane + 64 * i; });
        u[0] = f2ord(s2[0]); u[1] = f2ord(s2[1]);
        wave_select<2>(u, 16, lane, [&](int i, int pos) { l2v[h * 16 + pos] = s2[i]; l2i[h * 16 + pos] = lane + 64 * i; });
        asm volatile("s_waitcnt lgkmcnt(0)" ::: "memory");
        float cv[4]; unsigned cu[4];
        const int a = lane >> 2;
#pragma unroll
        for (int i = 0; i < 4; ++i) { cv[i] = l1v[h * 16 + a] + l2v[h * 16 + (lane & 3) * 4 + i]; cu[i] = f2ord(cv[i]); }
        wave_select<4>(cu, 16, lane, [&](int i, int pos) { route_g[h * 16 + pos] = cv[i]; route_e[h * 16 + pos] = l1i[h * 16 + a] * 128 + l2i[h * 16 + (lane & 3) * 4 + i]; });
        asm volatile("s_waitcnt lgkmcnt(0)" ::: "memory");
        float sc = (lane < 16) ? route_g[h * 16 + lane] : -3.0e38f;
        const float mx = wave_max(sc);
        const float ex = (lane < 16) ? __expf(sc - mx) : 0.f;
        const float sm = wave_sum(ex);
        asm volatile("s_waitcnt lgkmcnt(0)" ::: "memory");
        if (lane < 16) route_g[h * 16 + lane] = ex / sm;
        asm volatile("s_waitcnt lgkmcnt(0)" ::: "memory");
    }
    {
        const void* hnb = SAMPLE ? (const void*)p.SHN : (const void*)p.HN;
        const void* ub = SAMPLE ? (const void*)p.peer_u : (const void*)p.PU;
        const void* vb = SAMPLE ? (const void*)p.peer_v : (const void*)p.PV;
        const size_t hrow = SAMPLE ? (size_t)ts : (size_t)tk;
        float hv[SAMPLE ? 32 : 1], facc[32];
        u32x4 hp[SAMPLE ? 1 : 4];
        if constexpr (SAMPLE) {
#pragma unroll
            for (int jj = 0; jj < 2; ++jj) { load_row8<true>(hnb, hrow, 2 * (lane + 64 * jj), hv + 16 * jj); load_row8<true>(hnb, hrow, 2 * (lane + 64 * jj) + 1, hv + 16 * jj + 8); }
        } else {
#pragma unroll
            for (int jj = 0; jj < 2; ++jj) { hp[2 * jj] = *(const u32x4*)((const h16*)hnb + hrow * D + (lane + 64 * jj) * 16); hp[2 * jj + 1] = *(const u32x4*)((const h16*)hnb + hrow * D + (lane + 64 * jj) * 16 + 8); }
        }
#pragma unroll
        for (int i = 0; i < 32; ++i) facc[i] = 0.f;
        if constexpr (SAMPLE) {
#pragma unroll 1
            for (int k = 0; k < 16; ++k) {
                const size_t e = (size_t)route_e[h * 16 + k];
                const float* up = (const float*)ub + e * D; const float* vp = (const float*)vb + e * D;
                f32x4 ur[8], vr[8];
#pragma unroll
                for (int jj = 0; jj < 2; ++jj)
#pragma unroll
                    for (int q = 0; q < 4; ++q) { ur[4 * jj + q] = *(const f32x4*)(up + (lane + 64 * jj) * 16 + 4 * q); vr[4 * jj + q] = *(const f32x4*)(vp + (lane + 64 * jj) * 16 + 4 * q); }
                float d = 0.f;
#pragma unroll
                for (int i = 0; i < 8; ++i) d += hv[4 * i] * ur[i].x + hv[4 * i + 1] * ur[i].y + hv[4 * i + 2] * ur[i].z + hv[4 * i + 3] * ur[i].w;
                d = wave_sum(d);
                const float cw = route_g[h * 16 + k] * gelu_exact(d);
#pragma unroll
                for (int i = 0; i < 8; ++i) { facc[4 * i] += cw * vr[i].x; facc[4 * i + 1] += cw * vr[i].y; facc[4 * i + 2] += cw * vr[i].z; facc[4 * i + 3] += cw * vr[i].w; }
            }
        } else {
            const unsigned char* u8 = (const unsigned char*)ub; const unsigned char* v8 = (const unsigned char*)vb;
#pragma unroll 1
            for (int k = 0; k < 16; k += 8) {
                u32x4 ur[8][2], vr[8][2];
#pragma unroll
                for (int x = 0; x < 8; ++x) {
                    const size_t e = (size_t)route_e[h * 16 + k + x];
#pragma unroll
                    for (int jj = 0; jj < 2; ++jj) { ur[x][jj] = *(const u32x4*)(u8 + e * D + (lane + 64 * jj) * 16); vr[x][jj] = *(const u32x4*)(v8 + e * D + (lane + 64 * jj) * 16); }
                }
#pragma unroll
                for (int x = 0; x < 8; ++x) {
                    float d = 0.f;
#pragma unroll
                    for (int jj = 0; jj < 2; ++jj)
#pragma unroll
                        for (int q = 0; q < 4; ++q) {
                            const int w = (int)ur[x][jj][q];
                            const f32x2 lo = __builtin_amdgcn_cvt_pk_f32_fp8(w, false), hi = __builtin_amdgcn_cvt_pk_f32_fp8(w, true);
                            const unsigned h0 = hp[2 * jj + (q >> 1)][2 * (q & 1)], h1 = hp[2 * jj + (q >> 1)][2 * (q & 1) + 1];
                            const h16x2 p0 = __builtin_bit_cast(h16x2, h0), p1 = __builtin_bit_cast(h16x2, h1);
                            d += (float)p0.x * lo.x + (float)p0.y * lo.y + (float)p1.x * hi.x + (float)p1.y * hi.y;
                        }
                    d = wave_sum(d) * (1.f / 64.f);
                    const float cw = route_g[h * 16 + k + x] * gelu_exact(d) * (1.f / 16.f);
#pragma unroll
                    for (int jj = 0; jj < 2; ++jj)
#pragma unroll
                        for (int q = 0; q < 4; ++q) {
                            const int w = (int)vr[x][jj][q];
                            const f32x2 lo = __builtin_amdgcn_cvt_pk_f32_fp8(w, false), hi = __builtin_amdgcn_cvt_pk_f32_fp8(w, true);
                            facc[16 * jj + 4 * q] += cw * lo.x; facc[16 * jj + 4 * q + 1] += cw * lo.y; facc[16 * jj + 4 * q + 2] += cw * hi.x; facc[16 * jj + 4 * q + 3] += cw * hi.y;
                        }
                }
            }
        }
#pragma unroll
        for (int jj = 0; jj < 2; ++jj) {
            float* dst = parts + h * 2048 + (lane + 64 * jj) * 16;
#pragma unroll
            for (int q = 0; q < 4; ++q) { f32x4 a = {facc[16 * jj + 4 * q], facc[16 * jj + 4 * q + 1], facc[16 * jj + 4 * q + 2], facc[16 * jj + 4 * q + 3]}; *(f32x4*)(dst + 4 * q) = a; }
        }
    }
    __syncthreads();
    {
        f32x4 f = {0.f, 0.f, 0.f, 0.f};
#pragma unroll
        for (int w = 0; w < 8; ++w) { const f32x4 a = *(const f32x4*)(parts + w * 2048 + tid * 4); f.x += a.x; f.y += a.y; f.z += a.z; f.w += a.w; }
        float* y = SAMPLE ? p.out + O_YS + (size_t)ts * D + tid * 4 : p.out + O_YP + (size_t)tk * D + tid * 4;
        f32x4 hh = *(const f32x4*)y;
        hh.x += f.x; hh.y += f.y; hh.z += f.z; hh.w += f.w;
        *(f32x4*)y = hh;
    }
}

static __device__ const unsigned char PAIR_LUT[64] = {0,1,2,3,4,5,6,7,8,9,10,11,12,13,14,15,16,17,18,19,20,21,22,23,32,33,34,35,36,48,49,50,51,64,65,66,80,81,96,97,112,113,128,144,160,176,192,208,224,240,0,0,0,0,0,0,0,0,0,0,0,0,0,0};
__device__ __forceinline__ void peer_route_wg(const Params& p, char* smem) {
    const int tid = otid(), lane = tid & 63, wave = tid >> 6;
    const int c = blockIdx.x, G = gridDim.x, h = c & 7;
    constexpr int KS = 144;
    char* K1 = smem; char* K2 = smem + 128 * KS;
    float* qw = (float*)(smem + 2 * 128 * KS) + wave * 128;
    float* lst = (float*)(smem + 2 * 128 * KS + 8 * 512) + wave * 160;
    float* l1v = lst; int* l1i = (int*)(lst + 16); float* l2v = lst + 32; int* l2i = (int*)(lst + 48); float* scv = lst + 64; int* eid = (int*)(lst + 80);
    __syncthreads();
    for (int i = tid; i < 2 * 128 * 8; i += 512) {
        const int tbl = i >> 10, r = (i >> 3) & 127, ch = i & 7;
        const h16* src = (tbl ? p.K2H : p.K1H) + ((size_t)(h * 128 + r)) * 64 + ch * 8;
        *(u32x4*)((tbl ? K2 : K1) + r * KS + ch * 16) = *(const u32x4*)src;
    }
    __syncthreads();
    const int nblk = TP / 64;
    volatile int* s_next = (volatile int*)(smem + LDS_BYTES - 64);
    for (;;) {
        __syncthreads();
        if (threadIdx.x == 0) s_next[0] = (int)atomicAdd(&p.ctl[6400 + 64 * h], 1u);
        __syncthreads();
        const int tb = s_next[0];
        if (tb >= nblk) break;
        float* SW = (float*)(smem + 65536) + wave * 2048;
        {
            const int r16 = lane & 15, g = lane >> 4;
            const h16* qrow = (const h16*)p.PQ + (size_t)(64 * tb + wave * 8 + (r16 & 7)) * 1024 + h * 128 + g * 8;
            h16x8 qa[2][2];
#pragma unroll
            for (int tb2 = 0; tb2 < 2; ++tb2)
#pragma unroll
                for (int kk = 0; kk < 2; ++kk) qa[tb2][kk] = *(const h16x8*)(qrow + tb2 * 64 + kk * 32);
#pragma unroll
            for (int tb2 = 0; tb2 < 2; ++tb2) {
                const char* KT = tb2 ? K2 : K1;
#pragma unroll
                for (int nt = 0; nt < 8; ++nt) {
                    f32x4 a = {0.f, 0.f, 0.f, 0.f};
#pragma unroll
                    for (int kk = 0; kk < 2; ++kk) {
                        const h16x8 kb = *(const h16x8*)(KT + (16 * nt + r16) * KS + (kk * 4 + g) * 16);
                        a = __builtin_amdgcn_mfma_f32_16x16x32_f16(qa[tb2][kk], kb, a, 0, 0, 0);
                    }
                    if (g < 2) {
#pragma unroll
                        for (int j = 0; j < 4; ++j) SW[(tb2 * 8 + 4 * g + j) * 128 + 16 * nt + r16] = a[j];
                    }
                }
            }
            asm volatile("s_waitcnt lgkmcnt(0)" ::: "memory");
        }
        for (int j = 0; j < 8; ++j) {
            const int tk = 64 * tb + wave * 8 + j;
            float s1[2], s2[2];
            s1[0] = SW[j * 128 + lane]; s1[1] = SW[j * 128 + 64 + lane]; s2[0] = SW[(8 + j) * 128 + lane]; s2[1] = SW[(8 + j) * 128 + 64 + lane];
            unsigned u[2];
            u[0] = f2ord(s1[0]); u[1] = f2ord(s1[1]);
            wave_select<2>(u, 16, lane, [&](int i, int pos) { l1v[pos] = s1[i]; l1i[pos] = lane + 64 * i; });
            u[0] = f2ord(s2[0]); u[1] = f2ord(s2[1]);
            wave_select<2>(u, 16, lane, [&](int i, int pos) { l2v[pos] = s2[i]; l2i[pos] = lane + 64 * i; });
            asm volatile("s_waitcnt lgkmcnt(0)" ::: "memory");
            {
                const int li16 = lane & 15; const bool second = (lane & 16) != 0;
                const float* lv = second ? l2v : l1v; const int* lix = second ? l2i : l1i;
                const float myv = lv[li16]; const int myi = lix[li16];
                int rank = 0;
#pragma unroll
                for (int b4 = 0; b4 < 4; ++b4) {
                    const f32x4 o = *(const f32x4*)(lv + 4 * b4);
                    rank += ((o.x > myv) || (o.x == myv && 4 * b4 < li16)) ? 1 : 0;
                    rank += ((o.y > myv) || (o.y == myv && 4 * b4 + 1 < li16)) ? 1 : 0;
                    rank += ((o.z > myv) || (o.z == myv && 4 * b4 + 2 < li16)) ? 1 : 0;
                    rank += ((o.w > myv) || (o.w == myv && 4 * b4 + 3 < li16)) ? 1 : 0;
                }
                float* sv = lst + 96 + (second ? 32 : 0); int* si = (int*)sv + 16;
                if (lane < 32) { sv[rank] = myv; si[rank] = myi; }
            }
            asm volatile("s_waitcnt lgkmcnt(0)" ::: "memory");
            float cv1; int e1; unsigned cu1[1];
            {
                const int ab = PAIR_LUT[lane], a = ab >> 4, b = ab & 15;
                const float* s1v = lst + 96; const int* s1i = (const int*)(lst + 112); const float* s2v = lst + 128; const int* s2i = (const int*)(lst + 144);
                cv1 = s1v[a] + s2v[b]; e1 = s1i[a] * 128 + s2i[b];
                cu1[0] = (lane < 50) ? f2ord(cv1) : 0u;
            }
            asm volatile("s_waitcnt lgkmcnt(0)" ::: "memory");
            wave_select<1>(cu1, 16, lane, [&](int i, int pos) { scv[pos] = cv1; eid[pos] = e1; });
            asm volatile("s_waitcnt lgkmcnt(0)" ::: "memory");
            const float sc = (lane < 16) ? scv[lane] : -3.0e38f;
            const float mx = wave_max(sc);
            const float ex = (lane < 16) ? __expf(sc - mx) : 0.f;
            const float sm = wave_sum(ex);
            if (lane < 16) { int2 o; o.x = eid[lane]; o.y = __float_as_int(ex / sm); p.ROUTE[((size_t)tk * 8 + h) * 16 + lane] = o; }
            asm volatile("s_waitcnt lgkmcnt(0)" ::: "memory");
        }
    }
}

__device__ __forceinline__ void peer_gather_wave(const Params& p, int tk, char* smem) {
    const int lane = otid() & 63;
    const int2 r0 = p.ROUTE[(size_t)tk * 128 + lane], r1 = p.ROUTE[(size_t)tk * 128 + 64 + lane];
    f32x2 hv[16];
#pragma unroll
    for (int k = 0; k < 4; ++k) {
        float t8[8]; unpk8(*(const u32x4*)(p.HN + (size_t)tk * D + 32 * lane + 8 * k), t8);
#pragma unroll
        for (int e = 0; e < 4; ++e) hv[4 * k + e] = (f32x2){t8[2 * e], t8[2 * e + 1]};
    }
    f32x2 facc[16];
#pragma unroll
    for (int i = 0; i < 16; ++i) facc[i] = (f32x2){0.f, 0.f};
    const float rs64 = rsqrtf(p.ROWSS[tk] * (1.f / D) + EPS) * (1.f / 64.f);
    const unsigned char* u8 = (const unsigned char*)p.PU; const unsigned char* v8 = (const unsigned char*)p.PV;
    const int xl = ((lane >> 5) & 1) * 4 + ((lane >> 4) & 1) * 2 + ((lane >> 3) & 1);
    u32x4 uA[8], uB[8], vv[8];
#define PG_ISSUE_U(b, uu) { const int _es = ((b) < 8) ? r0.x : r1.x; \
    _Pragma("unroll") for (int x = 0; x < 8; ++x) { const size_t e = (size_t)(unsigned)__builtin_amdgcn_readlane(_es, 8 * ((b) & 7) + x); \
        uu[x] = *(const u32x4*)(u8 + e * (D / 2) + lane * 16); } }
#define PG_APPLY(b, uu) { const int _es = ((b) < 8) ? r0.x : r1.x; const int _gs = ((b) < 8) ? r0.y : r1.y; \
    _Pragma("unroll") for (int x = 0; x < 8; ++x) { const size_t e = (size_t)(unsigned)__builtin_amdgcn_readlane(_es, 8 * ((b) & 7) + x); \
        vv[x] = *(const u32x4*)(v8 + e * (D / 2) + lane * 16); } \
    const float gl = __int_as_float(__shfl(_gs, 8 * ((b) & 7) + xl)); \
    float d[8]; \
    _Pragma("unroll") for (int x = 0; x < 8; ++x) { f32x2 a2 = {0.f, 0.f}; \
        _Pragma("unroll") for (int q = 0; q < 4; ++q) { const unsigned w = uu[x][q]; \
            a2 += hv[4 * q] * __builtin_amdgcn_cvt_scalef32_pk_f32_fp4(w, 1.0f, 0); a2 += hv[4 * q + 1] * __builtin_amdgcn_cvt_scalef32_pk_f32_fp4(w, 1.0f, 1); \
            a2 += hv[4 * q + 2] * __builtin_amdgcn_cvt_scalef32_pk_f32_fp4(w, 1.0f, 2); a2 += hv[4 * q + 3] * __builtin_amdgcn_cvt_scalef32_pk_f32_fp4(w, 1.0f, 3); } \
        d[x] = a2.x + a2.y; } \
    float r4[4], r2[2], r1v; \
    { const bool hi = (lane & 32) != 0; \
      _Pragma("unroll") for (int k = 0; k < 4; ++k) { const float keep = hi ? d[k + 4] : d[k], send = hi ? d[k] : d[k + 4]; r4[k] = keep + __shfl_xor(send, 32); } } \
    { const bool hi = (lane & 16) != 0; \
      _Pragma("unroll") for (int k = 0; k < 2; ++k) { const float keep = hi ? r4[k + 2] : r4[k], send = hi ? r4[k] : r4[k + 2]; r2[k] = keep + __shfl_xor(send, 16); } } \
    { const bool hi = (lane & 8) != 0; const float keep = hi ? r2[1] : r2[0], send = hi ? r2[0] : r2[1]; r1v = keep + __shfl_xor(send, 8); } \
    r1v += __shfl_xor(r1v, 4); r1v += __shfl_xor(r1v, 2); r1v += __shfl_xor(r1v, 1); \
    const float cwv = gl * gelu_exact(r1v * rs64) * (1.f / 16.f); \
    _Pragma("unroll") for (int x = 0; x < 8; ++x) { const float cw = __int_as_float(__builtin_amdgcn_readlane(__float_as_int(cwv), 8 * x)); const f32x2 cw2 = {cw, cw}; \
        _Pragma("unroll") for (int q = 0; q < 4; ++q) { const unsigned w = vv[x][q]; \
            facc[4 * q] += cw2 * __builtin_amdgcn_cvt_scalef32_pk_f32_fp4(w, 1.0f, 0); facc[4 * q + 1] += cw2 * __builtin_amdgcn_cvt_scalef32_pk_f32_fp4(w, 1.0f, 1); \
            facc[4 * q + 2] += cw2 * __builtin_amdgcn_cvt_scalef32_pk_f32_fp4(w, 1.0f, 2); facc[4 * q + 3] += cw2 * __builtin_amdgcn_cvt_scalef32_pk_f32_fp4(w, 1.0f, 3); } } }
    PG_ISSUE_U(0, uA)
#pragma unroll 1
    for (int b = 0; b < 16; b += 2) {
        PG_ISSUE_U(b + 1, uB)
        __builtin_amdgcn_sched_barrier(0);
        PG_APPLY(b, uA)
        __builtin_amdgcn_sched_barrier(0);
        if (b + 2 < 16) PG_ISSUE_U(b + 2, uA)
        __builtin_amdgcn_sched_barrier(0);
        PG_APPLY(b + 1, uB)
        __builtin_amdgcn_sched_barrier(0);
    }
#undef PG_ISSUE_U
#undef PG_APPLY
    float* y = p.out + O_YP + (size_t)tk * D + 32 * lane;
#pragma unroll
    for (int q = 0; q < 8; ++q) {
        f32x4 hh = {hv[2 * q].x + facc[2 * q].x, hv[2 * q].y + facc[2 * q].y, hv[2 * q + 1].x + facc[2 * q + 1].x, hv[2 * q + 1].y + facc[2 * q + 1].y};
        *(f32x4*)(y + 4 * q) = hh;
    }
}

__device__ __forceinline__ void phase9(const Params& p, char* smem) {
    const int c = blockIdx.x, G = gridDim.x;
    for (int tk = TP + (G - 1 - c); tk < TT; tk += G) peer_item<true>(p, tk, smem);
    peer_route_wg(p, smem);
}
__device__ __forceinline__ void phase10(const Params& p, char* smem) {
    const int gw = blockIdx.x * 8 + (otid() >> 6), NGW = gridDim.x * 8;
    for (int tk = gw; tk < TP; tk += NGW) peer_gather_wave(p, tk, smem);
}

__global__ __launch_bounds__(512, 2) void fwd_kernel(KArgs ka) {
    extern __shared__ __attribute__((aligned(16))) char smem[];
    const Params p = make_params(ka);
    volatile LAS unsigned* st = (volatile LAS unsigned*)(smem + LDS_BYTES - 16);
    if (threadIdx.x == 0) { st[0] = 0u; st[1] = 0u; }
    __syncthreads();
    XcdBarrier bar = xcd_barrier_post(p.ctl, st);
#ifndef PHASE_MASK
#define PHASE_MASK 0x7ff
#endif
#ifndef REP_MASK
  #define REP_MASK 0
#endif
#define PH(k, call) if (((PHASE_MASK >> (k)) & 1) && ka.ph_lo <= (k) && (k) < ka.ph_hi) { \
    for (int rep = 0; rep < 1 + ((REP_MASK >> (k)) & 1); ++rep) { call; if (rep + 1 < 1 + ((REP_MASK >> (k)) & 1)) xcd_barrier(bar); } \
    if ((k) + 1 < ka.ph_hi) xcd_barrier(bar); }
    PH(0, phase0(p, smem))
    PH(1, phase1(p, smem))
    PH(2, phase2(p, smem))
    PH(3, phase3(p, smem, rep))
    PH(4, phase4(p, smem))
    PH(5, phase5(p, smem))
    PH(6, phase6(p, smem))
    PH(8, phase8(p, smem, rep))
    PH(9, phase9(p, smem))
    PH(10, phase10(p, smem))
#undef PH
}


#ifdef DBG_RET_NAIVE
__global__ void dbg_ret_naive(KArgs ka) {
    const Params p = make_params(ka);
    const int idx = blockIdx.x * blockDim.x + threadIdx.x;
    const int dv = idx & 255, dk = (idx >> 8) & 127, h = (idx >> 15) & 7, b = idx >> 18;
    const float g = 1.f - exp2f(-5.f - (float)h);
    float S = 0.f;
    for (int t = 0; t < SEQ; ++t) {
        const size_t tok = (size_t)b * SEQ + t;
        S = g * S + (float)p.RK[tok * 1024 + h * 128 + dk] * (float)p.RV[tok * 2048 + h * 256 + dv];
    }
    p.out[O_SP + ((size_t)((b * 8 + h) * 128 + dk)) * 256 + dv] = S;
}
#endif
#ifdef DBG_SCALES
__global__ void dbg_scale_kernel(float* out) {
    const float sc[10] = {DBG_SCALES};
    const size_t offs[11] = {O_YP, O_YS, O_KP, O_VP, O_IKP, O_SP, O_KS, O_VS, O_IKS, O_SS, 28861440};
    for (size_t i = (size_t)blockIdx.x * blockDim.x + threadIdx.x; i < 28861440; i += (size_t)gridDim.x * blockDim.x) {
        float s = 0.f;
#pragma unroll
        for (int k = 0; k < 10; ++k) if (i >= offs[k] && i < offs[k + 1]) s = sc[k];
        out[i] = (s == 0.f) ? 0.f : out[i] * s;
    }
}
#endif
#ifndef MK_MULTI
#define MK_MULTI 0
#endif
extern "C" void kernel_launch(void* const* d_in, const int* in_sizes, int n_in, void* d_out, int out_size, void* d_ws, size_t ws_size, hipStream_t stream) {
    static int grid = 0;
    if (grid == 0) {
        int dev = 0, cus = 0;
        (void)hipGetDevice(&dev); (void)hipDeviceGetAttribute(&cus, hipDeviceAttributeMultiprocessorCount, dev);
        (void)hipFuncSetAttribute((const void*)fwd_kernel, hipFuncAttributeMaxDynamicSharedMemorySize, LDS_BYTES);
        int per_cu = 0;
        (void)hipOccupancyMaxActiveBlocksPerMultiprocessor(&per_cu, (const void*)fwd_kernel, 512, LDS_BYTES);
        (void)hipGetLastError();
        grid = (cus > 0 ? cus : 256) * 1;
        if (per_cu < 1) fprintf(stderr, "kernel_launch: occupancy query reports %d blocks per CU\n", per_cu);
    }
    KArgs p;
    memset(&p, 0, sizeof(p));
    if (n_in < 21) { fprintf(stderr, "kernel_launch: expected 21 inputs, got %d\n", n_in); return; }
    for (int i = 0; i < 21; ++i) p.in[i] = d_in[i];
    p.out = (float*)d_out;
    p.ws = (char*)d_ws;
    if (WS_END > ws_size) { fprintf(stderr, "kernel_launch: workspace too small (%zu > %zu)\n", (size_t)WS_END, ws_size); return; }
    (void)hipMemsetAsync(d_ws, 0, 65536, stream);
#if MK_MULTI
    for (int k = 0; k < 11; ++k) {
        p.ph_lo = k; p.ph_hi = k + 1;
        hipLaunchKernelGGL(fwd_kernel, dim3(grid), dim3(512), LDS_BYTES, stream, p);
    }
#else
    p.ph_lo = 0; p.ph_hi = 11;
    hipLaunchKernelGGL(fwd_kernel, dim3(grid), dim3(512), LDS_BYTES, stream, p);
#endif
#ifdef DBG_RET_NAIVE
    hipLaunchKernelGGL(dbg_ret_naive, dim3(2 * 8 * 128 * 256 / 256), dim3(256), 0, stream, p);
#endif
#ifdef DBG_SCALES
    hipLaunchKernelGGL(dbg_scale_kernel, dim3(1024), dim3(256), 0, stream, (float*)d_out);
#endif
}
```

```cpp
#include <hip/hip_runtime.h>
#include <stdint.h>
#include <stdio.h>
#include <string.h>
#include <math.h>
#include <type_traits>

typedef _Float16 h16;
typedef _Float16 h16x8 __attribute__((ext_vector_type(8)));
typedef _Float16 h16x4 __attribute__((ext_vector_type(4)));
typedef _Float16 h16x2 __attribute__((ext_vector_type(2)));
typedef float f32x4 __attribute__((ext_vector_type(4)));
typedef float f32x2 __attribute__((ext_vector_type(2)));
typedef unsigned u32x4 __attribute__((ext_vector_type(4)));
typedef unsigned long long u64;

#define LAS __attribute__((address_space(3)))

constexpr int D = 2048, SEQ = 4096, TP = 8192, NS = 8, TT = TP + NS;
constexpr int NWP = 15616;
constexpr int NW0 = 15504;
constexpr int PAST = 16384, PAGE = 128, NPAGES = 128, LS = PAST + 1;
constexpr int NEXP = 16384;
constexpr float EPS = 1e-6f;
constexpr int C_RQ = 0, C_RK = 1024, C_RV = 2048, C_RG = 4096, C_AQ = 6144, C_AK = 8192, C_AV = 8704, C_IQ = 9216, C_IK = 11264, C_IW = 11392, C_GR = 11408, C_GA = 13456;
constexpr size_t O_YP = 0, O_YS = 16777216, O_KP = 16793600, O_VP = 20987904, O_IKP = 25182208, O_SP = 26230784,
                 O_KS = 26755072, O_VS = 26759168, O_IKS = 26763264, O_SS = 26764288;
constexpr int LDS_BYTES = 139264;
constexpr int SCS = 4112;
constexpr int SSCS = 16400;

#define XB_TMO      128
#define XB_XCNT(j)  (256  + 64 * (j))
#define XB_XSUB(j)  (1280 + 64 * (j))
#define XB_XGEN(j)  (2304 + 64 * (j))
#define XB_TOP      3328
#define XB_TOPGEN   3392
#define XCD_BAR_WORDS 3456
#define XB_SPIN_CAP (1u << 22)
__device__ __forceinline__ unsigned xb_ld(unsigned* p)              { return __hip_atomic_load(p, __ATOMIC_RELAXED, __HIP_MEMORY_SCOPE_AGENT); }
__device__ __forceinline__ unsigned xb_add(unsigned* p, unsigned v) { return __hip_atomic_fetch_add(p, v, __ATOMIC_RELAXED, __HIP_MEMORY_SCOPE_AGENT); }
__device__ __forceinline__ unsigned xb_xcc_id() { return (unsigned)__builtin_amdgcn_s_getreg((3 << 11) | 20) & 0xFu; }
#define XB_SPIN(cond, bar) do { unsigned _sp = 0; while (cond) { __builtin_amdgcn_s_sleep(1); \
    if ((++_sp & 255u) == 0u) { if (xb_ld(&(bar)[XB_TMO])) break; if (_sp > XB_SPIN_CAP) { atomicAdd(&(bar)[XB_TMO], 1u); break; } } } } while (0)
struct XcdBarrier { unsigned* bar; unsigned x; volatile LAS unsigned* st; };
__device__ __forceinline__ XcdBarrier xcd_barrier_post(unsigned* bar, volatile LAS unsigned* st) {
    XcdBarrier b; b.bar = bar; b.x = xb_xcc_id(); b.st = st;
    if (threadIdx.x == 0) (void)xb_add(&bar[XB_XCNT(b.x)], 1u);
    return b;
}
__device__ __forceinline__ void xcd_barrier_complete(unsigned* bar, unsigned x, unsigned& nloc, unsigned& nx) {
    const unsigned G = gridDim.x * gridDim.y * gridDim.z;
    unsigned sum, cnt, mine, sp = 0u;
    for (;;) {
        sum = 0u; cnt = 0u; mine = 0u;
#pragma unroll
        for (unsigned j = 0; j < 16; ++j) { const unsigned c = xb_ld(&bar[XB_XCNT(j)]); sum += c; cnt += (c > 0u) ? 1u : 0u; mine = (j == x) ? c : mine; }
        if (sum == G) break;
        __builtin_amdgcn_s_sleep(1);
        if ((++sp & 255u) == 0u) { if (xb_ld(&bar[XB_TMO])) break; if (sp > XB_SPIN_CAP) { atomicAdd(&bar[XB_TMO], 1u); break; } }
    }
    nloc = mine > 0u ? mine : 1u; nx = cnt > 0u ? cnt : 1u;
}
__device__ __forceinline__ void xcd_barrier(const XcdBarrier& b) {
    asm volatile("s_waitcnt vmcnt(0)" ::: "memory");
    __syncthreads();
    if (threadIdx.x == 0) {
        unsigned* bar = b.bar;
        __builtin_amdgcn_s_waitcnt(0);
        volatile LAS unsigned* stw = (volatile LAS unsigned*)(unsigned)(LDS_BYTES - 16);
        unsigned nloc = stw[0], nx = stw[1];
        if (nloc == 0u) { xcd_barrier_complete(bar, b.x, nloc, nx); stw[0] = nloc; stw[1] = nx; }
        const unsigned old = xb_add(&bar[XB_XSUB(b.x)], 1u);
        const unsigned gen = old / nloc;
        if (old + 1u == (gen + 1u) * nloc) {
            __builtin_amdgcn_fence(__ATOMIC_RELEASE, "agent");
            asm volatile("s_waitcnt vmcnt(0)" ::: "memory");
            const unsigned og = xb_add(&bar[XB_TOP], 1u);
            const unsigned tg = og / nx;
            if (og + 1u == (tg + 1u) * nx) xb_add(&bar[XB_TOPGEN], 1u);
            else XB_SPIN(xb_ld(&bar[XB_TOPGEN]) == tg, bar);
            __builtin_amdgcn_fence(__ATOMIC_ACQUIRE, "agent");
            xb_add(&bar[XB_XGEN(b.x)], 1u);
            asm volatile("s_waitcnt vmcnt(0)" ::: "memory");
        } else {
            XB_SPIN(xb_ld(&bar[XB_XGEN(b.x)]) == gen, bar);
            __builtin_amdgcn_fence(__ATOMIC_ACQUIRE, "agent");
            asm volatile("s_waitcnt vmcnt(0)" ::: "memory");
        }
    }
    __syncthreads();
}

struct Params {
    const float *x_prompt, *x_sample, *cache_k, *cache_v, *cache_kidx, *state_ret;
    const int* page_table;
    const float *norm1_w, *w_in, *q_norm_w, *k_norm_w, *ret_gn_w, *w_ret_o, *w_att_o, *w_out, *norm2_w, *peer_wq, *peer_k1, *peer_k2, *peer_u, *peer_v;
    float* out;
    unsigned* ctl;
    float* ROWSS;
    h16 *XN, *WinT, *WrT, *WaT, *WoT, *WqT, *PU, *PV, *K1H, *K2H;
    int2* ROUTE;
    unsigned char *AQ8, *AK8;
    h16 *RQ, *RK, *RV, *RG, *AQ, *AK, *AV, *IQ, *IK, *GR, *GA;
    float* IW;
    float* KV; h16* SPT; int* TOPI; h16 *RN, *ATT, *MIX, *HN; float* MIXF; float* PQ;
    float2* ROPE;
    float *XNS, *ZS, *SRQ, *SRK, *SRV, *SRG, *SAQ, *SAK, *SAV, *SIQ, *SIK, *SIW, *SGR, *SGA, *SSC;
    int* STOP;
    float *SRN, *SATT, *SMIX, *SHN, *SPQ;
};
struct KArgs {
    const void* in[21];
    float* out;
    char* ws;
    int ph_lo, ph_hi;
};
constexpr size_t al256(size_t x) { return (x + 255) & ~(size_t)255; }
constexpr size_t WS_CTL = 0;
constexpr size_t WS_XN = WS_CTL + 65536;
constexpr size_t WS_WINT = WS_XN + al256((size_t)TP * D * 2);
constexpr size_t WS_WRT = WS_WINT + al256((size_t)NWP * D * 2);
constexpr size_t WS_WAT = WS_WRT + al256((size_t)D * D * 2);
constexpr size_t WS_WOT = WS_WAT + al256((size_t)D * D * 2);
constexpr size_t WS_WQT = WS_WOT + al256((size_t)D * D * 2);
constexpr size_t WS_PU = WS_WQT + al256((size_t)1024 * D * 2);
constexpr size_t WS_PV = WS_PU + al256((size_t)NEXP * D * 2);
constexpr size_t WS_RQ = WS_PV + al256((size_t)NEXP * D * 2);
constexpr size_t WS_RK = WS_RQ + al256((size_t)TP * 1024 * 2);
constexpr size_t WS_RV = WS_RK + al256((size_t)TP * 1024 * 2);
constexpr size_t WS_RG = WS_RV + al256((size_t)TP * 2048 * 2);
constexpr size_t WS_AQ = WS_RG + al256((size_t)TP * 2048 * 2);
constexpr size_t WS_AK = WS_AQ + al256((size_t)TP * 2048 * 2);
constexpr size_t WS_AV = WS_AK + al256((size_t)TP * 512 * 2);
constexpr size_t WS_IQ = WS_AV + al256((size_t)TP * 512 * 2);
constexpr size_t WS_IK = WS_IQ + al256((size_t)TP * 2048 * 2);
constexpr size_t WS_GR = WS_IK + al256((size_t)TP * 128 * 2);
constexpr size_t WS_GA = WS_GR + al256((size_t)TP * 2048 * 2);
constexpr size_t WS_IW = WS_GA + al256((size_t)TP * 2048 * 2);
constexpr size_t WS_KV = WS_IW + al256((size_t)TP * 16 * 4);
constexpr size_t WS_SPT = WS_KV + al256((size_t)2 * 8 * 32 * 128 * 256 * 4);
constexpr size_t WS_TOPI = WS_SPT + al256((size_t)2 * 8 * 32 * 256 * 128 * 2);
constexpr size_t WS_RN = WS_TOPI + al256((size_t)TP * 256 * 4);
constexpr size_t WS_ATT = WS_RN + al256((size_t)TP * D * 2);
constexpr size_t WS_MIX = WS_ATT + al256((size_t)TP * D * 2);
constexpr size_t WS_HN = WS_MIX + al256((size_t)TP * D * 2);
constexpr size_t WS_MIXF = WS_HN + al256((size_t)TP * D * 2);
constexpr size_t WS_PQ = WS_MIXF + al256((size_t)TP * D * 4);
constexpr size_t WS_ROPE = WS_PQ + al256((size_t)TP * 1024 * 4);
constexpr size_t WS_XNS = WS_ROPE + al256((size_t)4097 * 64 * 8);
constexpr size_t WS_ZS = WS_XNS + al256(8 * D * 4);
constexpr size_t WS_SRQ = WS_ZS + al256((size_t)8 * NW0 * 4);
constexpr size_t WS_SRK = WS_SRQ + al256(8 * 1024 * 4);
constexpr size_t WS_SRV = WS_SRK + al256(8 * 1024 * 4);
constexpr size_t WS_SRG = WS_SRV + al256(8 * 2048 * 4);
constexpr size_t WS_SAQ = WS_SRG + al256(8 * 2048 * 4);
constexpr size_t WS_SAK = WS_SAQ + al256(8 * 2048 * 4);
constexpr size_t WS_SAV = WS_SAK + al256(8 * 512 * 4);
constexpr size_t WS_SIQ = WS_SAV + al256(8 * 512 * 4);
constexpr size_t WS_SIK = WS_SIQ + al256(8 * 2048 * 4);
constexpr size_t WS_SIW = WS_SIK + al256(8 * 128 * 4);
constexpr size_t WS_SGR = WS_SIW + al256(8 * 16 * 4);
constexpr size_t WS_SGA = WS_SGR + al256(8 * 2048 * 4);
constexpr size_t WS_SSC = WS_SGA + al256(8 * 2048 * 4);
constexpr size_t WS_STOP = WS_SSC + al256((size_t)8 * SSCS * 4);
constexpr size_t WS_SRN = WS_STOP + al256(8 * 256 * 4);
constexpr size_t WS_SATT = WS_SRN + al256(8 * 2048 * 4);
constexpr size_t WS_SMIX = WS_SATT + al256(8 * 2048 * 4);
constexpr size_t WS_SHN = WS_SMIX + al256(8 * 2048 * 4);
constexpr size_t WS_SPQ = WS_SHN + al256(8 * 2048 * 4);
constexpr size_t WS_K1H = WS_SPQ + al256(8 * 1024 * 4);
constexpr size_t WS_K2H = WS_K1H + al256(8 * 128 * 64 * 2);
constexpr size_t WS_ROUTE = WS_K2H + al256(8 * 128 * 64 * 2);
constexpr size_t WS_AQ8 = WS_ROUTE + al256((size_t)TP * 128 * 8);
constexpr size_t WS_AK8 = WS_AQ8 + al256((size_t)TP * 2048);
constexpr size_t WS_END = WS_AK8 + al256((size_t)TP * 512);
__device__ __forceinline__ Params make_params(const KArgs& a) {
    Params p;
    p.x_prompt = (const float*)a.in[0]; p.x_sample = (const float*)a.in[1]; p.cache_k = (const float*)a.in[2]; p.cache_v = (const float*)a.in[3];
    p.cache_kidx = (const float*)a.in[4]; p.state_ret = (const float*)a.in[5]; p.page_table = (const int*)a.in[6];
    p.norm1_w = (const float*)a.in[7]; p.w_in = (const float*)a.in[8]; p.q_norm_w = (const float*)a.in[9]; p.k_norm_w = (const float*)a.in[10];
    p.ret_gn_w = (const float*)a.in[11]; p.w_ret_o = (const float*)a.in[12]; p.w_att_o = (const float*)a.in[13]; p.w_out = (const float*)a.in[14];
    p.norm2_w = (const float*)a.in[15]; p.peer_wq = (const float*)a.in[16]; p.peer_k1 = (const float*)a.in[17]; p.peer_k2 = (const float*)a.in[18];
    p.peer_u = (const float*)a.in[19]; p.peer_v = (const float*)a.in[20];
    p.out = a.out;
    char* w = a.ws;
    p.ctl = (unsigned*)(w + WS_CTL); p.ROWSS = (float*)(w + WS_CTL + 32768);
    p.XN = (h16*)(w + WS_XN); p.WinT = (h16*)(w + WS_WINT); p.WrT = (h16*)(w + WS_WRT); p.WaT = (h16*)(w + WS_WAT); p.WoT = (h16*)(w + WS_WOT); p.WqT = (h16*)(w + WS_WQT);
    p.PU = (h16*)(w + WS_PU); p.PV = (h16*)(w + WS_PV); p.K1H = (h16*)(w + WS_K1H); p.K2H = (h16*)(w + WS_K2H); p.ROUTE = (int2*)(w + WS_ROUTE); p.AQ8 = (unsigned char*)(w + WS_AQ8); p.AK8 = (unsigned char*)(w + WS_AK8);
    p.RQ = (h16*)(w + WS_RQ); p.RK = (h16*)(w + WS_RK); p.RV = (h16*)(w + WS_RV); p.RG = (h16*)(w + WS_RG);
    p.AQ = (h16*)(w + WS_AQ); p.AK = (h16*)(w + WS_AK); p.AV = (h16*)(w + WS_AV); p.IQ = (h16*)(w + WS_IQ); p.IK = (h16*)(w + WS_IK);
    p.GR = (h16*)(w + WS_GR); p.GA = (h16*)(w + WS_GA); p.IW = (float*)(w + WS_IW);
    p.KV = (float*)(w + WS_KV); p.SPT = (h16*)(w + WS_SPT); p.TOPI = (int*)(w + WS_TOPI);
    p.RN = (h16*)(w + WS_RN); p.ATT = (h16*)(w + WS_ATT); p.MIX = (h16*)(w + WS_MIX); p.HN = (h16*)(w + WS_HN);
    p.MIXF = (float*)(w + WS_MIXF); p.PQ = (float*)(w + WS_PQ); p.ROPE = (float2*)(w + WS_ROPE);
    p.XNS = (float*)(w + WS_XNS); p.ZS = (float*)(w + WS_ZS);
    p.SRQ = (float*)(w + WS_SRQ); p.SRK = (float*)(w + WS_SRK); p.SRV = (float*)(w + WS_SRV); p.SRG = (float*)(w + WS_SRG);
    p.SAQ = (float*)(w + WS_SAQ); p.SAK = (float*)(w + WS_SAK); p.SAV = (float*)(w + WS_SAV);
    p.SIQ = (float*)(w + WS_SIQ); p.SIK = (float*)(w + WS_SIK); p.SIW = (float*)(w + WS_SIW);
    p.SGR = (float*)(w + WS_SGR); p.SGA = (float*)(w + WS_SGA); p.SSC = (float*)(w + WS_SSC); p.STOP = (int*)(w + WS_STOP);
    p.SRN = (float*)(w + WS_SRN); p.SATT = (float*)(w + WS_SATT); p.SMIX = (float*)(w + WS_SMIX); p.SHN = (float*)(w + WS_SHN); p.SPQ = (float*)(w + WS_SPQ);
    return p;
}

__device__ __forceinline__ float wave_sum(float v) {
#pragma unroll
    for (int o = 32; o > 0; o >>= 1) v += __shfl_xor(v, o);
    return v;
}
__device__ __forceinline__ float wave_max(float v) {
#pragma unroll
    for (int o = 32; o > 0; o >>= 1) v = fmaxf(v, __shfl_xor(v, o));
    return v;
}
__device__ __forceinline__ int otid() { int t = threadIdx.x; asm volatile("" : "+v"(t)); return t; }
__device__ __forceinline__ unsigned f2ord(float f) { unsigned b = __float_as_uint(f); return b ^ ((unsigned)((int)b >> 31) | 0x80000000u); }
__device__ __forceinline__ unsigned pkh(float lo, float hi) { h16x2 v; v.x = (h16)lo; v.y = (h16)hi; return __builtin_bit_cast(unsigned, v); }
__device__ __forceinline__ u32x4 pk8(const float* v) { u32x4 r; r.x = pkh(v[0], v[1]); r.y = pkh(v[2], v[3]); r.z = pkh(v[4], v[5]); r.w = pkh(v[6], v[7]); return r; }
__device__ __forceinline__ void unpk8(u32x4 r, float* v) {
    const unsigned rx = r.x, ry = r.y, rz = r.z, rw = r.w;
    h16x2 a = __builtin_bit_cast(h16x2, rx), b = __builtin_bit_cast(h16x2, ry), c = __builtin_bit_cast(h16x2, rz), d = __builtin_bit_cast(h16x2, rw);
    v[0] = (float)a.x; v[1] = (float)a.y; v[2] = (float)b.x; v[3] = (float)b.y; v[4] = (float)c.x; v[5] = (float)c.y; v[6] = (float)d.x; v[7] = (float)d.y;
}
__device__ __forceinline__ float sigmoidf_(float x) { return __builtin_amdgcn_rcpf(1.f + __expf(-x)); }
__device__ __forceinline__ float siluf_(float x) { return x * __builtin_amdgcn_rcpf(1.f + __expf(-x)); }
__device__ __forceinline__ float gelu_exact(float x) { return 0.5f * x * (1.f + erff(x * 0.70710678118654752f)); }
__device__ __forceinline__ float ret_log_g(int h) { return logf(1.f - exp2f(-5.f - (float)h)); }

__device__ __forceinline__ unsigned off_b(unsigned row, unsigned ch) { return 256u * row + 16u * (ch ^ (((row & 3) << 2) | ((row >> 2) & 3))); }
__device__ __forceinline__ unsigned tr_addr16(unsigned lane, unsigned c, unsigned t) {
    const unsigned g = lane >> 4, q = (lane & 15) >> 2, p = lane & 3;
    return off_b(8 * g + 4 * t + q, 2 * c + (p >> 1)) + 8 * (p & 1);
}
template <int IMM>
__device__ __forceinline__ h16x8 tr_read8o(unsigned a0, unsigned a1) {
    h16x4 r0, r1;
    asm volatile("ds_read_b64_tr_b16 %0, %2 offset:%4\n\tds_read_b64_tr_b16 %1, %3 offset:%4\n\ts_waitcnt lgkmcnt(0)" : "=&v"(r0), "=&v"(r1) : "v"(a0), "v"(a1), "n"(IMM) : "memory");
    h16x8 r; r[0] = r0[0]; r[1] = r0[1]; r[2] = r0[2]; r[3] = r0[3]; r[4] = r1[0]; r[5] = r1[1]; r[6] = r1[2]; r[7] = r1[3];
    return r;
}
__device__ __forceinline__ void tr_read8x4(unsigned z0, unsigned z1, unsigned c0, h16x8 (&out)[4]) {
    h16x4 r[8];
    const unsigned a0 = z0 ^ (32u * c0), a1 = z1 ^ (32u * c0), a2 = z0 ^ (32u * (c0 + 1)), a3 = z1 ^ (32u * (c0 + 1));
    const unsigned a4 = z0 ^ (32u * (c0 + 2)), a5 = z1 ^ (32u * (c0 + 2)), a6 = z0 ^ (32u * (c0 + 3)), a7 = z1 ^ (32u * (c0 + 3));
    asm volatile("ds_read_b64_tr_b16 %0, %8\n\tds_read_b64_tr_b16 %1, %9\n\tds_read_b64_tr_b16 %2, %10\n\tds_read_b64_tr_b16 %3, %11\n\t"
                 "ds_read_b64_tr_b16 %4, %12\n\tds_read_b64_tr_b16 %5, %13\n\tds_read_b64_tr_b16 %6, %14\n\tds_read_b64_tr_b16 %7, %15\n\ts_waitcnt lgkmcnt(0)"
                 : "=&v"(r[0]), "=&v"(r[1]), "=&v"(r[2]), "=&v"(r[3]), "=&v"(r[4]), "=&v"(r[5]), "=&v"(r[6]), "=&v"(r[7])
                 : "v"(a0), "v"(a1), "v"(a2), "v"(a3), "v"(a4), "v"(a5), "v"(a6), "v"(a7) : "memory");
#pragma unroll
    for (int i = 0; i < 4; ++i) { h16x8 v; v[0] = r[2 * i][0]; v[1] = r[2 * i][1]; v[2] = r[2 * i][2]; v[3] = r[2 * i][3]; v[4] = r[2 * i + 1][0]; v[5] = r[2 * i + 1][1]; v[6] = r[2 * i + 1][2]; v[7] = r[2 * i + 1][3]; out[i] = v; }
}
template <int I, int N, class F>
__device__ __forceinline__ void static_for(F&& f) { if constexpr (I < N) { f(std::integral_constant<int, I>{}); static_for<I + 1, N>(f); } }
__device__ __forceinline__ unsigned lds_u32(const void* p) { return (unsigned)(size_t)(const LAS char*)p; }

__device__ __forceinline__ int wave_sum_small(unsigned cnt) {
    int c = 0;
#pragma unroll
    for (int b = 0; b < 7; ++b) c += __popcll(__ballot((cnt >> b) & 1u)) << b;
    return c;
}
template <int NV>
__device__ __forceinline__ void wave_kth_r4(const unsigned (&u)[NV], int K, unsigned& tau, int& need_eq) {
    tau = 0u; bool exact = false;
    for (int bit = 30; bit >= 0; bit -= 2) {
        const unsigned c1 = tau | (1u << bit), c2 = tau | (2u << bit), c3 = tau | (3u << bit);
        int n1 = 0, n2 = 0, n3 = 0;
#pragma unroll
        for (int i = 0; i < NV; ++i) { n1 += __popcll(__ballot(u[i] >= c1)); n2 += __popcll(__ballot(u[i] >= c2)); n3 += __popcll(__ballot(u[i] >= c3)); }
        int n = -1;
        if (n3 >= K) { tau = c3; n = n3; } else if (n2 >= K) { tau = c2; n = n2; } else if (n1 >= K) { tau = c1; n = n1; }
        if (n == K) { exact = true; break; }
    }
    int cg = 0;
    if (!exact && tau != 0xFFFFFFFFu) {
#pragma unroll
        for (int i = 0; i < NV; ++i) cg += __popcll(__ballot(u[i] > tau));
    }
    need_eq = exact ? K : K - cg;
}
template <int NV>
__device__ __forceinline__ void wave_kth_dyn(const unsigned (&u)[NV], int ngrp, int K, unsigned& tau, int& need_eq) {
    tau = 0u; int cg = 0; bool exact = false;
    for (int bit = 31; bit >= -1; --bit) {
        const unsigned cand = (bit >= 0) ? (tau | (1u << bit)) : tau + 1u;
        unsigned cnt = 0u;
        static_for<0, NV / 8>([&](auto G8) {
            constexpr int g8 = decltype(G8)::value;
            if (g8 < ngrp) {
#pragma unroll
                for (int i = 0; i < 8; ++i) cnt += (u[g8 * 8 + i] >= cand) ? 1u : 0u;
            }
        });
        const int c = wave_sum_small(cnt);
        if (bit >= 0) { if (c >= K) tau = cand; if (c == K) { exact = true; break; } } else cg = (tau == 0xFFFFFFFFu) ? 0 : c;
    }
    need_eq = exact ? K : K - cg;
}
template <int NV>
__device__ __forceinline__ void wave_kth(const unsigned (&u)[NV], int K, unsigned& tau, int& need_eq) {
    tau = 0u; int cg = 0; bool exact = false;
    for (int bit = 31; bit >= -1; --bit) {
        const unsigned cand = (bit >= 0) ? (tau | (1u << bit)) : tau + 1u;
        int c = 0;
        if constexpr (NV >= 8) {
            unsigned cnt = 0u;
#pragma unroll
            for (int i = 0; i < NV; ++i) cnt += (u[i] >= cand) ? 1u : 0u;
            c = wave_sum_small(cnt);
        } else {
#pragma unroll
            for (int i = 0; i < NV; ++i) c += __popcll(__ballot(u[i] >= cand));
        }
        if (bit >= 0) { if (c >= K) tau = cand; if (c == K) { exact = true; break; } } else cg = (tau == 0xFFFFFFFFu) ? 0 : c;
    }
    need_eq = exact ? K : K - cg;
}

template <bool WIN>
__device__ __forceinline__ void p0_transpose_item(const float* W, int K, int N, h16* WT, float* scr, int item, int nblk, int lane, const float* kscale = nullptr) {
    const int kb = item / nblk, nb = item % nblk, k0 = 64 * kb, n0 = 32 * nb;
    float tv[32];
#pragma unroll
    for (int i = 0; i < 32; ++i) { const int kk = 2 * i + (lane >> 5), n = n0 + (lane & 31); tv[i] = (n < N) ? W[(size_t)(k0 + kk) * N + n] : 0.f; }
#pragma unroll
    for (int i = 0; i < 32; ++i) { const int kk = 2 * i + (lane >> 5); scr[kk * 33 + (lane & 31)] = tv[i]; }
    asm volatile("s_waitcnt lgkmcnt(0)" ::: "memory");
    const int c = lane & 7;
#pragma unroll
    for (int j = 0; j < 4; ++j) {
        const int nl = (lane >> 3) + 8 * j, n = n0 + nl;
        const float* s = scr + (8 * c) * 33 + nl;
        float v[8];
#pragma unroll
        for (int e = 0; e < 8; ++e) v[e] = s[e * 33];
        if (kscale) {
#pragma unroll
            for (int e = 0; e < 8; ++e) v[e] *= kscale[k0 + 8 * c + e];
        }
        int dst = n;
        if (WIN) { if (n >= C_GR) dst = n - 16; else if (n >= C_IW) dst = 15488 + (n - C_IW); }
        if (n < N) *(u32x4*)(WT + (size_t)dst * K + k0 + 8 * c) = pk8(v);
    }
    asm volatile("s_waitcnt lgkmcnt(0)" ::: "memory");
}

__device__ __forceinline__ void phase0(const Params& p, char* smem) {
    const int tid = otid(), lane = tid & 63, wave = tid >> 6;
    const int gw = blockIdx.x * 8 + wave, NGW = gridDim.x * 8;
    const int gt = blockIdx.x * 512 + tid, NGT = gridDim.x * 512;
    for (int r = gw; r < TT; r += NGW) {
        const float* x = (r < TP) ? p.x_prompt + (size_t)r * D : p.x_sample + (size_t)(r - TP) * D;
        f32x4 v[8]; float ss = 0.f;
#pragma unroll
        for (int j = 0; j < 8; ++j) { v[j] = *(const f32x4*)(x + 4 * (lane + 64 * j)); ss += v[j].x * v[j].x + v[j].y * v[j].y + v[j].z * v[j].z + v[j].w * v[j].w; }
        ss = wave_sum(ss);
        const float rs = rsqrtf(ss * (1.f / D) + EPS);
#pragma unroll
        for (int j = 0; j < 8; ++j) {
            const f32x4 w = *(const f32x4*)(p.norm1_w + 4 * (lane + 64 * j));
            const float a = v[j].x * rs * w.x, b = v[j].y * rs * w.y, c = v[j].z * rs * w.z, d = v[j].w * rs * w.w;
            if (r < TP) { f32x2 o; o.x = __uint_as_float(pkh(a, b)); o.y = __uint_as_float(pkh(c, d)); *(f32x2*)(p.XN + (size_t)r * D + 4 * (lane + 64 * j)) = o; }
            else { f32x4 o = {a, b, c, d}; *(f32x4*)(p.XNS + (size_t)(r - TP) * D + 4 * (lane + 64 * j)) = o; }
        }
    }
    {
        float* scr = (float*)smem + wave * (64 * 33);
        constexpr int NB_IN = (NW0 + 31) / 32;
        constexpr int I_IN = 32 * NB_IN;
        for (int it = gw; it < I_IN; it += NGW) p0_transpose_item<true>(p.w_in, D, NW0, p.WinT, scr, it, NB_IN, lane);
    }
    for (int i = gt; i < (NWP - NW0) * D / 8; i += NGT) { u32x4 z = {0u, 0u, 0u, 0u}; *(u32x4*)(p.WinT + (size_t)NW0 * D + (size_t)i * 8) = z; }
    for (int i = gt; i < 2 * 8 * 128 * 64 / 8; i += NGT) {
        const int half = 8 * 128 * 64 / 8;
        const float* src = (i < half) ? p.peer_k1 + (size_t)i * 8 : p.peer_k2 + (size_t)(i - half) * 8;
        h16* dst = (i < half) ? p.K1H + (size_t)i * 8 : p.K2H + (size_t)(i - half) * 8;
        const f32x4 a = *(const f32x4*)src, b = *(const f32x4*)(src + 4);
        u32x4 o; o.x = pkh(a.x, a.y); o.y = pkh(a.z, a.w); o.z = pkh(b.x, b.y); o.w = pkh(b.z, b.w);
        *(u32x4*)dst = o;
    }
    for (int i = gt; i < 4097 * 64; i += NGT) {
        const int pi = i >> 6, fi = i & 63;
        const double pos = (pi == 4096) ? 16384.0 : (double)pi;
        double fq = 1.0;
        if (fi & 1) fq *= 0.86596432336006535; if (fi & 2) fq *= 0.74989420933245583; if (fi & 4) fq *= 0.56234132519034908;
        if (fi & 8) fq *= 0.31622776601683794; if (fi & 16) fq *= 0.1; if (fi & 32) fq *= 0.01;
        const double rev = pos * fq * 0.15915494309189533577;
        const double fr = rev - __builtin_rint(rev);
        float2 cs; cs.x = __builtin_amdgcn_cosf((float)fr); cs.y = __builtin_amdgcn_sinf((float)fr);
        p.ROPE[i] = cs;
    }
}

constexpr int G_BK = 64, G_HALF = 128, G_HT = G_HALF * G_BK;
__device__ __forceinline__ int g_lds_byte(int r, int c) {
    int st = (r >> 4) * 2 + (c >> 5), rr = r & 15, cc = c & 31, ob = rr * 64 + cc * 2;
    return st * 1024 + (ob ^ (((ob >> 9) & 1) << 5));
}
__device__ __forceinline__ void g_stage_rc(int b, int& R, int& C) {
    int st = b / 1024, sb = b % 1024, swz = sb ^ (((sb >> 9) & 1) << 5);
    R = (st >> 1) * 16 + swz / 64; C = (st & 1) * 32 + (swz % 64) / 2;
}

__device__ __forceinline__ void gemm_core(const h16* A, const h16* Bt, const int brow, const int bcol, const int K, f32x4 (&acc)[2][2][4][2], h16* shm) {
  #define SA(b,h) (shm+((b)*2+(h))*G_HT)
  #define SB(b,h) (shm+(4+(b)*2+(h))*G_HT)
  #define STAGE_X(T,P,BASE,br,kt) do{const char* _ub=(const char*)(BASE)+((long)(br)*K+(long)(kt)*G_BK)*2; \
    for(int _i=0;_i<2;++_i){int _b=(T)*16+_i*8192;int _r,_c;g_stage_rc(_b,_r,_c); \
      const unsigned _vo=(unsigned)((_r*K+_c)*2); \
      __builtin_amdgcn_global_load_lds((const unsigned*)(_ub+_vo), \
        (unsigned*)((char*)(P)+_b),16,0,0);}}while(0)
  #define STAGE(P,BASE,br,kt) STAGE_X(t0,P,BASE,br,kt)
  #define LDA(dst,b,h) for(int m=0;m<4;++m)for(int k=0;k<2;++k) \
    dst[m][k]=*reinterpret_cast<const h16x8*>((char*)SA(b,h)+g_lds_byte(wr*64+m*16+fr,k*32+fq*8))
  #define LDB(dst,b,h) for(int n=0;n<2;++n)for(int k=0;k<2;++k) \
    dst[n][k]=*reinterpret_cast<const h16x8*>((char*)SB(b,h)+g_lds_byte(wc*32+n*16+fr,k*32+fq*8))
  #define MMA(ai,bj,At,Bx) do{__builtin_amdgcn_s_setprio(1); \
    for(int m=0;m<4;++m)for(int n=0;n<2;++n)for(int k=0;k<2;++k) \
      acc[ai][bj][m][n]=__builtin_amdgcn_mfma_f32_16x16x32_f16(Bx[n][k],At[m][k],acc[ai][bj][m][n],0,0,0); \
    __builtin_amdgcn_s_setprio(0);}while(0)
  #define WAIT_V(n) asm volatile("s_waitcnt vmcnt(" #n ")":::"memory")
  #define WAIT_L(n) asm volatile("s_waitcnt lgkmcnt(" #n ")":::"memory")
  #define BAR __builtin_amdgcn_s_barrier()
  #define SCHED __builtin_amdgcn_sched_barrier(0)
  const int t0=otid();
  int wid=t0>>6,lane=t0&63,wr=wid>>2,wc=wid&3,fr=lane&15,fq=lane>>4;
  h16x8 At[4][2],B0[2][2],B1[2][2];
  const int nt=K/G_BK;
  STAGE(SB(0,0),Bt,bcol,0); STAGE(SA(0,0),A,brow,0);
  STAGE(SB(0,1),Bt,bcol+G_HALF,0); STAGE(SA(0,1),A,brow+G_HALF,0);
  if(wr==1)BAR;
  WAIT_V(4); BAR;
  STAGE(SB(1,0),Bt,bcol,1); STAGE(SA(1,0),A,brow,1); STAGE(SB(1,1),Bt,bcol+G_HALF,1);
  WAIT_V(6); BAR;
  for(int t=0;t<nt-2;t+=2){
    LDB(B0,0,0); SCHED; LDA(At,0,0); STAGE(SA(1,1),A,brow+G_HALF,t+1);
    WAIT_L(8); BAR; WAIT_L(0); MMA(0,0,At,B0); BAR; SCHED;
    LDB(B1,0,1); STAGE(SB(0,0),Bt,bcol,t+2);
    BAR; WAIT_L(0); MMA(0,1,At,B1); BAR;
    LDA(At,0,1); STAGE(SA(0,0),A,brow,t+2);
    BAR; WAIT_L(0); MMA(1,0,At,B0); BAR; SCHED;
    STAGE(SB(0,1),Bt,bcol+G_HALF,t+2);
    WAIT_V(6); BAR; MMA(1,1,At,B1); BAR;
    LDB(B0,1,0); SCHED; LDA(At,1,0); STAGE(SA(0,1),A,brow+G_HALF,t+2);
    WAIT_L(8); BAR; WAIT_L(0); MMA(0,0,At,B0); BAR; SCHED;
    LDB(B1,1,1); STAGE(SB(1,0),Bt,bcol,t+3);
    BAR; WAIT_L(0); MMA(0,1,At,B1); BAR;
    LDA(At,1,1); STAGE(SA(1,0),A,brow,t+3);
    BAR; WAIT_L(0); MMA(1,0,At,B0); BAR; SCHED;
    STAGE(SB(1,1),Bt,bcol+G_HALF,t+3);
    WAIT_V(6); BAR; MMA(1,1,At,B1); BAR;
  }
  int tz=otid(); wid=tz>>6; lane=tz&63; wr=wid>>2; wc=wid&3; fr=lane&15; fq=lane>>4;
  { LDB(B0,0,0); WAIT_V(0); LDA(At,0,0); STAGE_X(tz,SA(1,1),A,brow+G_HALF,nt-1);
    BAR; WAIT_L(0); MMA(0,0,At,B0); BAR;
    LDB(B1,0,1); BAR; WAIT_L(0); MMA(0,1,At,B1); BAR;
    LDA(At,0,1); WAIT_V(4); BAR; WAIT_L(0); MMA(1,0,At,B0); MMA(1,1,At,B1); BAR; }
  { LDB(B0,1,0); LDA(At,1,0); WAIT_V(2); BAR; WAIT_L(0); MMA(0,0,At,B0); BAR;
    LDB(B1,1,1); WAIT_V(0); BAR; WAIT_L(0); MMA(0,1,At,B1); BAR;
    LDA(At,1,1); BAR; WAIT_L(0); MMA(1,0,At,B0); MMA(1,1,At,B1); BAR; }
  if(wr==0)BAR;
  #undef SA
  #undef SB
  #undef STAGE_X
  #undef STAGE
  #undef LDA
  #undef LDB
  #undef MMA
}

__device__ __forceinline__ bool unit_next(int i, int nM, int nN, int& pm, int& pn) {
    const int nwg = nM * nN; const long L = (long)i * gridDim.x + blockIdx.x; if (L >= nwg) return false;
    int wgid = (int)L; { const int q = nwg / 8, r = nwg % 8, xcd = wgid % 8, off = wgid / 8; wgid = (xcd < r ? xcd * (q + 1) : r * (q + 1) + (xcd - r) * q) + off; }
    const int nig = 8 * nN, gid = wgid / nig, fm = gid * 8, gsz = (nM - fm) < 8 ? (nM - fm) : 8;
    pm = fm + ((wgid % nig) % gsz); pn = (wgid % nig) / gsz; return true;
}

constexpr int ES = 132;
__device__ __forceinline__ void stage_quadrant(const f32x4 (&acc)[2][2][4][2], int ai, int bj, float* E, int tz) {
    const int wid = tz >> 6, lane = tz & 63, wr = wid >> 2, wc = wid & 3, fr = lane & 15, fq = lane >> 4;
#pragma unroll
    for (int m = 0; m < 4; ++m)
#pragma unroll
        for (int n = 0; n < 2; ++n) *(f32x4*)(E + (wr * 64 + m * 16 + fr) * ES + wc * 32 + n * 16 + fq * 4) = acc[ai][bj][m][n];
}
__device__ __forceinline__ void read_rowpart(const float* E, int r, int part, float* x1, float* x2) {
#pragma unroll
    for (int q = 0; q < 4; ++q) {
        const f32x4 a = *(const f32x4*)(E + r * ES + 16 * part + 4 * q), b = *(const f32x4*)(E + r * ES + 64 + 16 * part + 4 * q);
        x1[4 * q] = a.x; x1[4 * q + 1] = a.y; x1[4 * q + 2] = a.z; x1[4 * q + 3] = a.w;
        x2[4 * q] = b.x; x2[4 * q + 1] = b.y; x2[4 * q + 2] = b.z; x2[4 * q + 3] = b.w;
    }
}

constexpr int ES16 = 264;
__device__ __forceinline__ void stage_full16(const f32x4 (&acc)[2][2][4][2], h16* E16, int tz) {
    const int wid = tz >> 6, lane = tz & 63, wr = wid >> 2, wc = wid & 3, fr = lane & 15, fq = lane >> 4;
#pragma unroll
    for (int ai = 0; ai < 2; ++ai)
#pragma unroll
        for (int bj = 0; bj < 2; ++bj)
#pragma unroll
            for (int m = 0; m < 4; ++m)
#pragma unroll
                for (int n = 0; n < 2; ++n) {
                    const f32x4 a = acc[ai][bj][m][n];
                    f32x2 o; o.x = __uint_as_float(pkh(a.x, a.y)); o.y = __uint_as_float(pkh(a.z, a.w));
                    *(f32x2*)(E16 + (ai * 128 + wr * 64 + m * 16 + fr) * ES16 + bj * 128 + wc * 32 + n * 16 + fq * 4) = o;
                }
}
__device__ __forceinline__ void read_rowpart16(const h16* E16, int row, int bj, int part, float* x1, float* x2) {
    const h16* b = E16 + row * ES16 + bj * 128 + 16 * part;
    unpk8(*(const u32x4*)b, x1); unpk8(*(const u32x4*)(b + 8), x1 + 8);
    unpk8(*(const u32x4*)(b + 64), x2); unpk8(*(const u32x4*)(b + 72), x2 + 8);
}
template <class BODY>
__device__ __forceinline__ void epilogue_full(const f32x4 (&acc)[2][2][4][2], char* smem, BODY body) {
    h16* E16 = (h16*)smem;
    const int tz = otid();
    __syncthreads();
    stage_full16(acc, E16, tz);
    __syncthreads();
    const int r = tz >> 2, part = tz & 3;
#pragma unroll 1
    for (int q = 0; q < 4; ++q) {
        float x1[16], x2[16];
        read_rowpart16(E16, (q >> 1) * 128 + r, q & 1, part, x1, x2);
        body(q >> 1, q & 1, r, part, x1, x2);
    }
    __syncthreads();
}
__device__ __forceinline__ void rope32(float* x1, float* x2, const float2* rp, int part) {
#pragma unroll
    for (int i = 0; i < 16; ++i) { const float2 cs = rp[16 * part + i]; const float a = x1[i], b = x2[i]; x1[i] = a * cs.x - b * cs.y; x2[i] = b * cs.x + a * cs.y; }
}
struct RopeRegs { f32x4 v[8]; };
__device__ __forceinline__ void rope_load(RopeRegs& rr, const float2* rp, int part) {
#pragma unroll
    for (int k = 0; k < 8; ++k) rr.v[k] = *(const f32x4*)(rp + 16 * part + 2 * k);
}
__device__ __forceinline__ void rope32r(float* x1, float* x2, const RopeRegs& rr) {
#pragma unroll
    for (int k = 0; k < 8; ++k) {
        { const float c = rr.v[k].x, s = rr.v[k].y, a = x1[2 * k], b = x2[2 * k]; x1[2 * k] = a * c - b * s; x2[2 * k] = b * c + a * s; }
        { const float c = rr.v[k].z, s = rr.v[k].w, a = x1[2 * k + 1], b = x2[2 * k + 1]; x1[2 * k + 1] = a * c - b * s; x2[2 * k + 1] = b * c + a * s; }
    }
}
template <class BUF, class LD, class PR>
__device__ __forceinline__ void epilogue_pipe(const f32x4 (&acc)[2][2][4][2], float* E, int tz, LD ld, PR pr) {
    BUF b0, b1;
    const int r = tz >> 2, part = tz & 3;
    float x1[16], x2[16];
    ld(0, 0, r, part, b0);
    __syncthreads(); stage_quadrant(acc, 0, 0, E, tz); __syncthreads(); read_rowpart(E, r, part, x1, x2); ld(0, 1, r, part, b1); pr(0, 0, r, part, b0, x1, x2);
    __syncthreads(); stage_quadrant(acc, 0, 1, E, tz); __syncthreads(); read_rowpart(E, r, part, x1, x2); ld(1, 0, r, part, b0); pr(0, 1, r, part, b1, x1, x2);
    __syncthreads(); stage_quadrant(acc, 1, 0, E, tz); __syncthreads(); read_rowpart(E, r, part, x1, x2); ld(1, 1, r, part, b1); pr(1, 0, r, part, b0, x1, x2);
    __syncthreads(); stage_quadrant(acc, 1, 1, E, tz); __syncthreads(); read_rowpart(E, r, part, x1, x2); pr(1, 1, r, part, b1, x1, x2);
}
__device__ __forceinline__ void store_h16_32(h16* dst, int part, const float* x1, const float* x2) {
    *(u32x4*)(dst + 16 * part) = pk8(x1); *(u32x4*)(dst + 16 * part + 8) = pk8(x1 + 8);
    *(u32x4*)(dst + 64 + 16 * part) = pk8(x2); *(u32x4*)(dst + 64 + 16 * part + 8) = pk8(x2 + 8);
}
__device__ __forceinline__ void store_fp8_32(unsigned char* dst, int part, const float* x1, const float* x2, float sc) {
    u32x4 a, b;
#pragma unroll
    for (int q = 0; q < 4; ++q) {
        int w = __builtin_amdgcn_cvt_pk_fp8_f32(x1[4 * q] * sc, x1[4 * q + 1] * sc, 0, false);
        w = __builtin_amdgcn_cvt_pk_fp8_f32(x1[4 * q + 2] * sc, x1[4 * q + 3] * sc, w, true); a[q] = (unsigned)w;
        int v = __builtin_amdgcn_cvt_pk_fp8_f32(x2[4 * q] * sc, x2[4 * q + 1] * sc, 0, false);
        v = __builtin_amdgcn_cvt_pk_fp8_f32(x2[4 * q + 2] * sc, x2[4 * q + 3] * sc, v, true); b[q] = (unsigned)v;
    }
    *(u32x4*)(dst + 16 * part) = a; *(u32x4*)(dst + 64 + 16 * part) = b;
}
__device__ __forceinline__ void store_f32_32(float* dst, int part, const float* x1, const float* x2) {
#pragma unroll
    for (int q = 0; q < 4; ++q) {
        f32x4 a = {x1[4 * q], x1[4 * q + 1], x1[4 * q + 2], x1[4 * q + 3]}, b = {x2[4 * q], x2[4 * q + 1], x2[4 * q + 2], x2[4 * q + 3]};
        *(f32x4*)(dst + 16 * part + 4 * q) = a; *(f32x4*)(dst + 64 + 16 * part + 4 * q) = b;
    }
}
__device__ __forceinline__ float quad_sum(float v) { v += __shfl_xor(v, 1); v += __shfl_xor(v, 2); return v; }

__device__ __forceinline__ void inproj_block(const Params& p, int cb, int tok, int part, float* x1, float* x2, const RopeRegs& rr) {
    if (cb < 8) {
        rope32r(x1, x2, rr); store_h16_32(p.RQ + (size_t)tok * 1024 + cb * 128, part, x1, x2);
    } else if (cb < 16) {
        rope32r(x1, x2, rr);
#pragma unroll
        for (int i = 0; i < 16; ++i) { x1[i] *= 0.08838834764831845f; x2[i] *= 0.08838834764831845f; }
        store_h16_32(p.RK + (size_t)tok * 1024 + (cb - 8) * 128, part, x1, x2);
    } else if (cb < 32) {
        store_h16_32(p.RV + (size_t)tok * 2048 + (cb - 16) * 128, part, x1, x2);
    } else if (cb < 48) {
#pragma unroll
        for (int i = 0; i < 16; ++i) { x1[i] = siluf_(x1[i]); x2[i] = siluf_(x2[i]); }
        store_h16_32(p.RG + (size_t)tok * 2048 + (cb - 32) * 128, part, x1, x2);
    } else if (cb < 68) {
        const bool isq = cb < 64;
        float ss = 0.f;
#pragma unroll
        for (int i = 0; i < 16; ++i) ss += x1[i] * x1[i] + x2[i] * x2[i];
        ss = quad_sum(ss);
        const float rs = rsqrtf(ss * (1.f / 128.f) + EPS);
        const float* nw = isq ? p.q_norm_w : p.k_norm_w;
#pragma unroll
        for (int i = 0; i < 16; ++i) { x1[i] *= rs * nw[16 * part + i]; x2[i] *= rs * nw[64 + 16 * part + i]; }
        rope32r(x1, x2, rr);
        if (isq) {
#pragma unroll
            for (int i = 0; i < 16; ++i) { x1[i] *= 0.08838834764831845f; x2[i] *= 0.08838834764831845f; }
            store_fp8_32(p.AQ8 + (size_t)tok * 2048 + (cb - 48) * 128, part, x1, x2, 16.f);
        } else {
            store_fp8_32(p.AK8 + (size_t)tok * 512 + (cb - 64) * 128, part, x1, x2, 1.f);
            store_f32_32(p.out + O_KP + (size_t)tok * 512 + (cb - 64) * 128, part, x1, x2);
        }
    } else if (cb < 72) {
        store_h16_32(p.AV + (size_t)tok * 512 + (cb - 68) * 128, part, x1, x2);
        store_f32_32(p.out + O_VP + (size_t)tok * 512 + (cb - 68) * 128, part, x1, x2);
    } else if (cb < 88) {
        rope32r(x1, x2, rr);
#pragma unroll
        for (int i = 0; i < 16; ++i) { x1[i] *= 0.08838834764831845f; x2[i] *= 0.08838834764831845f; }
        store_h16_32(p.IQ + (size_t)tok * 2048 + (cb - 72) * 128, part, x1, x2);
    } else if (cb == 88) {
        rope32r(x1, x2, rr);
        store_h16_32(p.IK + (size_t)tok * 128, part, x1, x2);
        store_f32_32(p.out + O_IKP + (size_t)tok * 128, part, x1, x2);
    } else if (cb < 121) {
#pragma unroll
        for (int i = 0; i < 16; ++i) { x1[i] = sigmoidf_(x1[i]); x2[i] = sigmoidf_(x2[i]); }
        h16* dst = (cb < 105) ? p.GR + (size_t)tok * 2048 + (cb - 89) * 128 : p.GA + (size_t)tok * 2048 + (cb - 105) * 128;
        store_h16_32(dst, part, x1, x2);
    } else {
        if (part == 0) {
#pragma unroll
            for (int q = 0; q < 4; ++q) { f32x4 a = {x1[4 * q] * 0.25f, x1[4 * q + 1] * 0.25f, x1[4 * q + 2] * 0.25f, x1[4 * q + 3] * 0.25f}; *(f32x4*)(p.IW + (size_t)tok * 16 + 4 * q) = a; }
        }
    }
}

template <int CB, class F>
__device__ __forceinline__ void gemv8_item(const float* A, const float* W, int N, int n0, char* smem, F f, const float* normw = nullptr, float* shn_out = nullptr) {
    constexpr int C4 = CB / 4, KG = 512 / C4, NL = 2048 / KG, OUT = 8 * CB, P = 512 / OUT;
    const int tid = otid();
    float* AT = (float*)smem;
    float* red = AT + 2048 * 8;
    float* rs8 = (float*)(smem + 131072);
    __syncthreads();
    if (normw) {
        float ssl[8];
#pragma unroll
        for (int t = 0; t < 8; ++t) ssl[t] = 0.f;
#pragma unroll
        for (int j = 0; j < 32; ++j) { const int i = tid + 512 * j, t = i >> 11, k = i & 2047; const float a = A[i]; AT[k * 8 + t] = a * normw[k]; ssl[j >> 2] += a * a; }
#pragma unroll
        for (int t = 0; t < 8; ++t) { const float s = wave_sum(ssl[t]); if ((tid & 63) == 0) rs8[8 + (tid >> 6) * 8 + t] = s; }
        __syncthreads();
        if (tid < 8) { float s = 0.f; for (int w = 0; w < 8; ++w) s += rs8[8 + w * 8 + tid]; rs8[tid] = rsqrtf(s * (1.f / 2048.f) + EPS); }
        __syncthreads();
        if (shn_out) for (int i = tid; i < 8 * 2048; i += 512) { const int t = i >> 11, k = i & 2047; shn_out[i] = AT[k * 8 + t] * rs8[t]; }
    } else {
        float av32[32];
#pragma unroll
        for (int j = 0; j < 32; ++j) av32[j] = A[tid + 512 * j];
#pragma unroll
        for (int j = 0; j < 32; ++j) { const int i = tid + 512 * j, t = i >> 11, k = i & 2047; AT[k * 8 + t] = av32[j]; }
        __syncthreads();
    }
    const int c4 = tid % C4, kg = tid / C4, n = n0 + 4 * c4;
    const bool ok = (n + 3) < N;
    float acc[8][4];
#pragma unroll
    for (int t = 0; t < 8; ++t)
#pragma unroll
        for (int c = 0; c < 4; ++c) acc[t][c] = 0.f;
    const float* wp = W + (size_t)kg * N + (ok ? n : 0);
#pragma unroll 16
    for (int j = 0; j < NL; ++j) {
        const int k = kg + KG * j;
        f32x4 w = *(const f32x4*)(wp + (size_t)(KG * j) * N);
        if (!ok) w = (f32x4){0.f, 0.f, 0.f, 0.f};
        const f32x4 a0 = *(const f32x4*)(AT + k * 8), a1 = *(const f32x4*)(AT + k * 8 + 4);
        const float av[8] = {a0.x, a0.y, a0.z, a0.w, a1.x, a1.y, a1.z, a1.w};
#pragma unroll
        for (int t = 0; t < 8; ++t) { acc[t][0] += av[t] * w.x; acc[t][1] += av[t] * w.y; acc[t][2] += av[t] * w.z; acc[t][3] += av[t] * w.w; }
    }
#pragma unroll
    for (int t = 0; t < 8; ++t) { f32x4 v = {acc[t][0], acc[t][1], acc[t][2], acc[t][3]}; *(f32x4*)(red + (kg * 8 + t) * CB + 4 * c4) = v; }
    __syncthreads();
    {
        const int o = tid % OUT, part = tid / OUT, t = o / CB, col = o % CB;
        float s = 0.f;
#pragma unroll 8
        for (int q = 0; q < 32; ++q) s += red[((part * 32 + q) * 8 + t) * CB + col];
        if (P > 1) {
            AT[part * OUT + o] = s;
            __syncthreads();
            if (tid < OUT) {
                s = 0.f;
#pragma unroll
                for (int q = 0; q < P; ++q) s += AT[q * OUT + o];
            }
        }
        if (tid < OUT && (n0 + col) < N) f(t, n0 + col, normw ? s * rs8[t] : s);
    }
}

__device__ __forceinline__ void late_weight_transposes(const Params& p, char* smem, int first) {
    const int t0 = otid(), lane = t0 & 63, wave = t0 >> 6;
    const int G = gridDim.x, gw = ((int)blockIdx.x - first) * 8 + wave, NGW = (G - first) * 8;
    float* scr = (float*)smem + wave * (64 * 33);
    constexpr int I_SQ = 32 * 64, I_WQ = 32 * 32, NIT = 3 * I_SQ + I_WQ;
    __syncthreads();
    for (int it = gw; it < NIT; it += NGW) {
        int r = it;
        if (r < I_SQ) { p0_transpose_item<false>(p.w_ret_o, D, D, p.WrT, scr, r, 64, lane); continue; } r -= I_SQ;
        if (r < I_SQ) { p0_transpose_item<false>(p.w_att_o, D, D, p.WaT, scr, r, 64, lane); continue; } r -= I_SQ;
        if (r < I_SQ) { p0_transpose_item<false>(p.w_out, D, D, p.WoT, scr, r, 64, lane); continue; } r -= I_SQ;
        p0_transpose_item<false>(p.peer_wq, D, 1024, p.WqT, scr, r, 32, lane, p.norm2_w);
    }
    __syncthreads();
}

__device__ __forceinline__ void phase1(const Params& p, char* smem) {
    const int tid = otid();
    for (int i = 0;; ++i) {
        int pm, pn; if (!unit_next(i, TP / 256, NWP / 256, pm, pn)) break;
        f32x4 acc[2][2][4][2] = {};
        gemm_core(p.XN, p.WinT, pm * 256, pn * 256, D, acc, (h16*)smem);
        epilogue_full(acc, smem, [&](int ai, int bj, int r, int part, float* x1, float* x2) {
            RopeRegs rr;
            rope_load(rr, p.ROPE + (size_t)((pm * 256 + ai * 128 + r) & (SEQ - 1)) * 64, part);
            inproj_block(p, pn * 2 + bj, pm * 256 + ai * 128 + r, part, x1, x2, rr);
        });
    }
    {
        const int G = gridDim.x, first = (G > 160) ? 160 : 0, nw = G - first;
        if ((int)blockIdx.x >= first) {
            for (int it = blockIdx.x - first; it < (NW0 + 63) / 64; it += nw) {
                float* ZS = p.ZS;
                gemv8_item<64>(p.XNS, p.w_in, NW0, it * 64, smem, [=](int t, int n, float v) { ZS[(size_t)t * NW0 + n] = v; });
            }
            late_weight_transposes(p, smem, first);
        }
    }
}

__device__ __forceinline__ void indexer_item(const Params& p, int b, int g, char* smem) {
    const int tid = otid(), lane = tid & 63, wave = tid >> 6, r16 = lane & 15, kq = lane >> 4;
    float* SC = (float*)smem;
    const int t0 = 8 * g, nkeys = 8 * g + 8, ntile = (nkeys + 15) >> 4;
    const size_t tb = (size_t)b * SEQ;
    {
        h16x8 af[2][4][4];
        float* WL = (float*)(smem + 8 * SCS * 4);
        if (tid < 128) WL[tid] = p.IW[(tb + t0) * 16 + tid];
#pragma unroll
        for (int Qg = 0; Qg < 2; ++Qg)
#pragma unroll
            for (int hg = 0; hg < 4; ++hg) {
                const h16* qp = p.IQ + (tb + t0 + Qg * 4 + (r16 >> 2)) * 2048 + (hg * 4 + (r16 & 3)) * 128 + kq * 8;
#pragma unroll
                for (int kk = 0; kk < 4; ++kk) af[Qg][hg][kk] = *(const h16x8*)(qp + kk * 32);
            }
        __syncthreads();
        f32x4 wv[2][4];
#pragma unroll
        for (int Qg = 0; Qg < 2; ++Qg)
#pragma unroll
            for (int hg = 0; hg < 4; ++hg) wv[Qg][hg] = *(const f32x4*)(WL + (Qg * 4 + kq) * 16 + hg * 4);
        const h16* kbase = p.IK + (tb + r16) * 128 + kq * 8;
        const int last = ntile - 1;
        h16x8 b0[4], b1[4], b2[4];
#define IDX_LOAD(dst, tl) { const int _t = (tl) < last ? (tl) : last; const h16* _kp = kbase + (size_t)_t * 16 * 128; \
    asm volatile("global_load_dwordx4 %0, %4, off\n\tglobal_load_dwordx4 %1, %4, off offset:64\n\tglobal_load_dwordx4 %2, %4, off offset:128\n\tglobal_load_dwordx4 %3, %4, off offset:192" \
                 : "=&v"(dst[0]), "=&v"(dst[1]), "=&v"(dst[2]), "=&v"(dst[3]) : "v"(_kp) : "memory"); }
#define IDX_WAIT8(bfr) asm volatile("s_waitcnt vmcnt(8)" : "+v"(bfr[0]), "+v"(bfr[1]), "+v"(bfr[2]), "+v"(bfr[3]) :: "memory")
#define IDX_TILE(bfr, tl) { const int _t = (tl) < last ? (tl) : last; \
    _Pragma("unroll") for (int Qg = 0; Qg < 2; ++Qg) { float sc = 0.f; \
        _Pragma("unroll") for (int hg = 0; hg < 4; ++hg) { f32x4 a = {0.f, 0.f, 0.f, 0.f}; \
            _Pragma("unroll") for (int kk = 0; kk < 4; ++kk) a = __builtin_amdgcn_mfma_f32_16x16x32_f16(af[Qg][hg][kk], bfr[kk], a, 0, 0, 0); \
            sc += wv[Qg][hg].x * fmaxf(a.x, 0.f) + wv[Qg][hg].y * fmaxf(a.y, 0.f) + wv[Qg][hg].z * fmaxf(a.z, 0.f) + wv[Qg][hg].w * fmaxf(a.w, 0.f); } \
        SC[(Qg * 4 + kq) * SCS + _t * 16 + r16] = sc; } }
#pragma unroll
        for (int Qg = 0; Qg < 2; ++Qg)
#pragma unroll
            for (int hg = 0; hg < 4; ++hg) asm volatile("" : "+v"(af[Qg][hg][0]), "+v"(af[Qg][hg][1]), "+v"(af[Qg][hg][2]), "+v"(af[Qg][hg][3]));
#pragma unroll
        for (int Qg = 0; Qg < 2; ++Qg) asm volatile("" : "+v"(wv[Qg][0]), "+v"(wv[Qg][1]), "+v"(wv[Qg][2]), "+v"(wv[Qg][3]));
        IDX_LOAD(b0, wave) IDX_LOAD(b1, wave + 8) IDX_LOAD(b2, wave + 16)
        for (int tile = wave; tile < ntile; tile += 24) {
            IDX_WAIT8(b0); IDX_TILE(b0, tile) IDX_LOAD(b0, tile + 24)
            IDX_WAIT8(b1); IDX_TILE(b1, tile + 8) IDX_LOAD(b1, tile + 32)
            IDX_WAIT8(b2); IDX_TILE(b2, tile + 16) IDX_LOAD(b2, tile + 40)
        }
        asm volatile("s_waitcnt vmcnt(0)" ::: "memory");
#undef IDX_WAIT8
#undef IDX_LOAD
#undef IDX_TILE
    }
    __syncthreads();
    {
        const int t = t0 + wave, nvalid = t + 1;
        int* outp = p.TOPI + (tb + t) * 256;
        if (nvalid <= 256) {
#pragma unroll
            for (int i = 0; i < 4; ++i) { const int j = lane + 64 * i; outp[j] = (j < nvalid) ? j : -1; }
        } else {
            unsigned u[64];
#pragma unroll
            for (int i = 0; i < 64; ++i) { const int s = i * 64 + lane; const unsigned o = f2ord(SC[wave * SCS + s]); u[i] = (s <= t) ? o : 0u; }
            unsigned tau; int need_eq;
            const int nreg = __builtin_amdgcn_readfirstlane((t >> 6) + 1);
            wave_kth_dyn<64>(u, (nreg + 7) >> 3, 256, tau, need_eq);
            const u64 lt = (1ull << lane) - 1ull;
            int base = 0, eqt = 0;
            unsigned tau2 = tau; asm volatile("" : "+v"(tau2));
            static_for<0, 16>([&](auto G4) {
                constexpr int g4 = decltype(G4)::value;
                if (g4 * 4 < nreg) {
#pragma unroll
                    for (int ii = 0; ii < 4; ++ii) {
                        constexpr int dummy = 0; (void)dummy;
                        const int i = g4 * 4 + ii;
                        const bool gt = u[i] > tau2, eq = u[i] == tau2;
                        const u64 meq = __ballot(eq);
                        const bool sel = gt || (eq && (eqt + __popcll(meq & lt)) < need_eq);
                        const u64 ms = __ballot(sel);
                        if (sel) outp[base + __popcll(ms & lt)] = i * 64 + lane;
                        base += __popcll(ms); eqt += __popcll(meq);
                    }
                    __builtin_amdgcn_sched_barrier(0);
                }
            });
        }
    }
    __syncthreads();
}

__device__ __forceinline__ void kv_item(const Params& p, int b, int h, int c, char* smem) {
    const int tid = otid(), lane = tid & 63, wave = tid >> 6;
    char* Kimg = smem;
    char* Vimg = smem + 32768;
    const size_t tok0 = (size_t)b * SEQ + c * 128;
    const float lg = ret_log_g(h);
#pragma unroll
    for (int i = 0; i < 4; ++i) {
        const int q = tid + 512 * i, tt = q >> 4, ch = q & 15;
        const u32x4 raw = *(const u32x4*)(p.RK + (tok0 + tt) * 1024 + h * 128 + ch * 8);
        float v[8]; unpk8(raw, v);
        const float dec = __expf((float)(127 - tt) * lg);
#pragma unroll
        for (int e = 0; e < 8; ++e) v[e] *= dec;
        *(u32x4*)(Kimg + (tt >> 5) * 8192 + off_b(tt & 31, ch)) = pk8(v);
    }
#pragma unroll
    for (int i = 0; i < 8; ++i) {
        const int q = tid + 512 * i, tt = q >> 5, c32 = q & 31;
        const u32x4 raw = *(const u32x4*)(p.RV + (tok0 + tt) * 2048 + h * 256 + c32 * 8);
        *(u32x4*)(Vimg + ((tt >> 5) * 2 + (c32 >> 4)) * 8192 + off_b(tt & 31, c32 & 15)) = raw;
    }
    __syncthreads();
    f32x4 acc[16];
#pragma unroll
    for (int nt = 0; nt < 16; ++nt) acc[nt] = (f32x4){0.f, 0.f, 0.f, 0.f};
    const unsigned z0 = lds_u32(smem) + tr_addr16(lane, 0, 0), z1 = lds_u32(smem) + tr_addr16(lane, 0, 1);
    static_for<0, 4>([&](auto KS) {
        constexpr int ks = decltype(KS)::value;
        const h16x8 af = tr_read8o<ks * 8192>(z0 ^ (32u * wave), z1 ^ (32u * wave));
        static_for<0, 16>([&](auto NT) {
            constexpr int nt = decltype(NT)::value;
            const h16x8 bf = tr_read8o<(ks * 2 + (nt >> 3)) * 8192>((z0 + 32768u) ^ (32u * (nt & 7)), (z1 + 32768u) ^ (32u * (nt & 7)));
            acc[nt] = __builtin_amdgcn_mfma_f32_16x16x32_f16(bf, af, acc[nt], 0, 0, 0);
        });
    });
    float* dst = p.KV + ((size_t)((b * 8 + h) * 32 + c) * 128) * 256;
#pragma unroll
    for (int nt = 0; nt < 16; ++nt) *(f32x4*)(dst + (size_t)(16 * wave + (lane & 15)) * 256 + 16 * nt + 4 * (lane >> 4)) = acc[nt];
    __syncthreads();
}

__device__ __forceinline__ void sample_post_item(const Params& p) {
    const int tid = otid();
    const float2* rp = p.ROPE + (size_t)4096 * 64;
    for (int q = tid; q < 8 * 122 * 4; q += 512) {
        const int part = q & 3, cb = (q >> 2) % 122, t = (q >> 2) / 122;
        const int col0 = (cb < 89) ? cb * 128 : (cb < 105) ? C_GR + (cb - 89) * 128 : (cb < 121) ? C_GA + (cb - 105) * 128 : C_IW;
        const float* z = p.ZS + (size_t)t * NW0 + col0;
        float x1[16], x2[16];
        if (cb < 121) {
#pragma unroll
            for (int i = 0; i < 16; ++i) { x1[i] = z[16 * part + i]; x2[i] = z[64 + 16 * part + i]; }
        } else {
#pragma unroll
            for (int i = 0; i < 16; ++i) { x1[i] = z[i]; x2[i] = 0.f; }
        }
        if (cb < 8) { rope32(x1, x2, rp, part); store_f32_32(p.SRQ + t * 1024 + cb * 128, part, x1, x2); }
        else if (cb < 16) {
            rope32(x1, x2, rp, part);
#pragma unroll
            for (int i = 0; i < 16; ++i) { x1[i] *= 0.08838834764831845f; x2[i] *= 0.08838834764831845f; }
            store_f32_32(p.SRK + t * 1024 + (cb - 8) * 128, part, x1, x2);
        } else if (cb < 32) store_f32_32(p.SRV + t * 2048 + (cb - 16) * 128, part, x1, x2);
        else if (cb < 48) {
#pragma unroll
            for (int i = 0; i < 16; ++i) { x1[i] = siluf_(x1[i]); x2[i] = siluf_(x2[i]); }
            store_f32_32(p.SRG + t * 2048 + (cb - 32) * 128, part, x1, x2);
        } else if (cb < 68) {
            const bool isq = cb < 64;
            float ss = 0.f;
#pragma unroll
            for (int i = 0; i < 16; ++i) ss += x1[i] * x1[i] + x2[i] * x2[i];
            ss = quad_sum(ss);
            const float rs = rsqrtf(ss * (1.f / 128.f) + EPS);
            const float* nw = isq ? p.q_norm_w : p.k_norm_w;
#pragma unroll
            for (int i = 0; i < 16; ++i) { x1[i] *= rs * nw[16 * part + i]; x2[i] *= rs * nw[64 + 16 * part + i]; }
            rope32(x1, x2, rp, part);
            if (isq) {
#pragma unroll
                for (int i = 0; i < 16; ++i) { x1[i] *= 0.08838834764831845f; x2[i] *= 0.08838834764831845f; }
                store_f32_32(p.SAQ + t * 2048 + (cb - 48) * 128, part, x1, x2);
            } else {
                store_f32_32(p.SAK + t * 512 + (cb - 64) * 128, part, x1, x2);
                store_f32_32(p.out + O_KS + t * 512 + (cb - 64) * 128, part, x1, x2);
            }
        } else if (cb < 72) {
            store_f32_32(p.SAV + t * 512 + (cb - 68) * 128, part, x1, x2);
            store_f32_32(p.out + O_VS + t * 512 + (cb - 68) * 128, part, x1, x2);
        } else if (cb < 88) {
        } else if (cb == 88) {
            rope32(x1, x2, rp, part);
            store_f32_32(p.SIK + t * 128, part, x1, x2);
            store_f32_32(p.out + O_IKS + t * 128, part, x1, x2);
        } else if (cb < 121) {
#pragma unroll
            for (int i = 0; i < 16; ++i) { x1[i] = sigmoidf_(x1[i]); x2[i] = sigmoidf_(x2[i]); }
            float* dst = (cb < 105) ? p.SGR + t * 2048 + (cb - 89) * 128 : p.SGA + t * 2048 + (cb - 105) * 128;
            store_f32_32(dst, part, x1, x2);
        }
    }
}

__device__ __forceinline__ void sample_indexer_item(const Params& p, int t, int kr, char* smem) {
    const int tid = otid();
    float* qs = (float*)smem;
    float* ws = qs + 2048;
    float* kself = ws + 16;
    float* tmp = kself + 128;
    const float2* rp = p.ROPE + (size_t)4096 * 64;
    const float* z = p.ZS + (size_t)t * NW0;
    __syncthreads();
#pragma unroll
    for (int i = 0; i < 2; ++i) {
        const int pr = tid + 512 * i, hh = pr >> 6, d = pr & 63;
        const float a = z[C_IQ + hh * 128 + d], b = z[C_IQ + hh * 128 + 64 + d];
        const float2 cs = rp[d];
        qs[hh * 128 + d] = (a * cs.x - b * cs.y) * 0.08838834764831845f;
        qs[hh * 128 + 64 + d] = (b * cs.x + a * cs.y) * 0.08838834764831845f;
    }
    if (tid < 16) ws[tid] = z[C_IW + tid] * 0.25f;
    if (tid < 64) { const float a = z[C_IK + tid], b = z[C_IK + 64 + tid]; const float2 cs = rp[tid]; kself[tid] = a * cs.x - b * cs.y; kself[64 + tid] = b * cs.x + a * cs.y; }
    __syncthreads();
    {
        const int lane = tid & 63, wave = tid >> 6, r16 = lane & 15, g = lane >> 4;
        h16x8 qhi[4], qlo[4];
#pragma unroll
        for (int kk = 0; kk < 4; ++kk) {
            const float* qp = qs + r16 * 128 + kk * 32 + g * 8;
            const f32x4 a = *(const f32x4*)qp, b = *(const f32x4*)(qp + 4);
            const float v[8] = {a.x, a.y, a.z, a.w, b.x, b.y, b.z, b.w};
#pragma unroll
            for (int e = 0; e < 8; ++e) { const h16 hv = (h16)v[e]; qhi[kk][e] = hv; qlo[kk][e] = (h16)(v[e] - (float)hv); }
        }
        f32x4 wv4 = *(const f32x4*)(ws + 4 * g);
        f32x4 kraw[4][4][2];
#pragma unroll
        for (int tl = 0; tl < 4; ++tl) {
            const int s = kr * 512 + (wave * 4 + tl) * 16 + r16;
            const int page = p.page_table[t * NPAGES + (s >> 7)];
            const float* kp = p.cache_kidx + ((size_t)page * PAGE + (s & 127)) * 128 + g * 8;
#pragma unroll
            for (int kk = 0; kk < 4; ++kk) { kraw[tl][kk][0] = *(const f32x4*)(kp + kk * 32); kraw[tl][kk][1] = *(const f32x4*)(kp + kk * 32 + 4); }
        }
#pragma unroll
        for (int tl = 0; tl < 4; ++tl) {
            f32x4 acc = {0.f, 0.f, 0.f, 0.f};
#pragma unroll
            for (int kk = 0; kk < 4; ++kk) {
                const f32x4 a = kraw[tl][kk][0], b = kraw[tl][kk][1];
                const float v[8] = {a.x, a.y, a.z, a.w, b.x, b.y, b.z, b.w};
                h16x8 khi, klo;
#pragma unroll
                for (int e = 0; e < 8; ++e) { const h16 hv = (h16)v[e]; khi[e] = hv; klo[e] = (h16)(v[e] - (float)hv); }
                acc = __builtin_amdgcn_mfma_f32_16x16x32_f16(qlo[kk], khi, acc, 0, 0, 0);
                acc = __builtin_amdgcn_mfma_f32_16x16x32_f16(qhi[kk], klo, acc, 0, 0, 0);
                acc = __builtin_amdgcn_mfma_f32_16x16x32_f16(qhi[kk], khi, acc, 0, 0, 0);
            }
            float sc = wv4.x * fmaxf(acc.x, 0.f) + wv4.y * fmaxf(acc.y, 0.f) + wv4.z * fmaxf(acc.z, 0.f) + wv4.w * fmaxf(acc.w, 0.f);
            sc += __shfl_xor(sc, 16); sc += __shfl_xor(sc, 32);
            if (g == 0) p.SSC[(size_t)t * SSCS + kr * 512 + (wave * 4 + tl) * 16 + r16] = sc;
        }
    }
    if (kr == 31) {
        if (tid < 16) { float d = 0.f;
#pragma unroll 4
            for (int i = 0; i < 128; ++i) d += qs[tid * 128 + i] * kself[i]; tmp[tid] = ws[tid] * fmaxf(d, 0.f); }
        __syncthreads();
        if (tid == 0) { float sc = 0.f; for (int i = 0; i < 16; ++i) sc += tmp[i]; p.SSC[(size_t)t * SSCS + PAST] = sc; }
    }
    __syncthreads();
}

__device__ __forceinline__ void phase2(const Params& p, char* smem) {
    const int c = blockIdx.x, G = gridDim.x;
    for (int k = 0;; ++k) {
        const int rr = (k >> 1) * 2 * G, r = (k & 1) ? rr + 2 * G - 1 - c : rr + c;
        if (rr >= 1024) break;
        if (r < 1024) indexer_item(p, r & 1, 511 - (r >> 1), smem);
    }
    for (int it = c; it < 512; it += G) kv_item(p, it >> 8, (it >> 5) & 7, it & 31, smem);
    for (int it = c; it < 256; it += G) sample_indexer_item(p, it >> 5, it & 31, smem);
    if (c == G - 1) sample_post_item(p);
}

__device__ __forceinline__ void scan_item(const Params& p, int item) {
    const int idx = item * 512 + otid();
    const int dv = idx & 255, dkb = (idx >> 8) & 15, h = (idx >> 12) & 7, b = idx >> 15;
    const float gC = __expf(128.f * ret_log_g(h));
    float S[8];
#pragma unroll
    for (int i = 0; i < 8; ++i) S[i] = 0.f;
    const size_t bh = (size_t)(b * 8 + h);
#pragma unroll 4
    for (int c = 0; c < 32; ++c) {
        *(u32x4*)(p.SPT + (((bh * 32 + c) * 256 + dv) * 128) + dkb * 8) = pk8(S);
        const float* kv = p.KV + ((bh * 32 + c) * 128 + dkb * 8) * 256 + dv;
#pragma unroll
        for (int i = 0; i < 8; ++i) S[i] = gC * S[i] + kv[(size_t)i * 256];
    }
#pragma unroll
    for (int i = 0; i < 8; ++i) p.out[O_SP + (bh * 128 + dkb * 8 + i) * 256 + dv] = S[i];
}

__device__ __forceinline__ void attn_item(const Params& p, int b, int n, int qg, char* smem) {
    const int tid = otid(), lane = tid & 63, wave = tid >> 6, r16 = lane & 15, g = lane >> 4;
    const int tt = 8 * qg + wave, t = b * SEQ + tt;
    const int cnt = (tt + 1 < 256) ? tt + 1 : 256;
    int* lidx = (int*)(smem + wave * 9216);
    char* img = smem + wave * 9216 + 1024;
    const unsigned az0 = lds_u32(img) + tr_addr16(lane, 0, 0), az1 = lds_u32(img) + tr_addr16(lane, 0, 1);
    const size_t tb = (size_t)b * SEQ;
#pragma unroll
    for (int i = 0; i < 4; ++i) { const int v = p.TOPI[(size_t)t * 256 + lane + 64 * i]; lidx[lane + 64 * i] = v < 0 ? 0 : v; }
    long qf[4];
    {
        const unsigned char* qp = p.AQ8 + (size_t)t * 2048 + (n * 4 + (r16 & 3)) * 128 + 16 * g;
        u32x4 c0 = *(const u32x4*)qp, c1 = *(const u32x4*)(qp + 64);
        if (r16 >= 4) { c0 = (u32x4){0u, 0u, 0u, 0u}; c1 = c0; }
        qf[0] = (long)(((u64)c0.y << 32) | c0.x); qf[1] = (long)(((u64)c0.w << 32) | c0.z);
        qf[2] = (long)(((u64)c1.y << 32) | c1.x); qf[3] = (long)(((u64)c1.w << 32) | c1.z);
    }
    const unsigned char* kbase = p.AK8 + tb * 512 + n * 128 + 16 * g;
    const h16* vbase = p.AV + tb * 512 + n * 128;
    f32x4 sacc[16];
    {
        u32x4 kf[16][2];
#pragma unroll
        for (int i = 0; i < 16; ++i) {
            const unsigned char* kp = kbase + (size_t)lidx[16 * i + r16] * 512;
            kf[i][0] = *(const u32x4*)kp; kf[i][1] = *(const u32x4*)(kp + 64);
        }
#pragma unroll
        for (int i = 0; i < 16; ++i) {
            const u32x4 k0 = kf[i][0], k1 = kf[i][1];
            f32x4 a = {0.f, 0.f, 0.f, 0.f};
            a = __builtin_amdgcn_mfma_f32_16x16x32_fp8_fp8((long)(((u64)k0.y << 32) | k0.x), qf[0], a, 0, 0, 0);
            a = __builtin_amdgcn_mfma_f32_16x16x32_fp8_fp8((long)(((u64)k0.w << 32) | k0.z), qf[1], a, 0, 0, 0);
            a = __builtin_amdgcn_mfma_f32_16x16x32_fp8_fp8((long)(((u64)k1.y << 32) | k1.x), qf[2], a, 0, 0, 0);
            a = __builtin_amdgcn_mfma_f32_16x16x32_fp8_fp8((long)(((u64)k1.w << 32) | k1.z), qf[3], a, 0, 0, 0);
#pragma unroll
            for (int j = 0; j < 4; ++j) sacc[i][j] = ((16 * i + 4 * g + j) < cnt) ? a[j] * (1.f / 16.f) : -3.0e38f;
        }
    }
    u32x4 vr[3][8];
#pragma unroll
    for (int b0 = 0; b0 < 3; ++b0)
#pragma unroll
        for (int i2 = 0; i2 < 8; ++i2) {
            const int q = lane + 64 * i2, s = q >> 4, ch = q & 15;
            const int slot = (2 * b0 + ((s >> 2) & 1)) * 16 + 4 * (s >> 3) + (s & 3);
            vr[b0][i2] = *(const u32x4*)(vbase + (size_t)lidx[slot] * 512 + ch * 8);
        }
    float mx = -3.0e38f;
#pragma unroll
    for (int i = 0; i < 16; ++i)
#pragma unroll
        for (int j = 0; j < 4; ++j) mx = fmaxf(mx, sacc[i][j]);
    mx = fmaxf(mx, __shfl_xor(mx, 16)); mx = fmaxf(mx, __shfl_xor(mx, 32));
    float sum = 0.f;
#pragma unroll
    for (int i = 0; i < 16; ++i)
#pragma unroll
        for (int j = 0; j < 4; ++j) { const float e = __expf(sacc[i][j] - mx); sacc[i][j] = e; sum += e; }
    sum += __shfl_xor(sum, 16); sum += __shfl_xor(sum, 32);
    f32x4 oacc[8];
#pragma unroll
    for (int c = 0; c < 8; ++c) oacc[c] = (f32x4){0.f, 0.f, 0.f, 0.f};
#pragma unroll
    for (int bI = 0; bI < 8; ++bI) {
#pragma unroll
        for (int i2 = 0; i2 < 8; ++i2) { const int q = lane + 64 * i2; *(u32x4*)(img + off_b(q >> 4, q & 15)) = vr[bI % 3][i2]; }
        if (bI + 3 < 8) {
#pragma unroll
            for (int i2 = 0; i2 < 8; ++i2) {
                const int q = lane + 64 * i2, s = q >> 4, ch = q & 15;
                const int slot = (2 * (bI + 3) + ((s >> 2) & 1)) * 16 + 4 * (s >> 3) + (s & 3);
                vr[bI % 3][i2] = *(const u32x4*)(vbase + (size_t)lidx[slot] * 512 + ch * 8);
            }
        }
        h16x8 pf;
        {
            const f32x4 a0 = sacc[2 * bI], a1 = sacc[2 * bI + 1];
            pf[0] = (h16)a0.x; pf[1] = (h16)a0.y; pf[2] = (h16)a0.z; pf[3] = (h16)a0.w;
            pf[4] = (h16)a1.x; pf[5] = (h16)a1.y; pf[6] = (h16)a1.z; pf[7] = (h16)a1.w;
        }
#pragma unroll
        for (int c0 = 0; c0 < 8; c0 += 4) {
            h16x8 vf[4];
            tr_read8x4(az0, az1, c0, vf);
#pragma unroll
            for (int c = 0; c < 4; ++c) oacc[c0 + c] = __builtin_amdgcn_mfma_f32_16x16x32_f16(pf, vf[c], oacc[c0 + c], 0, 0, 0);
        }
    }
    float inv[4];
#pragma unroll
    for (int j = 0; j < 4; ++j) inv[j] = 1.f / __shfl(sum, j);
    h16* ost = (h16*)img;
    if (g == 0) {
#pragma unroll
        for (int c = 0; c < 8; ++c)
#pragma unroll
            for (int j = 0; j < 4; ++j) ost[j * 128 + 16 * c + r16] = (h16)(oacc[c][j] * inv[j]);
    }
    asm volatile("s_waitcnt lgkmcnt(0)" ::: "memory");
    *(u32x4*)(p.ATT + (size_t)t * 2048 + n * 512 + lane * 8) = *(const u32x4*)(ost + lane * 8);
    asm volatile("s_waitcnt lgkmcnt(0)" ::: "memory");
}

__device__ __forceinline__ void sample_topk_item(const Params& p, int t, char* smem) {
    const int tid = otid(), lane = tid & 63, wave = tid >> 6;
    int* red = (int*)smem;
    int* cnts = red + 16;
    __syncthreads();
    unsigned u[33];
#pragma unroll
    for (int i = 0; i < 33; ++i) { const int s = i * 512 + tid; u[i] = (s < LS) ? f2ord(p.SSC[(size_t)t * SSCS + s]) : 0u; }
    unsigned tau = 0u;
    for (int bit = 31; bit >= 0; --bit) {
        const unsigned cand = tau | (1u << bit);
        int c = 0;
#pragma unroll
        for (int i = 0; i < 33; ++i) c += (u[i] >= cand) ? 1 : 0;
#pragma unroll
        for (int o = 32; o > 0; o >>= 1) c += __shfl_xor(c, o);
        if (lane == 0) red[wave] = c;
        __syncthreads();
        int tot = 0;
#pragma unroll
        for (int w = 0; w < 8; ++w) tot += red[w];
        __syncthreads();
        if (tot >= 256) tau = cand;
    }
    const u64 lt = (1ull << lane) - 1ull;
#pragma unroll
    for (int i = 0; i < 33; ++i) {
        const u64 mg = __ballot(u[i] > tau), me = __ballot(u[i] == tau);
        if (lane == 0) { cnts[i * 8 + wave] = __popcll(mg); cnts[264 + i * 8 + wave] = __popcll(me); }
        if ((i & 3) == 3) __builtin_amdgcn_sched_barrier(0);
    }
    __syncthreads();
    int cg_tot = 0;
#pragma unroll 8
    for (int i = 0; i < 264; ++i) cg_tot += cnts[i];
    const int need_eq = 256 - cg_tot;
    int eq_before = 0, sel_before = 0;
    int* outp = p.STOP + t * 256;
    unsigned tau2 = tau; asm volatile("" : "+v"(tau2));
#pragma unroll
    for (int i = 0; i < 33; ++i) {
        int eb = eq_before, sb = sel_before;
        for (int w = 0; w < wave; ++w) {
            const int ng = cnts[i * 8 + w], ne = cnts[264 + i * 8 + w];
            int take_e = need_eq - eb; take_e = take_e < 0 ? 0 : (take_e > ne ? ne : take_e);
            eb += ne; sb += ng + take_e;
        }
        const bool gt = u[i] > tau2, eq = u[i] == tau2;
        const u64 me = __ballot(eq);
        const bool sel = gt || (eq && (eb + __popcll(me & lt)) < need_eq);
        const u64 ms = __ballot(sel);
        if (sel) outp[sb + __popcll(ms & lt)] = i * 512 + tid;
        for (int w = 0; w < 8; ++w) {
            const int ng = cnts[i * 8 + w], ne = cnts[264 + i * 8 + w];
            int take_e = need_eq - eq_before; take_e = take_e < 0 ? 0 : (take_e > ne ? ne : take_e);
            eq_before += ne; sel_before += ng + take_e;
        }
        __builtin_amdgcn_sched_barrier(0);
    }
    __syncthreads();
}

__device__ __forceinline__ void phase3(const Params& p, char* smem, int rep) {
    const int c = blockIdx.x, G = gridDim.x;
    for (int it = c; it < 136; it += G) { if (it < 128) scan_item(p, it); else sample_topk_item(p, it - 128, smem); }
    volatile int* s_next = (volatile int*)(smem + LDS_BYTES - 64);
    const unsigned home = xb_xcc_id() & 7u;
    int dead = 0;
    for (;;) {
        __syncthreads();
        if (threadIdx.x == 0) {
            int it = -1;
            for (int qi = dead; qi < 8; ++qi) {
                const unsigned q = (home + qi) & 7u;
                const int v = (int)atomicAdd(&p.ctl[4096 + 512 * rep + 64 * q], 2u);
                if (v < 512) { it = (int)q * 512 + v; s_next[1] = qi; break; }
            }
            if (it < 0) s_next[1] = 8;
            s_next[0] = it;
        }
        __syncthreads();
        const int it = s_next[0];
        dead = s_next[1];
        if (it < 0) break;
        const int q = it >> 9;
        attn_item(p, q >> 2, q & 3, it & 511, smem);
        attn_item(p, q >> 2, q & 3, (it & 511) + 1, smem);
    }
}

__device__ __forceinline__ void retout_item(const Params& p, int b, int h, int c, char* smem) {
    const int tid = otid(), lane = tid & 63, wave = tid >> 6, r16 = lane & 15, g = lane >> 4;
    char* Vimg = smem;
    const size_t tok0 = (size_t)b * SEQ + c * 128;
    const float lg = ret_log_g(h);
#pragma unroll
    for (int i = 0; i < 8; ++i) {
        const int q = tid + 512 * i, sg = q >> 5, c32 = q & 31, bI = sg >> 5, s = sg & 31;
        const int tokl = bI * 32 + ((s >> 2) & 1) * 16 + 4 * (s >> 3) + (s & 3);
        const u32x4 raw = *(const u32x4*)(p.RV + (tok0 + tokl) * 2048 + h * 256 + c32 * 8);
        *(u32x4*)(Vimg + (bI * 2 + (c32 >> 4)) * 8192 + off_b(s, c32 & 15)) = raw;
    }
    __syncthreads();
    const int il = 16 * wave + r16;
    h16x8 qf[4], qd[4];
    {
        const h16* qp = p.RQ + (tok0 + il) * 1024 + h * 128 + g * 8;
        const float dq = __expf((float)(il + 1) * lg);
#pragma unroll
        for (int kk = 0; kk < 4; ++kk) {
            const u32x4 raw = *(const u32x4*)(qp + kk * 32);
            qf[kk] = __builtin_bit_cast(h16x8, raw);
            float v[8]; unpk8(raw, v);
#pragma unroll
            for (int e = 0; e < 8; ++e) v[e] *= dq;
            qd[kk] = __builtin_bit_cast(h16x8, pk8(v));
        }
    }
    f32x4 sacc[8];
#pragma unroll
    for (int jr = 0; jr < 2; ++jr) {
        h16x8 kf[4][4];
        if (4 * jr <= wave) {
#pragma unroll
            for (int q = 0; q < 4; ++q) {
                const int jt = 4 * jr + q, jc = jt <= wave ? jt : wave;
                const h16* kp = p.RK + (tok0 + 16 * jc + r16) * 1024 + h * 128 + g * 8;
#pragma unroll
                for (int kk = 0; kk < 4; ++kk) kf[q][kk] = *(const h16x8*)(kp + kk * 32);
            }
        }
#pragma unroll
        for (int q = 0; q < 4; ++q) {
            const int jt = 4 * jr + q;
            sacc[jt] = (f32x4){0.f, 0.f, 0.f, 0.f};
            if (jt <= wave) {
#pragma unroll
                for (int kk = 0; kk < 4; ++kk) sacc[jt] = __builtin_amdgcn_mfma_f32_16x16x32_f16(kf[q][kk], qf[kk], sacc[jt], 0, 0, 0);
#pragma unroll
                for (int j = 0; j < 4; ++j) { const int jl = 16 * jt + 4 * g + j; sacc[jt][j] = (il >= jl) ? sacc[jt][j] * __expf((float)(il - jl) * lg) : 0.f; }
            }
        }
        __builtin_amdgcn_sched_barrier(0);
    }
    f32x4 oacc[16];
    const h16* sp = p.SPT + ((size_t)((b * 8 + h) * 32 + c) * 256) * 128;
#pragma unroll
    for (int er = 0; er < 4; ++er) {
        h16x8 sf[4][4];
#pragma unroll
        for (int q = 0; q < 4; ++q) {
            const h16* sr = sp + (size_t)(16 * (4 * er + q) + r16) * 128 + g * 8;
#pragma unroll
            for (int kk = 0; kk < 4; ++kk) sf[q][kk] = *(const h16x8*)(sr + kk * 32);
        }
#pragma unroll
        for (int q = 0; q < 4; ++q) {
            const int et = 4 * er + q;
            oacc[et] = (f32x4){0.f, 0.f, 0.f, 0.f};
#pragma unroll
            for (int kk = 0; kk < 4; ++kk) oacc[et] = __builtin_amdgcn_mfma_f32_16x16x32_f16(sf[q][kk], qd[kk], oacc[et], 0, 0, 0);
        }
        __builtin_amdgcn_sched_barrier(0);
    }
    const unsigned rz0 = lds_u32(Vimg) + tr_addr16(lane, 0, 0), rz1 = lds_u32(Vimg) + tr_addr16(lane, 0, 1);
    static_for<0, 4>([&](auto BI) {
        constexpr int bI = decltype(BI)::value;
        if (2 * bI <= wave) {
            h16x8 pf;
            const f32x4 a0 = sacc[2 * bI], a1 = sacc[2 * bI + 1];
            pf[0] = (h16)a0.x; pf[1] = (h16)a0.y; pf[2] = (h16)a0.z; pf[3] = (h16)a0.w;
            pf[4] = (h16)a1.x; pf[5] = (h16)a1.y; pf[6] = (h16)a1.z; pf[7] = (h16)a1.w;
            static_for<0, 16>([&](auto ET) {
                constexpr int et = decltype(ET)::value;
                const h16x8 vf = tr_read8o<(bI * 2 + (et >> 3)) * 8192>(rz0 ^ (32u * (et & 7)), rz1 ^ (32u * (et & 7)));
                oacc[et] = __builtin_amdgcn_mfma_f32_16x16x32_f16(vf, pf, oacc[et], 0, 0, 0);
            });
        }
    });
    float s1 = 0.f;
#pragma unroll
    for (int et = 0; et < 16; ++et) s1 += oacc[et].x + oacc[et].y + oacc[et].z + oacc[et].w;
    s1 += __shfl_xor(s1, 16); s1 += __shfl_xor(s1, 32);
    const float mu = s1 * (1.f / 256.f);
    float s2 = 0.f;
#pragma unroll
    for (int et = 0; et < 16; ++et)
#pragma unroll
        for (int j = 0; j < 4; ++j) { const float d = oacc[et][j] - mu; s2 += d * d; }
    s2 += __shfl_xor(s2, 16); s2 += __shfl_xor(s2, 32);
    const float rs = rsqrtf(s2 * (1.f / 256.f) + EPS);
    const size_t tok = tok0 + il;
#pragma unroll
    for (int et = 0; et < 16; ++et) {
        const int e0 = h * 256 + 16 * et + 4 * g;
        const f32x4 gw = *(const f32x4*)(p.ret_gn_w + e0);
        const f32x2 rgraw = *(const f32x2*)(p.RG + tok * 2048 + e0);
        const float rgx = rgraw.x, rgy = rgraw.y;
        const h16x2 r0 = __builtin_bit_cast(h16x2, rgx), r1 = __builtin_bit_cast(h16x2, rgy);
        const float o0 = (oacc[et].x - mu) * rs * gw.x * (float)r0.x, o1 = (oacc[et].y - mu) * rs * gw.y * (float)r0.y;
        const float o2 = (oacc[et].z - mu) * rs * gw.z * (float)r1.x, o3 = (oacc[et].w - mu) * rs * gw.w * (float)r1.y;
        f32x2 o; o.x = __uint_as_float(pkh(o0, o1)); o.y = __uint_as_float(pkh(o2, o3));
        *(f32x2*)(p.RN + tok * 2048 + e0) = o;
    }
    __syncthreads();
}

__device__ __forceinline__ void sample_ret_item(const Params& p, int t, int h, char* smem) {
    const int tid = otid(), dv = tid & 255, half = tid >> 8;
    float* qs = (float*)smem;
    float* ks = qs + 128;
    float* part = ks + 128;
    float* red = part + 512;
    __syncthreads();
    if (tid < 128) { qs[tid] = p.SRQ[t * 1024 + h * 128 + tid]; ks[tid] = p.SRK[t * 1024 + h * 128 + tid]; }
    __syncthreads();
    const float gm = 1.f - exp2f(-5.f - (float)h);
    float qk = 0.f;
#pragma unroll 4
    for (int i = 0; i < 128; ++i) qk += qs[i] * ks[i];
    const float v = p.SRV[t * 2048 + h * 256 + dv];
    const float* Sin = p.state_ret + ((size_t)(t * 8 + h) * 128) * 256;
    float* Sout = p.out + O_SS + ((size_t)(t * 8 + h) * 128) * 256;
    float cross = 0.f;
#pragma unroll 8
    for (int i = 0; i < 64; ++i) {
        const int dk = half * 64 + i;
        const float s = Sin[(size_t)dk * 256 + dv];
        cross += qs[dk] * s;
        Sout[(size_t)dk * 256 + dv] = gm * s + ks[dk] * v;
    }
    part[half * 256 + dv] = cross;
    __syncthreads();
    float o = 0.f;
    if (tid < 256) o = qk * v + gm * (part[dv] + part[256 + dv]);
    float s1 = (tid < 256) ? o : 0.f;
    s1 = wave_sum(s1);
    if ((tid & 63) == 0) red[tid >> 6] = s1;
    __syncthreads();
    const float mu = (red[0] + red[1] + red[2] + red[3]) * (1.f / 256.f);
    float d = (tid < 256) ? (o - mu) : 0.f;
    float s2 = wave_sum(d * d);
    if ((tid & 63) == 0) red[8 + (tid >> 6)] = s2;
    __syncthreads();
    const float rs = rsqrtf((red[8] + red[9] + red[10] + red[11]) * (1.f / 256.f) + EPS);
    if (tid < 256) p.SRN[t * 2048 + h * 256 + dv] = d * rs * p.ret_gn_w[h * 256 + dv] * p.SRG[t * 2048 + h * 256 + dv];
    __syncthreads();
}

__device__ __forceinline__ void sample_attn_item(const Params& p, int t, int n, char* smem) {
    const int tid = otid(), lane = tid & 63, wave = tid >> 6;
    float* qs = (float*)smem;
    int* rowk = (int*)(smem + 2048);
    float* lg = (float*)(smem + 3072);
    float* part = (float*)(smem + 7168);
    float* sums = (float*)(smem + 23552);
    __syncthreads();
    qs[tid] = p.SAQ[t * 2048 + n * 512 + tid];
    if (tid < 256) { const int idx = p.STOP[t * 256 + tid]; rowk[tid] = (idx < PAST) ? p.page_table[t * NPAGES + (idx >> 7)] * PAGE + (idx & 127) : -1; }
    __syncthreads();
    {
        const int key = wave * 32 + (lane >> 1), dh = lane & 1, row = rowk[key];
        const float* kp = (row >= 0) ? p.cache_k + ((size_t)row * 4 + n) * 128 + dh * 64 : p.SAK + t * 512 + n * 128 + dh * 64;
        f32x4 kv[16];
#pragma unroll
        for (int i = 0; i < 16; ++i) kv[i] = *(const f32x4*)(kp + 4 * i);
#pragma unroll
        for (int h = 0; h < 4; ++h) {
            float d = 0.f;
#pragma unroll
            for (int i = 0; i < 16; ++i) { const f32x4 q = *(const f32x4*)(qs + h * 128 + dh * 64 + 4 * i); d += kv[i].x * q.x + kv[i].y * q.y + kv[i].z * q.z + kv[i].w * q.w; }
            d += __shfl_xor(d, 1);
            if (dh == 0) lg[h * 256 + key] = d;
        }
    }
    __syncthreads();
    if (wave < 4) {
        float v[4];
#pragma unroll
        for (int i = 0; i < 4; ++i) v[i] = lg[wave * 256 + lane + 64 * i];
        const float mx = wave_max(fmaxf(fmaxf(v[0], v[1]), fmaxf(v[2], v[3])));
        float s = 0.f;
#pragma unroll
        for (int i = 0; i < 4; ++i) { v[i] = __expf(v[i] - mx); s += v[i]; lg[wave * 256 + lane + 64 * i] = v[i]; }
        s = wave_sum(s);
        if (lane == 0) sums[wave] = s;
    }
    __syncthreads();
    {
        const int sub = lane >> 4, dc = lane & 15;
        float acc[4][8];
#pragma unroll
        for (int h = 0; h < 4; ++h)
#pragma unroll
            for (int e = 0; e < 8; ++e) acc[h][e] = 0.f;
        f32x4 va[8], vb[8];
#pragma unroll
        for (int j = 0; j < 8; ++j) {
            const int row = rowk[wave * 32 + sub * 8 + j];
            const float* vp = (row >= 0) ? p.cache_v + ((size_t)row * 4 + n) * 128 + dc * 8 : p.SAV + t * 512 + n * 128 + dc * 8;
            va[j] = *(const f32x4*)vp; vb[j] = *(const f32x4*)(vp + 4);
        }
#pragma unroll
        for (int j = 0; j < 8; ++j) {
            const int key = wave * 32 + sub * 8 + j;
#pragma unroll
            for (int h = 0; h < 4; ++h) {
                const float pk = lg[h * 256 + key];
                acc[h][0] += pk * va[j].x; acc[h][1] += pk * va[j].y; acc[h][2] += pk * va[j].z; acc[h][3] += pk * va[j].w;
                acc[h][4] += pk * vb[j].x; acc[h][5] += pk * vb[j].y; acc[h][6] += pk * vb[j].z; acc[h][7] += pk * vb[j].w;
            }
        }
#pragma unroll
        for (int h = 0; h < 4; ++h)
#pragma unroll
            for (int e = 0; e < 8; ++e) { float v = acc[h][e]; v += __shfl_xor(v, 16); v += __shfl_xor(v, 32); if (sub == 0) part[(wave * 4 + h) * 128 + dc * 8 + e] = v; }
    }
    __syncthreads();
    {
        const int h = tid >> 7, d = tid & 127;
        float o = 0.f;
#pragma unroll
        for (int w = 0; w < 8; ++w) o += part[(w * 4 + h) * 128 + d];
        p.SATT[t * 2048 + (n * 4 + h) * 128 + d] = o / sums[h];
    }
    __syncthreads();
}

__device__ __forceinline__ void phase4(const Params& p, char* smem) {
    const int c = blockIdx.x, G = gridDim.x;
    for (int it = G - 1 - c; it < 96; it += G) {
        if (it < 32) sample_attn_item(p, it >> 2, it & 3, smem);
        else sample_ret_item(p, (it - 32) >> 3, (it - 32) & 7, smem);
    }
    for (int it = c; it < 512; it += G) retout_item(p, it >> 8, (it >> 5) & 7, it & 31, smem);
}

__device__ __forceinline__ void phase5(const Params& p, char* smem) {
    const int tid = otid();
    for (int i = 0;; ++i) {
        int pm, pn; if (!unit_next(i, TP / 256, D / 256, pm, pn)) break;
        f32x4 acc[2][2][4][2] = {};
        gemm_core(p.RN, p.WrT, pm * 256, pn * 256, D, acc, (h16*)smem);
        {
            const int tz = otid(), wid = tz >> 6, lane = tz & 63, wr = wid >> 2, wc = wid & 3, fr = lane & 15, fq = lane >> 4;
            h16* R16 = (h16*)smem;
            __syncthreads();
#pragma unroll 4
            for (int i = 0; i < 16; ++i) {
                const int q = tz + 512 * i, row = q >> 5, ch = q & 31;
                const size_t off = (size_t)(pm * 256 + row) * D + pn * 256 + ch * 8;
                float gr[8], ga[8];
                unpk8(*(const u32x4*)(p.GR + off), gr); unpk8(*(const u32x4*)(p.GA + off), ga);
#pragma unroll
                for (int e = 0; e < 8; ++e) gr[e] *= __builtin_amdgcn_rcpf(fmaxf(ga[e], 1e-4f));
                *(u32x4*)(R16 + row * ES16 + ch * 8) = pk8(gr);
            }
            __syncthreads();
#pragma unroll
            for (int ai = 0; ai < 2; ++ai)
#pragma unroll
                for (int bj = 0; bj < 2; ++bj)
#pragma unroll
                    for (int m = 0; m < 4; ++m)
#pragma unroll
                        for (int n = 0; n < 2; ++n) {
                            const f32x2 rr = *(const f32x2*)(R16 + (ai * 128 + wr * 64 + m * 16 + fr) * ES16 + bj * 128 + wc * 32 + n * 16 + fq * 4);
                            const float rx = rr.x, ry = rr.y;
                            const h16x2 r0 = __builtin_bit_cast(h16x2, rx), r1 = __builtin_bit_cast(h16x2, ry);
                            acc[ai][bj][m][n].x *= (float)r0.x; acc[ai][bj][m][n].y *= (float)r0.y; acc[ai][bj][m][n].z *= (float)r1.x; acc[ai][bj][m][n].w *= (float)r1.y;
                        }
        }
        __syncthreads();
        gemm_core(p.ATT, p.WaT, pm * 256, pn * 256, D, acc, (h16*)smem);
        epilogue_full(acc, smem, [&](int ai, int bj, int r, int part, float* x1, float* x2) {
            const size_t rowoff = (size_t)(pm * 256 + ai * 128 + r) * D + pn * 256 + bj * 128;
            const h16* gp = p.GA + rowoff;
            float g1[16], g2[16];
            unpk8(*(const u32x4*)(gp + 16 * part), g1); unpk8(*(const u32x4*)(gp + 16 * part + 8), g1 + 8);
            unpk8(*(const u32x4*)(gp + 64 + 16 * part), g2); unpk8(*(const u32x4*)(gp + 64 + 16 * part + 8), g2 + 8);
#pragma unroll
            for (int e = 0; e < 16; ++e) { x1[e] *= fmaxf(g1[e], 1e-4f); x2[e] *= fmaxf(g2[e], 1e-4f); }
            store_h16_32(p.MIX + rowoff, part, x1, x2);
        });
    }
    for (int it = blockIdx.x; it < 256; it += gridDim.x) {
        float* SMIX = p.SMIX; const float* SGR = p.SGR; const float* SGA = p.SGA;
        gemv8_item<8>(p.SRN, p.w_ret_o, D, it * 8, smem, [=](int t, int n, float v) { SMIX[t * D + n] = SGR[t * D + n] * v; });
        gemv8_item<8>(p.SATT, p.w_att_o, D, it * 8, smem, [=](int t, int n, float v) { SMIX[t * D + n] += SGA[t * D + n] * v; });
    }
}

__device__ __forceinline__ void phase6(const Params& p, char* smem) {
    const int tid = otid();
    for (int i = 0;; ++i) {
        int pm, pn; if (!unit_next(i, TP / 256, D / 256, pm, pn)) break;
        f32x4 acc[2][2][4][2] = {};
#ifdef GEMM_TWICE
        gemm_core(p.MIX, p.WoT, pm * 256, pn * 256, D, acc, (h16*)smem);
        __syncthreads();
        for (int a = 0; a < 2; ++a) for (int b = 0; b < 2; ++b) for (int m = 0; m < 4; ++m) for (int n = 0; n < 2; ++n) acc[a][b][m][n] = acc[a][b][m][n] * 0.0f;
#endif
        gemm_core(p.MIX, p.WoT, pm * 256, pn * 256, D, acc, (h16*)smem);
        epilogue_full(acc, smem, [&](int ai, int bj, int r, int part, float* x1, float* x2) {
            const size_t rowoff = (size_t)(pm * 256 + ai * 128 + r) * D + pn * 256 + bj * 128;
            const float* xp = p.x_prompt + rowoff;
#pragma unroll
            for (int q = 0; q < 4; ++q) {
                const f32x4 a = *(const f32x4*)(xp + 16 * part + 4 * q), bq = *(const f32x4*)(xp + 64 + 16 * part + 4 * q);
                x1[4 * q] += a.x; x1[4 * q + 1] += a.y; x1[4 * q + 2] += a.z; x1[4 * q + 3] += a.w;
                x2[4 * q] += bq.x; x2[4 * q + 1] += bq.y; x2[4 * q + 2] += bq.z; x2[4 * q + 3] += bq.w;
            }
            store_h16_32(p.HN + rowoff, part, x1, x2);
            float ss = 0.f;
#pragma unroll
            for (int e = 0; e < 16; ++e) ss += x1[e] * x1[e] + x2[e] * x2[e];
            ss = quad_sum(ss);
            if (part == 0) atomicAdd(p.ROWSS + pm * 256 + ai * 128 + r, ss);
        });
    }
    for (int it = blockIdx.x; it < 256; it += gridDim.x) {
        float* out = p.out; const float* xs = p.x_sample;
        gemv8_item<8>(p.SMIX, p.w_out, D, it * 8, smem, [=](int t, int n, float v) { out[O_YS + t * D + n] = xs[t * D + n] + v; });
    }
}

__device__ __forceinline__ void phase7(const Params& p) {
    const int t0 = otid(), lane = t0 & 63, gw = blockIdx.x * 8 + (t0 >> 6), NGW = gridDim.x * 8;
    for (int r = gw; r < TT; r += NGW) {
        const float* x = (r < TP) ? p.out + O_YP + (size_t)r * D : p.out + O_YS + (size_t)(r - TP) * D;
        f32x4 v[8]; float ss = 0.f;
#pragma unroll
        for (int j = 0; j < 8; ++j) { v[j] = *(const f32x4*)(x + 4 * (lane + 64 * j)); ss += v[j].x * v[j].x + v[j].y * v[j].y + v[j].z * v[j].z + v[j].w * v[j].w; }
        ss = wave_sum(ss);
        const float rs = rsqrtf(ss * (1.f / D) + EPS);
#pragma unroll
        for (int j = 0; j < 8; ++j) {
            const f32x4 w = *(const f32x4*)(p.norm2_w + 4 * (lane + 64 * j));
            const float a = v[j].x * rs * w.x, b = v[j].y * rs * w.y, c = v[j].z * rs * w.z, d = v[j].w * rs * w.w;
            if (r < TP) { f32x2 o; o.x = __uint_as_float(pkh(a, b)); o.y = __uint_as_float(pkh(c, d)); *(f32x2*)(p.HN + (size_t)r * D + 4 * (lane + 64 * j)) = o; }
            else { f32x4 o = {a, b, c, d}; *(f32x4*)(p.SHN + (size_t)(r - TP) * D + 4 * (lane + 64 * j)) = o; }
        }
    }
}

constexpr int PCV_ITER = 4;
constexpr int PCV_UCH = (int)(((size_t)NEXP * D / 32) / (512 * PCV_ITER));
constexpr int PCV_VCH = PCV_UCH;
constexpr int PCV_CHUNKS = PCV_UCH + PCV_VCH;
__device__ __forceinline__ void peer_convert_chunk(const Params& p, int chunk) {
    const int tid = otid();
    const bool isu = chunk < PCV_UCH;
    const size_t base = (size_t)(isu ? chunk : chunk - PCV_UCH) * (512 * PCV_ITER) + tid;
    const float* tab = isu ? p.peer_u : p.peer_v;
    unsigned char* outp = (unsigned char*)(isu ? p.PU : p.PV);
    const float sc = isu ? 64.f : 16.f;
#pragma unroll 2
    for (int r = 0; r < PCV_ITER; ++r) {
        const float* src = tab + (base + (size_t)r * 512) * 32;
        f32x4 a[8];
#pragma unroll
        for (int q = 0; q < 8; ++q) a[q] = *(const f32x4*)(src + 4 * q);
        if (isu) {
            const float* wk = p.norm2_w + (int)(((base + (size_t)r * 512) & 63) * 32);
#pragma unroll
            for (int q = 0; q < 8; ++q) { const f32x4 w4 = *(const f32x4*)(wk + 4 * q); a[q].x *= w4.x; a[q].y *= w4.y; a[q].z *= w4.z; a[q].w *= w4.w; }
        }
        u32x4 o;
#pragma unroll
        for (int q = 0; q < 4; ++q) {
            unsigned w = 0u;
            w = __builtin_amdgcn_cvt_scalef32_pk_fp4_f32(w, a[2 * q].x * sc, a[2 * q].y * sc, 1.0f, 0);
            w = __builtin_amdgcn_cvt_scalef32_pk_fp4_f32(w, a[2 * q].z * sc, a[2 * q].w * sc, 1.0f, 1);
            w = __builtin_amdgcn_cvt_scalef32_pk_fp4_f32(w, a[2 * q + 1].x * sc, a[2 * q + 1].y * sc, 1.0f, 2);
            w = __builtin_amdgcn_cvt_scalef32_pk_fp4_f32(w, a[2 * q + 1].z * sc, a[2 * q + 1].w * sc, 1.0f, 3);
            o[q] = w;
        }
        *(u32x4*)(outp + (base + (size_t)r * 512) * 16) = o;
    }
}
__device__ __forceinline__ void peer_convert_pull(const Params& p, char* smem, int rep) {
    volatile int* s_next = (volatile int*)(smem + LDS_BYTES - 64);
    for (;;) {
        __syncthreads();
        if (threadIdx.x == 0) s_next[0] = (int)atomicAdd(&p.ctl[6144 + 64 * rep], 1u);
        __syncthreads();
        const int ch = s_next[0];
        if (ch >= PCV_CHUNKS) break;
        peer_convert_chunk(p, ch);
    }
}

__device__ __forceinline__ void phase8(const Params& p, char* smem, int rep) {
    const int tid = otid();
    for (int i = 0;; ++i) {
        int pm, pn; if (!unit_next(i, TP / 256, 1024 / 256, pm, pn)) break;
        f32x4 acc[2][2][4][2] = {};
        gemm_core(p.HN, p.WqT, pm * 256, pn * 256, D, acc, (h16*)smem);
        epilogue_full(acc, smem, [&](int ai, int bj, int r, int part, float* x1, float* x2) {
            const float rs = rsqrtf(p.ROWSS[pm * 256 + ai * 128 + r] * (1.f / D) + EPS);
#pragma unroll
            for (int e = 0; e < 16; ++e) { x1[e] *= rs; x2[e] *= rs; }
            store_h16_32((h16*)p.PQ + (size_t)(pm * 256 + ai * 128 + r) * 1024 + pn * 256 + bj * 128, part, x1, x2);
        });
    }
    {
        const int G = gridDim.x, first = (G > 144) ? 128 : 0;
        if ((int)blockIdx.x >= first)
            for (int it = blockIdx.x - first; it < 128; it += G - first) {
                float* SPQ = p.SPQ;
                gemv8_item<8>(p.out + O_YS, p.peer_wq, 1024, it * 8, smem, [=](int t, int n, float v) { SPQ[t * 1024 + n] = v; }, p.norm2_w, it == 0 ? p.SHN : nullptr);
            }
    }
    peer_convert_pull(p, smem, rep);
}

template <int NV, class EMIT>
__device__ __forceinline__ void wave_select(const unsigned (&u)[NV], int K, int lane, EMIT emit) {
    unsigned tau; int need_eq;
    if constexpr (NV < 8) wave_kth_r4<NV>(u, K, tau, need_eq); else wave_kth<NV>(u, K, tau, need_eq);
    const u64 lt = (1ull << lane) - 1ull;
    int base = 0, eqt = 0;
    unsigned tau2 = tau; asm volatile("" : "+v"(tau2));
#pragma unroll
    for (int i = 0; i < NV; ++i) {
        const bool gt = u[i] > tau2, eq = u[i] == tau2;
        const u64 meq = __ballot(eq);
        const bool sel = gt || (eq && (eqt + __popcll(meq & lt)) < need_eq);
        const u64 ms = __ballot(sel);
        if (sel) emit(i, base + __popcll(ms & lt));
        base += __popcll(ms); eqt += __popcll(meq);
    }
}

template <bool SAMPLE>
__device__ __forceinline__ void load_row8(const void* base, size_t row, int chunk, float* v) {
    if (SAMPLE) {
        const float* r = (const float*)base + row * D + chunk * 8;
        const f32x4 a = *(const f32x4*)r, b = *(const f32x4*)(r + 4);
        v[0] = a.x; v[1] = a.y; v[2] = a.z; v[3] = a.w; v[4] = b.x; v[5] = b.y; v[6] = b.z; v[7] = b.w;
    } else {
        unpk8(*(const u32x4*)((const h16*)base + row * D + chunk * 8), v);
    }
}

template <bool SAMPLE>
__device__ __forceinline__ void peer_item(const Params& p, int tk, char* smem) {
    const int tid = otid(), lane = tid & 63, h = tid >> 6;
    float* qsh = (float*)smem;
    int* route_e = (int*)(smem + 4096);
    float* route_g = (float*)(smem + 4608);
    float* l1v = (float*)(smem + 5120);
    int* l1i = (int*)(smem + 5632);
    float* l2v = (float*)(smem + 6144);
    int* l2i = (int*)(smem + 6656);
    float* parts = (float*)(smem + 8192);
    const int ts = tk - TP;
    __syncthreads();
    { const float* q = SAMPLE ? p.SPQ + (size_t)ts * 1024 : p.PQ + (size_t)tk * 1024; qsh[tid] = q[tid]; qsh[tid + 512] = q[tid + 512]; }
    __syncthreads();
    {
        float s1[2], s2[2];
#pragma unroll
        for (int i = 0; i < 2; ++i) {
            const int key = lane + 64 * i;
            float a = 0.f, b = 0.f;
            if constexpr (SAMPLE) {
                const float* k1 = p.peer_k1 + ((size_t)(h * 128 + key)) * 64;
                const float* k2 = p.peer_k2 + ((size_t)(h * 128 + key)) * 64;
#pragma unroll 4
                for (int c4 = 0; c4 < 16; ++c4) {
                    const f32x4 x = *(const f32x4*)(k1 + 4 * c4), y = *(const f32x4*)(k2 + 4 * c4);
                    const f32x4 q1 = *(const f32x4*)(qsh + h * 128 + 4 * c4), q2 = *(const f32x4*)(qsh + h * 128 + 64 + 4 * c4);
                    a += x.x * q1.x + x.y * q1.y + x.z * q1.z + x.w * q1.w;
                    b += y.x * q2.x + y.y * q2.y + y.z * q2.z + y.w * q2.w;
                }
            } else {
                const h16* k1 = p.K1H + ((size_t)(h * 128 + key)) * 64;
                const h16* k2 = p.K2H + ((size_t)(h * 128 + key)) * 64;
#pragma unroll 2
                for (int c8 = 0; c8 < 8; ++c8) {
                    float x[8], y[8]; unpk8(*(const u32x4*)(k1 + 8 * c8), x); unpk8(*(const u32x4*)(k2 + 8 * c8), y);
                    const f32x4 q1a = *(const f32x4*)(qsh + h * 128 + 8 * c8), q1b = *(const f32x4*)(qsh + h * 128 + 8 * c8 + 4);
                    const f32x4 q2a = *(const f32x4*)(qsh + h * 128 + 64 + 8 * c8), q2b = *(const f32x4*)(qsh + h * 128 + 64 + 8 * c8 + 4);
                    a += x[0] * q1a.x + x[1] * q1a.y + x[2] * q1a.z + x[3] * q1a.w + x[4] * q1b.x + x[5] * q1b.y + x[6] * q1b.z + x[7] * q1b.w;
                    b += y[0] * q2a.x + y[1] * q2a.y + y[2] * q2a.z + y[3] * q2a.w + y[4] * q2b.x + y[5] * q2b.y + y[6] * q2b.z + y[7] * q2b.w;
                }
            }
            s1[i] = a; s2[i] = b;
        }
        unsigned u[2];
        u[0] = f2ord(s1[0]); u[1] = f2ord(s1[1]);
        wave_select<2>(u, 16, lane, [&](int i, int pos) { l1v[h * 16 + pos] = s1[i]; l1i[h * 16 + pos] = lane + 64 * i; });
        u[0] = f2ord(s2[0]); u[1] = f2ord(s2[1]);
        wave_select<2>(u, 16, lane, [&](int i, int pos) { l2v[h * 16 + pos] = s2[i]; l2i[h * 16 + pos] = lane + 64 * i; });
        asm volatile("s_waitcnt lgkmcnt(0)" ::: "memory");
        float cv[4]; unsigned cu[4];
        const int a = lane >> 2;
#pragma unroll
        for (int i = 0; i < 4; ++i) { cv[i] = l1v[h * 16 + a] + l2v[h * 16 + (lane & 3) * 4 + i]; cu[i] = f2ord(cv[i]); }
        wave_select<4>(cu, 16, lane, [&](int i, int pos) { route_g[h * 16 + pos] = cv[i]; route_e[h * 16 + pos] = l1i[h * 16 + a] * 128 + l2i[h * 16 + (lane & 3) * 4 + i]; });
        asm volatile("s_waitcnt lgkmcnt(0)" ::: "memory");
        float sc = (lane < 16) ? route_g[h * 16 + lane] : -3.0e38f;
        const float mx = wave_max(sc);
        const float ex = (lane < 16) ? __expf(sc - mx) : 0.f;
        const float sm = wave_sum(ex);
        asm volatile("s_waitcnt lgkmcnt(0)" ::: "memory");
        if (lane < 16) route_g[h * 16 + lane] = ex / sm;
        asm volatile("s_waitcnt lgkmcnt(0)" ::: "memory");
    }
    {
        const void* hnb = SAMPLE ? (const void*)p.SHN : (const void*)p.HN;
        const void* ub = SAMPLE ? (const void*)p.peer_u : (const void*)p.PU;
        const void* vb = SAMPLE ? (const void*)p.peer_v : (const void*)p.PV;
        const size_t hrow = SAMPLE ? (size_t)ts : (size_t)tk;
        float hv[SAMPLE ? 32 : 1], facc[32];
        u32x4 hp[SAMPLE ? 1 : 4];
        if constexpr (SAMPLE) {
#pragma unroll
            for (int jj = 0; jj < 2; ++jj) { load_row8<true>(hnb, hrow, 2 * (lane + 64 * jj), hv + 16 * jj); load_row8<true>(hnb, hrow, 2 * (lane + 64 * jj) + 1, hv + 16 * jj + 8); }
        } else {
#pragma unroll
            for (int jj = 0; jj < 2; ++jj) { hp[2 * jj] = *(const u32x4*)((const h16*)hnb + hrow * D + (lane + 64 * jj) * 16); hp[2 * jj + 1] = *(const u32x4*)((const h16*)hnb + hrow * D + (lane + 64 * jj) * 16 + 8); }
        }
#pragma unroll
        for (int i = 0; i < 32; ++i) facc[i] = 0.f;
        if constexpr (SAMPLE) {
#pragma unroll 1
            for (int k = 0; k < 16; ++k) {
                const size_t e = (size_t)route_e[h * 16 + k];
                const float* up = (const float*)ub + e * D; const float* vp = (const float*)vb + e * D;
                f32x4 ur[8], vr[8];
#pragma unroll
                for (int jj = 0; jj < 2; ++jj)
#pragma unroll
                    for (int q = 0; q < 4; ++q) { ur[4 * jj + q] = *(const f32x4*)(up + (lane + 64 * jj) * 16 + 4 * q); vr[4 * jj + q] = *(const f32x4*)(vp + (lane + 64 * jj) * 16 + 4 * q); }
                float d = 0.f;
#pragma unroll
                for (int i = 0; i < 8; ++i) d += hv[4 * i] * ur[i].x + hv[4 * i + 1] * ur[i].y + hv[4 * i + 2] * ur[i].z + hv[4 * i + 3] * ur[i].w;
                d = wave_sum(d);
                const float cw = route_g[h * 16 + k] * gelu_exact(d);
#pragma unroll
                for (int i = 0; i < 8; ++i) { facc[4 * i] += cw * vr[i].x; facc[4 * i + 1] += cw * vr[i].y; facc[4 * i + 2] += cw * vr[i].z; facc[4 * i + 3] += cw * vr[i].w; }
            }
        } else {
            const unsigned char* u8 = (const unsigned char*)ub; const unsigned char* v8 = (const unsigned char*)vb;
#pragma unroll 1
            for (int k = 0; k < 16; k += 8) {
                u32x4 ur[8][2], vr[8][2];
#pragma unroll
                for (int x = 0; x < 8; ++x) {
                    const size_t e = (size_t)route_e[h * 16 + k + x];
#pragma unroll
                    for (int jj = 0; jj < 2; ++jj) { ur[x][jj] = *(const u32x4*)(u8 + e * D + (lane + 64 * jj) * 16); vr[x][jj] = *(const u32x4*)(v8 + e * D + (lane + 64 * jj) * 16); }
                }
#pragma unroll
                for (int x = 0; x < 8; ++x) {
                    float d = 0.f;
#pragma unroll
                    for (int jj = 0; jj < 2; ++jj)
#pragma unroll
                        for (int q = 0; q < 4; ++q) {
                            const int w = (int)ur[x][jj][q];
                            const f32x2 lo = __builtin_amdgcn_cvt_pk_f32_fp8(w, false), hi = __builtin_amdgcn_cvt_pk_f32_fp8(w, true);
                            const unsigned h0 = hp[2 * jj + (q >> 1)][2 * (q & 1)], h1 = hp[2 * jj + (q >> 1)][2 * (q & 1) + 1];
                            const h16x2 p0 = __builtin_bit_cast(h16x2, h0), p1 = __builtin_bit_cast(h16x2, h1);
                            d += (float)p0.x * lo.x + (float)p0.y * lo.y + (float)p1.x * hi.x + (float)p1.y * hi.y;
                        }
                    d = wave_sum(d) * (1.f / 64.f);
                    const float cw = route_g[h * 16 + k + x] * gelu_exact(d) * (1.f / 16.f);
#pragma unroll
                    for (int jj = 0; jj < 2; ++jj)
#pragma unroll
                        for (int q = 0; q < 4; ++q) {
                            const int w = (int)vr[x][jj][q];
                            const f32x2 lo = __builtin_amdgcn_cvt_pk_f32_fp8(w, false), hi = __builtin_amdgcn_cvt_pk_f32_fp8(w, true);
                            facc[16 * jj + 4 * q] += cw * lo.x; facc[16 * jj + 4 * q + 1] += cw * lo.y; facc[16 * jj + 4 * q + 2] += cw * hi.x; facc[16 * jj + 4 * q + 3] += cw * hi.y;
                        }
                }
            }
        }
#pragma unroll
        for (int jj = 0; jj < 2; ++jj) {
            float* dst = parts + h * 2048 + (lane + 64 * jj) * 16;
#pragma unroll
            for (int q = 0; q < 4; ++q) { f32x4 a = {facc[16 * jj + 4 * q], facc[16 * jj + 4 * q + 1], facc[16 * jj + 4 * q + 2], facc[16 * jj + 4 * q + 3]}; *(f32x4*)(dst + 4 * q) = a; }
        }
    }
    __syncthreads();
    {
        f32x4 f = {0.f, 0.f, 0.f, 0.f};
#pragma unroll
        for (int w = 0; w < 8; ++w) { const f32x4 a = *(const f32x4*)(parts + w * 2048 + tid * 4); f.x += a.x; f.y += a.y; f.z += a.z; f.w += a.w; }
        float* y = SAMPLE ? p.out + O_YS + (size_t)ts * D + tid * 4 : p.out + O_YP + (size_t)tk * D + tid * 4;
        f32x4 hh = *(const f32x4*)y;
        hh.x += f.x; hh.y += f.y; hh.z += f.z; hh.w += f.w;
        *(f32x4*)y = hh;
    }
}

static __device__ const unsigned char PAIR_LUT[64] = {0,1,2,3,4,5,6,7,8,9,10,11,12,13,14,15,16,17,18,19,20,21,22,23,32,33,34,35,36,48,49,50,51,64,65,66,80,81,96,97,112,113,128,144,160,176,192,208,224,240,0,0,0,0,0,0,0,0,0,0,0,0,0,0};
__device__ __forceinline__ void peer_route_wg(const Params& p, char* smem) {
    const int tid = otid(), lane = tid & 63, wave = tid >> 6;
    const int c = blockIdx.x, G = gridDim.x, h = c & 7;
    constexpr int KS = 144;
    char* K1 = smem; char* K2 = smem + 128 * KS;
    float* qw = (float*)(smem + 2 * 128 * KS) + wave * 128;
    float* lst = (float*)(smem + 2 * 128 * KS + 8 * 512) + wave * 160;
    float* l1v = lst; int* l1i = (int*)(lst + 16); float* l2v = lst + 32; int* l2i = (int*)(lst + 48); float* scv = lst + 64; int* eid = (int*)(lst + 80);
    __syncthreads();
    for (int i = tid; i < 2 * 128 * 8; i += 512) {
        const int tbl = i >> 10, r = (i >> 3) & 127, ch = i & 7;
        const h16* src = (tbl ? p.K2H : p.K1H) + ((size_t)(h * 128 + r)) * 64 + ch * 8;
        *(u32x4*)((tbl ? K2 : K1) + r * KS + ch * 16) = *(const u32x4*)src;
    }
    __syncthreads();
    const int nblk = TP / 64;
    volatile int* s_next = (volatile int*)(smem + LDS_BYTES - 64);
    for (;;) {
        __syncthreads();
        if (threadIdx.x == 0) s_next[0] = (int)atomicAdd(&p.ctl[6400 + 64 * h], 1u);
        __syncthreads();
        const int tb = s_next[0];
        if (tb >= nblk) break;
        float* SW = (float*)(smem + 65536) + wave * 2048;
        {
            const int r16 = lane & 15, g = lane >> 4;
            const h16* qrow = (const h16*)p.PQ + (size_t)(64 * tb + wave * 8 + (r16 & 7)) * 1024 + h * 128 + g * 8;
            h16x8 qa[2][2];
#pragma unroll
            for (int tb2 = 0; tb2 < 2; ++tb2)
#pragma unroll
                for (int kk = 0; kk < 2; ++kk) qa[tb2][kk] = *(const h16x8*)(qrow + tb2 * 64 + kk * 32);
#pragma unroll
            for (int tb2 = 0; tb2 < 2; ++tb2) {
                const char* KT = tb2 ? K2 : K1;
#pragma unroll
                for (int nt = 0; nt < 8; ++nt) {
                    f32x4 a = {0.f, 0.f, 0.f, 0.f};
#pragma unroll
                    for (int kk = 0; kk < 2; ++kk) {
                        const h16x8 kb = *(const h16x8*)(KT + (16 * nt + r16) * KS + (kk * 4 + g) * 16);
                        a = __builtin_amdgcn_mfma_f32_16x16x32_f16(qa[tb2][kk], kb, a, 0, 0, 0);
                    }
                    if (g < 2) {
#pragma unroll
                        for (int j = 0; j < 4; ++j) SW[(tb2 * 8 + 4 * g + j) * 128 + 16 * nt + r16] = a[j];
                    }
                }
            }
            asm volatile("s_waitcnt lgkmcnt(0)" ::: "memory");
        }
        for (int j = 0; j < 8; ++j) {
            const int tk = 64 * tb + wave * 8 + j;
            float s1[2], s2[2];
            s1[0] = SW[j * 128 + lane]; s1[1] = SW[j * 128 + 64 + lane]; s2[0] = SW[(8 + j) * 128 + lane]; s2[1] = SW[(8 + j) * 128 + 64 + lane];
            unsigned u[2];
            u[0] = f2ord(s1[0]); u[1] = f2ord(s1[1]);
            wave_select<2>(u, 16, lane, [&](int i, int pos) { l1v[pos] = s1[i]; l1i[pos] = lane + 64 * i; });
            u[0] = f2ord(s2[0]); u[1] = f2ord(s2[1]);
            wave_select<2>(u, 16, lane, [&](int i, int pos) { l2v[pos] = s2[i]; l2i[pos] = lane + 64 * i; });
            asm volatile("s_waitcnt lgkmcnt(0)" ::: "memory");
            {
                const int li16 = lane & 15; const bool second = (lane & 16) != 0;
                const float* lv = second ? l2v : l1v; const int* lix = second ? l2i : l1i;
                const float myv = lv[li16]; const int myi = lix[li16];
                int rank = 0;
#pragma unroll
                for (int b4 = 0; b4 < 4; ++b4) {
                    const f32x4 o = *(const f32x4*)(lv + 4 * b4);
                    rank += ((o.x > myv) || (o.x == myv && 4 * b4 < li16)) ? 1 : 0;
                    rank += ((o.y > myv) || (o.y == myv && 4 * b4 + 1 < li16)) ? 1 : 0;
                    rank += ((o.z > myv) || (o.z == myv && 4 * b4 + 2 < li16)) ? 1 : 0;
                    rank += ((o.w > myv) || (o.w == myv && 4 * b4 + 3 < li16)) ? 1 : 0;
                }
                float* sv = lst + 96 + (second ? 32 : 0); int* si = (int*)sv + 16;
                if (lane < 32) { sv[rank] = myv; si[rank] = myi; }
            }
            asm volatile("s_waitcnt lgkmcnt(0)" ::: "memory");
            float cv1; int e1; unsigned cu1[1];
            {
                const int ab = PAIR_LUT[lane], a = ab >> 4, b = ab & 15;
                const float* s1v = lst + 96; const int* s1i = (const int*)(lst + 112); const float* s2v = lst + 128; const int* s2i = (const int*)(lst + 144);
                cv1 = s1v[a] + s2v[b]; e1 = s1i[a] * 128 + s2i[b];
                cu1[0] = (lane < 50) ? f2ord(cv1) : 0u;
            }
            asm volatile("s_waitcnt lgkmcnt(0)" ::: "memory");
            wave_select<1>(cu1, 16, lane, [&](int i, int pos) { scv[pos] = cv1; eid[pos] = e1; });
            asm volatile("s_waitcnt lgkmcnt(0)" ::: "memory");
            const float sc = (lane < 16) ? scv[lane] : -3.0e38f;
            const float mx = wave_max(sc);
            const float ex = (lane < 16) ? __expf(sc - mx) : 0.f;
            const float sm = wave_sum(ex);
            if (lane < 16) { int2 o; o.x = eid[lane]; o.y = __float_as_int(ex / sm); p.ROUTE[((size_t)tk * 8 + h) * 16 + lane] = o; }
            asm volatile("s_waitcnt lgkmcnt(0)" ::: "memory");
        }
    }
}

__device__ __forceinline__ void peer_gather_wave(const Params& p, int tk, char* smem) {
    const int lane = otid() & 63;
    const int2 r0 = p.ROUTE[(size_t)tk * 128 + lane], r1 = p.ROUTE[(size_t)tk * 128 + 64 + lane];
    f32x2 hv[16];
#pragma unroll
    for (int k = 0; k < 4; ++k) {
        float t8[8]; unpk8(*(const u32x4*)(p.HN + (size_t)tk * D + 32 * lane + 8 * k), t8);
#pragma unroll
        for (int e = 0; e < 4; ++e) hv[4 * k + e] = (f32x2){t8[2 * e], t8[2 * e + 1]};
    }
    f32x2 facc[16];
#pragma unroll
    for (int i = 0; i < 16; ++i) facc[i] = (f32x2){0.f, 0.f};
    const float rs64 = rsqrtf(p.ROWSS[tk] * (1.f / D) + EPS) * (1.f / 64.f);
    const unsigned char* u8 = (const unsigned char*)p.PU; const unsigned char* v8 = (const unsigned char*)p.PV;
    const int xl = ((lane >> 5) & 1) * 4 + ((lane >> 4) & 1) * 2 + ((lane >> 3) & 1);
    u32x4 uA[8], uB[8], vv[8];
#define PG_ISSUE_U(b, uu) { const int _es = ((b) < 8) ? r0.x : r1.x; \
    _Pragma("unroll") for (int x = 0; x < 8; ++x) { const size_t e = (size_t)(unsigned)__builtin_amdgcn_readlane(_es, 8 * ((b) & 7) + x); \
        uu[x] = *(const u32x4*)(u8 + e * (D / 2) + lane * 16); } }
#define PG_APPLY(b, uu) { const int _es = ((b) < 8) ? r0.x : r1.x; const int _gs = ((b) < 8) ? r0.y : r1.y; \
    _Pragma("unroll") for (int x = 0; x < 8; ++x) { const size_t e = (size_t)(unsigned)__builtin_amdgcn_readlane(_es, 8 * ((b) & 7) + x); \
        vv[x] = *(const u32x4*)(v8 + e * (D / 2) + lane * 16); } \
    const float gl = __int_as_float(__shfl(_gs, 8 * ((b) & 7) + xl)); \
    float d[8]; \
    _Pragma("unroll") for (int x = 0; x < 8; ++x) { f32x2 a2 = {0.f, 0.f}; \
        _Pragma("unroll") for (int q = 0; q < 4; ++q) { const unsigned w = uu[x][q]; \
            a2 += hv[4 * q] * __builtin_amdgcn_cvt_scalef32_pk_f32_fp4(w, 1.0f, 0); a2 += hv[4 * q + 1] * __builtin_amdgcn_cvt_scalef32_pk_f32_fp4(w, 1.0f, 1); \
            a2 += hv[4 * q + 2] * __builtin_amdgcn_cvt_scalef32_pk_f32_fp4(w, 1.0f, 2); a2 += hv[4 * q + 3] * __builtin_amdgcn_cvt_scalef32_pk_f32_fp4(w, 1.0f, 3); } \
        d[x] = a2.x + a2.y; } \
    float r4[4], r2[2], r1v; \
    { const bool hi = (lane & 32) != 0; \
      _Pragma("unroll") for (int k = 0; k < 4; ++k) { const float keep = hi ? d[k + 4] : d[k], send = hi ? d[k] : d[k + 4]; r4[k] = keep + __shfl_xor(send, 32); } } \
    { const bool hi = (lane & 16) != 0; \
      _Pragma("unroll") for (int k = 0; k < 2; ++k) { const float keep = hi ? r4[k + 2] : r4[k], send = hi ? r4[k] : r4[k + 2]; r2[k] = keep + __shfl_xor(send, 16); } } \
    { const bool hi = (lane & 8) != 0; const float keep = hi ? r2[1] : r2[0], send = hi ? r2[0] : r2[1]; r1v = keep + __shfl_xor(send, 8); } \
    r1v += __shfl_xor(r1v, 4); r1v += __shfl_xor(r1v, 2); r1v += __shfl_xor(r1v, 1); \
    const float cwv = gl * gelu_exact(r1v * rs64) * (1.f / 16.f); \
    _Pragma("unroll") for (int x = 0; x < 8; ++x) { const float cw = __int_as_float(__builtin_amdgcn_readlane(__float_as_int(cwv), 8 * x)); const f32x2 cw2 = {cw, cw}; \
        _Pragma("unroll") for (int q = 0; q < 4; ++q) { const unsigned w = vv[x][q]; \
            facc[4 * q] += cw2 * __builtin_amdgcn_cvt_scalef32_pk_f32_fp4(w, 1.0f, 0); facc[4 * q + 1] += cw2 * __builtin_amdgcn_cvt_scalef32_pk_f32_fp4(w, 1.0f, 1); \
            facc[4 * q + 2] += cw2 * __builtin_amdgcn_cvt_scalef32_pk_f32_fp4(w, 1.0f, 2); facc[4 * q + 3] += cw2 * __builtin_amdgcn_cvt_scalef32_pk_f32_fp4(w, 1.0f, 3); } } }
    PG_ISSUE_U(0, uA)
#pragma unroll 1
    for (int b = 0; b < 16; b += 2) {
        PG_ISSUE_U(b + 1, uB)
        __builtin_amdgcn_sched_barrier(0);
        PG_APPLY(b, uA)
        __builtin_amdgcn_sched_barrier(0);
        if (b + 2 < 16) PG_ISSUE_U(b + 2, uA)
        __builtin_amdgcn_sched_barrier(0);
        PG_APPLY(b + 1, uB)
        __builtin_amdgcn_sched_barrier(0);
    }
#undef PG_ISSUE_U
#undef PG_APPLY
    float* y = p.out + O_YP + (size_t)tk * D + 32 * lane;
#pragma unroll
    for (int q = 0; q < 8; ++q) {
        f32x4 hh = {hv[2 * q].x + facc[2 * q].x, hv[2 * q].y + facc[2 * q].y, hv[2 * q + 1].x + facc[2 * q + 1].x, hv[2 * q + 1].y + facc[2 * q + 1].y};
        *(f32x4*)(y + 4 * q) = hh;
    }
}

__device__ __forceinline__ void phase9(const Params& p, char* smem) {
    const int c = blockIdx.x, G = gridDim.x;
    for (int tk = TP + (G - 1 - c); tk < TT; tk += G) peer_item<true>(p, tk, smem);
    peer_route_wg(p, smem);
}
__device__ __forceinline__ void phase10(const Params& p, char* smem) {
    const int gw = blockIdx.x * 8 + (otid() >> 6), NGW = gridDim.x * 8;
    for (int tk = gw; tk < TP; tk += NGW) peer_gather_wave(p, tk, smem);
}

__global__ __launch_bounds__(512, 2) void fwd_kernel(KArgs ka) {
    extern __shared__ __attribute__((aligned(16))) char smem[];
    const Params p = make_params(ka);
    volatile LAS unsigned* st = (volatile LAS unsigned*)(smem + LDS_BYTES - 16);
    if (threadIdx.x == 0) { st[0] = 0u; st[1] = 0u; }
    __syncthreads();
    XcdBarrier bar = xcd_barrier_post(p.ctl, st);
#ifndef PHASE_MASK
#define PHASE_MASK 0x7ff
#endif
#ifndef REP_MASK
  #define REP_MASK 0
#endif
#define PH(k, call) if (((PHASE_MASK >> (k)) & 1) && ka.ph_lo <= (k) && (k) < ka.ph_hi) { \
    for (int rep = 0; rep < 1 + ((REP_MASK >> (k)) & 1); ++rep) { call; if (rep + 1 < 1 + ((REP_MASK >> (k)) & 1)) xcd_barrier(bar); } \
    if ((k) + 1 < ka.ph_hi) xcd_barrier(bar); }
    PH(0, phase0(p, smem))
    PH(1, phase1(p, smem))
    PH(2, phase2(p, smem))
    PH(3, phase3(p, smem, rep))
    PH(4, phase4(p, smem))
    PH(5, phase5(p, smem))
    PH(6, phase6(p, smem))
    PH(8, phase8(p, smem, rep))
    PH(9, phase9(p, smem))
    PH(10, phase10(p, smem))
#undef PH
}


#ifdef DBG_RET_NAIVE
__global__ void dbg_ret_naive(KArgs ka) {
    const Params p = make_params(ka);
    const int idx = blockIdx.x * blockDim.x + threadIdx.x;
    const int dv = idx & 255, dk = (idx >> 8) & 127, h = (idx >> 15) & 7, b = idx >> 18;
    const float g = 1.f - exp2f(-5.f - (float)h);
    float S = 0.f;
    for (int t = 0; t < SEQ; ++t) {
        const size_t tok = (size_t)b * SEQ + t;
        S = g * S + (float)p.RK[tok * 1024 + h * 128 + dk] * (float)p.RV[tok * 2048 + h * 256 + dv];
    }
    p.out[O_SP + ((size_t)((b * 8 + h) * 128 + dk)) * 256 + dv] = S;
}
#endif
#ifdef DBG_SCALES
__global__ void dbg_scale_kernel(float* out) {
    const float sc[10] = {DBG_SCALES};
    const size_t offs[11] = {O_YP, O_YS, O_KP, O_VP, O_IKP, O_SP, O_KS, O_VS, O_IKS, O_SS, 28861440};
    for (size_t i = (size_t)blockIdx.x * blockDim.x + threadIdx.x; i < 28861440; i += (size_t)gridDim.x * blockDim.x) {
        float s = 0.f;
#pragma unroll
        for (int k = 0; k < 10; ++k) if (i >= offs[k] && i < offs[k + 1]) s = sc[k];
        out[i] = (s == 0.f) ? 0.f : out[i] * s;
    }
}
#endif
#ifndef MK_MULTI
#define MK_MULTI 0
#endif
extern "C" void kernel_launch(void* const* d_in, const int* in_sizes, int n_in, void* d_out, int out_size, void* d_ws, size_t ws_size, hipStream_t stream) {
    static int grid = 0;
    if (grid == 0) {
        int dev = 0, cus = 0;
        (void)hipGetDevice(&dev); (void)hipDeviceGetAttribute(&cus, hipDeviceAttributeMultiprocessorCount, dev);
        (void)hipFuncSetAttribute((const void*)fwd_kernel, hipFuncAttributeMaxDynamicSharedMemorySize, LDS_BYTES);
        int per_cu = 0;
        (void)hipOccupancyMaxActiveBlocksPerMultiprocessor(&per_cu, (const void*)fwd_kernel, 512, LDS_BYTES);
        (void)hipGetLastError();
        grid = (cus > 0 ? cus : 256) * 1;
        if (per_cu < 1) fprintf(stderr, "kernel_launch: occupancy query reports %d blocks per CU\n", per_cu);
    }
    KArgs p;
    memset(&p, 0, sizeof(p));
    if (n_in < 21) { fprintf(stderr, "kernel_launch: expected 21 inputs, got %d\n", n_in); return; }
    for (int i = 0; i < 21; ++i) p.in[i] = d_in[i];
    p.out = (float*)d_out;
    p.ws = (char*)d_ws;
    if (WS_END > ws_size) { fprintf(stderr, "kernel_launch: workspace too small (%zu > %zu)\n", (size_t)WS_END, ws_size); return; }
    (void)hipMemsetAsync(d_ws, 0, 65536, stream);
#if MK_MULTI
    for (int k = 0; k < 11; ++k) {
        p.ph_lo = k; p.ph_hi = k + 1;
        hipLaunchKernelGGL(fwd_kernel, dim3(grid), dim3(512), LDS_BYTES, stream, p);
    }
#else
    p.ph_lo = 0; p.ph_hi = 11;
    hipLaunchKernelGGL(fwd_kernel, dim3(grid), dim3(512), LDS_BYTES, stream, p);
#endif
#ifdef DBG_RET_NAIVE
    hipLaunchKernelGGL(dbg_ret_naive, dim3(2 * 8 * 128 * 256 / 256), dim3(256), 0, stream, p);
#endif
#ifdef DBG_SCALES
    hipLaunchKernelGGL(dbg_scale_kernel, dim3(1024), dim3(256), 0, stream, (float*)d_out);
#endif
}
```

```cpp
#include <hip/hip_runtime.h>
#include <stdint.h>
#include <stdio.h>
#include <string.h>
#include <math.h>
#include <type_traits>

typedef _Float16 h16;
typedef _Float16 h16x8 __attribute__((ext_vector_type(8)));
typedef _Float16 h16x4 __attribute__((ext_vector_type(4)));
typedef _Float16 h16x2 __attribute__((ext_vector_type(2)));
typedef float f32x4 __attribute__((ext_vector_type(4)));
typedef float f32x2 __attribute__((ext_vector_type(2)));
typedef unsigned u32x4 __attribute__((ext_vector_type(4)));
typedef unsigned long long u64;

#define LAS __attribute__((address_space(3)))

constexpr int D = 2048, SEQ = 4096, TP = 8192, NS = 8, TT = TP + NS;
constexpr int NWP = 15616;
constexpr int NW0 = 15504;
constexpr int PAST = 16384, PAGE = 128, NPAGES = 128, LS = PAST + 1;
constexpr int NEXP = 16384;
constexpr float EPS = 1e-6f;
constexpr int C_RQ = 0, C_RK = 1024, C_RV = 2048, C_RG = 4096, C_AQ = 6144, C_AK = 8192, C_AV = 8704, C_IQ = 9216, C_IK = 11264, C_IW = 11392, C_GR = 11408, C_GA = 13456;
constexpr size_t O_YP = 0, O_YS = 16777216, O_KP = 16793600, O_VP = 20987904, O_IKP = 25182208, O_SP = 26230784,
                 O_KS = 26755072, O_VS = 26759168, O_IKS = 26763264, O_SS = 26764288;
constexpr int LDS_BYTES = 139264;
constexpr int SCS = 4112;
constexpr int SSCS = 16400;

#define XB_TMO      128
#define XB_XCNT(j)  (256  + 64 * (j))
#define XB_XSUB(j)  (1280 + 64 * (j))
#define XB_XGEN(j)  (2304 + 64 * (j))
#define XB_TOP      3328
#define XB_TOPGEN   3392
#define XCD_BAR_WORDS 3456
#define XB_SPIN_CAP (1u << 22)
__device__ __forceinline__ unsigned xb_ld(unsigned* p)              { return __hip_atomic_load(p, __ATOMIC_RELAXED, __HIP_MEMORY_SCOPE_AGENT); }
__device__ __forceinline__ unsigned xb_add(unsigned* p, unsigned v) { return __hip_atomic_fetch_add(p, v, __ATOMIC_RELAXED, __HIP_MEMORY_SCOPE_AGENT); }
__device__ __forceinline__ unsigned xb_xcc_id() { return (unsigned)__builtin_amdgcn_s_getreg((3 << 11) | 20) & 0xFu; }
#define XB_SPIN(cond, bar) do { unsigned _sp = 0; while (cond) { __builtin_amdgcn_s_sleep(1); \
    if ((++_sp & 255u) == 0u) { if (xb_ld(&(bar)[XB_TMO])) break; if (_sp > XB_SPIN_CAP) { atomicAdd(&(bar)[XB_TMO], 1u); break; } } } } while (0)
struct XcdBarrier { unsigned* bar; unsigned x; volatile LAS unsigned* st; };
__device__ __forceinline__ XcdBarrier xcd_barrier_post(unsigned* bar, volatile LAS unsigned* st) {
    XcdBarrier b; b.bar = bar; b.x = xb_xcc_id(); b.st = st;
    if (threadIdx.x == 0) (void)xb_add(&bar[XB_XCNT(b.x)], 1u);
    return b;
}
__device__ __forceinline__ void xcd_barrier_complete(unsigned* bar, unsigned x, unsigned& nloc, unsigned& nx) {
    const unsigned G = gridDim.x * gridDim.y * gridDim.z;
    unsigned sum, cnt, mine, sp = 0u;
    for (;;) {
        sum = 0u; cnt = 0u; mine = 0u;
#pragma unroll
        for (unsigned j = 0; j < 16; ++j) { const unsigned c = xb_ld(&bar[XB_XCNT(j)]); sum += c; cnt += (c > 0u) ? 1u : 0u; mine = (j == x) ? c : mine; }
        if (sum == G) break;
        __builtin_amdgcn_s_sleep(1);
        if ((++sp & 255u) == 0u) { if (xb_ld(&bar[XB_TMO])) break; if (sp > XB_SPIN_CAP) { atomicAdd(&bar[XB_TMO], 1u); break; } }
    }
    nloc = mine > 0u ? mine : 1u; nx = cnt > 0u ? cnt : 1u;
}
__device__ __forceinline__ void xcd_barrier(const XcdBarrier& b) {
    asm volatile("s_waitcnt vmcnt(0)" ::: "memory");
    __syncthreads();
    if (threadIdx.x == 0) {
        unsigned* bar = b.bar;
        __builtin_amdgcn_s_waitcnt(0);
        volatile LAS unsigned* stw = (volatile LAS unsigned*)(unsigned)(LDS_BYTES - 16);
        unsigned nloc = stw[0], nx = stw[1];
        if (nloc == 0u) { xcd_barrier_complete(bar, b.x, nloc, nx); stw[0] = nloc; stw[1] = nx; }
        const unsigned old = xb_add(&bar[XB_XSUB(b.x)], 1u);
        const unsigned gen = old / nloc;
        if (old + 1u == (gen + 1u) * nloc) {
            __builtin_amdgcn_fence(__ATOMIC_RELEASE, "agent");
            asm volatile("s_waitcnt vmcnt(0)" ::: "memory");
            const unsigned og = xb_add(&bar[XB_TOP], 1u);
            const unsigned tg = og / nx;
            if (og + 1u == (tg + 1u) * nx) xb_add(&bar[XB_TOPGEN], 1u);
            else XB_SPIN(xb_ld(&bar[XB_TOPGEN]) == tg, bar);
            __builtin_amdgcn_fence(__ATOMIC_ACQUIRE, "agent");
            xb_add(&bar[XB_XGEN(b.x)], 1u);
            asm volatile("s_waitcnt vmcnt(0)" ::: "memory");
        } else {
            XB_SPIN(xb_ld(&bar[XB_XGEN(b.x)]) == gen, bar);
            __builtin_amdgcn_fence(__ATOMIC_ACQUIRE, "agent");
            asm volatile("s_waitcnt vmcnt(0)" ::: "memory");
        }
    }
    __syncthreads();
}

struct Params {
    const float *x_prompt, *x_sample, *cache_k, *cache_v, *cache_kidx, *state_ret;
    const int* page_table;
    const float *norm1_w, *w_in, *q_norm_w, *k_norm_w, *ret_gn_w, *w_ret_o, *w_att_o, *w_out, *norm2_w, *peer_wq, *peer_k1, *peer_k2, *peer_u, *peer_v;
    float* out;
    unsigned* ctl;
    float* ROWSS;
    h16 *XN, *WinT, *WrT, *WaT, *WoT, *WqT, *PU, *PV, *K1H, *K2H;
    int2* ROUTE;
    unsigned char *AQ8, *AK8;
    h16 *RQ, *RK, *RV, *RG, *AQ, *AK, *AV, *IQ, *IK, *GR, *GA;
    float* IW;
    float* KV; h16* SPT; int* TOPI; h16 *RN, *ATT, *MIX, *HN; float* MIXF; float* PQ;
    float2* ROPE;
    float *XNS, *ZS, *SRQ, *SRK, *SRV, *SRG, *SAQ, *SAK, *SAV, *SIQ, *SIK, *SIW, *SGR, *SGA, *SSC;
    int* STOP;
    float *SRN, *SATT, *SMIX, *SHN, *SPQ;
};
struct KArgs {
    const void* in[21];
    float* out;
    char* ws;
    int ph_lo, ph_hi;
};
constexpr size_t al256(size_t x) { return (x + 255) & ~(size_t)255; }
constexpr size_t WS_CTL = 0;
constexpr size_t WS_XN = WS_CTL + 65536;
constexpr size_t WS_WINT = WS_XN + al256((size_t)TP * D * 2);
constexpr size_t WS_WRT = WS_WINT + al256((size_t)NWP * D * 2);
constexpr size_t WS_WAT = WS_WRT + al256((size_t)D * D * 2);
constexpr size_t WS_WOT = WS_WAT + al256((size_t)D * D * 2);
constexpr size_t WS_WQT = WS_WOT + al256((size_t)D * D * 2);
constexpr size_t WS_PU = WS_WQT + al256((size_t)1024 * D * 2);
constexpr size_t WS_PV = WS_PU + al256((size_t)NEXP * D * 2);
constexpr size_t WS_RQ = WS_PV + al256((size_t)NEXP * D * 2);
constexpr size_t WS_RK = WS_RQ + al256((size_t)TP * 1024 * 2);
constexpr size_t WS_RV = WS_RK + al256((size_t)TP * 1024 * 2);
constexpr size_t WS_RG = WS_RV + al256((size_t)TP * 2048 * 2);
constexpr size_t WS_AQ = WS_RG + al256((size_t)TP * 2048 * 2);
constexpr size_t WS_AK = WS_AQ + al256((size_t)TP * 2048 * 2);
constexpr size_t WS_AV = WS_AK + al256((size_t)TP * 512 * 2);
constexpr size_t WS_IQ = WS_AV + al256((size_t)TP * 512 * 2);
constexpr size_t WS_IK = WS_IQ + al256((size_t)TP * 2048 * 2);
constexpr size_t WS_GR = WS_IK + al256((size_t)TP * 128 * 2);
constexpr size_t WS_GA = WS_GR + al256((size_t)TP * 2048 * 2);
constexpr size_t WS_IW = WS_GA + al256((size_t)TP * 2048 * 2);
constexpr size_t WS_KV = WS_IW + al256((size_t)TP * 16 * 4);
constexpr size_t WS_SPT = WS_KV + al256((size_t)2 * 8 * 32 * 128 * 256 * 4);
constexpr size_t WS_TOPI = WS_SPT + al256((size_t)2 * 8 * 32 * 256 * 128 * 2);
constexpr size_t WS_RN = WS_TOPI + al256((size_t)TP * 256 * 4);
constexpr size_t WS_ATT = WS_RN + al256((size_t)TP * D * 2);
constexpr size_t WS_MIX = WS_ATT + al256((size_t)TP * D * 2);
constexpr size_t WS_HN = WS_MIX + al256((size_t)TP * D * 2);
constexpr size_t WS_MIXF = WS_HN + al256((size_t)TP * D * 2);
constexpr size_t WS_PQ = WS_MIXF + al256((size_t)TP * D * 4);
constexpr size_t WS_ROPE = WS_PQ + al256((size_t)TP * 1024 * 4);
constexpr size_t WS_XNS = WS_ROPE + al256((size_t)4097 * 64 * 8);
constexpr size_t WS_ZS = WS_XNS + al256(8 * D * 4);
constexpr size_t WS_SRQ = WS_ZS + al256((size_t)8 * NW0 * 4);
constexpr size_t WS_SRK = WS_SRQ + al256(8 * 1024 * 4);
constexpr size_t WS_SRV = WS_SRK + al256(8 * 1024 * 4);
constexpr size_t WS_SRG = WS_SRV + al256(8 * 2048 * 4);
constexpr size_t WS_SAQ = WS_SRG + al256(8 * 2048 * 4);
constexpr size_t WS_SAK = WS_SAQ + al256(8 * 2048 * 4);
constexpr size_t WS_SAV = WS_SAK + al256(8 * 512 * 4);
constexpr size_t WS_SIQ = WS_SAV + al256(8 * 512 * 4);
constexpr size_t WS_SIK = WS_SIQ + al256(8 * 2048 * 4);
constexpr size_t WS_SIW = WS_SIK + al256(8 * 128 * 4);
constexpr size_t WS_SGR = WS_SIW + al256(8 * 16 * 4);
constexpr size_t WS_SGA = WS_SGR + al256(8 * 2048 * 4);
constexpr size_t WS_SSC = WS_SGA + al256(8 * 2048 * 4);
constexpr size_t WS_STOP = WS_SSC + al256((size_t)8 * SSCS * 4);
constexpr size_t WS_SRN = WS_STOP + al256(8 * 256 * 4);
constexpr size_t WS_SATT = WS_SRN + al256(8 * 2048 * 4);
constexpr size_t WS_SMIX = WS_SATT + al256(8 * 2048 * 4);
constexpr size_t WS_SHN = WS_SMIX + al256(8 * 2048 * 4);
constexpr size_t WS_SPQ = WS_SHN + al256(8 * 2048 * 4);
constexpr size_t WS_K1H = WS_SPQ + al256(8 * 1024 * 4);
constexpr size_t WS_K2H = WS_K1H + al256(8 * 128 * 64 * 2);
constexpr size_t WS_ROUTE = WS_K2H + al256(8 * 128 * 64 * 2);
constexpr size_t WS_AQ8 = WS_ROUTE + al256((size_t)TP * 128 * 8);
constexpr size_t WS_AK8 = WS_AQ8 + al256((size_t)TP * 2048);
constexpr size_t WS_END = WS_AK8 + al256((size_t)TP * 512);
__device__ __forceinline__ Params make_params(const KArgs& a) {
    Params p;
    p.x_prompt = (const float*)a.in[0]; p.x_sample = (const float*)a.in[1]; p.cache_k = (const float*)a.in[2]; p.cache_v = (const float*)a.in[3];
    p.cache_kidx = (const float*)a.in[4]; p.state_ret = (const float*)a.in[5]; p.page_table = (const int*)a.in[6];
    p.norm1_w = (const float*)a.in[7]; p.w_in = (const float*)a.in[8]; p.q_norm_w = (const float*)a.in[9]; p.k_norm_w = (const float*)a.in[10];
    p.ret_gn_w = (const float*)a.in[11]; p.w_ret_o = (const float*)a.in[12]; p.w_att_o = (const float*)a.in[13]; p.w_out = (const float*)a.in[14];
    p.norm2_w = (const float*)a.in[15]; p.peer_wq = (const float*)a.in[16]; p.peer_k1 = (const float*)a.in[17]; p.peer_k2 = (const float*)a.in[18];
    p.peer_u = (const float*)a.in[19]; p.peer_v = (const float*)a.in[20];
    p.out = a.out;
    char* w = a.ws;
    p.ctl = (unsigned*)(w + WS_CTL); p.ROWSS = (float*)(w + WS_CTL + 32768);
    p.XN = (h16*)(w + WS_XN); p.WinT = (h16*)(w + WS_WINT); p.WrT = (h16*)(w + WS_WRT); p.WaT = (h16*)(w + WS_WAT); p.WoT = (h16*)(w + WS_WOT); p.WqT = (h16*)(w + WS_WQT);
    p.PU = (h16*)(w + WS_PU); p.PV = (h16*)(w + WS_PV); p.K1H = (h16*)(w + WS_K1H); p.K2H = (h16*)(w + WS_K2H); p.ROUTE = (int2*)(w + WS_ROUTE); p.AQ8 = (unsigned char*)(w + WS_AQ8); p.AK8 = (unsigned char*)(w + WS_AK8);
    p.RQ = (h16*)(w + WS_RQ); p.RK = (h16*)(w + WS_RK); p.RV = (h16*)(w + WS_RV); p.RG = (h16*)(w + WS_RG);
    p.AQ = (h16*)(w + WS_AQ); p.AK = (h16*)(w + WS_AK); p.AV = (h16*)(w + WS_AV); p.IQ = (h16*)(w + WS_IQ); p.IK = (h16*)(w + WS_IK);
    p.GR = (h16*)(w + WS_GR); p.GA = (h16*)(w + WS_GA); p.IW = (float*)(w + WS_IW);
    p.KV = (float*)(w + WS_KV); p.SPT = (h16*)(w + WS_SPT); p.TOPI = (int*)(w + WS_TOPI);
    p.RN = (h16*)(w + WS_RN); p.ATT = (h16*)(w + WS_ATT); p.MIX = (h16*)(w + WS_MIX); p.HN = (h16*)(w + WS_HN);
    p.MIXF = (float*)(w + WS_MIXF); p.PQ = (float*)(w + WS_PQ); p.ROPE = (float2*)(w + WS_ROPE);
    p.XNS = (float*)(w + WS_XNS); p.ZS = (float*)(w + WS_ZS);
    p.SRQ = (float*)(w + WS_SRQ); p.SRK = (float*)(w + WS_SRK); p.SRV = (float*)(w + WS_SRV); p.SRG = (float*)(w + WS_SRG);
    p.SAQ = (float*)(w + WS_SAQ); p.SAK = (float*)(w + WS_SAK); p.SAV = (float*)(w + WS_SAV);
    p.SIQ = (float*)(w + WS_SIQ); p.SIK = (float*)(w + WS_SIK); p.SIW = (float*)(w + WS_SIW);
    p.SGR = (float*)(w + WS_SGR); p.SGA = (float*)(w + WS_SGA); p.SSC = (float*)(w + WS_SSC); p.STOP = (int*)(w + WS_STOP);
    p.SRN = (float*)(w + WS_SRN); p.SATT = (float*)(w + WS_SATT); p.SMIX = (float*)(w + WS_SMIX); p.SHN = (float*)(w + WS_SHN); p.SPQ = (float*)(w + WS_SPQ);
    return p;
}

__device__ __forceinline__ float wave_sum(float v) {
#pragma unroll
    for (int o = 32; o > 0; o >>= 1) v += __shfl_xor(v, o);
    return v;
}
__device__ __forceinline__ float wave_max(float v) {
#pragma unroll
    for (int o = 32; o > 0; o >>= 1) v = fmaxf(v, __shfl_xor(v, o));
    return v;
}
__device__ __forceinline__ int otid() { int t = threadIdx.x; asm volatile("" : "+v"(t)); return t; }
__device__ __forceinline__ unsigned f2ord(float f) { unsigned b = __float_as_uint(f); return b ^ ((unsigned)((int)b >> 31) | 0x80000000u); }
__device__ __forceinline__ unsigned pkh(float lo, float hi) { h16x2 v; v.x = (h16)lo; v.y = (h16)hi; return __builtin_bit_cast(unsigned, v); }
__device__ __forceinline__ u32x4 pk8(const float* v) { u32x4 r; r.x = pkh(v[0], v[1]); r.y = pkh(v[2], v[3]); r.z = pkh(v[4], v[5]); r.w = pkh(v[6], v[7]); return r; }
__device__ __forceinline__ void unpk8(u32x4 r, float* v) {
    const unsigned rx = r.x, ry = r.y, rz = r.z, rw = r.w;
    h16x2 a = __builtin_bit_cast(h16x2, rx), b = __builtin_bit_cast(h16x2, ry), c = __builtin_bit_cast(h16x2, rz), d = __builtin_bit_cast(h16x2, rw);
    v[0] = (float)a.x; v[1] = (float)a.y; v[2] = (float)b.x; v[3] = (float)b.y; v[4] = (float)c.x; v[5] = (float)c.y; v[6] = (float)d.x; v[7] = (float)d.y;
}
__device__ __forceinline__ float sigmoidf_(float x) { return __builtin_amdgcn_rcpf(1.f + __expf(-x)); }
__device__ __forceinline__ float siluf_(float x) { return x * __builtin_amdgcn_rcpf(1.f + __expf(-x)); }
__device__ __forceinline__ float gelu_exact(float x) { return 0.5f * x * (1.f + erff(x * 0.70710678118654752f)); }
__device__ __forceinline__ float ret_log_g(int h) { return logf(1.f - exp2f(-5.f - (float)h)); }

__device__ __forceinline__ unsigned off_b(unsigned row, unsigned ch) { return 256u * row + 16u * (ch ^ (((row & 3) << 2) | ((row >> 2) & 3))); }
__device__ __forceinline__ unsigned tr_addr16(unsigned lane, unsigned c, unsigned t) {
    const unsigned g = lane >> 4, q = (lane & 15) >> 2, p = lane & 3;
    return off_b(8 * g + 4 * t + q, 2 * c + (p >> 1)) + 8 * (p & 1);
}
template <int IMM>
__device__ __forceinline__ h16x8 tr_read8o(unsigned a0, unsigned a1) {
    h16x4 r0, r1;
    asm volatile("ds_read_b64_tr_b16 %0, %2 offset:%4\n\tds_read_b64_tr_b16 %1, %3 offset:%4\n\ts_waitcnt lgkmcnt(0)" : "=&v"(r0), "=&v"(r1) : "v"(a0), "v"(a1), "n"(IMM) : "memory");
    h16x8 r; r[0] = r0[0]; r[1] = r0[1]; r[2] = r0[2]; r[3] = r0[3]; r[4] = r1[0]; r[5] = r1[1]; r[6] = r1[2]; r[7] = r1[3];
    return r;
}
__device__ __forceinline__ void tr_read8x4(unsigned z0, unsigned z1, unsigned c0, h16x8 (&out)[4]) {
    h16x4 r[8];
    const unsigned a0 = z0 ^ (32u * c0), a1 = z1 ^ (32u * c0), a2 = z0 ^ (32u * (c0 + 1)), a3 = z1 ^ (32u * (c0 + 1));
    const unsigned a4 = z0 ^ (32u * (c0 + 2)), a5 = z1 ^ (32u * (c0 + 2)), a6 = z0 ^ (32u * (c0 + 3)), a7 = z1 ^ (32u * (c0 + 3));
    asm volatile("ds_read_b64_tr_b16 %0, %8\n\tds_read_b64_tr_b16 %1, %9\n\tds_read_b64_tr_b16 %2, %10\n\tds_read_b64_tr_b16 %3, %11\n\t"
                 "ds_read_b64_tr_b16 %4, %12\n\tds_read_b64_tr_b16 %5, %13\n\tds_read_b64_tr_b16 %6, %14\n\tds_read_b64_tr_b16 %7, %15\n\ts_waitcnt lgkmcnt(0)"
                 : "=&v"(r[0]), "=&v"(r[1]), "=&v"(r[2]), "=&v"(r[3]), "=&v"(r[4]), "=&v"(r[5]), "=&v"(r[6]), "=&v"(r[7])
                 : "v"(a0), "v"(a1), "v"(a2), "v"(a3), "v"(a4), "v"(a5), "v"(a6), "v"(a7) : "memory");
#pragma unroll
    for (int i = 0; i < 4; ++i) { h16x8 v; v[0] = r[2 * i][0]; v[1] = r[2 * i][1]; v[2] = r[2 * i][2]; v[3] = r[2 * i][3]; v[4] = r[2 * i + 1][0]; v[5] = r[2 * i + 1][1]; v[6] = r[2 * i + 1][2]; v[7] = r[2 * i + 1][3]; out[i] = v; }
}
template <int I, int N, class F>
__device__ __forceinline__ void static_for(F&& f) { if constexpr (I < N) { f(std::integral_constant<int, I>{}); static_for<I + 1, N>(f); } }
__device__ __forceinline__ unsigned lds_u32(const void* p) { return (unsigned)(size_t)(const LAS char*)p; }

__device__ __forceinline__ int wave_sum_small(unsigned cnt) {
    int c = 0;
#pragma unroll
    for (int b = 0; b < 7; ++b) c += __popcll(__ballot((cnt >> b) & 1u)) << b;
    return c;
}
template <int NV>
__device__ __forceinline__ void wave_kth_r4(const unsigned (&u)[NV], int K, unsigned& tau, int& need_eq) {
    tau = 0u; bool exact = false;
    for (int bit = 30; bit >= 0; bit -= 2) {
        const unsigned c1 = tau | (1u << bit), c2 = tau | (2u << bit), c3 = tau | (3u << bit);
        int n1 = 0, n2 = 0, n3 = 0;
#pragma unroll
        for (int i = 0; i < NV; ++i) { n1 += __popcll(__ballot(u[i] >= c1)); n2 += __popcll(__ballot(u[i] >= c2)); n3 += __popcll(__ballot(u[i] >= c3)); }
        int n = -1;
        if (n3 >= K) { tau = c3; n = n3; } else if (n2 >= K) { tau = c2; n = n2; } else if (n1 >= K) { tau = c1; n = n1; }
        if (n == K) { exact = true; break; }
    }
    int cg = 0;
    if (!exact && tau != 0xFFFFFFFFu) {
#pragma unroll
        for (int i = 0; i < NV; ++i) cg += __popcll(__ballot(u[i] > tau));
    }
    need_eq = exact ? K : K - cg;
}
template <int NV>
__device__ __forceinline__ void wave_kth_dyn(const unsigned (&u)[NV], int ngrp, int K, unsigned& tau, int& need_eq) {
    tau = 0u; int cg = 0; bool exact = false;
    for (int bit = 31; bit >= -1; --bit) {
        const unsigned cand = (bit >= 0) ? (tau | (1u << bit)) : tau + 1u;
        unsigned cnt = 0u;
        static_for<0, NV / 8>([&](auto G8) {
            constexpr int g8 = decltype(G8)::value;
            if (g8 < ngrp) {
#pragma unroll
                for (int i = 0; i < 8; ++i) cnt += (u[g8 * 8 + i] >= cand) ? 1u : 0u;
            }
        });
        const int c = wave_sum_small(cnt);
        if (bit >= 0) { if (c >= K) tau = cand; if (c == K) { exact = true; break; } } else cg = (tau == 0xFFFFFFFFu) ? 0 : c;
    }
    need_eq = exact ? K : K - cg;
}
template <int NV>
__device__ __forceinline__ void wave_kth(const unsigned (&u)[NV], int K, unsigned& tau, int& need_eq) {
    tau = 0u; int cg = 0; bool exact = false;
    for (int bit = 31; bit >= -1; --bit) {
        const unsigned cand = (bit >= 0) ? (tau | (1u << bit)) : tau + 1u;
        int c = 0;
        if constexpr (NV >= 8) {
            unsigned cnt = 0u;
#pragma unroll
            for (int i = 0; i < NV; ++i) cnt += (u[i] >= cand) ? 1u : 0u;
            c = wave_sum_small(cnt);
        } else {
#pragma unroll
            for (int i = 0; i < NV; ++i) c += __popcll(__ballot(u[i] >= cand));
        }
        if (bit >= 0) { if (c >= K) tau = cand; if (c == K) { exact = true; break; } } else cg = (tau == 0xFFFFFFFFu) ? 0 : c;
    }
    need_eq = exact ? K : K - cg;
}

template <bool WIN>
__device__ __forceinline__ void p0_transpose_item(const float* W, int K, int N, h16* WT, float* scr, int item, int nblk, int lane, const float* kscale = nullptr) {
    const int kb = item / nblk, nb = item % nblk, k0 = 64 * kb, n0 = 32 * nb;
    float tv[32];
#pragma unroll
    for (int i = 0; i < 32; ++i) { const int kk = 2 * i + (lane >> 5), n = n0 + (lane & 31); tv[i] = (n < N) ? W[(size_t)(k0 + kk) * N + n] : 0.f; }
#pragma unroll
    for (int i = 0; i < 32; ++i) { const int kk = 2 * i + (lane >> 5); scr[kk * 33 + (lane & 31)] = tv[i]; }
    asm volatile("s_waitcnt lgkmcnt(0)" ::: "memory");
    const int c = lane & 7;
#pragma unroll
    for (int j = 0; j < 4; ++j) {
        const int nl = (lane >> 3) + 8 * j, n = n0 + nl;
        const float* s = scr + (8 * c) * 33 + nl;
        float v[8];
#pragma unroll
        for (int e = 0; e < 8; ++e) v[e] = s[e * 33];
        if (kscale) {
#pragma unroll
            for (int e = 0; e < 8; ++e) v[e] *= kscale[k0 + 8 * c + e];
        }
        int dst = n;
        if (WIN) { if (n >= C_GR) dst = n - 16; else if (n >= C_IW) dst = 15488 + (n - C_IW); }
        if (n < N) *(u32x4*)(WT + (size_t)dst * K + k0 + 8 * c) = pk8(v);
    }
    asm volatile("s_waitcnt lgkmcnt(0)" ::: "memory");
}

__device__ __forceinline__ void phase0(const Params& p, char* smem) {
    const int tid = otid(), lane = tid & 63, wave = tid >> 6;
    const int gw = blockIdx.x * 8 + wave, NGW = gridDim.x * 8;
    const int gt = blockIdx.x * 512 + tid, NGT = gridDim.x * 512;
    for (int r = gw; r < TT; r += NGW) {
        const float* x = (r < TP) ? p.x_prompt + (size_t)r * D : p.x_sample + (size_t)(r - TP) * D;
        f32x4 v[8]; float ss = 0.f;
#pragma unroll
        for (int j = 0; j < 8; ++j) { v[j] = *(const f32x4*)(x + 4 * (lane + 64 * j)); ss += v[j].x * v[j].x + v[j].y * v[j].y + v[j].z * v[j].z + v[j].w * v[j].w; }
        ss = wave_sum(ss);
        const float rs = rsqrtf(ss * (1.f / D) + EPS);
#pragma unroll
        for (int j = 0; j < 8; ++j) {
            const f32x4 w = *(const f32x4*)(p.norm1_w + 4 * (lane + 64 * j));
            const float a = v[j].x * rs * w.x, b = v[j].y * rs * w.y, c = v[j].z * rs * w.z, d = v[j].w * rs * w.w;
            if (r < TP) { f32x2 o; o.x = __uint_as_float(pkh(a, b)); o.y = __uint_as_float(pkh(c, d)); *(f32x2*)(p.XN + (size_t)r * D + 4 * (lane + 64 * j)) = o; }
            else { f32x4 o = {a, b, c, d}; *(f32x4*)(p.XNS + (size_t)(r - TP) * D + 4 * (lane + 64 * j)) = o; }
        }
    }
    {
        float* scr = (float*)smem + wave * (64 * 33);
        constexpr int NB_IN = (NW0 + 31) / 32;
        constexpr int I_IN = 32 * NB_IN;
        for (int it = gw; it < I_IN; it += NGW) p0_transpose_item<true>(p.w_in, D, NW0, p.WinT, scr, it, NB_IN, lane);
    }
    for (int i = gt; i < (NWP - NW0) * D / 8; i += NGT) { u32x4 z = {0u, 0u, 0u, 0u}; *(u32x4*)(p.WinT + (size_t)NW0 * D + (size_t)i * 8) = z; }
    for (int i = gt; i < 2 * 8 * 128 * 64 / 8; i += NGT) {
        const int half = 8 * 128 * 64 / 8;
        const float* src = (i < half) ? p.peer_k1 + (size_t)i * 8 : p.peer_k2 + (size_t)(i - half) * 8;
        h16* dst = (i < half) ? p.K1H + (size_t)i * 8 : p.K2H + (size_t)(i - half) * 8;
        const f32x4 a = *(const f32x4*)src, b = *(const f32x4*)(src + 4);
        u32x4 o; o.x = pkh(a.x, a.y); o.y = pkh(a.z, a.w); o.z = pkh(b.x, b.y); o.w = pkh(b.z, b.w);
        *(u32x4*)dst = o;
    }
    for (int i = gt; i < 4097 * 64; i += NGT) {
        const int pi = i >> 6, fi = i & 63;
        const double pos = (pi == 4096) ? 16384.0 : (double)pi;
        double fq = 1.0;
        if (fi & 1) fq *= 0.86596432336006535; if (fi & 2) fq *= 0.74989420933245583; if (fi & 4) fq *= 0.56234132519034908;
        if (fi & 8) fq *= 0.31622776601683794; if (fi & 16) fq *= 0.1; if (fi & 32) fq *= 0.01;
        const double rev = pos * fq * 0.15915494309189533577;
        const double fr = rev - __builtin_rint(rev);
        float2 cs; cs.x = __builtin_amdgcn_cosf((float)fr); cs.y = __builtin_amdgcn_sinf((float)fr);
        p.ROPE[i] = cs;
    }
}

constexpr int G_BK = 64, G_HALF = 128, G_HT = G_HALF * G_BK;
__device__ __forceinline__ int g_lds_byte(int r, int c) {
    int st = (r >> 4) * 2 + (c >> 5), rr = r & 15, cc = c & 31, ob = rr * 64 + cc * 2;
    return st * 1024 + (ob ^ (((ob >> 9) & 1) << 5));
}
__device__ __forceinline__ void g_stage_rc(int b, int& R, int& C) {
    int st = b / 1024, sb = b % 1024, swz = sb ^ (((sb >> 9) & 1) << 5);
    R = (st >> 1) * 16 + swz / 64; C = (st & 1) * 32 + (swz % 64) / 2;
}

__device__ __forceinline__ void gemm_core(const h16* A, const h16* Bt, const int brow, const int bcol, const int K, f32x4 (&acc)[2][2][4][2], h16* shm) {
  #define SA(b,h) (shm+((b)*2+(h))*G_HT)
  #define SB(b,h) (shm+(4+(b)*2+(h))*G_HT)
  #define STAGE_X(T,P,BASE,br,kt) do{const char* _ub=(const char*)(BASE)+((long)(br)*K+(long)(kt)*G_BK)*2; \
    for(int _i=0;_i<2;++_i){int _b=(T)*16+_i*8192;int _r,_c;g_stage_rc(_b,_r,_c); \
      const unsigned _vo=(unsigned)((_r*K+_c)*2); \
      __builtin_amdgcn_global_load_lds((const unsigned*)(_ub+_vo), \
        (unsigned*)((char*)(P)+_b),16,0,0);}}while(0)
  #define STAGE(P,BASE,br,kt) STAGE_X(t0,P,BASE,br,kt)
  #define LDA(dst,b,h) for(int m=0;m<4;++m)for(int k=0;k<2;++k) \
    dst[m][k]=*reinterpret_cast<const h16x8*>((char*)SA(b,h)+g_lds_byte(wr*64+m*16+fr,k*32+fq*8))
  #define LDB(dst,b,h) for(int n=0;n<2;++n)for(int k=0;k<2;++k) \
    dst[n][k]=*reinterpret_cast<const h16x8*>((char*)SB(b,h)+g_lds_byte(wc*32+n*16+fr,k*32+fq*8))
  #define MMA(ai,bj,At,Bx) do{__builtin_amdgcn_s_setprio(1); \
    for(int m=0;m<4;++m)for(int n=0;n<2;++n)for(int k=0;k<2;++k) \
      acc[ai][bj][m][n]=__builtin_amdgcn_mfma_f32_16x16x32_f16(Bx[n][k],At[m][k],acc[ai][bj][m][n],0,0,0); \
    __builtin_amdgcn_s_setprio(0);}while(0)
  #define WAIT_V(n) asm volatile("s_waitcnt vmcnt(" #n ")":::"memory")
  #define WAIT_L(n) asm volatile("s_waitcnt lgkmcnt(" #n ")":::"memory")
  #define BAR __builtin_amdgcn_s_barrier()
  #define SCHED __builtin_amdgcn_sched_barrier(0)
  const int t0=otid();
  int wid=t0>>6,lane=t0&63,wr=wid>>2,wc=wid&3,fr=lane&15,fq=lane>>4;
  h16x8 At[4][2],B0[2][2],B1[2][2];
  const int nt=K/G_BK;
  STAGE(SB(0,0),Bt,bcol,0); STAGE(SA(0,0),A,brow,0);
  STAGE(SB(0,1),Bt,bcol+G_HALF,0); STAGE(SA(0,1),A,brow+G_HALF,0);
  if(wr==1)BAR;
  WAIT_V(4); BAR;
  STAGE(SB(1,0),Bt,bcol,1); STAGE(SA(1,0),A,brow,1); STAGE(SB(1,1),Bt,bcol+G_HALF,1);
  WAIT_V(6); BAR;
  for(int t=0;t<nt-2;t+=2){
    LDB(B0,0,0); SCHED; LDA(At,0,0); STAGE(SA(1,1),A,brow+G_HALF,t+1);
    WAIT_L(8); BAR; WAIT_L(0); MMA(0,0,At,B0); BAR; SCHED;
    LDB(B1,0,1); STAGE(SB(0,0),Bt,bcol,t+2);
    BAR; WAIT_L(0); MMA(0,1,At,B1); BAR;
    LDA(At,0,1); STAGE(SA(0,0),A,brow,t+2);
    BAR; WAIT_L(0); MMA(1,0,At,B0); BAR; SCHED;
    STAGE(SB(0,1),Bt,bcol+G_HALF,t+2);
    WAIT_V(6); BAR; MMA(1,1,At,B1); BAR;
    LDB(B0,1,0); SCHED; LDA(At,1,0); STAGE(SA(0,1),A,brow+G_HALF,t+2);
    WAIT_L(8); BAR; WAIT_L(0); MMA(0,0,At,B0); BAR; SCHED;
    LDB(B1,1,1); STAGE(SB(1,0),Bt,bcol,t+3);
    BAR; WAIT_L(0); MMA(0,1,At,B1); BAR;
    LDA(At,1,1); STAGE(SA(1,0),A,brow,t+3);
    BAR; WAIT_L(0); MMA(1,0,At,B0); BAR; SCHED;
    STAGE(SB(1,1),Bt,bcol+G_HALF,t+3);
    WAIT_V(6); BAR; MMA(1,1,At,B1); BAR;
  }
  int tz=otid(); wid=tz>>6; lane=tz&63; wr=wid>>2; wc=wid&3; fr=lane&15; fq=lane>>4;
  { LDB(B0,0,0); WAIT_V(0); LDA(At,0,0); STAGE_X(tz,SA(1,1),A,brow+G_HALF,nt-1);
    BAR; WAIT_L(0); MMA(0,0,At,B0); BAR;
    LDB(B1,0,1); BAR; WAIT_L(0); MMA(0,1,At,B1); BAR;
    LDA(At,0,1); WAIT_V(4); BAR; WAIT_L(0); MMA(1,0,At,B0); MMA(1,1,At,B1); BAR; }
  { LDB(B0,1,0); LDA(At,1,0); WAIT_V(2); BAR; WAIT_L(0); MMA(0,0,At,B0); BAR;
    LDB(B1,1,1); WAIT_V(0); BAR; WAIT_L(0); MMA(0,1,At,B1); BAR;
    LDA(At,1,1); BAR; WAIT_L(0); MMA(1,0,At,B0); MMA(1,1,At,B1); BAR; }
  if(wr==0)BAR;
  #undef SA
  #undef SB
  #undef STAGE_X
  #undef STAGE
  #undef LDA
  #undef LDB
  #undef MMA
}

__device__ __forceinline__ bool unit_next(int i, int nM, int nN, int& pm, int& pn) {
    const int nwg = nM * nN; const long L = (long)i * gridDim.x + blockIdx.x; if (L >= nwg) return false;
    int wgid = (int)L; { const int q = nwg / 8, r = nwg % 8, xcd = wgid % 8, off = wgid / 8; wgid = (xcd < r ? xcd * (q + 1) : r * (q + 1) + (xcd - r) * q) + off; }
    const int nig = 8 * nN, gid = wgid / nig, fm = gid * 8, gsz = (nM - fm) < 8 ? (nM - fm) : 8;
    pm = fm + ((wgid % nig) % gsz); pn = (wgid % nig) / gsz; return true;
}

constexpr int ES = 132;
__device__ __forceinline__ void stage_quadrant(const f32x4 (&acc)[2][2][4][2], int ai, int bj, float* E, int tz) {
    const int wid = tz >> 6, lane = tz & 63, wr = wid >> 2, wc = wid & 3, fr = lane & 15, fq = lane >> 4;
#pragma unroll
    for (int m = 0; m < 4; ++m)
#pragma unroll
        for (int n = 0; n < 2; ++n) *(f32x4*)(E + (wr * 64 + m * 16 + fr) * ES + wc * 32 + n * 16 + fq * 4) = acc[ai][bj][m][n];
}
__device__ __forceinline__ void read_rowpart(const float* E, int r, int part, float* x1, float* x2) {
#pragma unroll
    for (int q = 0; q < 4; ++q) {
        const f32x4 a = *(const f32x4*)(E + r * ES + 16 * part + 4 * q), b = *(const f32x4*)(E + r * ES + 64 + 16 * part + 4 * q);
        x1[4 * q] = a.x; x1[4 * q + 1] = a.y; x1[4 * q + 2] = a.z; x1[4 * q + 3] = a.w;
        x2[4 * q] = b.x; x2[4 * q + 1] = b.y; x2[4 * q + 2] = b.z; x2[4 * q + 3] = b.w;
    }
}

constexpr int ES16 = 264;
__device__ __forceinline__ void stage_full16(const f32x4 (&acc)[2][2][4][2], h16* E16, int tz) {
    const int wid = tz >> 6, lane = tz & 63, wr = wid >> 2, wc = wid & 3, fr = lane & 15, fq = lane >> 4;
#pragma unroll
    for (int ai = 0; ai < 2; ++ai)
#pragma unroll
        for (int bj = 0; bj < 2; ++bj)
#pragma unroll
            for (int m = 0; m < 4; ++m)
#pragma unroll
                for (int n = 0; n < 2; ++n) {
                    const f32x4 a = acc[ai][bj][m][n];
                    f32x2 o; o.x = __uint_as_float(pkh(a.x, a.y)); o.y = __uint_as_float(pkh(a.z, a.w));
                    *(f32x2*)(E16 + (ai * 128 + wr * 64 + m * 16 + fr) * ES16 + bj * 128 + wc * 32 + n * 16 + fq * 4) = o;
                }
}
__device__ __forceinline__ void read_rowpart16(const h16* E16, int row, int bj, int part, float* x1, float* x2) {
    const h16* b = E16 + row * ES16 + bj * 128 + 16 * part;
    unpk8(*(const u32x4*)b, x1); unpk8(*(const u32x4*)(b + 8), x1 + 8);
    unpk8(*(const u32x4*)(b + 64), x2); unpk8(*(const u32x4*)(b + 72), x2 + 8);
}
template <class BODY>
__device__ __forceinline__ void epilogue_full(const f32x4 (&acc)[2][2][4][2], char* smem, BODY body) {
    h16* E16 = (h16*)smem;
    const int tz = otid();
    __syncthreads();
    stage_full16(acc, E16, tz);
    __syncthreads();
    const int r = tz >> 2, part = tz & 3;
#pragma unroll 1
    for (int q = 0; q < 4; ++q) {
        float x1[16], x2[16];
        read_rowpart16(E16, (q >> 1) * 128 + r, q & 1, part, x1, x2);
        body(q >> 1, q & 1, r, part, x1, x2);
    }
    __syncthreads();
}
__device__ __forceinline__ void rope32(float* x1, float* x2, const float2* rp, int part) {
#pragma unroll
    for (int i = 0; i < 16; ++i) { const float2 cs = rp[16 * part + i]; const float a = x1[i], b = x2[i]; x1[i] = a * cs.x - b * cs.y; x2[i] = b * cs.x + a * cs.y; }
}
struct RopeRegs { f32x4 v[8]; };
__device__ __forceinline__ void rope_load(RopeRegs& rr, const float2* rp, int part) {
#pragma unroll
    for (int k = 0; k < 8; ++k) rr.v[k] = *(const f32x4*)(rp + 16 * part + 2 * k);
}
__device__ __forceinline__ void rope32r(float* x1, float* x2, const RopeRegs& rr) {
#pragma unroll
    for (int k = 0; k < 8; ++k) {
        { const float c = rr.v[k].x, s = rr.v[k].y, a = x1[2 * k], b = x2[2 * k]; x1[2 * k] = a * c - b * s; x2[2 * k] = b * c + a * s; }
        { const float c = rr.v[k].z, s = rr.v[k].w, a = x1[2 * k + 1], b = x2[2 * k + 1]; x1[2 * k + 1] = a * c - b * s; x2[2 * k + 1] = b * c + a * s; }
    }
}
template <class BUF, class LD, class PR>
__device__ __forceinline__ void epilogue_pipe(const f32x4 (&acc)[2][2][4][2], float* E, int tz, LD ld, PR pr) {
    BUF b0, b1;
    const int r = tz >> 2, part = tz & 3;
    float x1[16], x2[16];
    ld(0, 0, r, part, b0);
    __syncthreads(); stage_quadrant(acc, 0, 0, E, tz); __syncthreads(); read_rowpart(E, r, part, x1, x2); ld(0, 1, r, part, b1); pr(0, 0, r, part, b0, x1, x2);
    __syncthreads(); stage_quadrant(acc, 0, 1, E, tz); __syncthreads(); read_rowpart(E, r, part, x1, x2); ld(1, 0, r, part, b0); pr(0, 1, r, part, b1, x1, x2);
    __syncthreads(); stage_quadrant(acc, 1, 0, E, tz); __syncthreads(); read_rowpart(E, r, part, x1, x2); ld(1, 1, r, part, b1); pr(1, 0, r, part, b0, x1, x2);
    __syncthreads(); stage_quadrant(acc, 1, 1, E, tz); __syncthreads(); read_rowpart(E, r, part, x1, x2); pr(1, 1, r, part, b1, x1, x2);
}
__device__ __forceinline__ void store_h16_32(h16* dst, int part, const float* x1, const float* x2) {
    *(u32x4*)(dst + 16 * part) = pk8(x1); *(u32x4*)(dst + 16 * part + 8) = pk8(x1 + 8);
    *(u32x4*)(dst + 64 + 16 * part) = pk8(x2); *(u32x4*)(dst + 64 + 16 * part + 8) = pk8(x2 + 8);
}
__device__ __forceinline__ void store_fp8_32(unsigned char* dst, int part, const float* x1, const float* x2, float sc) {
    u32x4 a, b;
#pragma unroll
    for (int q = 0; q < 4; ++q) {
        int w = __builtin_amdgcn_cvt_pk_fp8_f32(x1[4 * q] * sc, x1[4 * q + 1] * sc, 0, false);
        w = __builtin_amdgcn_cvt_pk_fp8_f32(x1[4 * q + 2] * sc, x1[4 * q + 3] * sc, w, true); a[q] = (unsigned)w;
        int v = __builtin_amdgcn_cvt_pk_fp8_f32(x2[4 * q] * sc, x2[4 * q + 1] * sc, 0, false);
        v = __builtin_amdgcn_cvt_pk_fp8_f32(x2[4 * q + 2] * sc, x2[4 * q + 3] * sc, v, true); b[q] = (unsigned)v;
    }
    *(u32x4*)(dst + 16 * part) = a; *(u32x4*)(dst + 64 + 16 * part) = b;
}
__device__ __forceinline__ void store_f32_32(float* dst, int part, const float* x1, const float* x2) {
#pragma unroll
    for (int q = 0; q < 4; ++q) {
        f32x4 a = {x1[4 * q], x1[4 * q + 1], x1[4 * q + 2], x1[4 * q + 3]}, b = {x2[4 * q], x2[4 * q + 1], x2[4 * q + 2], x2[4 * q + 3]};
        *(f32x4*)(dst + 16 * part + 4 * q) = a; *(f32x4*)(dst + 64 + 16 * part + 4 * q) = b;
    }
}
__device__ __forceinline__ float quad_sum(float v) { v += __shfl_xor(v, 1); v += __shfl_xor(v, 2); return v; }

__device__ __forceinline__ void inproj_block(const Params& p, int cb, int tok, int part, float* x1, float* x2, const RopeRegs& rr) {
    if (cb < 8) {
        rope32r(x1, x2, rr); store_h16_32(p.RQ + (size_t)tok * 1024 + cb * 128, part, x1, x2);
    } else if (cb < 16) {
        rope32r(x1, x2, rr);
#pragma unroll
        for (int i = 0; i < 16; ++i) { x1[i] *= 0.08838834764831845f; x2[i] *= 0.08838834764831845f; }
        store_h16_32(p.RK + (size_t)tok * 1024 + (cb - 8) * 128, part, x1, x2);
    } else if (cb < 32) {
        store_h16_32(p.RV + (size_t)tok * 2048 + (cb - 16) * 128, part, x1, x2);
    } else if (cb < 48) {
#pragma unroll
        for (int i = 0; i < 16; ++i) { x1[i] = siluf_(x1[i]); x2[i] = siluf_(x2[i]); }
        store_h16_32(p.RG + (size_t)tok * 2048 + (cb - 32) * 128, part, x1, x2);
    } else if (cb < 68) {
        const bool isq = cb < 64;
        float ss = 0.f;
#pragma unroll
        for (int i = 0; i < 16; ++i) ss += x1[i] * x1[i] + x2[i] * x2[i];
        ss = quad_sum(ss);
        const float rs = rsqrtf(ss * (1.f / 128.f) + EPS);
        const float* nw = isq ? p.q_norm_w : p.k_norm_w;
#pragma unroll
        for (int i = 0; i < 16; ++i) { x1[i] *= rs * nw[16 * part + i]; x2[i] *= rs * nw[64 + 16 * part + i]; }
        rope32r(x1, x2, rr);
        if (isq) {
#pragma unroll
            for (int i = 0; i < 16; ++i) { x1[i] *= 0.08838834764831845f; x2[i] *= 0.08838834764831845f; }
            store_fp8_32(p.AQ8 + (size_t)tok * 2048 + (cb - 48) * 128, part, x1, x2, 16.f);
        } else {
            store_fp8_32(p.AK8 + (size_t)tok * 512 + (cb - 64) * 128, part, x1, x2, 1.f);
            store_f32_32(p.out + O_KP + (size_t)tok * 512 + (cb - 64) * 128, part, x1, x2);
        }
    } else if (cb < 72) {
        store_h16_32(p.AV + (size_t)tok * 512 + (cb - 68) * 128, part, x1, x2);
        store_f32_32(p.out + O_VP + (size_t)tok * 512 + (cb - 68) * 128, part, x1, x2);
    } else if (cb < 88) {
        rope32r(x1, x2, rr);
#pragma unroll
        for (int i = 0; i < 16; ++i) { x1[i] *= 0.08838834764831845f; x2[i] *= 0.08838834764831845f; }
        store_h16_32(p.IQ + (size_t)tok * 2048 + (cb - 72) * 128, part, x1, x2);
    } else if (cb == 88) {
        rope32r(x1, x2, rr);
        store_h16_32(p.IK + (size_t)tok * 128, part, x1, x2);
        store_f32_32(p.out + O_IKP + (size_t)tok * 128, part, x1, x2);
    } else if (cb < 121) {
#pragma unroll
        for (int i = 0; i < 16; ++i) { x1[i] = sigmoidf_(x1[i]); x2[i] = sigmoidf_(x2[i]); }
        h16* dst = (cb < 105) ? p.GR + (size_t)tok * 2048 + (cb - 89) * 128 : p.GA + (size_t)tok * 2048 + (cb - 105) * 128;
        store_h16_32(dst, part, x1, x2);
    } else {
        if (part == 0) {
#pragma unroll
            for (int q = 0; q < 4; ++q) { f32x4 a = {x1[4 * q] * 0.25f, x1[4 * q + 1] * 0.25f, x1[4 * q + 2] * 0.25f, x1[4 * q + 3] * 0.25f}; *(f32x4*)(p.IW + (size_t)tok * 16 + 4 * q) = a; }
        }
    }
}

template <int CB, class F>
__device__ __forceinline__ void gemv8_item(const float* A, const float* W, int N, int n0, char* smem, F f, const float* normw = nullptr, float* shn_out = nullptr) {
    constexpr int C4 = CB / 4, KG = 512 / C4, NL = 2048 / KG, OUT = 8 * CB, P = 512 / OUT;
    const int tid = otid();
    float* AT = (float*)smem;
    float* red = AT + 2048 * 8;
    float* rs8 = (float*)(smem + 131072);
    __syncthreads();
    if (normw) {
        float ssl[8];
#pragma unroll
        for (int t = 0; t < 8; ++t) ssl[t] = 0.f;
#pragma unroll
        for (int j = 0; j < 32; ++j) { const int i = tid + 512 * j, t = i >> 11, k = i & 2047; const float a = A[i]; AT[k * 8 + t] = a * normw[k]; ssl[j >> 2] += a * a; }
#pragma unroll
        for (int t = 0; t < 8; ++t) { const float s = wave_sum(ssl[t]); if ((tid & 63) == 0) rs8[8 + (tid >> 6) * 8 + t] = s; }
        __syncthreads();
        if (tid < 8) { float s = 0.f; for (int w = 0; w < 8; ++w) s += rs8[8 + w * 8 + tid]; rs8[tid] = rsqrtf(s * (1.f / 2048.f) + EPS); }
        __syncthreads();
        if (shn_out) for (int i = tid; i < 8 * 2048; i += 512) { const int t = i >> 11, k = i & 2047; shn_out[i] = AT[k * 8 + t] * rs8[t]; }
    } else {
        float av32[32];
#pragma unroll
        for (int j = 0; j < 32; ++j) av32[j] = A[tid + 512 * j];
#pragma unroll
        for (int j = 0; j < 32; ++j) { const int i = tid + 512 * j, t = i >> 11, k = i & 2047; AT[k * 8 + t] = av32[j]; }
        __syncthreads();
    }
    const int c4 = tid % C4, kg = tid / C4, n = n0 + 4 * c4;
    const bool ok = (n + 3) < N;
    float acc[8][4];
#pragma unroll
    for (int t = 0; t < 8; ++t)
#pragma unroll
        for (int c = 0; c < 4; ++c) acc[t][c] = 0.f;
    const float* wp = W + (size_t)kg * N + (ok ? n : 0);
#pragma unroll 16
    for (int j = 0; j < NL; ++j) {
        const int k = kg + KG * j;
        f32x4 w = *(const f32x4*)(wp + (size_t)(KG * j) * N);
        if (!ok) w = (f32x4){0.f, 0.f, 0.f, 0.f};
        const f32x4 a0 = *(const f32x4*)(AT + k * 8), a1 = *(const f32x4*)(AT + k * 8 + 4);
        const float av[8] = {a0.x, a0.y, a0.z, a0.w, a1.x, a1.y, a1.z, a1.w};
#pragma unroll
        for (int t = 0; t < 8; ++t) { acc[t][0] += av[t] * w.x; acc[t][1] += av[t] * w.y; acc[t][2] += av[t] * w.z; acc[t][3] += av[t] * w.w; }
    }
#pragma unroll
    for (int t = 0; t < 8; ++t) { f32x4 v = {acc[t][0], acc[t][1], acc[t][2], acc[t][3]}; *(f32x4*)(red + (kg * 8 + t) * CB + 4 * c4) = v; }
    __syncthreads();
    {
        const int o = tid % OUT, part = tid / OUT, t = o / CB, col = o % CB;
        float s = 0.f;
#pragma unroll 8
        for (int q = 0; q < 32; ++q) s += red[((part * 32 + q) * 8 + t) * CB + col];
        if (P > 1) {
            AT[part * OUT + o] = s;
            __syncthreads();
            if (tid < OUT) {
                s = 0.f;
#pragma unroll
                for (int q = 0; q < P; ++q) s += AT[q * OUT + o];
            }
        }
        if (tid < OUT && (n0 + col) < N) f(t, n0 + col, normw ? s * rs8[t] : s);
    }
}

__device__ __forceinline__ void late_weight_transposes(const Params& p, char* smem, int first) {
    const int t0 = otid(), lane = t0 & 63, wave = t0 >> 6;
    const int G = gridDim.x, gw = ((int)blockIdx.x - first) * 8 + wave, NGW = (G - first) * 8;
    float* scr = (float*)smem + wave * (64 * 33);
    constexpr int I_SQ = 32 * 64, I_WQ = 32 * 32, NIT = 3 * I_SQ + I_WQ;
    __syncthreads();
    for (int it = gw; it < NIT; it += NGW) {
        int r = it;
        if (r < I_SQ) { p0_transpose_item<false>(p.w_ret_o, D, D, p.WrT, scr, r, 64, lane); continue; } r -= I_SQ;
        if (r < I_SQ) { p0_transpose_item<false>(p.w_att_o, D, D, p.WaT, scr, r, 64, lane); continue; } r -= I_SQ;
        if (r < I_SQ) { p0_transpose_item<false>(p.w_out, D, D, p.WoT, scr, r, 64, lane); continue; } r -= I_SQ;
        p0_transpose_item<false>(p.peer_wq, D, 1024, p.WqT, scr, r, 32, lane, p.norm2_w);
    }
    __syncthreads();
}

__device__ __forceinline__ void phase1(const Params& p, char* smem) {
    const int tid = otid();
    for (int i = 0;; ++i) {
        int pm, pn; if (!unit_next(i, TP / 256, NWP / 256, pm, pn)) break;
        f32x4 acc[2][2][4][2] = {};
        gemm_core(p.XN, p.WinT, pm * 256, pn * 256, D, acc, (h16*)smem);
        epilogue_full(acc, smem, [&](int ai, int bj, int r, int part, float* x1, float* x2) {
            RopeRegs rr;
            rope_load(rr, p.ROPE + (size_t)((pm * 256 + ai * 128 + r) & (SEQ - 1)) * 64, part);
            inproj_block(p, pn * 2 + bj, pm * 256 + ai * 128 + r, part, x1, x2, rr);
        });
    }
    {
        const int G = gridDim.x, first = (G > 160) ? 160 : 0, nw = G - first;
        if ((int)blockIdx.x >= first) {
            for (int it = blockIdx.x - first; it < (NW0 + 63) / 64; it += nw) {
                float* ZS = p.ZS;
                gemv8_item<64>(p.XNS, p.w_in, NW0, it * 64, smem, [=](int t, int n, float v) { ZS[(size_t)t * NW0 + n] = v; });
            }
            late_weight_transposes(p, smem, first);
        }
    }
}

__device__ __forceinline__ void indexer_item(const Params& p, int b, int g, char* smem) {
    const int tid = otid(), lane = tid & 63, wave = tid >> 6, r16 = lane & 15, kq = lane >> 4;
    float* SC = (float*)smem;
    const int t0 = 8 * g, nkeys = 8 * g + 8, ntile = (nkeys + 15) >> 4;
    const size_t tb = (size_t)b * SEQ;
    {
        h16x8 af[2][4][4];
        float* WL = (float*)(smem + 8 * SCS * 4);
        if (tid < 128) WL[tid] = p.IW[(tb + t0) * 16 + tid];
#pragma unroll
        for (int Qg = 0; Qg < 2; ++Qg)
#pragma unroll
            for (int hg = 0; hg < 4; ++hg) {
                const h16* qp = p.IQ + (tb + t0 + Qg * 4 + (r16 >> 2)) * 2048 + (hg * 4 + (r16 & 3)) * 128 + kq * 8;
#pragma unroll
                for (int kk = 0; kk < 4; ++kk) af[Qg][hg][kk] = *(const h16x8*)(qp + kk * 32);
            }
        __syncthreads();
        f32x4 wv[2][4];
#pragma unroll
        for (int Qg = 0; Qg < 2; ++Qg)
#pragma unroll
            for (int hg = 0; hg < 4; ++hg) wv[Qg][hg] = *(const f32x4*)(WL + (Qg * 4 + kq) * 16 + hg * 4);
        const h16* kbase = p.IK + (tb + r16) * 128 + kq * 8;
        const int last = ntile - 1;
        h16x8 b0[4], b1[4], b2[4];
#define IDX_LOAD(dst, tl) { const int _t = (tl) < last ? (tl) : last; const h16* _kp = kbase + (size_t)_t * 16 * 128; \
    asm volatile("global_load_dwordx4 %0, %4, off\n\tglobal_load_dwordx4 %1, %4, off offset:64\n\tglobal_load_dwordx4 %2, %4, off offset:128\n\tglobal_load_dwordx4 %3, %4, off offset:192" \
                 : "=&v"(dst[0]), "=&v"(dst[1]), "=&v"(dst[2]), "=&v"(dst[3]) : "v"(_kp) : "memory"); }
#define IDX_WAIT8(bfr) asm volatile("s_waitcnt vmcnt(8)" : "+v"(bfr[0]), "+v"(bfr[1]), "+v"(bfr[2]), "+v"(bfr[3]) :: "memory")
#define IDX_TILE(bfr, tl) { const int _t = (tl) < last ? (tl) : last; \
    _Pragma("unroll") for (int Qg = 0; Qg < 2; ++Qg) { float sc = 0.f; \
        _Pragma("unroll") for (int hg = 0; hg < 4; ++hg) { f32x4 a = {0.f, 0.f, 0.f, 0.f}; \
            _Pragma("unroll") for (int kk = 0; kk < 4; ++kk) a = __builtin_amdgcn_mfma_f32_16x16x32_f16(af[Qg][hg][kk], bfr[kk], a, 0, 0, 0); \
            sc += wv[Qg][hg].x * fmaxf(a.x, 0.f) + wv[Qg][hg].y * fmaxf(a.y, 0.f) + wv[Qg][hg].z * fmaxf(a.z, 0.f) + wv[Qg][hg].w * fmaxf(a.w, 0.f); } \
        SC[(Qg * 4 + kq) * SCS + _t * 16 + r16] = sc; } }
#pragma unroll
        for (int Qg = 0; Qg < 2; ++Qg)
#pragma unroll
            for (int hg = 0; hg < 4; ++hg) asm volatile("" : "+v"(af[Qg][hg][0]), "+v"(af[Qg][hg][1]), "+v"(af[Qg][hg][2]), "+v"(af[Qg][hg][3]));
#pragma unroll
        for (int Qg = 0; Qg < 2; ++Qg) asm volatile("" : "+v"(wv[Qg][0]), "+v"(wv[Qg][1]), "+v"(wv[Qg][2]), "+v"(wv[Qg][3]));
        IDX_LOAD(b0, wave) IDX_LOAD(b1, wave + 8) IDX_LOAD(b2, wave + 16)
        for (int tile = wave; tile < ntile; tile += 24) {
            IDX_WAIT8(b0); IDX_TILE(b0, tile) IDX_LOAD(b0, tile + 24)
            IDX_WAIT8(b1); IDX_TILE(b1, tile + 8) IDX_LOAD(b1, tile + 32)
            IDX_WAIT8(b2); IDX_TILE(b2, tile + 16) IDX_LOAD(b2, tile + 40)
        }
        asm volatile("s_waitcnt vmcnt(0)" ::: "memory");
#undef IDX_WAIT8
#undef IDX_LOAD
#undef IDX_TILE
    }
    __syncthreads();
    {
        const int t = t0 + wave, nvalid = t + 1;
        int* outp = p.TOPI + (tb + t) * 256;
        if (nvalid <= 256) {
#pragma unroll
            for (int i = 0; i < 4; ++i) { const int j = lane + 64 * i; outp[j] = (j < nvalid) ? j : -1; }
        } else {
            unsigned u[64];
#pragma unroll
            for (int i = 0; i < 64; ++i) { const int s = i * 64 + lane; const unsigned o = f2ord(SC[wave * SCS + s]); u[i] = (s <= t) ? o : 0u; }
            unsigned tau; int need_eq;
            const int nreg = __builtin_amdgcn_readfirstlane((t >> 6) + 1);
            wave_kth_dyn<64>(u, (nreg + 7) >> 3, 256, tau, need_eq);
            const u64 lt = (1ull << lane) - 1ull;
            int base = 0, eqt = 0;
            unsigned tau2 = tau; asm volatile("" : "+v"(tau2));
            static_for<0, 16>([&](auto G4) {
                constexpr int g4 = decltype(G4)::value;
                if (g4 * 4 < nreg) {
#pragma unroll
                    for (int ii = 0; ii < 4; ++ii) {
                        constexpr int dummy = 0; (void)dummy;
                        const int i = g4 * 4 + ii;
                        const bool gt = u[i] > tau2, eq = u[i] == tau2;
                        const u64 meq = __ballot(eq);
                        const bool sel = gt || (eq && (eqt + __popcll(meq & lt)) < need_eq);
                        const u64 ms = __ballot(sel);
                        if (sel) outp[base + __popcll(ms & lt)] = i * 64 + lane;
                        base += __popcll(ms); eqt += __popcll(meq);
                    }
                    __builtin_amdgcn_sched_barrier(0);
                }
            });
        }
    }
    __syncthreads();
}

__device__ __forceinline__ void kv_item(const Params& p, int b, int h, int c, char* smem) {
    const int tid = otid(), lane = tid & 63, wave = tid >> 6;
    char* Kimg = smem;
    char* Vimg = smem + 32768;
    const size_t tok0 = (size_t)b * SEQ + c * 128;
    const float lg = ret_log_g(h);
#pragma unroll
    for (int i = 0; i < 4; ++i) {
        const int q = tid + 512 * i, tt = q >> 4, ch = q & 15;
        const u32x4 raw = *(const u32x4*)(p.RK + (tok0 + tt) * 1024 + h * 128 + ch * 8);
        float v[8]; unpk8(raw, v);
        const float dec = __expf((float)(127 - tt) * lg);
#pragma unroll
        for (int e = 0; e < 8; ++e) v[e] *= dec;
        *(u32x4*)(Kimg + (tt >> 5) * 8192 + off_b(tt & 31, ch)) = pk8(v);
    }
#pragma unroll
    for (int i = 0; i < 8; ++i) {
        const int q = tid + 512 * i, tt = q >> 5, c32 = q & 31;
        const u32x4 raw = *(const u32x4*)(p.RV + (tok0 + tt) * 2048 + h * 256 + c32 * 8);
        *(u32x4*)(Vimg + ((tt >> 5) * 2 + (c32 >> 4)) * 8192 + off_b(tt & 31, c32 & 15)) = raw;
    }
    __syncthreads();
    f32x4 acc[16];
#pragma unroll
    for (int nt = 0; nt < 16; ++nt) acc[nt] = (f32x4){0.f, 0.f, 0.f, 0.f};
    const unsigned z0 = lds_u32(smem) + tr_addr16(lane, 0, 0), z1 = lds_u32(smem) + tr_addr16(lane, 0, 1);
    static_for<0, 4>([&](auto KS) {
        constexpr int ks = decltype(KS)::value;
        const h16x8 af = tr_read8o<ks * 8192>(z0 ^ (32u * wave), z1 ^ (32u * wave));
        static_for<0, 16>([&](auto NT) {
            constexpr int nt = decltype(NT)::value;
            const h16x8 bf = tr_read8o<(ks * 2 + (nt >> 3)) * 8192>((z0 + 32768u) ^ (32u * (nt & 7)), (z1 + 32768u) ^ (32u * (nt & 7)));
            acc[nt] = __builtin_amdgcn_mfma_f32_16x16x32_f16(bf, af, acc[nt], 0, 0, 0);
        });
    });
    float* dst = p.KV + ((size_t)((b * 8 + h) * 32 + c) * 128) * 256;
#pragma unroll
    for (int nt = 0; nt < 16; ++nt) *(f32x4*)(dst + (size_t)(16 * wave + (lane & 15)) * 256 + 16 * nt + 4 * (lane >> 4)) = acc[nt];
    __syncthreads();
}

__device__ __forceinline__ void sample_post_item(const Params& p) {
    const int tid = otid();
    const float2* rp = p.ROPE + (size_t)4096 * 64;
    for (int q = tid; q < 8 * 122 * 4; q += 512) {
        const int part = q & 3, cb = (q >> 2) % 122, t = (q >> 2) / 122;
        const int col0 = (cb < 89) ? cb * 128 : (cb < 105) ? C_GR + (cb - 89) * 128 : (cb < 121) ? C_GA + (cb - 105) * 128 : C_IW;
        const float* z = p.ZS + (size_t)t * NW0 + col0;
        float x1[16], x2[16];
        if (cb < 121) {
#pragma unroll
            for (int i = 0; i < 16; ++i) { x1[i] = z[16 * part + i]; x2[i] = z[64 + 16 * part + i]; }
        } else {
#pragma unroll
            for (int i = 0; i < 16; ++i) { x1[i] = z[i]; x2[i] = 0.f; }
        }
        if (cb < 8) { rope32(x1, x2, rp, part); store_f32_32(p.SRQ + t * 1024 + cb * 128, part, x1, x2); }
        else if (cb < 16) {
            rope32(x1, x2, rp, part);
#pragma unroll
            for (int i = 0; i < 16; ++i) { x1[i] *= 0.08838834764831845f; x2[i] *= 0.08838834764831845f; }
            store_f32_32(p.SRK + t * 1024 + (cb - 8) * 128, part, x1, x2);
        } else if (cb < 32) store_f32_32(p.SRV + t * 2048 + (cb - 16) * 128, part, x1, x2);
        else if (cb < 48) {
#pragma unroll
            for (int i = 0; i < 16; ++i) { x1[i] = siluf_(x1[i]); x2[i] = siluf_(x2[i]); }
            store_f32_32(p.SRG + t * 2048 + (cb - 32) * 128, part, x1, x2);
        } else if (cb < 68) {
            const bool isq = cb < 64;
            float ss = 0.f;
#pragma unroll
            for (int i = 0; i < 16; ++i) ss += x1[i] * x1[i] + x2[i] * x2[i];
            ss = quad_sum(ss);
            const float rs = rsqrtf(ss * (1.f / 128.f) + EPS);
            const float* nw = isq ? p.q_norm_w : p.k_norm_w;
#pragma unroll
            for (int i = 0; i < 16; ++i) { x1[i] *= rs * nw[16 * part + i]; x2[i] *= rs * nw[64 + 16 * part + i]; }
            rope32(x1, x2, rp, part);
            if (isq) {
#pragma unroll
                for (int i = 0; i < 16; ++i) { x1[i] *= 0.08838834764831845f; x2[i] *= 0.08838834764831845f; }
                store_f32_32(p.SAQ + t * 2048 + (cb - 48) * 128, part, x1, x2);
            } else {
                store_f32_32(p.SAK + t * 512 + (cb - 64) * 128, part, x1, x2);
                store_f32_32(p.out + O_KS + t * 512 + (cb - 64) * 128, part, x1, x2);
            }
        } else if (cb < 72) {
            store_f32_32(p.SAV + t * 512 + (cb - 68) * 128, part, x1, x2);
            store_f32_32(p.out + O_VS + t * 512 + (cb - 68) * 128, part, x1, x2);
        } else if (cb < 88) {
        } else if (cb == 88) {
            rope32(x1, x2, rp, part);
            store_f32_32(p.SIK + t * 128, part, x1, x2);
            store_f32_32(p.out + O_IKS + t * 128, part, x1, x2);
        } else if (cb < 121) {
#pragma unroll
            for (int i = 0; i < 16; ++i) { x1[i] = sigmoidf_(x1[i]); x2[i] = sigmoidf_(x2[i]); }
            float* dst = (cb < 105) ? p.SGR + t * 2048 + (cb - 89) * 128 : p.SGA + t * 2048 + (cb - 105) * 128;
            store_f32_32(dst, part, x1, x2);
        }
    }
}

__device__ __forceinline__ void sample_indexer_item(const Params& p, int t, int kr, char* smem) {
    const int tid = otid();
    float* qs = (float*)smem;
    float* ws = qs + 2048;
    float* kself = ws + 16;
    float* tmp = kself + 128;
    const float2* rp = p.ROPE + (size_t)4096 * 64;
    const float* z = p.ZS + (size_t)t * NW0;
    __syncthreads();
#pragma unroll
    for (int i = 0; i < 2; ++i) {
        const int pr = tid + 512 * i, hh = pr >> 6, d = pr & 63;
        const float a = z[C_IQ + hh * 128 + d], b = z[C_IQ + hh * 128 + 64 + d];
        const float2 cs = rp[d];
        qs[hh * 128 + d] = (a * cs.x - b * cs.y) * 0.08838834764831845f;
        qs[hh * 128 + 64 + d] = (b * cs.x + a * cs.y) * 0.08838834764831845f;
    }
    if (tid < 16) ws[tid] = z[C_IW + tid] * 0.25f;
    if (tid < 64) { const float a = z[C_IK + tid], b = z[C_IK + 64 + tid]; const float2 cs = rp[tid]; kself[tid] = a * cs.x - b * cs.y; kself[64 + tid] = b * cs.x + a * cs.y; }
    __syncthreads();
    {
        const int lane = tid & 63, wave = tid >> 6, r16 = lane & 15, g = lane >> 4;
        h16x8 qhi[4], qlo[4];
#pragma unroll
        for (int kk = 0; kk < 4; ++kk) {
            const float* qp = qs + r16 * 128 + kk * 32 + g * 8;
            const f32x4 a = *(const f32x4*)qp, b = *(const f32x4*)(qp + 4);
            const float v[8] = {a.x, a.y, a.z, a.w, b.x, b.y, b.z, b.w};
#pragma unroll
            for (int e = 0; e < 8; ++e) { const h16 hv = (h16)v[e]; qhi[kk][e] = hv; qlo[kk][e] = (h16)(v[e] - (float)hv); }
        }
        f32x4 wv4 = *(const f32x4*)(ws + 4 * g);
        f32x4 kraw[4][4][2];
#pragma unroll
        for (int tl = 0; tl < 4; ++tl) {
            const int s = kr * 512 + (wave * 4 + tl) * 16 + r16;
            const int page = p.page_table[t * NPAGES + (s >> 7)];
            const float* kp = p.cache_kidx + ((size_t)page * PAGE + (s & 127)) * 128 + g * 8;
#pragma unroll
            for (int kk = 0; kk < 4; ++kk) { kraw[tl][kk][0] = *(const f32x4*)(kp + kk * 32); kraw[tl][kk][1] = *(const f32x4*)(kp + kk * 32 + 4); }
        }
#pragma unroll
        for (int tl = 0; tl < 4; ++tl) {
            f32x4 acc = {0.f, 0.f, 0.f, 0.f};
#pragma unroll
            for (int kk = 0; kk < 4; ++kk) {
                const f32x4 a = kraw[tl][kk][0], b = kraw[tl][kk][1];
                const float v[8] = {a.x, a.y, a.z, a.w, b.x, b.y, b.z, b.w};
                h16x8 khi, klo;
#pragma unroll
                for (int e = 0; e < 8; ++e) { const h16 hv = (h16)v[e]; khi[e] = hv; klo[e] = (h16)(v[e] - (float)hv); }
                acc = __builtin_amdgcn_mfma_f32_16x16x32_f16(qlo[kk], khi, acc, 0, 0, 0);
                acc = __builtin_amdgcn_mfma_f32_16x16x32_f16(qhi[kk], klo, acc, 0, 0, 0);
                acc = __builtin_amdgcn_mfma_f32_16x16x32_f16(qhi[kk], khi, acc, 0, 0, 0);
            }
            float sc = wv4.x * fmaxf(acc.x, 0.f) + wv4.y * fmaxf(acc.y, 0.f) + wv4.z * fmaxf(acc.z, 0.f) + wv4.w * fmaxf(acc.w, 0.f);
            sc += __shfl_xor(sc, 16); sc += __shfl_xor(sc, 32);
            if (g == 0) p.SSC[(size_t)t * SSCS + kr * 512 + (wave * 4 + tl) * 16 + r16] = sc;
        }
    }
    if (kr == 31) {
        if (tid < 16) { float d = 0.f;
#pragma unroll 4
            for (int i = 0; i < 128; ++i) d += qs[tid * 128 + i] * kself[i]; tmp[tid] = ws[tid] * fmaxf(d, 0.f); }
        __syncthreads();
        if (tid == 0) { float sc = 0.f; for (int i = 0; i < 16; ++i) sc += tmp[i]; p.SSC[(size_t)t * SSCS + PAST] = sc; }
    }
    __syncthreads();
}

__device__ __forceinline__ void phase2(const Params& p, char* smem) {
    const int c = blockIdx.x, G = gridDim.x;
    for (int k = 0;; ++k) {
        const int rr = (k >> 1) * 2 * G, r = (k & 1) ? rr + 2 * G - 1 - c : rr + c;
        if (rr >= 1024) break;
        if (r < 1024) indexer_item(p, r & 1, 511 - (r >> 1), smem);
    }
    for (int it = c; it < 512; it += G) kv_item(p, it >> 8, (it >> 5) & 7, it & 31, smem);
    for (int it = c; it < 256; it += G) sample_indexer_item(p, it >> 5, it & 31, smem);
    if (c == G - 1) sample_post_item(p);
}

__device__ __forceinline__ void scan_item(const Params& p, int item) {
    const int idx = item * 512 + otid();
    const int dv = idx & 255, dkb = (idx >> 8) & 15, h = (idx >> 12) & 7, b = idx >> 15;
    const float gC = __expf(128.f * ret_log_g(h));
    float S[8];
#pragma unroll
    for (int i = 0; i < 8; ++i) S[i] = 0.f;
    const size_t bh = (size_t)(b * 8 + h);
#pragma unroll 4
    for (int c = 0; c < 32; ++c) {
        *(u32x4*)(p.SPT + (((bh * 32 + c) * 256 + dv) * 128) + dkb * 8) = pk8(S);
        const float* kv = p.KV + ((bh * 32 + c) * 128 + dkb * 8) * 256 + dv;
#pragma unroll
        for (int i = 0; i < 8; ++i) S[i] = gC * S[i] + kv[(size_t)i * 256];
    }
#pragma unroll
    for (int i = 0; i < 8; ++i) p.out[O_SP + (bh * 128 + dkb * 8 + i) * 256 + dv] = S[i];
}

__device__ __forceinline__ void attn_item(const Params& p, int b, int n, int qg, char* smem) {
    const int tid = otid(), lane = tid & 63, wave = tid >> 6, r16 = lane & 15, g = lane >> 4;
    const int tt = 8 * qg + wave, t = b * SEQ + tt;
    const int cnt = (tt + 1 < 256) ? tt + 1 : 256;
    int* lidx = (int*)(smem + wave * 9216);
    char* img = smem + wave * 9216 + 1024;
    const unsigned az0 = lds_u32(img) + tr_addr16(lane, 0, 0), az1 = lds_u32(img) + tr_addr16(lane, 0, 1);
    const size_t tb = (size_t)b * SEQ;
#pragma unroll
    for (int i = 0; i < 4; ++i) { const int v = p.TOPI[(size_t)t * 256 + lane + 64 * i]; lidx[lane + 64 * i] = v < 0 ? 0 : v; }
    long qf[4];
    {
        const unsigned char* qp = p.AQ8 + (size_t)t * 2048 + (n * 4 + (r16 & 3)) * 128 + 16 * g;
        u32x4 c0 = *(const u32x4*)qp, c1 = *(const u32x4*)(qp + 64);
        if (r16 >= 4) { c0 = (u32x4){0u, 0u, 0u, 0u}; c1 = c0; }
        qf[0] = (long)(((u64)c0.y << 32) | c0.x); qf[1] = (long)(((u64)c0.w << 32) | c0.z);
        qf[2] = (long)(((u64)c1.y << 32) | c1.x); qf[3] = (long)(((u64)c1.w << 32) | c1.z);
    }
    const unsigned char* kbase = p.AK8 + tb * 512 + n * 128 + 16 * g;
    const h16* vbase = p.AV + tb * 512 + n * 128;
    f32x4 sacc[16];
    {
        u32x4 kf[16][2];
#pragma unroll
        for (int i = 0; i < 16; ++i) {
            const unsigned char* kp = kbase + (size_t)lidx[16 * i + r16] * 512;
            kf[i][0] = *(const u32x4*)kp; kf[i][1] = *(const u32x4*)(kp + 64);
        }
#pragma unroll
        for (int i = 0; i < 16; ++i) {
            const u32x4 k0 = kf[i][0], k1 = kf[i][1];
            f32x4 a = {0.f, 0.f, 0.f, 0.f};
            a = __builtin_amdgcn_mfma_f32_16x16x32_fp8_fp8((long)(((u64)k0.y << 32) | k0.x), qf[0], a, 0, 0, 0);
            a = __builtin_amdgcn_mfma_f32_16x16x32_fp8_fp8((long)(((u64)k0.w << 32) | k0.z), qf[1], a, 0, 0, 0);
            a = __builtin_amdgcn_mfma_f32_16x16x32_fp8_fp8((long)(((u64)k1.y << 32) | k1.x), qf[2], a, 0, 0, 0);
            a = __builtin_amdgcn_mfma_f32_16x16x32_fp8_fp8((long)(((u64)k1.w << 32) | k1.z), qf[3], a, 0, 0, 0);
#pragma unroll
            for (int j = 0; j < 4; ++j) sacc[i][j] = ((16 * i + 4 * g + j) < cnt) ? a[j] * (1.f / 16.f) : -3.0e38f;
        }
    }
    u32x4 vr[3][8];
#pragma unroll
    for (int b0 = 0; b0 < 3; ++b0)
#pragma unroll
        for (int i2 = 0; i2 < 8; ++i2) {
            const int q = lane + 64 * i2, s = q >> 4, ch = q & 15;
            const int slot = (2 * b0 + ((s >> 2) & 1)) * 16 + 4 * (s >> 3) + (s & 3);
            vr[b0][i2] = *(const u32x4*)(vbase + (size_t)lidx[slot] * 512 + ch * 8);
        }
    float mx = -3.0e38f;
#pragma unroll
    for (int i = 0; i < 16; ++i)
#pragma unroll
        for (int j = 0; j < 4; ++j) mx = fmaxf(mx, sacc[i][j]);
    mx = fmaxf(mx, __shfl_xor(mx, 16)); mx = fmaxf(mx, __shfl_xor(mx, 32));
    float sum = 0.f;
#pragma unroll
    for (int i = 0; i < 16; ++i)
#pragma unroll
        for (int j = 0; j < 4; ++j) { const float e = __expf(sacc[i][j] - mx); sacc[i][j] = e; sum += e; }
    sum += __shfl_xor(sum, 16); sum += __shfl_xor(sum, 32);
    f32x4 oacc[8];
#pragma unroll
    for (int c = 0; c < 8; ++c) oacc[c] = (f32x4){0.f, 0.f, 0.f, 0.f};
#pragma unroll
    for (int bI = 0; bI < 8; ++bI) {
#pragma unroll
        for (int i2 = 0; i2 < 8; ++i2) { const int q = lane + 64 * i2; *(u32x4*)(img + off_b(q >> 4, q & 15)) = vr[bI % 3][i2]; }
        if (bI + 3 < 8) {
#pragma unroll
            for (int i2 = 0; i2 < 8; ++i2) {
                const int q = lane + 64 * i2, s = q >> 4, ch = q & 15;
                const int slot = (2 * (bI + 3) + ((s >> 2) & 1)) * 16 + 4 * (s >> 3) + (s & 3);
                vr[bI % 3][i2] = *(const u32x4*)(vbase + (size_t)lidx[slot] * 512 + ch * 8);
            }
        }
        h16x8 pf;
        {
            const f32x4 a0 = sacc[2 * bI], a1 = sacc[2 * bI + 1];
            pf[0] = (h16)a0.x; pf[1] = (h16)a0.y; pf[2] = (h16)a0.z; pf[3] = (h16)a0.w;
            pf[4] = (h16)a1.x; pf[5] = (h16)a1.y; pf[6] = (h16)a1.z; pf[7] = (h16)a1.w;
        }
#pragma unroll
        for (int c0 = 0; c0 < 8; c0 += 4) {
            h16x8 vf[4];
            tr_read8x4(az0, az1, c0, vf);
#pragma unroll
            for (int c = 0; c < 4; ++c) oacc[c0 + c] = __builtin_amdgcn_mfma_f32_16x16x32_f16(pf, vf[c], oacc[c0 + c], 0, 0, 0);
        }
    }
    float inv[4];
#pragma unroll
    for (int j = 0; j < 4; ++j) inv[j] = 1.f / __shfl(sum, j);
    h16* ost = (h16*)img;
    if (g == 0) {
#pragma unroll
        for (int c = 0; c < 8; ++c)
#pragma unroll
            for (int j = 0; j < 4; ++j) ost[j * 128 + 16 * c + r16] = (h16)(oacc[c][j] * inv[j]);
    }
    asm volatile("s_waitcnt lgkmcnt(0)" ::: "memory");
    *(u32x4*)(p.ATT + (size_t)t * 2048 + n * 512 + lane * 8) = *(const u32x4*)(ost + lane * 8);
    asm volatile("s_waitcnt lgkmcnt(0)" ::: "memory");
}

__device__ __forceinline__ void sample_topk_item(const Params& p, int t, char* smem) {
    const int tid = otid(), lane = tid & 63, wave = tid >> 6;
    int* red = (int*)smem;
    int* cnts = red + 16;
    __syncthreads();
    unsigned u[33];
#pragma unroll
    for (int i = 0; i < 33; ++i) { const int s = i * 512 + tid; u[i] = (s < LS) ? f2ord(p.SSC[(size_t)t * SSCS + s]) : 0u; }
    unsigned tau = 0u;
    for (int bit = 31; bit >= 0; --bit) {
        const unsigned cand = tau | (1u << bit);
        int c = 0;
#pragma unroll
        for (int i = 0; i < 33; ++i) c += (u[i] >= cand) ? 1 : 0;
#pragma unroll
        for (int o = 32; o > 0; o >>= 1) c += __shfl_xor(c, o);
        if (lane == 0) red[wave] = c;
        __syncthreads();
        int tot = 0;
#pragma unroll
        for (int w = 0; w < 8; ++w) tot += red[w];
        __syncthreads();
        if (tot >= 256) tau = cand;
    }
    const u64 lt = (1ull << lane) - 1ull;
#pragma unroll
    for (int i = 0; i < 33; ++i) {
        const u64 mg = __ballot(u[i] > tau), me = __ballot(u[i] == tau);
        if (lane == 0) { cnts[i * 8 + wave] = __popcll(mg); cnts[264 + i * 8 + wave] = __popcll(me); }
        if ((i & 3) == 3) __builtin_amdgcn_sched_barrier(0);
    }
    __syncthreads();
    int cg_tot = 0;
#pragma unroll 8
    for (int i = 0; i < 264; ++i) cg_tot += cnts[i];
    const int need_eq = 256 - cg_tot;
    int eq_before = 0, sel_before = 0;
    int* outp = p.STOP + t * 256;
    unsigned tau2 = tau; asm volatile("" : "+v"(tau2));
#pragma unroll
    for (int i = 0; i < 33; ++i) {
        int eb = eq_before, sb = sel_before;
        for (int w = 0; w < wave; ++w) {
            const int ng = cnts[i * 8 + w], ne = cnts[264 + i * 8 + w];
            int take_e = need_eq - eb; take_e = take_e < 0 ? 0 : (take_e > ne ? ne : take_e);
            eb += ne; sb += ng + take_e;
        }
        const bool gt = u[i] > tau2, eq = u[i] == tau2;
        const u64 me = __ballot(eq);
        const bool sel = gt || (eq && (eb + __popcll(me & lt)) < need_eq);
        const u64 ms = __ballot(sel);
        if (sel) outp[sb + __popcll(ms & lt)] = i * 512 + tid;
        for (int w = 0; w < 8; ++w) {
            const int ng = cnts[i * 8 + w], ne = cnts[264 + i * 8 + w];
            int take_e = need_eq - eq_before; take_e = take_e < 0 ? 0 : (take_e > ne ? ne : take_e);
            eq_before += ne; sel_before += ng + take_e;
        }
        __builtin_amdgcn_sched_barrier(0);
    }
    __syncthreads();
}

__device__ __forceinline__ void phase3(const Params& p, char* smem, int rep) {
    const int c = blockIdx.x, G = gridDim.x;
    for (int it = c; it < 136; it += G) { if (it < 128) scan_item(p, it); else sample_topk_item(p, it - 128, smem); }
    volatile int* s_next = (volatile int*)(smem + LDS_BYTES - 64);
    const unsigned home = xb_xcc_id() & 7u;
    int dead = 0;
    for (;;) {
        __syncthreads();
        if (threadIdx.x == 0) {
            int it = -1;
            for (int qi = dead; qi < 8; ++qi) {
                const unsigned q = (home + qi) & 7u;
                const int v = (int)atomicAdd(&p.ctl[4096 + 512 * rep + 64 * q], 2u);
                if (v < 512) { it = (int)q * 512 + v; s_next[1] = qi; break; }
            }
            if (it < 0) s_next[1] = 8;
            s_next[0] = it;
        }
        __syncthreads();
        const int it = s_next[0];
        dead = s_next[1];
        if (it < 0) break;
        const int q = it >> 9;
        attn_item(p, q >> 2, q & 3, it & 511, smem);
        attn_item(p, q >> 2, q & 3, (it & 511) + 1, smem);
    }
}

__device__ __forceinline__ void retout_item(const Params& p, int b, int h, int c, char* smem) {
    const int tid = otid(), lane = tid & 63, wave = tid >> 6, r16 = lane & 15, g = lane >> 4;
    char* Vimg = smem;
    const size_t tok0 = (size_t)b * SEQ + c * 128;
    const float lg = ret_log_g(h);
#pragma unroll
    for (int i = 0; i < 8; ++i) {
        const int q = tid + 512 * i, sg = q >> 5, c32 = q & 31, bI = sg >> 5, s = sg & 31;
        const int tokl = bI * 32 + ((s >> 2) & 1) * 16 + 4 * (s >> 3) + (s & 3);
        const u32x4 raw = *(const u32x4*)(p.RV + (tok0 + tokl) * 2048 + h * 256 + c32 * 8);
        *(u32x4*)(Vimg + (bI * 2 + (c32 >> 4)) * 8192 + off_b(s, c32 & 15)) = raw;
    }
    __syncthreads();
    const int il = 16 * wave + r16;
    h16x8 qf[4], qd[4];
    {
        const h16* qp = p.RQ + (tok0 + il) * 1024 + h * 128 + g * 8;
        const float dq = __expf((float)(il + 1) * lg);
#pragma unroll
        for (int kk = 0; kk < 4; ++kk) {
            const u32x4 raw = *(const u32x4*)(qp + kk * 32);
            qf[kk] = __builtin_bit_cast(h16x8, raw);
            float v[8]; unpk8(raw, v);
#pragma unroll
            for (int e = 0; e < 8; ++e) v[e] *= dq;
            qd[kk] = __builtin_bit_cast(h16x8, pk8(v));
        }
    }
    f32x4 sacc[8];
#pragma unroll
    for (int jr = 0; jr < 2; ++jr) {
        h16x8 kf[4][4];
        if (4 * jr <= wave) {
#pragma unroll
            for (int q = 0; q < 4; ++q) {
                const int jt = 4 * jr + q, jc = jt <= wave ? jt : wave;
                const h16* kp = p.RK + (tok0 + 16 * jc + r16) * 1024 + h * 128 + g * 8;
#pragma unroll
                for (int kk = 0; kk < 4; ++kk) kf[q][kk] = *(const h16x8*)(kp + kk * 32);
            }
        }
#pragma unroll
        for (int q = 0; q < 4; ++q) {
            const int jt = 4 * jr + q;
            sacc[jt] = (f32x4){0.f, 0.f, 0.f, 0.f};
            if (jt <= wave) {
#pragma unroll
                for (int kk = 0; kk < 4; ++kk) sacc[jt] = __builtin_amdgcn_mfma_f32_16x16x32_f16(kf[q][kk], qf[kk], sacc[jt], 0, 0, 0);
#pragma unroll
                for (int j = 0; j < 4; ++j) { const int jl = 16 * jt + 4 * g + j; sacc[jt][j] = (il >= jl) ? sacc[jt][j] * __expf((float)(il - jl) * lg) : 0.f; }
            }
        }
        __builtin_amdgcn_sched_barrier(0);
    }
    f32x4 oacc[16];
    const h16* sp = p.SPT + ((size_t)((b * 8 + h) * 32 + c) * 256) * 128;
#pragma unroll
    for (int er = 0; er < 4; ++er) {
        h16x8 sf[4][4];
#pragma unroll
        for (int q = 0; q < 4; ++q) {
            const h16* sr = sp + (size_t)(16 * (4 * er + q) + r16) * 128 + g * 8;
#pragma unroll
            for (int kk = 0; kk < 4; ++kk) sf[q][kk] = *(const h16x8*)(sr + kk * 32);
        }
#pragma unroll
        for (int q = 0; q < 4; ++q) {
            const int et = 4 * er + q;
            oacc[et] = (f32x4){0.f, 0.f, 0.f, 0.f};
#pragma unroll
            for (int kk = 0; kk < 4; ++kk) oacc[et] = __builtin_amdgcn_mfma_f32_16x16x32_f16(sf[q][kk], qd[kk], oacc[et], 0, 0, 0);
        }
        __builtin_amdgcn_sched_barrier(0);
    }
    const unsigned rz0 = lds_u32(Vimg) + tr_addr16(lane, 0, 0), rz1 = lds_u32(Vimg) + tr_addr16(lane, 0, 1);
    static_for<0, 4>([&](auto BI) {
        constexpr int bI = decltype(BI)::value;
        if (2 * bI <= wave) {
            h16x8 pf;
            const f32x4 a0 = sacc[2 * bI], a1 = sacc[2 * bI + 1];
            pf[0] = (h16)a0.x; pf[1] = (h16)a0.y; pf[2] = (h16)a0.z; pf[3] = (h16)a0.w;
            pf[4] = (h16)a1.x; pf[5] = (h16)a1.y; pf[6] = (h16)a1.z; pf[7] = (h16)a1.w;
            static_for<0, 16>([&](auto ET) {
                constexpr int et = decltype(ET)::value;
                const h16x8 vf = tr_read8o<(bI * 2 + (et >> 3)) * 8192>(rz0 ^ (32u * (et & 7)), rz1 ^ (32u * (et & 7)));
                oacc[et] = __builtin_amdgcn_mfma_f32_16x16x32_f16(vf, pf, oacc[et], 0, 0, 0);
            });
        }
    });
    float s1 = 0.f;
#pragma unroll
    for (int et = 0; et < 16; ++et) s1 += oacc[et].x + oacc[et].y + oacc[et].z + oacc[et].w;
    s1 += __shfl_xor(s1, 16); s1 += __shfl_xor(s1, 32);
    const float mu = s1 * (1.f / 256.f);
    float s2 = 0.f;
#pragma unroll
    for (int et = 0; et < 16; ++et)
#pragma unroll
        for (int j = 0; j < 4; ++j) { const float d = oacc[et][j] - mu; s2 += d * d; }
    s2 += __shfl_xor(s2, 16); s2 += __shfl_xor(s2, 32);
    const float rs = rsqrtf(s2 * (1.f / 256.f) + EPS);
    const size_t tok = tok0 + il;
#pragma unroll
    for (int et = 0; et < 16; ++et) {
        const int e0 = h * 256 + 16 * et + 4 * g;
        const f32x4 gw = *(const f32x4*)(p.ret_gn_w + e0);
        const f32x2 rgraw = *(const f32x2*)(p.RG + tok * 2048 + e0);
        const float rgx = rgraw.x, rgy = rgraw.y;
        const h16x2 r0 = __builtin_bit_cast(h16x2, rgx), r1 = __builtin_bit_cast(h16x2, rgy);
        const float o0 = (oacc[et].x - mu) * rs * gw.x * (float)r0.x, o1 = (oacc[et].y - mu) * rs * gw.y * (float)r0.y;
        const float o2 = (oacc[et].z - mu) * rs * gw.z * (float)r1.x, o3 = (oacc[et].w - mu) * rs * gw.w * (float)r1.y;
        f32x2 o; o.x = __uint_as_float(pkh(o0, o1)); o.y = __uint_as_float(pkh(o2, o3));
        *(f32x2*)(p.RN + tok * 2048 + e0) = o;
    }
    __syncthreads();
}

__device__ __forceinline__ void sample_ret_item(const Params& p, int t, int h, char* smem) {
    const int tid = otid(), dv = tid & 255, half = tid >> 8;
    float* qs = (float*)smem;
    float* ks = qs + 128;
    float* part = ks + 128;
    float* red = part + 512;
    __syncthreads();
    if (tid < 128) { qs[tid] = p.SRQ[t * 1024 + h * 128 + tid]; ks[tid] = p.SRK[t * 1024 + h * 128 + tid]; }
    __syncthreads();
    const float gm = 1.f - exp2f(-5.f - (float)h);
    float qk = 0.f;
#pragma unroll 4
    for (int i = 0; i < 128; ++i) qk += qs[i] * ks[i];
    const float v = p.SRV[t * 2048 + h * 256 + dv];
    const float* Sin = p.state_ret + ((size_t)(t * 8 + h) * 128) * 256;
    float* Sout = p.out + O_SS + ((size_t)(t * 8 + h) * 128) * 256;
    float cross = 0.f;
#pragma unroll 8
    for (int i = 0; i < 64; ++i) {
        const int dk = half * 64 + i;
        const float s = Sin[(size_t)dk * 256 + dv];
        cross += qs[dk] * s;
        Sout[(size_t)dk * 256 + dv] = gm * s + ks[dk] * v;
    }
    part[half * 256 + dv] = cross;
    __syncthreads();
    float o = 0.f;
    if (tid < 256) o = qk * v + gm * (part[dv] + part[256 + dv]);
    float s1 = (tid < 256) ? o : 0.f;
    s1 = wave_sum(s1);
    if ((tid & 63) == 0) red[tid >> 6] = s1;
    __syncthreads();
    const float mu = (red[0] + red[1] + red[2] + red[3]) * (1.f / 256.f);
    float d = (tid < 256) ? (o - mu) : 0.f;
    float s2 = wave_sum(d * d);
    if ((tid & 63) == 0) red[8 + (tid >> 6)] = s2;
    __syncthreads();
    const float rs = rsqrtf((red[8] + red[9] + red[10] + red[11]) * (1.f / 256.f) + EPS);
    if (tid < 256) p.SRN[t * 2048 + h * 256 + dv] = d * rs * p.ret_gn_w[h * 256 + dv] * p.SRG[t * 2048 + h * 256 + dv];
    __syncthreads();
}

__device__ __forceinline__ void sample_attn_item(const Params& p, int t, int n, char* smem) {
    const int tid = otid(), lane = tid & 63, wave = tid >> 6;
    float* qs = (float*)smem;
    int* rowk = (int*)(smem + 2048);
    float* lg = (float*)(smem + 3072);
    float* part = (float*)(smem + 7168);
    float* sums = (float*)(smem + 23552);
    __syncthreads();
    qs[tid] = p.SAQ[t * 2048 + n * 512 + tid];
    if (tid < 256) { const int idx = p.STOP[t * 256 + tid]; rowk[tid] = (idx < PAST) ? p.page_table[t * NPAGES + (idx >> 7)] * PAGE + (idx & 127) : -1; }
    __syncthreads();
    {
        const int key = wave * 32 + (lane >> 1), dh = lane & 1, row = rowk[key];
        const float* kp = (row >= 0) ? p.cache_k + ((size_t)row * 4 + n) * 128 + dh * 64 : p.SAK + t * 512 + n * 128 + dh * 64;
        f32x4 kv[16];
#pragma unroll
        for (int i = 0; i < 16; ++i) kv[i] = *(const f32x4*)(kp + 4 * i);
#pragma unroll
        for (int h = 0; h < 4; ++h) {
            float d = 0.f;
#pragma unroll
            for (int i = 0; i < 16; ++i) { const f32x4 q = *(const f32x4*)(qs + h * 128 + dh * 64 + 4 * i); d += kv[i].x * q.x + kv[i].y * q.y + kv[i].z * q.z + kv[i].w * q.w; }
            d += __shfl_xor(d, 1);
            if (dh == 0) lg[h * 256 + key] = d;
        }
    }
    __syncthreads();
    if (wave < 4) {
        float v[4];
#pragma unroll
        for (int i = 0; i < 4; ++i) v[i] = lg[wave * 256 + lane + 64 * i];
        const float mx = wave_max(fmaxf(fmaxf(v[0], v[1]), fmaxf(v[2], v[3])));
        float s = 0.f;
#pragma unroll
        for (int i = 0; i < 4; ++i) { v[i] = __expf(v[i] - mx); s += v[i]; lg[wave * 256 + lane + 64 * i] = v[i]; }
        s = wave_sum(s);
        if (lane == 0) sums[wave] = s;
    }
    __syncthreads();
    {
        const int sub = lane >> 4, dc = lane & 15;
        float acc[4][8];
#pragma unroll
        for (int h = 0; h < 4; ++h)
#pragma unroll
            for (int e = 0; e < 8; ++e) acc[h][e] = 0.f;
        f32x4 va[8], vb[8];
#pragma unroll
        for (int j = 0; j < 8; ++j) {
            const int row = rowk[wave * 32 + sub * 8 + j];
            const float* vp = (row >= 0) ? p.cache_v + ((size_t)row * 4 + n) * 128 + dc * 8 : p.SAV + t * 512 + n * 128 + dc * 8;
            va[j] = *(const f32x4*)vp; vb[j] = *(const f32x4*)(vp + 4);
        }
#pragma unroll
        for (int j = 0; j < 8; ++j) {
            const int key = wave * 32 + sub * 8 + j;
#pragma unroll
            for (int h = 0; h < 4; ++h) {
                const float pk = lg[h * 256 + key];
                acc[h][0] += pk * va[j].x; acc[h][1] += pk * va[j].y; acc[h][2] += pk * va[j].z; acc[h][3] += pk * va[j].w;
                acc[h][4] += pk * vb[j].x; acc[h][5] += pk * vb[j].y; acc[h][6] += pk * vb[j].z; acc[h][7] += pk * vb[j].w;
            }
        }
#pragma unroll
        for (int h = 0; h < 4; ++h)
#pragma unroll
            for (int e = 0; e < 8; ++e) { float v = acc[h][e]; v += __shfl_xor(v, 16); v += __shfl_xor(v, 32); if (sub == 0) part[(wave * 4 + h) * 128 + dc * 8 + e] = v; }
    }
    __syncthreads();
    {
        const int h = tid >> 7, d = tid & 127;
        float o = 0.f;
#pragma unroll
        for (int w = 0; w < 8; ++w) o += part[(w * 4 + h) * 128 + d];
        p.SATT[t * 2048 + (n * 4 + h) * 128 + d] = o / sums[h];
    }
    __syncthreads();
}

__device__ __forceinline__ void phase4(const Params& p, char* smem) {
    const int c = blockIdx.x, G = gridDim.x;
    for (int it = G - 1 - c; it < 96; it += G) {
        if (it < 32) sample_attn_item(p, it >> 2, it & 3, smem);
        else sample_ret_item(p, (it - 32) >> 3, (it - 32) & 7, smem);
    }
    for (int it = c; it < 512; it += G) retout_item(p, it >> 8, (it >> 5) & 7, it & 31, smem);
}

__device__ __forceinline__ void phase5(const Params& p, char* smem) {
    const int tid = otid();
    for (int i = 0;; ++i) {
        int pm, pn; if (!unit_next(i, TP / 256, D / 256, pm, pn)) break;
        f32x4 acc[2][2][4][2] = {};
        gemm_core(p.RN, p.WrT, pm * 256, pn * 256, D, acc, (h16*)smem);
        {
            const int tz = otid(), wid = tz >> 6, lane = tz & 63, wr = wid >> 2, wc = wid & 3, fr = lane & 15, fq = lane >> 4;
            h16* R16 = (h16*)smem;
            __syncthreads();
#pragma unroll 4
            for (int i = 0; i < 16; ++i) {
                const int q = tz + 512 * i, row = q >> 5, ch = q & 31;
                const size_t off = (size_t)(pm * 256 + row) * D + pn * 256 + ch * 8;
                float gr[8], ga[8];
                unpk8(*(const u32x4*)(p.GR + off), gr); unpk8(*(const u32x4*)(p.GA + off), ga);
#pragma unroll
                for (int e = 0; e < 8; ++e) gr[e] *= __builtin_amdgcn_rcpf(fmaxf(ga[e], 1e-4f));
                *(u32x4*)(R16 + row * ES16 + ch * 8) = pk8(gr);
            }
            __syncthreads();
#pragma unroll
            for (int ai = 0; ai < 2; ++ai)
#pragma unroll
                for (int bj = 0; bj < 2; ++bj)
#pragma unroll
                    for (int m = 0; m < 4; ++m)
#pragma unroll
                        for (int n = 0; n < 2; ++n) {
                            const f32x2 rr = *(const f32x2*)(R16 + (ai * 128 + wr * 64 + m * 16 + fr) * ES16 + bj * 128 + wc * 32 + n * 16 + fq * 4);
                            const float rx = rr.x, ry = rr.y;
                            const h16x2 r0 = __builtin_bit_cast(h16x2, rx), r1 = __builtin_bit_cast(h16x2, ry);
                            acc[ai][bj][m][n].x *= (float)r0.x; acc[ai][bj][m][n].y *= (float)r0.y; acc[ai][bj][m][n].z *= (float)r1.x; acc[ai][bj][m][n].w *= (float)r1.y;
                        }
        }
        __syncthreads();
        gemm_core(p.ATT, p.WaT, pm * 256, pn * 256, D, acc, (h16*)smem);
        epilogue_full(acc, smem, [&](int ai, int bj, int r, int part, float* x1, float* x2) {
            const size_t rowoff = (size_t)(pm * 256 + ai * 128 + r) * D + pn * 256 + bj * 128;
            const h16* gp = p.GA + rowoff;
            float g1[16], g2[16];
            unpk8(*(const u32x4*)(gp + 16 * part), g1); unpk8(*(const u32x4*)(gp + 16 * part + 8), g1 + 8);
            unpk8(*(const u32x4*)(gp + 64 + 16 * part), g2); unpk8(*(const u32x4*)(gp + 64 + 16 * part + 8), g2 + 8);
#pragma unroll
            for (int e = 0; e < 16; ++e) { x1[e] *= fmaxf(g1[e], 1e-4f); x2[e] *= fmaxf(g2[e], 1e-4f); }
            store_h16_32(p.MIX + rowoff, part, x1, x2);
        });
    }
    for (int it = blockIdx.x; it < 256; it += gridDim.x) {
        float* SMIX = p.SMIX; const float* SGR = p.SGR; const float* SGA = p.SGA;
        gemv8_item<8>(p.SRN, p.w_ret_o, D, it * 8, smem, [=](int t, int n, float v) { SMIX[t * D + n] = SGR[t * D + n] * v; });
        gemv8_item<8>(p.SATT, p.w_att_o, D, it * 8, smem, [=](int t, int n, float v) { SMIX[t * D + n] += SGA[t * D + n] * v; });
    }
}

__device__ __forceinline__ void phase6(const Params& p, char* smem) {
    const int tid = otid();
    for (int i = 0;; ++i) {
        int pm, pn; if (!unit_next(i, TP / 256, D / 256, pm, pn)) break;
        f32x4 acc[2][2][4][2] = {};
#ifdef GEMM_TWICE
        gemm_core(p.MIX, p.WoT, pm * 256, pn * 256, D, acc, (h16*)smem);
        __syncthreads();
        for (int a = 0; a < 2; ++a) for (int b = 0; b < 2; ++b) for (int m = 0; m < 4; ++m) for (int n = 0; n < 2; ++n) acc[a][b][m][n] = acc[a][b][m][n] * 0.0f;
#endif
        gemm_core(p.MIX, p.WoT, pm * 256, pn * 256, D, acc, (h16*)smem);
        epilogue_full(acc, smem, [&](int ai, int bj, int r, int part, float* x1, float* x2) {
            const size_t rowoff = (size_t)(pm * 256 + ai * 128 + r) * D + pn * 256 + bj * 128;
            const float* xp = p.x_prompt + rowoff;
#pragma unroll
            for (int q = 0; q < 4; ++q) {
                const f32x4 a = *(const f32x4*)(xp + 16 * part + 4 * q), bq = *(const f32x4*)(xp + 64 + 16 * part + 4 * q);
                x1[4 * q] += a.x; x1[4 * q + 1] += a.y; x1[4 * q + 2] += a.z; x1[4 * q + 3] += a.w;
                x2[4 * q] += bq.x; x2[4 * q + 1] += bq.y; x2[4 * q + 2] += bq.z; x2[4 * q + 3] += bq.w;
            }
            store_h16_32(p.HN + rowoff, part, x1, x2);
            float ss = 0.f;
#pragma unroll
            for (int e = 0; e < 16; ++e) ss += x1[e] * x1[e] + x2[e] * x2[e];
            ss = quad_sum(ss);
            if (part == 0) atomicAdd(p.ROWSS + pm * 256 + ai * 128 + r, ss);
        });
    }
    for (int it = blockIdx.x; it < 256; it += gridDim.x) {
        float* out = p.out; const float* xs = p.x_sample;
        gemv8_item<8>(p.SMIX, p.w_out, D, it * 8, smem, [=](int t, int n, float v) { out[O_YS + t * D + n] = xs[t * D + n] + v; });
    }
}

__device__ __forceinline__ void phase7(const Params& p) {
    const int t0 = otid(), lane = t0 & 63, gw = blockIdx.x * 8 + (t0 >> 6), NGW = gridDim.x * 8;
    for (int r = gw; r < TT; r += NGW) {
        const float* x = (r < TP) ? p.out + O_YP + (size_t)r * D : p.out + O_YS + (size_t)(r - TP) * D;
        f32x4 v[8]; float ss = 0.f;
#pragma unroll
        for (int j = 0; j < 8; ++j) { v[j] = *(const f32x4*)(x + 4 * (lane + 64 * j)); ss += v[j].x * v[j].x + v[j].y * v[j].y + v[j].z * v[j].z + v[j].w * v[j].w; }
        ss = wave_sum(ss);
        const float rs = rsqrtf(ss * (1.f / D) + EPS);
#pragma unroll
        for (int j = 0; j < 8; ++j) {
            const f32x4 w = *(const f32x4*)(p.norm2_w + 4 * (lane + 64 * j));
            const float a = v[j].x * rs * w.x, b = v[j].y * rs * w.y, c = v[j].z * rs * w.z, d = v[j].w * rs * w.w;
            if (r < TP) { f32x2 o; o.x = __uint_as_float(pkh(a, b)); o.y = __uint_as_float(pkh(c, d)); *(f32x2*)(p.HN + (size_t)r * D + 4 * (lane + 64 * j)) = o; }
            else { f32x4 o = {a, b, c, d}; *(f32x4*)(p.SHN + (size_t)(r - TP) * D + 4 * (lane + 64 * j)) = o; }
        }
    }
}

constexpr int PCV_ITER = 4;
constexpr int PCV_UCH = (int)(((size_t)NEXP * D / 32) / (512 * PCV_ITER));
constexpr int PCV_VCH = PCV_UCH;
constexpr int PCV_CHUNKS = PCV_UCH + PCV_VCH;
__device__ __forceinline__ void peer_convert_chunk(const Params& p, int chunk) {
    const int tid = otid();
    const bool isu = chunk < PCV_UCH;
    const size_t base = (size_t)(isu ? chunk : chunk - PCV_UCH) * (512 * PCV_ITER) + tid;
    const float* tab = isu ? p.peer_u : p.peer_v;
    unsigned char* outp = (unsigned char*)(isu ? p.PU : p.PV);
    const float sc = isu ? 64.f : 16.f;
#pragma unroll 2
    for (int r = 0; r < PCV_ITER; ++r) {
        const float* src = tab + (base + (size_t)r * 512) * 32;
        f32x4 a[8];
#pragma unroll
        for (int q = 0; q < 8; ++q) a[q] = *(const f32x4*)(src + 4 * q);
        if (isu) {
            const float* wk = p.norm2_w + (int)(((base + (size_t)r * 512) & 63) * 32);
#pragma unroll
            for (int q = 0; q < 8; ++q) { const f32x4 w4 = *(const f32x4*)(wk + 4 * q); a[q].x *= w4.x; a[q].y *= w4.y; a[q].z *= w4.z; a[q].w *= w4.w; }
        }
        u32x4 o;
#pragma unroll
        for (int q = 0; q < 4; ++q) {
            unsigned w = 0u;
            w = __builtin_amdgcn_cvt_scalef32_pk_fp4_f32(w, a[2 * q].x * sc, a[2 * q].y * sc, 1.0f, 0);
            w = __builtin_amdgcn_cvt_scalef32_pk_fp4_f32(w, a[2 * q].z * sc, a[2 * q].w * sc, 1.0f, 1);
            w = __builtin_amdgcn_cvt_scalef32_pk_fp4_f32(w, a[2 * q + 1].x * sc, a[2 * q + 1].y * sc, 1.0f, 2);
            w = __builtin_amdgcn_cvt_scalef32_pk_fp4_f32(w, a[2 * q + 1].z * sc, a[2 * q + 1].w * sc, 1.0f, 3);
            o[q] = w;
        }
        *(u32x4*)(outp + (base + (size_t)r * 512) * 16) = o;
    }
}
__device__ __forceinline__ void peer_convert_pull(const Params& p, char* smem, int rep) {
    volatile int* s_next = (volatile int*)(smem + LDS_BYTES - 64);
    for (;;) {
        __syncthreads();
        if (threadIdx.x == 0) s_next[0] = (int)atomicAdd(&p.ctl[6144 + 64 * rep], 1u);
        __syncthreads();
        const int ch = s_next[0];
        if (ch >= PCV_CHUNKS) break;
        peer_convert_chunk(p, ch);
    }
}

__device__ __forceinline__ void phase8(const Params& p, char* smem, int rep) {
    const int tid = otid();
    for (int i = 0;; ++i) {
        int pm, pn; if (!unit_next(i, TP / 256, 1024 / 256, pm, pn)) break;
        f32x4 acc[2][2][4][2] = {};
        gemm_core(p.HN, p.WqT, pm * 256, pn * 256, D, acc, (h16*)smem);
        epilogue_full(acc, smem, [&](int ai, int bj, int r, int part, float* x1, float* x2) {
            const float rs = rsqrtf(p.ROWSS[pm * 256 + ai * 128 + r] * (1.f / D) + EPS);
#pragma unroll
            for (int e = 0; e < 16; ++e) { x1[e] *= rs; x2[e] *= rs; }
            store_h16_32((h16*)p.PQ + (size_t)(pm * 256 + ai * 128 + r) * 1024 + pn * 256 + bj * 128, part, x1, x2);
        });
    }
    {
        const int G = gridDim.x, first = (G > 144) ? 128 : 0;
        if ((int)blockIdx.x >= first)
            for (int it = blockIdx.x - first; it < 128; it += G - first) {
                float* SPQ = p.SPQ;
                gemv8_item<8>(p.out + O_YS, p.peer_wq, 1024, it * 8, smem, [=](int t, int n, float v) { SPQ[t * 1024 + n] = v; }, p.norm2_w, it == 0 ? p.SHN : nullptr);
            }
    }
    peer_convert_pull(p, smem, rep);
}

template <int NV, class EMIT>
__device__ __forceinline__ void wave_select(const unsigned (&u)[NV], int K, int lane, EMIT emit) {
    unsigned tau; int need_eq;
    if constexpr (NV < 8) wave_kth_r4<NV>(u, K, tau, need_eq); else wave_kth<NV>(u, K, tau, need_eq);
    const u64 lt = (1ull << lane) - 1ull;
    int base = 0, eqt = 0;
    unsigned tau2 = tau; asm volatile("" : "+v"(tau2));
#pragma unroll
    for (int i = 0; i < NV; ++i) {
        const bool gt = u[i] > tau2, eq = u[i] == tau2;
        const u64 meq = __ballot(eq);
        const bool sel = gt || (eq && (eqt + __popcll(meq & lt)) < need_eq);
        const u64 ms = __ballot(sel);
        if (sel) emit(i, base + __popcll(ms & lt));
        base += __popcll(ms); eqt += __popcll(meq);
    }
}

template <bool SAMPLE>
__device__ __forceinline__ void load_row8(const void* base, size_t row, int chunk, float* v) {
    if (SAMPLE) {
        const float* r = (const float*)base + row * D + chunk * 8;
        const f32x4 a = *(const f32x4*)r, b = *(const f32x4*)(r + 4);
        v[0] = a.x; v[1] = a.y; v[2] = a.z; v[3] = a.w; v[4] = b.x; v[5] = b.y; v[6] = b.z; v[7] = b.w;
    } else {
        unpk8(*(const u32x4*)((const h16*)base + row * D + chunk * 8), v);
    }
}

template <bool SAMPLE>
__device__ __forceinline__ void peer_item(const Params& p, int tk, char* smem) {
    const int tid = otid(), lane = tid & 63, h = tid >> 6;
    float* qsh = (float*)smem;
    int* route_e = (int*)(smem + 4096);
    float* route_g = (float*)(smem + 4608);
    float* l1v = (float*)(smem + 5120);
    int* l1i = (int*)(smem + 5632);
    float* l2v = (float*)(smem + 6144);
    int* l2i = (int*)(smem + 6656);
    float* parts = (float*)(smem + 8192);
    const int ts = tk - TP;
    __syncthreads();
    { const float* q = SAMPLE ? p.SPQ + (size_t)ts * 1024 : p.PQ + (size_t)tk * 1024; qsh[tid] = q[tid]; qsh[tid + 512] = q[tid + 512]; }
    __syncthreads();
    {
        float s1[2], s2[2];
#pragma unroll
        for (int i = 0; i < 2; ++i) {
            const int key = lane + 64 * i;
            float a = 0.f, b = 0.f;
            if constexpr (SAMPLE) {
                const float* k1 = p.peer_k1 + ((size_t)(h * 128 + key)) * 64;
                const float* k2 = p.peer_k2 + ((size_t)(h * 128 + key)) * 64;
#pragma unroll 4
                for (int c4 = 0; c4 < 16; ++c4) {
                    const f32x4 x = *(const f32x4*)(k1 + 4 * c4), y = *(const f32x4*)(k2 + 4 * c4);
                    const f32x4 q1 = *(const f32x4*)(qsh + h * 128 + 4 * c4), q2 = *(const f32x4*)(qsh + h * 128 + 64 + 4 * c4);
                    a += x.x * q1.x + x.y * q1.y + x.z * q1.z + x.w * q1.w;
                    b += y.x * q2.x + y.y * q2.y + y.z * q2.z + y.w * q2.w;
                }
            } else {
                const h16* k1 = p.K1H + ((size_t)(h * 128 + key)) * 64;
                const h16* k2 = p.K2H + ((size_t)(h * 128 + key)) * 64;
#pragma unroll 2
                for (int c8 = 0; c8 < 8; ++c8) {
                    float x[8], y[8]; unpk8(*(const u32x4*)(k1 + 8 * c8), x); unpk8(*(const u32x4*)(k2 + 8 * c8), y);
                    const f32x4 q1a = *(const f32x4*)(qsh + h * 128 + 8 * c8), q1b = *(const f32x4*)(qsh + h * 128 + 8 * c8 + 4);
                    const f32x4 q2a = *(const f32x4*)(qsh + h * 128 + 64 + 8 * c8), q2b = *(const f32x4*)(qsh + h * 128 + 64 + 8 * c8 + 4);
                    a += x[0] * q1a.x + x[1] * q1a.y + x[2] * q1a.z + x[3] * q1a.w + x[4] * q1b.x + x[5] * q1b.y + x[6] * q1b.z + x[7] * q1b.w;
                    b += y[0] * q2a.x + y[1] * q2a.y + y[2] * q2a.z + y[3] * q2a.w + y[4] * q2b.x + y[5] * q2b.y + y[6] * q2b.z + y[7] * q2b.w;
                }
            }
            s1[i] = a; s2[i] = b;
        }
        unsigned u[2];
        u[0] = f2ord(s1[0]); u[1] = f2ord(s1[1]);
        wave_select<2>(u, 16, lane, [&](int i, int pos) { l1v[h * 16 + pos] = s1[i]; l1i[h * 16 + pos] = lane + 64 * i; });
        u[0] = f2ord(s2[0]); u[1] = f2ord(s2[1]);
        wave_select<2>(u, 16, lane, [&](int i, int pos) { l2v[h * 16 + pos] = s2[i]; l2i[h * 16 + pos] = lane + 64 * i; });
        asm volatile("s_waitcnt lgkmcnt(0)" ::: "memory");
        float cv[4]; unsigned cu[4];
        const int a = lane >> 2;
#pragma unroll
        for (int i = 0; i < 4; ++i) { cv[i] = l1v[h * 16 + a] + l2v[h * 16 + (lane & 3) * 4 + i]; cu[i] = f2ord(cv[i]); }
        wave_select<4>(cu, 16, lane, [&](int i, int pos) { route_g[h * 16 + pos] = cv[i]; route_e[h * 16 + pos] = l1i[h * 16 + a] * 128 + l2i[h * 16 + (lane & 3) * 4 + i]; });
        asm volatile("s_waitcnt lgkmcnt(0)" ::: "memory");
        float sc = (lane < 16) ? route_g[h * 16 + lane] : -3.0e38f;
        const float mx = wave_max(sc);
        const float ex = (lane < 16) ? __expf(sc - mx) : 0.f;
        const float sm = wave_sum(ex);
        asm volatile("s_waitcnt lgkmcnt(0)" ::: "memory");
        if (lane < 16) route_g[h * 16 + lane] = ex / sm;
        asm volatile("s_waitcnt lgkmcnt(0)" ::: "memory");
    }
    {
        const void* hnb = SAMPLE ? (const void*)p.SHN : (const void*)p.HN;
        const void* ub = SAMPLE ? (const void*)p.peer_u : (const void*)p.PU;
        const void* vb = SAMPLE ? (const void*)p.peer_v : (const void*)p.PV;
        const size_t hrow = SAMPLE ? (size_t)ts : (size_t)tk;
        float hv[SAMPLE ? 32 : 1], facc[32];
        u32x4 hp[SAMPLE ? 1 : 4];
        if constexpr (SAMPLE) {
#pragma unroll
            for (int jj = 0; jj < 2; ++jj) { load_row8<true>(hnb, hrow, 2 * (lane + 64 * jj), hv + 16 * jj); load_row8<true>(hnb, hrow, 2 * (lane + 64 * jj) + 1, hv + 16 * jj + 8); }
        } else {
#pragma unroll
            for (int jj = 0; jj < 2; ++jj) { hp[2 * jj] = *(const u32x4*)((const h16*)hnb + hrow * D + (lane + 64 * jj) * 16); hp[2 * jj + 1] = *(const u32x4*)((const h16*)hnb + hrow * D + (lane + 64 * jj) * 16 + 8); }
        }
#pragma unroll
        for (int i = 0; i < 32; ++i) facc[i] = 0.f;
        if constexpr (SAMPLE) {
#pragma unroll 1
            for (int k = 0; k < 16; ++k) {
                const size_t e = (size_t)route_e[h * 16 + k];
                const float* up = (const float*)ub + e * D; const float* vp = (const float*)vb + e * D;
                f32x4 ur[8], vr[8];
#pragma unroll
                for (int jj = 0; jj < 2; ++jj)
#pragma unroll
                    for (int q = 0; q < 4; ++q) { ur[4 * jj + q] = *(const f32x4*)(up + (lane + 64 * jj) * 16 + 4 * q); vr[4 * jj + q] = *(const f32x4*)(vp + (lane + 64 * jj) * 16 + 4 * q); }
                float d = 0.f;
#pragma unroll
                for (int i = 0; i < 8; ++i) d += hv[4 * i] * ur[i].x + hv[4 * i + 1] * ur[i].y + hv[4 * i + 2] * ur[i].z + hv[4 * i + 3] * ur[i].w;
                d = wave_sum(d);
                const float cw = route_g[h * 16 + k] * gelu_exact(d);
#pragma unroll
                for (int i = 0; i < 8; ++i) { facc[4 * i] += cw * vr[i].x; facc[4 * i + 1] += cw * vr[i].y; facc[4 * i + 2] += cw * vr[i].z; facc[4 * i + 3] += cw * vr[i].w; }
            }
        } else {
            const unsigned char* u8 = (const unsigned char*)ub; const unsigned char* v8 = (const unsigned char*)vb;
#pragma unroll 1
            for (int k = 0; k < 16; k += 8) {
                u32x4 ur[8][2], vr[8][2];
#pragma unroll
                for (int x = 0; x < 8; ++x) {
                    const size_t e = (size_t)route_e[h * 16 + k + x];
#pragma unroll
                    for (int jj = 0; jj < 2; ++jj) { ur[x][jj] = *(const u32x4*)(u8 + e * D + (lane + 64 * jj) * 16); vr[x][jj] = *(const u32x4*)(v8 + e * D + (lane + 64 * jj) * 16); }
                }
#pragma unroll
                for (int x = 0; x < 8; ++x) {
                    float d = 0.f;
#pragma unroll
                    for (int jj = 0; jj < 2; ++jj)
#pragma unroll
                        for (int q = 0; q < 4; ++q) {
                            const int w = (int)ur[x][jj][q];
                            const f32x2 lo = __builtin_amdgcn_cvt_pk_f32_fp8(w, false), hi = __builtin_amdgcn_cvt_pk_f32_fp8(w, true);
                            const unsigned h0 = hp[2 * jj + (q >> 1)][2 * (q & 1)], h1 = hp[2 * jj + (q >> 1)][2 * (q & 1) + 1];
                            const h16x2 p0 = __builtin_bit_cast(h16x2, h0), p1 = __builtin_bit_cast(h16x2, h1);
                            d += (float)p0.x * lo.x + (float)p0.y * lo.y + (float)p1.x * hi.x + (float)p1.y * hi.y;
                        }
                    d = wave_sum(d) * (1.f / 64.f);
                    const float cw = route_g[h * 16 + k + x] * gelu_exact(d) * (1.f / 16.f);
#pragma unroll
                    for (int jj = 0; jj < 2; ++jj)
#pragma unroll
                        for (int q = 0; q < 4; ++q) {
                            const int w = (int)vr[x][jj][q];
                            const f32x2 lo = __builtin_amdgcn_cvt_pk_f32_fp8(w, false), hi = __builtin_amdgcn_cvt_pk_f32_fp8(w, true);
                            facc[16 * jj + 4 * q] += cw * lo.x; facc[16 * jj + 4 * q + 1] += cw * lo.y; facc[16 * jj + 4 * q + 2] += cw * hi.x; facc[16 * jj + 4 * q + 3] += cw * hi.y;
                        }
                }
            }
        }
#pragma unroll
        for (int jj = 0; jj < 2; ++jj) {
            float* dst = parts + h * 2048 + (lane + 64 * jj) * 16;
#pragma unroll
            for (int q = 0; q < 4; ++q) { f32x4 a = {facc[16 * jj + 4 * q], facc[16 * jj + 4 * q + 1], facc[16 * jj + 4 * q + 2], facc[16 * jj + 4 * q + 3]}; *(f32x4*)(dst + 4 * q) = a; }
        }
    }
    __syncthreads();
    {
        f32x4 f = {0.f, 0.f, 0.f, 0.f};
#pragma unroll
        for (int w = 0; w < 8; ++w) { const f32x4 a = *(const f32x4*)(parts + w * 2048 + tid * 4); f.x += a.x; f.y += a.y; f.z += a.z; f.w += a.w; }
        float* y = SAMPLE ? p.out + O_YS + (size_t)ts * D + tid * 4 : p.out + O_YP + (size_t)tk * D + tid * 4;
        f32x4 hh = *(const f32x4*)y;
        hh.x += f.x; hh.y += f.y; hh.z += f.z; hh.w += f.w;
        *(f32x4*)y = hh;
    }
}

static __device__ const unsigned char PAIR_LUT[64] = {0,1,2,3,4,5,6,7,8,9,10,11,12,13,14,15,16,17,18,19,20,21,22,23,32,33,34,35,36,48,49,50,51,64,65,66,80,81,96,97,112,113,128,144,160,176,192,208,224,240,0,0,0,0,0,0,0,0,0,0,0,0,0,0};
template <int J>
__device__ __forceinline__ unsigned bt_fetch(unsigned v) {
    if constexpr (J == 1) return (unsigned)__builtin_amdgcn_update_dpp(0, (int)v, 0xB1, 0xF, 0xF, true);
    else if constexpr (J == 2) return (unsigned)__builtin_amdgcn_update_dpp(0, (int)v, 0x4E, 0xF, 0xF, true);
    else if constexpr (J == 8) return (unsigned)__builtin_amdgcn_update_dpp(0, (int)v, 0x128, 0xF, 0xF, true);
    else if constexpr (J == 4) return (unsigned)__builtin_amdgcn_ds_swizzle((int)v, 0x101F);
    else if constexpr (J == 16) return (unsigned)__builtin_amdgcn_ds_swizzle((int)v, 0x401F);
    else return (unsigned)__shfl_xor((int)v, 32);
}
template <int J, u64 M>
__device__ __forceinline__ unsigned bt_cmpx(unsigned x) {
    const unsigned q = bt_fetch<J>(x);
    const unsigned mn = x < q ? x : q, mx = x < q ? q : x;
    unsigned r;
    asm("v_cndmask_b32 %0, %1, %2, %3" : "=v"(r) : "v"(mn), "v"(mx), "s"(M));
    return r;
}
__device__ __forceinline__ void bitonic_top16_x2(unsigned& a0, unsigned& a1, unsigned& b0, unsigned& b1) {
#define BT4(J, M0, M1) a0 = bt_cmpx<J, M0>(a0); b0 = bt_cmpx<J, M0>(b0); a1 = bt_cmpx<J, M1>(a1); b1 = bt_cmpx<J, M1>(b1);
#define BT2(J, M0) a0 = bt_cmpx<J, M0>(a0); b0 = bt_cmpx<J, M0>(b0);
    BT4(1, 0x9999999999999999ull, 0x9999999999999999ull)
    BT4(2, 0xc3c3c3c3c3c3c3c3ull, 0xc3c3c3c3c3c3c3c3ull)
    BT4(1, 0xa5a5a5a5a5a5a5a5ull, 0xa5a5a5a5a5a5a5a5ull)
    BT4(4, 0xf00ff00ff00ff00full, 0xf00ff00ff00ff00full)
    BT4(2, 0xcc33cc33cc33cc33ull, 0xcc33cc33cc33cc33ull)
    BT4(1, 0xaa55aa55aa55aa55ull, 0xaa55aa55aa55aa55ull)
    BT4(8, 0xff0000ffff0000ffull, 0x00ffff0000ffff00ull)
    BT4(4, 0xf0f00f0ff0f00f0full, 0x0f0ff0f00f0ff0f0ull)
    BT4(2, 0xcccc3333cccc3333ull, 0x3333cccc3333ccccull)
    BT4(1, 0xaaaa5555aaaa5555ull, 0x5555aaaa5555aaaaull)
    a0 = a0 > a1 ? a0 : a1; b0 = b0 > b1 ? b0 : b1;
    BT2(8, 0xff0000ffff0000ffull) BT2(4, 0xf0f00f0ff0f00f0full) BT2(2, 0xcccc3333cccc3333ull) BT2(1, 0xaaaa5555aaaa5555ull)
    { const unsigned qa = bt_fetch<16>(a0), qb = bt_fetch<16>(b0); a0 = a0 > qa ? a0 : qa; b0 = b0 > qb ? b0 : qb; }
    BT2(8, 0xff00ff0000ff00ffull) BT2(4, 0xf0f0f0f00f0f0f0full) BT2(2, 0xcccccccc33333333ull) BT2(1, 0xaaaaaaaa55555555ull)
    { const unsigned qa = bt_fetch<32>(a0), qb = bt_fetch<32>(b0); a0 = a0 > qa ? a0 : qa; b0 = b0 > qb ? b0 : qb; }
    BT2(8, 0x00ff00ff00ff00ffull) BT2(4, 0x0f0f0f0f0f0f0f0full) BT2(2, 0x3333333333333333ull) BT2(1, 0x5555555555555555ull)
#undef BT4
#undef BT2
}

__device__ __forceinline__ void peer_route_wg(const Params& p, char* smem) {
    const int tid = otid(), lane = tid & 63, wave = tid >> 6;
    const int c = blockIdx.x, G = gridDim.x, h = c & 7;
    constexpr int KS = 144;
    char* K1 = smem; char* K2 = smem + 128 * KS;
    float* qw = (float*)(smem + 2 * 128 * KS) + wave * 128;
    float* lst = (float*)(smem + 2 * 128 * KS + 8 * 512) + wave * 160;
    float* l1v = lst; int* l1i = (int*)(lst + 16); float* l2v = lst + 32; int* l2i = (int*)(lst + 48); float* scv = lst + 64; int* eid = (int*)(lst + 80);
    __syncthreads();
    for (int i = tid; i < 2 * 128 * 8; i += 512) {
        const int tbl = i >> 10, r = (i >> 3) & 127, ch = i & 7;
        const h16* src = (tbl ? p.K2H : p.K1H) + ((size_t)(h * 128 + r)) * 64 + ch * 8;
        *(u32x4*)((tbl ? K2 : K1) + r * KS + ch * 16) = *(const u32x4*)src;
    }
    __syncthreads();
    const int nblk = TP / 64;
    volatile int* s_next = (volatile int*)(smem + LDS_BYTES - 64);
    for (;;) {
        __syncthreads();
        if (threadIdx.x == 0) s_next[0] = (int)atomicAdd(&p.ctl[6400 + 64 * h], 1u);
        __syncthreads();
        const int tb = s_next[0];
        if (tb >= nblk) break;
        float* SW = (float*)(smem + 65536) + wave * 2048;
        {
            const int r16 = lane & 15, g = lane >> 4;
            const h16* qrow = (const h16*)p.PQ + (size_t)(64 * tb + wave * 8 + (r16 & 7)) * 1024 + h * 128 + g * 8;
            h16x8 qa[2][2];
#pragma unroll
            for (int tb2 = 0; tb2 < 2; ++tb2)
#pragma unroll
                for (int kk = 0; kk < 2; ++kk) qa[tb2][kk] = *(const h16x8*)(qrow + tb2 * 64 + kk * 32);
#pragma unroll
            for (int tb2 = 0; tb2 < 2; ++tb2) {
                const char* KT = tb2 ? K2 : K1;
#pragma unroll
                for (int nt = 0; nt < 8; ++nt) {
                    f32x4 a = {0.f, 0.f, 0.f, 0.f};
#pragma unroll
                    for (int kk = 0; kk < 2; ++kk) {
                        const h16x8 kb = *(const h16x8*)(KT + (16 * nt + r16) * KS + (kk * 4 + g) * 16);
                        a = __builtin_amdgcn_mfma_f32_16x16x32_f16(qa[tb2][kk], kb, a, 0, 0, 0);
                    }
                    if (g < 2) {
#pragma unroll
                        for (int j = 0; j < 4; ++j) SW[(tb2 * 8 + 4 * g + j) * 128 + 16 * nt + r16] = a[j];
                    }
                }
            }
            asm volatile("s_waitcnt lgkmcnt(0)" ::: "memory");
        }
        for (int j = 0; j < 8; ++j) {
            const int tk = 64 * tb + wave * 8 + j;
            const float* sw1 = SW + j * 128; const float* sw2 = SW + (8 + j) * 128;
            unsigned ka0 = (f2ord(sw1[lane]) & ~127u) | (unsigned)(127 - lane), ka1 = (f2ord(sw1[64 + lane]) & ~127u) | (unsigned)(63 - lane);
            unsigned kb0 = (f2ord(sw2[lane]) & ~127u) | (unsigned)(127 - lane), kb1 = (f2ord(sw2[64 + lane]) & ~127u) | (unsigned)(63 - lane);
            bitonic_top16_x2(ka0, ka1, kb0, kb1);
            {
                const bool second = (lane & 16) != 0;
                const unsigned key = second ? kb0 : ka0;
                const int idx = 127 - (int)(key & 127u);
                const float val = (second ? sw2 : sw1)[idx];
                float* sv = lst + 96 + (second ? 32 : 0); int* si = (int*)sv + 16;
                if (lane < 32) { sv[lane & 15] = val; si[lane & 15] = idx; }
            }
            asm volatile("s_waitcnt lgkmcnt(0)" ::: "memory");
            float cv1; int e1; unsigned cu1[1];
            {
                const int ab = PAIR_LUT[lane], a = ab >> 4, b = ab & 15;
                const float* s1v = lst + 96; const int* s1i = (const int*)(lst + 112); const float* s2v = lst + 128; const int* s2i = (const int*)(lst + 144);
                cv1 = s1v[a] + s2v[b]; e1 = s1i[a] * 128 + s2i[b];
                cu1[0] = (lane < 50) ? f2ord(cv1) : 0u;
            }
            asm volatile("s_waitcnt lgkmcnt(0)" ::: "memory");
            wave_select<1>(cu1, 16, lane, [&](int i, int pos) { scv[pos] = cv1; eid[pos] = e1; });
            asm volatile("s_waitcnt lgkmcnt(0)" ::: "memory");
            const float sc = (lane < 16) ? scv[lane] : -3.0e38f;
            const float mx = wave_max(sc);
            const float ex = (lane < 16) ? __expf(sc - mx) : 0.f;
            const float sm = wave_sum(ex);
            if (lane < 16) { int2 o; o.x = eid[lane]; o.y = __float_as_int(ex / sm); p.ROUTE[((size_t)tk * 8 + h) * 16 + lane] = o; }
            asm volatile("s_waitcnt lgkmcnt(0)" ::: "memory");
        }
    }
}

__device__ __forceinline__ void peer_gather_wave(const Params& p, int tk, char* smem) {
    const int lane = otid() & 63;
    const int2 r0 = p.ROUTE[(size_t)tk * 128 + lane], r1 = p.ROUTE[(size_t)tk * 128 + 64 + lane];
    f32x2 hv[16];
#pragma unroll
    for (int k = 0; k < 4; ++k) {
        float t8[8]; unpk8(*(const u32x4*)(p.HN + (size_t)tk * D + 32 * lane + 8 * k), t8);
#pragma unroll
        for (int e = 0; e < 4; ++e) hv[4 * k + e] = (f32x2){t8[2 * e], t8[2 * e + 1]};
    }
    f32x2 facc[16];
#pragma unroll
    for (int i = 0; i < 16; ++i) facc[i] = (f32x2){0.f, 0.f};
    const float rs64 = rsqrtf(p.ROWSS[tk] * (1.f / D) + EPS) * (1.f / 64.f);
    const unsigned char* u8 = (const unsigned char*)p.PU; const unsigned char* v8 = (const unsigned char*)p.PV;
    const int xl = ((lane >> 5) & 1) * 4 + ((lane >> 4) & 1) * 2 + ((lane >> 3) & 1);
    u32x4 uA[8], uB[8], vv[8];
#define PG_ISSUE_U(b, uu) { const int _es = ((b) < 8) ? r0.x : r1.x; \
    _Pragma("unroll") for (int x = 0; x < 8; ++x) { const size_t e = (size_t)(unsigned)__builtin_amdgcn_readlane(_es, 8 * ((b) & 7) + x); \
        uu[x] = *(const u32x4*)(u8 + e * (D / 2) + lane * 16); } }
#define PG_APPLY(b, uu) { const int _es = ((b) < 8) ? r0.x : r1.x; const int _gs = ((b) < 8) ? r0.y : r1.y; \
    _Pragma("unroll") for (int x = 0; x < 8; ++x) { const size_t e = (size_t)(unsigned)__builtin_amdgcn_readlane(_es, 8 * ((b) & 7) + x); \
        vv[x] = *(const u32x4*)(v8 + e * (D / 2) + lane * 16); } \
    const float gl = __int_as_float(__shfl(_gs, 8 * ((b) & 7) + xl)); \
    float d[8]; \
    _Pragma("unroll") for (int x = 0; x < 8; ++x) { f32x2 a2 = {0.f, 0.f}; \
        _Pragma("unroll") for (int q = 0; q < 4; ++q) { const unsigned w = uu[x][q]; \
            a2 += hv[4 * q] * __builtin_amdgcn_cvt_scalef32_pk_f32_fp4(w, 1.0f, 0); a2 += hv[4 * q + 1] * __builtin_amdgcn_cvt_scalef32_pk_f32_fp4(w, 1.0f, 1); \
            a2 += hv[4 * q + 2] * __builtin_amdgcn_cvt_scalef32_pk_f32_fp4(w, 1.0f, 2); a2 += hv[4 * q + 3] * __builtin_amdgcn_cvt_scalef32_pk_f32_fp4(w, 1.0f, 3); } \
        d[x] = a2.x + a2.y; } \
    float r4[4], r2[2], r1v; \
    { const bool hi = (lane & 32) != 0; \
      _Pragma("unroll") for (int k = 0; k < 4; ++k) { const float keep = hi ? d[k + 4] : d[k], send = hi ? d[k] : d[k + 4]; r4[k] = keep + __shfl_xor(send, 32); } } \
    { const bool hi = (lane & 16) != 0; \
      _Pragma("unroll") for (int k = 0; k < 2; ++k) { const float keep = hi ? r4[k + 2] : r4[k], send = hi ? r4[k] : r4[k + 2]; r2[k] = keep + __shfl_xor(send, 16); } } \
    { const bool hi = (lane & 8) != 0; const float keep = hi ? r2[1] : r2[0], send = hi ? r2[0] : r2[1]; r1v = keep + __shfl_xor(send, 8); } \
    r1v += __shfl_xor(r1v, 4); r1v += __shfl_xor(r1v, 2); r1v += __shfl_xor(r1v, 1); \
    const float cwv = gl * gelu_exact(r1v * rs64) * (1.f / 16.f); \
    _Pragma("unroll") for (int x = 0; x < 8; ++x) { const float cw = __int_as_float(__builtin_amdgcn_readlane(__float_as_int(cwv), 8 * x)); const f32x2 cw2 = {cw, cw}; \
        _Pragma("unroll") for (int q = 0; q < 4; ++q) { const unsigned w = vv[x][q]; \
            facc[4 * q] += cw2 * __builtin_amdgcn_cvt_scalef32_pk_f32_fp4(w, 1.0f, 0); facc[4 * q + 1] += cw2 * __builtin_amdgcn_cvt_scalef32_pk_f32_fp4(w, 1.0f, 1); \
            facc[4 * q + 2] += cw2 * __builtin_amdgcn_cvt_scalef32_pk_f32_fp4(w, 1.0f, 2); facc[4 * q + 3] += cw2 * __builtin_amdgcn_cvt_scalef32_pk_f32_fp4(w, 1.0f, 3); } } }
    PG_ISSUE_U(0, uA)
#pragma unroll 1
    for (int b = 0; b < 16; b += 2) {
        PG_ISSUE_U(b + 1, uB)
        __builtin_amdgcn_sched_barrier(0);
        PG_APPLY(b, uA)
        __builtin_amdgcn_sched_barrier(0);
        if (b + 2 < 16) PG_ISSUE_U(b + 2, uA)
        __builtin_amdgcn_sched_barrier(0);
        PG_APPLY(b + 1, uB)
        __builtin_amdgcn_sched_barrier(0);
    }
#undef PG_ISSUE_U
#undef PG_APPLY
    float* y = p.out + O_YP + (size_t)tk * D + 32 * lane;
#pragma unroll
    for (int q = 0; q < 8; ++q) {
        f32x4 hh = {hv[2 * q].x + facc[2 * q].x, hv[2 * q].y + facc[2 * q].y, hv[2 * q + 1].x + facc[2 * q + 1].x, hv[2 * q + 1].y + facc[2 * q + 1].y};
        *(f32x4*)(y + 4 * q) = hh;
    }
}

__device__ __forceinline__ void phase9(const Params& p, char* smem) {
    const int c = blockIdx.x, G = gridDim.x;
    for (int tk = TP + (G - 1 - c); tk < TT; tk += G) peer_item<true>(p, tk, smem);
    peer_route_wg(p, smem);
}
__device__ __forceinline__ void phase10(const Params& p, char* smem) {
    const int gw = blockIdx.x * 8 + (otid() >> 6), NGW = gridDim.x * 8;
    for (int tk = gw; tk < TP; tk += NGW) peer_gather_wave(p, tk, smem);
}

__global__ __launch_bounds__(512, 2) void fwd_kernel(KArgs ka) {
    extern __shared__ __attribute__((aligned(16))) char smem[];
    const Params p = make_params(ka);
    volatile LAS unsigned* st = (volatile LAS unsigned*)(smem + LDS_BYTES - 16);
    if (threadIdx.x == 0) { st[0] = 0u; st[1] = 0u; }
    __syncthreads();
    XcdBarrier bar = xcd_barrier_post(p.ctl, st);
#ifndef PHASE_MASK
#define PHASE_MASK 0x7ff
#endif
#ifndef REP_MASK
  #define REP_MASK 0
#endif
#define PH(k, call) if (((PHASE_MASK >> (k)) & 1) && ka.ph_lo <= (k) && (k) < ka.ph_hi) { \
    for (int rep = 0; rep < 1 + ((REP_MASK >> (k)) & 1); ++rep) { call; if (rep + 1 < 1 + ((REP_MASK >> (k)) & 1)) xcd_barrier(bar); } \
    if ((k) + 1 < ka.ph_hi) xcd_barrier(bar); }
    PH(0, phase0(p, smem))
    PH(1, phase1(p, smem))
    PH(2, phase2(p, smem))
    PH(3, phase3(p, smem, rep))
    PH(4, phase4(p, smem))
    PH(5, phase5(p, smem))
    PH(6, phase6(p, smem))
    PH(8, phase8(p, smem, rep))
    PH(9, phase9(p, smem))
    PH(10, phase10(p, smem))
#undef PH
}


#ifdef DBG_RET_NAIVE
__global__ void dbg_ret_naive(KArgs ka) {
    const Params p = make_params(ka);
    const int idx = blockIdx.x * blockDim.x + threadIdx.x;
    const int dv = idx & 255, dk = (idx >> 8) & 127, h = (idx >> 15) & 7, b = idx >> 18;
    const float g = 1.f - exp2f(-5.f - (float)h);
    float S = 0.f;
    for (int t = 0; t < SEQ; ++t) {
        const size_t tok = (size_t)b * SEQ + t;
        S = g * S + (float)p.RK[tok * 1024 + h * 128 + dk] * (float)p.RV[tok * 2048 + h * 256 + dv];
    }
    p.out[O_SP + ((size_t)((b * 8 + h) * 128 + dk)) * 256 + dv] = S;
}
#endif
#ifdef DBG_SCALES
__global__ void dbg_scale_kernel(float* out) {
    const float sc[10] = {DBG_SCALES};
    const size_t offs[11] = {O_YP, O_YS, O_KP, O_VP, O_IKP, O_SP, O_KS, O_VS, O_IKS, O_SS, 28861440};
    for (size_t i = (size_t)blockIdx.x * blockDim.x + threadIdx.x; i < 28861440; i += (size_t)gridDim.x * blockDim.x) {
        float s = 0.f;
#pragma unroll
        for (int k = 0; k < 10; ++k) if (i >= offs[k] && i < offs[k + 1]) s = sc[k];
        out[i] = (s == 0.f) ? 0.f : out[i] * s;
    }
}
#endif
#ifndef MK_MULTI
#define MK_MULTI 0
#endif
extern "C" void kernel_launch(void* const* d_in, const int* in_sizes, int n_in, void* d_out, int out_size, void* d_ws, size_t ws_size, hipStream_t stream) {
    static int grid = 0;
    if (grid == 0) {
        int dev = 0, cus = 0;
        (void)hipGetDevice(&dev); (void)hipDeviceGetAttribute(&cus, hipDeviceAttributeMultiprocessorCount, dev);
        (void)hipFuncSetAttribute((const void*)fwd_kernel, hipFuncAttributeMaxDynamicSharedMemorySize, LDS_BYTES);
        int per_cu = 0;
        (void)hipOccupancyMaxActiveBlocksPerMultiprocessor(&per_cu, (const void*)fwd_kernel, 512, LDS_BYTES);
        (void)hipGetLastError();
        grid = (cus > 0 ? cus : 256) * 1;
        if (per_cu < 1) fprintf(stderr, "kernel_launch: occupancy query reports %d blocks per CU\n", per_cu);
    }
    KArgs p;
    memset(&p, 0, sizeof(p));
    if (n_in < 21) { fprintf(stderr, "kernel_launch: expected 21 inputs, got %d\n", n_in); return; }
    for (int i = 0; i < 21; ++i) p.in[i] = d_in[i];
    p.out = (float*)d_out;
    p.ws = (char*)d_ws;
    if (WS_END > ws_size) { fprintf(stderr, "kernel_launch: workspace too small (%zu > %zu)\n", (size_t)WS_END, ws_size); return; }
    (void)hipMemsetAsync(d_ws, 0, 65536, stream);
#if MK_MULTI
    for (int k = 0; k < 11; ++k) {
        p.ph_lo = k; p.ph_hi = k + 1;
        hipLaunchKernelGGL(fwd_kernel, dim3(grid), dim3(512), LDS_BYTES, stream, p);
    }
#else
    p.ph_lo = 0; p.ph_hi = 11;
    hipLaunchKernelGGL(fwd_kernel, dim3(grid), dim3(512), LDS_BYTES, stream, p);
#endif
#ifdef DBG_RET_NAIVE
    hipLaunchKernelGGL(dbg_ret_naive, dim3(2 * 8 * 128 * 256 / 256), dim3(256), 0, stream, p);
#endif
#ifdef DBG_SCALES
    hipLaunchKernelGGL(dbg_scale_kernel, dim3(1024), dim3(256), 0, stream, (float*)d_out);
#endif
}
```

```cpp
#include <hip/hip_runtime.h>
#include <stdint.h>
#include <stdio.h>
#include <string.h>
#include <math.h>
#include <type_traits>

typedef _Float16 h16;
typedef _Float16 h16x8 __attribute__((ext_vector_type(8)));
typedef _Float16 h16x4 __attribute__((ext_vector_type(4)));
typedef _Float16 h16x2 __attribute__((ext_vector_type(2)));
typedef float f32x4 __attribute__((ext_vector_type(4)));
typedef float f32x2 __attribute__((ext_vector_type(2)));
typedef unsigned u32x4 __attribute__((ext_vector_type(4)));
typedef unsigned long long u64;

#define LAS __attribute__((address_space(3)))

constexpr int D = 2048, SEQ = 4096, TP = 8192, NS = 8, TT = TP + NS;
constexpr int NWP = 15616;
constexpr int NW0 = 15504;
constexpr int PAST = 16384, PAGE = 128, NPAGES = 128, LS = PAST + 1;
constexpr int NEXP = 16384;
constexpr float EPS = 1e-6f;
constexpr int C_RQ = 0, C_RK = 1024, C_RV = 2048, C_RG = 4096, C_AQ = 6144, C_AK = 8192, C_AV = 8704, C_IQ = 9216, C_IK = 11264, C_IW = 11392, C_GR = 11408, C_GA = 13456;
constexpr size_t O_YP = 0, O_YS = 16777216, O_KP = 16793600, O_VP = 20987904, O_IKP = 25182208, O_SP = 26230784,
                 O_KS = 26755072, O_VS = 26759168, O_IKS = 26763264, O_SS = 26764288;
constexpr int LDS_BYTES = 139264;
constexpr int SCS = 4112;
constexpr int SSCS = 16400;

#define XB_TMO      128
#define XB_XCNT(j)  (256  + 64 * (j))
#define XB_XSUB(j)  (1280 + 64 * (j))
#define XB_XGEN(j)  (2304 + 64 * (j))
#define XB_TOP      3328
#define XB_TOPGEN   3392
#define XCD_BAR_WORDS 3456
#define XB_SPIN_CAP (1u << 22)
__device__ __forceinline__ unsigned xb_ld(unsigned* p)              { return __hip_atomic_load(p, __ATOMIC_RELAXED, __HIP_MEMORY_SCOPE_AGENT); }
__device__ __forceinline__ unsigned xb_add(unsigned* p, unsigned v) { return __hip_atomic_fetch_add(p, v, __ATOMIC_RELAXED, __HIP_MEMORY_SCOPE_AGENT); }
__device__ __forceinline__ unsigned xb_xcc_id() { return (unsigned)__builtin_amdgcn_s_getreg((3 << 11) | 20) & 0xFu; }
#define XB_SPIN(cond, bar) do { unsigned _sp = 0; while (cond) { __builtin_amdgcn_s_sleep(1); \
    if ((++_sp & 255u) == 0u) { if (xb_ld(&(bar)[XB_TMO])) break; if (_sp > XB_SPIN_CAP) { atomicAdd(&(bar)[XB_TMO], 1u); break; } } } } while (0)
struct XcdBarrier { unsigned* bar; unsigned x; volatile LAS unsigned* st; };
__device__ __forceinline__ XcdBarrier xcd_barrier_post(unsigned* bar, volatile LAS unsigned* st) {
    XcdBarrier b; b.bar = bar; b.x = xb_xcc_id(); b.st = st;
    if (threadIdx.x == 0) (void)xb_add(&bar[XB_XCNT(b.x)], 1u);
    return b;
}
__device__ __forceinline__ void xcd_barrier_complete(unsigned* bar, unsigned x, unsigned& nloc, unsigned& nx) {
    const unsigned G = gridDim.x * gridDim.y * gridDim.z;
    unsigned sum, cnt, mine, sp = 0u;
    for (;;) {
        sum = 0u; cnt = 0u; mine = 0u;
#pragma unroll
        for (unsigned j = 0; j < 16; ++j) { const unsigned c = xb_ld(&bar[XB_XCNT(j)]); sum += c; cnt += (c > 0u) ? 1u : 0u; mine = (j == x) ? c : mine; }
        if (sum == G) break;
        __builtin_amdgcn_s_sleep(1);
        if ((++sp & 255u) == 0u) { if (xb_ld(&bar[XB_TMO])) break; if (sp > XB_SPIN_CAP) { atomicAdd(&bar[XB_TMO], 1u); break; } }
    }
    nloc = mine > 0u ? mine : 1u; nx = cnt > 0u ? cnt : 1u;
}
__device__ __forceinline__ void xcd_barrier(const XcdBarrier& b) {
    asm volatile("s_waitcnt vmcnt(0)" ::: "memory");
    __syncthreads();
    if (threadIdx.x == 0) {
        unsigned* bar = b.bar;
        __builtin_amdgcn_s_waitcnt(0);
        volatile LAS unsigned* stw = (volatile LAS unsigned*)(unsigned)(LDS_BYTES - 16);
        unsigned nloc = stw[0], nx = stw[1];
        if (nloc == 0u) { xcd_barrier_complete(bar, b.x, nloc, nx); stw[0] = nloc; stw[1] = nx; }
        const unsigned old = xb_add(&bar[XB_XSUB(b.x)], 1u);
        const unsigned gen = old / nloc;
        if (old + 1u == (gen + 1u) * nloc) {
            __builtin_amdgcn_fence(__ATOMIC_RELEASE, "agent");
            asm volatile("s_waitcnt vmcnt(0)" ::: "memory");
            const unsigned og = xb_add(&bar[XB_TOP], 1u);
            const unsigned tg = og / nx;
            if (og + 1u == (tg + 1u) * nx) xb_add(&bar[XB_TOPGEN], 1u);
            else XB_SPIN(xb_ld(&bar[XB_TOPGEN]) == tg, bar);
            __builtin_amdgcn_fence(__ATOMIC_ACQUIRE, "agent");
            xb_add(&bar[XB_XGEN(b.x)], 1u);
            asm volatile("s_waitcnt vmcnt(0)" ::: "memory");
        } else {
            XB_SPIN(xb_ld(&bar[XB_XGEN(b.x)]) == gen, bar);
            __builtin_amdgcn_fence(__ATOMIC_ACQUIRE, "agent");
            asm volatile("s_waitcnt vmcnt(0)" ::: "memory");
        }
    }
    __syncthreads();
}

struct Params {
    const float *x_prompt, *x_sample, *cache_k, *cache_v, *cache_kidx, *state_ret;
    const int* page_table;
    const float *norm1_w, *w_in, *q_norm_w, *k_norm_w, *ret_gn_w, *w_ret_o, *w_att_o, *w_out, *norm2_w, *peer_wq, *peer_k1, *peer_k2, *peer_u, *peer_v;
    float* out;
    unsigned* ctl;
    float* ROWSS;
    h16 *XN, *WinT, *WrT, *WaT, *WoT, *WqT, *PU, *PV, *K1H, *K2H;
    int2* ROUTE;
    unsigned char *AQ8, *AK8;
    h16 *RQ, *RK, *RV, *RG, *AQ, *AK, *AV, *IQ, *IK, *GR, *GA;
    float* IW;
    float* KV; h16* SPT; int* TOPI; h16 *RN, *ATT, *MIX, *HN; float* MIXF; float* PQ;
    float2* ROPE;
    float *XNS, *ZS, *SRQ, *SRK, *SRV, *SRG, *SAQ, *SAK, *SAV, *SIQ, *SIK, *SIW, *SGR, *SGA, *SSC;
    int* STOP;
    float *SRN, *SATT, *SMIX, *SHN, *SPQ;
};
struct KArgs {
    const void* in[21];
    float* out;
    char* ws;
    int ph_lo, ph_hi;
};
constexpr size_t al256(size_t x) { return (x + 255) & ~(size_t)255; }
constexpr size_t WS_CTL = 0;
constexpr size_t WS_XN = WS_CTL + 65536;
constexpr size_t WS_WINT = WS_XN + al256((size_t)TP * D * 2);
constexpr size_t WS_WRT = WS_WINT + al256((size_t)NWP * D * 2);
constexpr size_t WS_WAT = WS_WRT + al256((size_t)D * D * 2);
constexpr size_t WS_WOT = WS_WAT + al256((size_t)D * D * 2);
constexpr size_t WS_WQT = WS_WOT + al256((size_t)D * D * 2);
constexpr size_t WS_PU = WS_WQT + al256((size_t)1024 * D * 2);
constexpr size_t WS_PV = WS_PU + al256((size_t)NEXP * D * 2);
constexpr size_t WS_RQ = WS_PV + al256((size_t)NEXP * D * 2);
constexpr size_t WS_RK = WS_RQ + al256((size_t)TP * 1024 * 2);
constexpr size_t WS_RV = WS_RK + al256((size_t)TP * 1024 * 2);
constexpr size_t WS_RG = WS_RV + al256((size_t)TP * 2048 * 2);
constexpr size_t WS_AQ = WS_RG + al256((size_t)TP * 2048 * 2);
constexpr size_t WS_AK = WS_AQ + al256((size_t)TP * 2048 * 2);
constexpr size_t WS_AV = WS_AK + al256((size_t)TP * 512 * 2);
constexpr size_t WS_IQ = WS_AV + al256((size_t)TP * 512 * 2);
constexpr size_t WS_IK = WS_IQ + al256((size_t)TP * 2048 * 2);
constexpr size_t WS_GR = WS_IK + al256((size_t)TP * 128 * 2);
constexpr size_t WS_GA = WS_GR + al256((size_t)TP * 2048 * 2);
constexpr size_t WS_IW = WS_GA + al256((size_t)TP * 2048 * 2);
constexpr size_t WS_KV = WS_IW + al256((size_t)TP * 16 * 4);
constexpr size_t WS_SPT = WS_KV + al256((size_t)2 * 8 * 32 * 128 * 256 * 4);
constexpr size_t WS_TOPI = WS_SPT + al256((size_t)2 * 8 * 32 * 256 * 128 * 2);
constexpr size_t WS_RN = WS_TOPI + al256((size_t)TP * 256 * 4);
constexpr size_t WS_ATT = WS_RN + al256((size_t)TP * D * 2);
constexpr size_t WS_MIX = WS_ATT + al256((size_t)TP * D * 2);
constexpr size_t WS_HN = WS_MIX + al256((size_t)TP * D * 2);
constexpr size_t WS_MIXF = WS_HN + al256((size_t)TP * D * 2);
constexpr size_t WS_PQ = WS_MIXF + al256((size_t)TP * D * 4);
constexpr size_t WS_ROPE = WS_PQ + al256((size_t)TP * 1024 * 4);
constexpr size_t WS_XNS = WS_ROPE + al256((size_t)4097 * 64 * 8);
constexpr size_t WS_ZS = WS_XNS + al256(8 * D * 4);
constexpr size_t WS_SRQ = WS_ZS + al256((size_t)8 * NW0 * 4);
constexpr size_t WS_SRK = WS_SRQ + al256(8 * 1024 * 4);
constexpr size_t WS_SRV = WS_SRK + al256(8 * 1024 * 4);
constexpr size_t WS_SRG = WS_SRV + al256(8 * 2048 * 4);
constexpr size_t WS_SAQ = WS_SRG + al256(8 * 2048 * 4);
constexpr size_t WS_SAK = WS_SAQ + al256(8 * 2048 * 4);
constexpr size_t WS_SAV = WS_SAK + al256(8 * 512 * 4);
constexpr size_t WS_SIQ = WS_SAV + al256(8 * 512 * 4);
constexpr size_t WS_SIK = WS_SIQ + al256(8 * 2048 * 4);
constexpr size_t WS_SIW = WS_SIK + al256(8 * 128 * 4);
constexpr size_t WS_SGR = WS_SIW + al256(8 * 16 * 4);
constexpr size_t WS_SGA = WS_SGR + al256(8 * 2048 * 4);
constexpr size_t WS_SSC = WS_SGA + al256(8 * 2048 * 4);
constexpr size_t WS_STOP = WS_SSC + al256((size_t)8 * SSCS * 4);
constexpr size_t WS_SRN = WS_STOP + al256(8 * 256 * 4);
constexpr size_t WS_SATT = WS_SRN + al256(8 * 2048 * 4);
constexpr size_t WS_SMIX = WS_SATT + al256(8 * 2048 * 4);
constexpr size_t WS_SHN = WS_SMIX + al256(8 * 2048 * 4);
constexpr size_t WS_SPQ = WS_SHN + al256(8 * 2048 * 4);
constexpr size_t WS_K1H = WS_SPQ + al256(8 * 1024 * 4);
constexpr size_t WS_K2H = WS_K1H + al256(8 * 128 * 64 * 2);
constexpr size_t WS_ROUTE = WS_K2H + al256(8 * 128 * 64 * 2);
constexpr size_t WS_AQ8 = WS_ROUTE + al256((size_t)TP * 128 * 8);
constexpr size_t WS_AK8 = WS_AQ8 + al256((size_t)TP * 2048);
constexpr size_t WS_END = WS_AK8 + al256((size_t)TP * 512);
__device__ __forceinline__ Params make_params(const KArgs& a) {
    Params p;
    p.x_prompt = (const float*)a.in[0]; p.x_sample = (const float*)a.in[1]; p.cache_k = (const float*)a.in[2]; p.cache_v = (const float*)a.in[3];
    p.cache_kidx = (const float*)a.in[4]; p.state_ret = (const float*)a.in[5]; p.page_table = (const int*)a.in[6];
    p.norm1_w = (const float*)a.in[7]; p.w_in = (const float*)a.in[8]; p.q_norm_w = (const float*)a.in[9]; p.k_norm_w = (const float*)a.in[10];
    p.ret_gn_w = (const float*)a.in[11]; p.w_ret_o = (const float*)a.in[12]; p.w_att_o = (const float*)a.in[13]; p.w_out = (const float*)a.in[14];
    p.norm2_w = (const float*)a.in[15]; p.peer_wq = (const float*)a.in[16]; p.peer_k1 = (const float*)a.in[17]; p.peer_k2 = (const float*)a.in[18];
    p.peer_u = (const float*)a.in[19]; p.peer_v = (const float*)a.in[20];
    p.out = a.out;
    char* w = a.ws;
    p.ctl = (unsigned*)(w + WS_CTL); p.ROWSS = (float*)(w + WS_CTL + 32768);
    p.XN = (h16*)(w + WS_XN); p.WinT = (h16*)(w + WS_WINT); p.WrT = (h16*)(w + WS_WRT); p.WaT = (h16*)(w + WS_WAT); p.WoT = (h16*)(w + WS_WOT); p.WqT = (h16*)(w + WS_WQT);
    p.PU = (h16*)(w + WS_PU); p.PV = (h16*)(w + WS_PV); p.K1H = (h16*)(w + WS_K1H); p.K2H = (h16*)(w + WS_K2H); p.ROUTE = (int2*)(w + WS_ROUTE); p.AQ8 = (unsigned char*)(w + WS_AQ8); p.AK8 = (unsigned char*)(w + WS_AK8);
    p.RQ = (h16*)(w + WS_RQ); p.RK = (h16*)(w + WS_RK); p.RV = (h16*)(w + WS_RV); p.RG = (h16*)(w + WS_RG);
    p.AQ = (h16*)(w + WS_AQ); p.AK = (h16*)(w + WS_AK); p.AV = (h16*)(w + WS_AV); p.IQ = (h16*)(w + WS_IQ); p.IK = (h16*)(w + WS_IK);
    p.GR = (h16*)(w + WS_GR); p.GA = (h16*)(w + WS_GA); p.IW = (float*)(w + WS_IW);
    p.KV = (float*)(w + WS_KV); p.SPT = (h16*)(w + WS_SPT); p.TOPI = (int*)(w + WS_TOPI);
    p.RN = (h16*)(w + WS_RN); p.ATT = (h16*)(w + WS_ATT); p.MIX = (h16*)(w + WS_MIX); p.HN = (h16*)(w + WS_HN);
    p.MIXF = (float*)(w + WS_MIXF); p.PQ = (float*)(w + WS_PQ); p.ROPE = (float2*)(w + WS_ROPE);
    p.XNS = (float*)(w + WS_XNS); p.ZS = (float*)(w + WS_ZS);
    p.SRQ = (float*)(w + WS_SRQ); p.SRK = (float*)(w + WS_SRK); p.SRV = (float*)(w + WS_SRV); p.SRG = (float*)(w + WS_SRG);
    p.SAQ = (float*)(w + WS_SAQ); p.SAK = (float*)(w + WS_SAK); p.SAV = (float*)(w + WS_SAV);
    p.SIQ = (float*)(w + WS_SIQ); p.SIK = (float*)(w + WS_SIK); p.SIW = (float*)(w + WS_SIW);
    p.SGR = (float*)(w + WS_SGR); p.SGA = (float*)(w + WS_SGA); p.SSC = (float*)(w + WS_SSC); p.STOP = (int*)(w + WS_STOP);
    p.SRN = (float*)(w + WS_SRN); p.SATT = (float*)(w + WS_SATT); p.SMIX = (float*)(w + WS_SMIX); p.SHN = (float*)(w + WS_SHN); p.SPQ = (float*)(w + WS_SPQ);
    return p;
}

__device__ __forceinline__ float wave_sum(float v) {
#pragma unroll
    for (int o = 32; o > 0; o >>= 1) v += __shfl_xor(v, o);
    return v;
}
__device__ __forceinline__ float wave_max(float v) {
#pragma unroll
    for (int o = 32; o > 0; o >>= 1) v = fmaxf(v, __shfl_xor(v, o));
    return v;
}
__device__ __forceinline__ int otid() { int t = threadIdx.x; asm volatile("" : "+v"(t)); return t; }
__device__ __forceinline__ unsigned f2ord(float f) { unsigned b = __float_as_uint(f); return b ^ ((unsigned)((int)b >> 31) | 0x80000000u); }
__device__ __forceinline__ unsigned pkh(float lo, float hi) { h16x2 v; v.x = (h16)lo; v.y = (h16)hi; return __builtin_bit_cast(unsigned, v); }
__device__ __forceinline__ u32x4 pk8(const float* v) { u32x4 r; r.x = pkh(v[0], v[1]); r.y = pkh(v[2], v[3]); r.z = pkh(v[4], v[5]); r.w = pkh(v[6], v[7]); return r; }
__device__ __forceinline__ void unpk8(u32x4 r, float* v) {
    const unsigned rx = r.x, ry = r.y, rz = r.z, rw = r.w;
    h16x2 a = __builtin_bit_cast(h16x2, rx), b = __builtin_bit_cast(h16x2, ry), c = __builtin_bit_cast(h16x2, rz), d = __builtin_bit_cast(h16x2, rw);
    v[0] = (float)a.x; v[1] = (float)a.y; v[2] = (float)b.x; v[3] = (float)b.y; v[4] = (float)c.x; v[5] = (float)c.y; v[6] = (float)d.x; v[7] = (float)d.y;
}
__device__ __forceinline__ float sigmoidf_(float x) { return __builtin_amdgcn_rcpf(1.f + __expf(-x)); }
__device__ __forceinline__ float siluf_(float x) { return x * __builtin_amdgcn_rcpf(1.f + __expf(-x)); }
__device__ __forceinline__ float gelu_exact(float x) { return 0.5f * x * (1.f + erff(x * 0.70710678118654752f)); }
__device__ __forceinline__ float ret_log_g(int h) { return logf(1.f - exp2f(-5.f - (float)h)); }

__device__ __forceinline__ unsigned off_b(unsigned row, unsigned ch) { return 256u * row + 16u * (ch ^ (((row & 3) << 2) | ((row >> 2) & 3))); }
__device__ __forceinline__ unsigned tr_addr16(unsigned lane, unsigned c, unsigned t) {
    const unsigned g = lane >> 4, q = (lane & 15) >> 2, p = lane & 3;
    return off_b(8 * g + 4 * t + q, 2 * c + (p >> 1)) + 8 * (p & 1);
}
template <int IMM>
__device__ __forceinline__ h16x8 tr_read8o(unsigned a0, unsigned a1) {
    h16x4 r0, r1;
    asm volatile("ds_read_b64_tr_b16 %0, %2 offset:%4\n\tds_read_b64_tr_b16 %1, %3 offset:%4\n\ts_waitcnt lgkmcnt(0)" : "=&v"(r0), "=&v"(r1) : "v"(a0), "v"(a1), "n"(IMM) : "memory");
    h16x8 r; r[0] = r0[0]; r[1] = r0[1]; r[2] = r0[2]; r[3] = r0[3]; r[4] = r1[0]; r[5] = r1[1]; r[6] = r1[2]; r[7] = r1[3];
    return r;
}
__device__ __forceinline__ void tr_read8x4(unsigned z0, unsigned z1, unsigned c0, h16x8 (&out)[4]) {
    h16x4 r[8];
    const unsigned a0 = z0 ^ (32u * c0), a1 = z1 ^ (32u * c0), a2 = z0 ^ (32u * (c0 + 1)), a3 = z1 ^ (32u * (c0 + 1));
    const unsigned a4 = z0 ^ (32u * (c0 + 2)), a5 = z1 ^ (32u * (c0 + 2)), a6 = z0 ^ (32u * (c0 + 3)), a7 = z1 ^ (32u * (c0 + 3));
    asm volatile("ds_read_b64_tr_b16 %0, %8\n\tds_read_b64_tr_b16 %1, %9\n\tds_read_b64_tr_b16 %2, %10\n\tds_read_b64_tr_b16 %3, %11\n\t"
                 "ds_read_b64_tr_b16 %4, %12\n\tds_read_b64_tr_b16 %5, %13\n\tds_read_b64_tr_b16 %6, %14\n\tds_read_b64_tr_b16 %7, %15\n\ts_waitcnt lgkmcnt(0)"
                 : "=&v"(r[0]), "=&v"(r[1]), "=&v"(r[2]), "=&v"(r[3]), "=&v"(r[4]), "=&v"(r[5]), "=&v"(r[6]), "=&v"(r[7])
                 : "v"(a0), "v"(a1), "v"(a2), "v"(a3), "v"(a4), "v"(a5), "v"(a6), "v"(a7) : "memory");
#pragma unroll
    for (int i = 0; i < 4; ++i) { h16x8 v; v[0] = r[2 * i][0]; v[1] = r[2 * i][1]; v[2] = r[2 * i][2]; v[3] = r[2 * i][3]; v[4] = r[2 * i + 1][0]; v[5] = r[2 * i + 1][1]; v[6] = r[2 * i + 1][2]; v[7] = r[2 * i + 1][3]; out[i] = v; }
}
template <int I, int N, class F>
__device__ __forceinline__ void static_for(F&& f) { if constexpr (I < N) { f(std::integral_constant<int, I>{}); static_for<I + 1, N>(f); } }
__device__ __forceinline__ unsigned lds_u32(const void* p) { return (unsigned)(size_t)(const LAS char*)p; }

__device__ __forceinline__ int wave_sum_small(unsigned cnt) {
    int c = 0;
#pragma unroll
    for (int b = 0; b < 7; ++b) c += __popcll(__ballot((cnt >> b) & 1u)) << b;
    return c;
}
template <int NV>
__device__ __forceinline__ void wave_kth_r4(const unsigned (&u)[NV], int K, unsigned& tau, int& need_eq) {
    tau = 0u; bool exact = false;
    for (int bit = 30; bit >= 0; bit -= 2) {
        const unsigned c1 = tau | (1u << bit), c2 = tau | (2u << bit), c3 = tau | (3u << bit);
        int n1 = 0, n2 = 0, n3 = 0;
#pragma unroll
        for (int i = 0; i < NV; ++i) { n1 += __popcll(__ballot(u[i] >= c1)); n2 += __popcll(__ballot(u[i] >= c2)); n3 += __popcll(__ballot(u[i] >= c3)); }
        int n = -1;
        if (n3 >= K) { tau = c3; n = n3; } else if (n2 >= K) { tau = c2; n = n2; } else if (n1 >= K) { tau = c1; n = n1; }
        if (n == K) { exact = true; break; }
    }
    int cg = 0;
    if (!exact && tau != 0xFFFFFFFFu) {
#pragma unroll
        for (int i = 0; i < NV; ++i) cg += __popcll(__ballot(u[i] > tau));
    }
    need_eq = exact ? K : K - cg;
}
template <int NV>
__device__ __forceinline__ void wave_kth_dyn(const unsigned (&u)[NV], int ngrp, int K, unsigned& tau, int& need_eq) {
    tau = 0u; int cg = 0; bool exact = false;
    for (int bit = 31; bit >= -1; --bit) {
        const unsigned cand = (bit >= 0) ? (tau | (1u << bit)) : tau + 1u;
        unsigned cnt = 0u;
        static_for<0, NV / 8>([&](auto G8) {
            constexpr int g8 = decltype(G8)::value;
            if (g8 < ngrp) {
#pragma unroll
                for (int i = 0; i < 8; ++i) cnt += (u[g8 * 8 + i] >= cand) ? 1u : 0u;
            }
        });
        const int c = wave_sum_small(cnt);
        if (bit >= 0) { if (c >= K) tau = cand; if (c == K) { exact = true; break; } } else cg = (tau == 0xFFFFFFFFu) ? 0 : c;
    }
    need_eq = exact ? K : K - cg;
}
template <int NV>
__device__ __forceinline__ void wave_kth(const unsigned (&u)[NV], int K, unsigned& tau, int& need_eq) {
    tau = 0u; int cg = 0; bool exact = false;
    for (int bit = 31; bit >= -1; --bit) {
        const unsigned cand = (bit >= 0) ? (tau | (1u << bit)) : tau + 1u;
        int c = 0;
        if constexpr (NV >= 8) {
            unsigned cnt = 0u;
#pragma unroll
            for (int i = 0; i < NV; ++i) cnt += (u[i] >= cand) ? 1u : 0u;
            c = wave_sum_small(cnt);
        } else {
#pragma unroll
            for (int i = 0; i < NV; ++i) c += __popcll(__ballot(u[i] >= cand));
        }
        if (bit >= 0) { if (c >= K) tau = cand; if (c == K) { exact = true; break; } } else cg = (tau == 0xFFFFFFFFu) ? 0 : c;
    }
    need_eq = exact ? K : K - cg;
}

template <bool WIN>
__device__ __forceinline__ void p0_transpose_item(const float* W, int K, int N, h16* WT, float* scr, int item, int nblk, int lane, const float* kscale = nullptr) {
    const int kb = item / nblk, nb = item % nblk, k0 = 64 * kb, n0 = 32 * nb;
    float tv[32];
#pragma unroll
    for (int i = 0; i < 32; ++i) { const int kk = 2 * i + (lane >> 5), n = n0 + (lane & 31); tv[i] = (n < N) ? W[(size_t)(k0 + kk) * N + n] : 0.f; }
#pragma unroll
    for (int i = 0; i < 32; ++i) { const int kk = 2 * i + (lane >> 5); scr[kk * 33 + (lane & 31)] = tv[i]; }
    asm volatile("s_waitcnt lgkmcnt(0)" ::: "memory");
    const int c = lane & 7;
#pragma unroll
    for (int j = 0; j < 4; ++j) {
        const int nl = (lane >> 3) + 8 * j, n = n0 + nl;
        const float* s = scr + (8 * c) * 33 + nl;
        float v[8];
#pragma unroll
        for (int e = 0; e < 8; ++e) v[e] = s[e * 33];
        if (kscale) {
#pragma unroll
            for (int e = 0; e < 8; ++e) v[e] *= kscale[k0 + 8 * c + e];
        }
        int dst = n;
        if (WIN) { if (n >= C_GR) dst = n - 16; else if (n >= C_IW) dst = 15488 + (n - C_IW); }
        if (n < N) *(u32x4*)(WT + (size_t)dst * K + k0 + 8 * c) = pk8(v);
    }
    asm volatile("s_waitcnt lgkmcnt(0)" ::: "memory");
}

__device__ __forceinline__ void phase0(const Params& p, char* smem) {
    const int tid = otid(), lane = tid & 63, wave = tid >> 6;
    const int gw = blockIdx.x * 8 + wave, NGW = gridDim.x * 8;
    const int gt = blockIdx.x * 512 + tid, NGT = gridDim.x * 512;
    for (int r = gw; r < TT; r += NGW) {
        const float* x = (r < TP) ? p.x_prompt + (size_t)r * D : p.x_sample + (size_t)(r - TP) * D;
        f32x4 v[8]; float ss = 0.f;
#pragma unroll
        for (int j = 0; j < 8; ++j) { v[j] = *(const f32x4*)(x + 4 * (lane + 64 * j)); ss += v[j].x * v[j].x + v[j].y * v[j].y + v[j].z * v[j].z + v[j].w * v[j].w; }
        ss = wave_sum(ss);
        const float rs = rsqrtf(ss * (1.f / D) + EPS);
#pragma unroll
        for (int j = 0; j < 8; ++j) {
            const f32x4 w = *(const f32x4*)(p.norm1_w + 4 * (lane + 64 * j));
            const float a = v[j].x * rs * w.x, b = v[j].y * rs * w.y, c = v[j].z * rs * w.z, d = v[j].w * rs * w.w;
            if (r < TP) { f32x2 o; o.x = __uint_as_float(pkh(a, b)); o.y = __uint_as_float(pkh(c, d)); *(f32x2*)(p.XN + (size_t)r * D + 4 * (lane + 64 * j)) = o; }
            else { f32x4 o = {a, b, c, d}; *(f32x4*)(p.XNS + (size_t)(r - TP) * D + 4 * (lane + 64 * j)) = o; }
        }
    }
    {
        float* scr = (float*)smem + wave * (64 * 33);
        constexpr int NB_IN = (NW0 + 31) / 32;
        constexpr int I_IN = 32 * NB_IN;
        for (int it = gw; it < I_IN; it += NGW) p0_transpose_item<true>(p.w_in, D, NW0, p.WinT, scr, it, NB_IN, lane);
    }
    for (int i = gt; i < (NWP - NW0) * D / 8; i += NGT) { u32x4 z = {0u, 0u, 0u, 0u}; *(u32x4*)(p.WinT + (size_t)NW0 * D + (size_t)i * 8) = z; }
    for (int i = gt; i < 2 * 8 * 128 * 64 / 8; i += NGT) {
        const int half = 8 * 128 * 64 / 8;
        const float* src = (i < half) ? p.peer_k1 + (size_t)i * 8 : p.peer_k2 + (size_t)(i - half) * 8;
        h16* dst = (i < half) ? p.K1H + (size_t)i * 8 : p.K2H + (size_t)(i - half) * 8;
        const f32x4 a = *(const f32x4*)src, b = *(const f32x4*)(src + 4);
        u32x4 o; o.x = pkh(a.x, a.y); o.y = pkh(a.z, a.w); o.z = pkh(b.x, b.y); o.w = pkh(b.z, b.w);
        *(u32x4*)dst = o;
    }
    for (int i = gt; i < 4097 * 64; i += NGT) {
        const int pi = i >> 6, fi = i & 63;
        const double pos = (pi == 4096) ? 16384.0 : (double)pi;
        double fq = 1.0;
        if (fi & 1) fq *= 0.86596432336006535; if (fi & 2) fq *= 0.74989420933245583; if (fi & 4) fq *= 0.56234132519034908;
        if (fi & 8) fq *= 0.31622776601683794; if (fi & 16) fq *= 0.1; if (fi & 32) fq *= 0.01;
        const double rev = pos * fq * 0.15915494309189533577;
        const double fr = rev - __builtin_rint(rev);
        float2 cs; cs.x = __builtin_amdgcn_cosf((float)fr); cs.y = __builtin_amdgcn_sinf((float)fr);
        p.ROPE[i] = cs;
    }
}

constexpr int G_BK = 64, G_HALF = 128, G_HT = G_HALF * G_BK;
__device__ __forceinline__ int g_lds_byte(int r, int c) {
    int st = (r >> 4) * 2 + (c >> 5), rr = r & 15, cc = c & 31, ob = rr * 64 + cc * 2;
    return st * 1024 + (ob ^ (((ob >> 9) & 1) << 5));
}
__device__ __forceinline__ void g_stage_rc(int b, int& R, int& C) {
    int st = b / 1024, sb = b % 1024, swz = sb ^ (((sb >> 9) & 1) << 5);
    R = (st >> 1) * 16 + swz / 64; C = (st & 1) * 32 + (swz % 64) / 2;
}

__device__ __forceinline__ void gemm_core(const h16* A, const h16* Bt, const int brow, const int bcol, const int K, f32x4 (&acc)[2][2][4][2], h16* shm) {
  #define SA(b,h) (shm+((b)*2+(h))*G_HT)
  #define SB(b,h) (shm+(4+(b)*2+(h))*G_HT)
  #define STAGE_X(T,P,BASE,br,kt) do{const char* _ub=(const char*)(BASE)+((long)(br)*K+(long)(kt)*G_BK)*2; \
    for(int _i=0;_i<2;++_i){int _b=(T)*16+_i*8192;int _r,_c;g_stage_rc(_b,_r,_c); \
      const unsigned _vo=(unsigned)((_r*K+_c)*2); \
      __builtin_amdgcn_global_load_lds((const unsigned*)(_ub+_vo), \
        (unsigned*)((char*)(P)+_b),16,0,0);}}while(0)
  #define STAGE(P,BASE,br,kt) STAGE_X(t0,P,BASE,br,kt)
  #define LDA(dst,b,h) for(int m=0;m<4;++m)for(int k=0;k<2;++k) \
    dst[m][k]=*reinterpret_cast<const h16x8*>((char*)SA(b,h)+g_lds_byte(wr*64+m*16+fr,k*32+fq*8))
  #define LDB(dst,b,h) for(int n=0;n<2;++n)for(int k=0;k<2;++k) \
    dst[n][k]=*reinterpret_cast<const h16x8*>((char*)SB(b,h)+g_lds_byte(wc*32+n*16+fr,k*32+fq*8))
  #define MMA(ai,bj,At,Bx) do{__builtin_amdgcn_s_setprio(1); \
    for(int m=0;m<4;++m)for(int n=0;n<2;++n)for(int k=0;k<2;++k) \
      acc[ai][bj][m][n]=__builtin_amdgcn_mfma_f32_16x16x32_f16(Bx[n][k],At[m][k],acc[ai][bj][m][n],0,0,0); \
    __builtin_amdgcn_s_setprio(0);}while(0)
  #define WAIT_V(n) asm volatile("s_waitcnt vmcnt(" #n ")":::"memory")
  #define WAIT_L(n) asm volatile("s_waitcnt lgkmcnt(" #n ")":::"memory")
  #define BAR __builtin_amdgcn_s_barrier()
  #define SCHED __builtin_amdgcn_sched_barrier(0)
  const int t0=otid();
  int wid=t0>>6,lane=t0&63,wr=wid>>2,wc=wid&3,fr=lane&15,fq=lane>>4;
  h16x8 At[4][2],B0[2][2],B1[2][2];
  const int nt=K/G_BK;
  STAGE(SB(0,0),Bt,bcol,0); STAGE(SA(0,0),A,brow,0);
  STAGE(SB(0,1),Bt,bcol+G_HALF,0); STAGE(SA(0,1),A,brow+G_HALF,0);
  if(wr==1)BAR;
  WAIT_V(4); BAR;
  STAGE(SB(1,0),Bt,bcol,1); STAGE(SA(1,0),A,brow,1); STAGE(SB(1,1),Bt,bcol+G_HALF,1);
  WAIT_V(6); BAR;
  for(int t=0;t<nt-2;t+=2){
    LDB(B0,0,0); SCHED; LDA(At,0,0); STAGE(SA(1,1),A,brow+G_HALF,t+1);
    WAIT_L(8); BAR; WAIT_L(0); MMA(0,0,At,B0); BAR; SCHED;
    LDB(B1,0,1); STAGE(SB(0,0),Bt,bcol,t+2);
    BAR; WAIT_L(0); MMA(0,1,At,B1); BAR;
    LDA(At,0,1); STAGE(SA(0,0),A,brow,t+2);
    BAR; WAIT_L(0); MMA(1,0,At,B0); BAR; SCHED;
    STAGE(SB(0,1),Bt,bcol+G_HALF,t+2);
    WAIT_V(6); BAR; MMA(1,1,At,B1); BAR;
    LDB(B0,1,0); SCHED; LDA(At,1,0); STAGE(SA(0,1),A,brow+G_HALF,t+2);
    WAIT_L(8); BAR; WAIT_L(0); MMA(0,0,At,B0); BAR; SCHED;
    LDB(B1,1,1); STAGE(SB(1,0),Bt,bcol,t+3);
    BAR; WAIT_L(0); MMA(0,1,At,B1); BAR;
    LDA(At,1,1); STAGE(SA(1,0),A,brow,t+3);
    BAR; WAIT_L(0); MMA(1,0,At,B0); BAR; SCHED;
    STAGE(SB(1,1),Bt,bcol+G_HALF,t+3);
    WAIT_V(6); BAR; MMA(1,1,At,B1); BAR;
  }
  int tz=otid(); wid=tz>>6; lane=tz&63; wr=wid>>2; wc=wid&3; fr=lane&15; fq=lane>>4;
  { LDB(B0,0,0); WAIT_V(0); LDA(At,0,0); STAGE_X(tz,SA(1,1),A,brow+G_HALF,nt-1);
    BAR; WAIT_L(0); MMA(0,0,At,B0); BAR;
    LDB(B1,0,1); BAR; WAIT_L(0); MMA(0,1,At,B1); BAR;
    LDA(At,0,1); WAIT_V(4); BAR; WAIT_L(0); MMA(1,0,At,B0); MMA(1,1,At,B1); BAR; }
  { LDB(B0,1,0); LDA(At,1,0); WAIT_V(2); BAR; WAIT_L(0); MMA(0,0,At,B0); BAR;
    LDB(B1,1,1); WAIT_V(0); BAR; WAIT_L(0); MMA(0,1,At,B1); BAR;
    LDA(At,1,1); BAR; WAIT_L(0); MMA(1,0,At,B0); MMA(1,1,At,B1); BAR; }
  if(wr==0)BAR;
  #undef SA
  #undef SB
  #undef STAGE_X
  #undef STAGE
  #undef LDA
  #undef LDB
  #undef MMA
}

__device__ __forceinline__ bool unit_next(int i, int nM, int nN, int& pm, int& pn) {
    const int nwg = nM * nN; const long L = (long)i * gridDim.x + blockIdx.x; if (L >= nwg) return false;
    int wgid = (int)L; { const int q = nwg / 8, r = nwg % 8, xcd = wgid % 8, off = wgid / 8; wgid = (xcd < r ? xcd * (q + 1) : r * (q + 1) + (xcd - r) * q) + off; }
    const int nig = 8 * nN, gid = wgid / nig, fm = gid * 8, gsz = (nM - fm) < 8 ? (nM - fm) : 8;
    pm = fm + ((wgid % nig) % gsz); pn = (wgid % nig) / gsz; return true;
}

constexpr int ES = 132;
__device__ __forceinline__ void stage_quadrant(const f32x4 (&acc)[2][2][4][2], int ai, int bj, float* E, int tz) {
    const int wid = tz >> 6, lane = tz & 63, wr = wid >> 2, wc = wid & 3, fr = lane & 15, fq = lane >> 4;
#pragma unroll
    for (int m = 0; m < 4; ++m)
#pragma unroll
        for (int n = 0; n < 2; ++n) *(f32x4*)(E + (wr * 64 + m * 16 + fr) * ES + wc * 32 + n * 16 + fq * 4) = acc[ai][bj][m][n];
}
__device__ __forceinline__ void read_rowpart(const float* E, int r, int part, float* x1, float* x2) {
#pragma unroll
    for (int q = 0; q < 4; ++q) {
        const f32x4 a = *(const f32x4*)(E + r * ES + 16 * part + 4 * q), b = *(const f32x4*)(E + r * ES + 64 + 16 * part + 4 * q);
        x1[4 * q] = a.x; x1[4 * q + 1] = a.y; x1[4 * q + 2] = a.z; x1[4 * q + 3] = a.w;
        x2[4 * q] = b.x; x2[4 * q + 1] = b.y; x2[4 * q + 2] = b.z; x2[4 * q + 3] = b.w;
    }
}

constexpr int ES16 = 264;
__device__ __forceinline__ void stage_full16(const f32x4 (&acc)[2][2][4][2], h16* E16, int tz) {
    const int wid = tz >> 6, lane = tz & 63, wr = wid >> 2, wc = wid & 3, fr = lane & 15, fq = lane >> 4;
#pragma unroll
    for (int ai = 0; ai < 2; ++ai)
#pragma unroll
        for (int bj = 0; bj < 2; ++bj)
#pragma unroll
            for (int m = 0; m < 4; ++m)
#pragma unroll
                for (int n = 0; n < 2; ++n) {
                    const f32x4 a = acc[ai][bj][m][n];
                    f32x2 o; o.x = __uint_as_float(pkh(a.x, a.y)); o.y = __uint_as_float(pkh(a.z, a.w));
                    *(f32x2*)(E16 + (ai * 128 + wr * 64 + m * 16 + fr) * ES16 + bj * 128 + wc * 32 + n * 16 + fq * 4) = o;
                }
}
__device__ __forceinline__ void read_rowpart16(const h16* E16, int row, int bj, int part, float* x1, float* x2) {
    const h16* b = E16 + row * ES16 + bj * 128 + 16 * part;
    unpk8(*(const u32x4*)b, x1); unpk8(*(const u32x4*)(b + 8), x1 + 8);
    unpk8(*(const u32x4*)(b + 64), x2); unpk8(*(const u32x4*)(b + 72), x2 + 8);
}
template <class BODY>
__device__ __forceinline__ void epilogue_full(const f32x4 (&acc)[2][2][4][2], char* smem, BODY body) {
    h16* E16 = (h16*)smem;
    const int tz = otid();
    __syncthreads();
    stage_full16(acc, E16, tz);
    __syncthreads();
    const int r = tz >> 2, part = tz & 3;
#pragma unroll 1
    for (int q = 0; q < 4; ++q) {
        float x1[16], x2[16];
        read_rowpart16(E16, (q >> 1) * 128 + r, q & 1, part, x1, x2);
        body(q >> 1, q & 1, r, part, x1, x2);
    }
    __syncthreads();
}
__device__ __forceinline__ void rope32(float* x1, float* x2, const float2* rp, int part) {
#pragma unroll
    for (int i = 0; i < 16; ++i) { const float2 cs = rp[16 * part + i]; const float a = x1[i], b = x2[i]; x1[i] = a * cs.x - b * cs.y; x2[i] = b * cs.x + a * cs.y; }
}
struct RopeRegs { f32x4 v[8]; };
__device__ __forceinline__ void rope_load(RopeRegs& rr, const float2* rp, int part) {
#pragma unroll
    for (int k = 0; k < 8; ++k) rr.v[k] = *(const f32x4*)(rp + 16 * part + 2 * k);
}
__device__ __forceinline__ void rope32r(float* x1, float* x2, const RopeRegs& rr) {
#pragma unroll
    for (int k = 0; k < 8; ++k) {
        { const float c = rr.v[k].x, s = rr.v[k].y, a = x1[2 * k], b = x2[2 * k]; x1[2 * k] = a * c - b * s; x2[2 * k] = b * c + a * s; }
        { const float c = rr.v[k].z, s = rr.v[k].w, a = x1[2 * k + 1], b = x2[2 * k + 1]; x1[2 * k + 1] = a * c - b * s; x2[2 * k + 1] = b * c + a * s; }
    }
}
template <class BUF, class LD, class PR>
__device__ __forceinline__ void epilogue_pipe(const f32x4 (&acc)[2][2][4][2], float* E, int tz, LD ld, PR pr) {
    BUF b0, b1;
    const int r = tz >> 2, part = tz & 3;
    float x1[16], x2[16];
    ld(0, 0, r, part, b0);
    __syncthreads(); stage_quadrant(acc, 0, 0, E, tz); __syncthreads(); read_rowpart(E, r, part, x1, x2); ld(0, 1, r, part, b1); pr(0, 0, r, part, b0, x1, x2);
    __syncthreads(); stage_quadrant(acc, 0, 1, E, tz); __syncthreads(); read_rowpart(E, r, part, x1, x2); ld(1, 0, r, part, b0); pr(0, 1, r, part, b1, x1, x2);
    __syncthreads(); stage_quadrant(acc, 1, 0, E, tz); __syncthreads(); read_rowpart(E, r, part, x1, x2); ld(1, 1, r, part, b1); pr(1, 0, r, part, b0, x1, x2);
    __syncthreads(); stage_quadrant(acc, 1, 1, E, tz); __syncthreads(); read_rowpart(E, r, part, x1, x2); pr(1, 1, r, part, b1, x1, x2);
}
__device__ __forceinline__ void store_h16_32(h16* dst, int part, const float* x1, const float* x2) {
    *(u32x4*)(dst + 16 * part) = pk8(x1); *(u32x4*)(dst + 16 * part + 8) = pk8(x1 + 8);
    *(u32x4*)(dst + 64 + 16 * part) = pk8(x2); *(u32x4*)(dst + 64 + 16 * part + 8) = pk8(x2 + 8);
}
__device__ __forceinline__ void store_fp8_32(unsigned char* dst, int part, const float* x1, const float* x2, float sc) {
    u32x4 a, b;
#pragma unroll
    for (int q = 0; q < 4; ++q) {
        int w = __builtin_amdgcn_cvt_pk_fp8_f32(x1[4 * q] * sc, x1[4 * q + 1] * sc, 0, false);
        w = __builtin_amdgcn_cvt_pk_fp8_f32(x1[4 * q + 2] * sc, x1[4 * q + 3] * sc, w, true); a[q] = (unsigned)w;
        int v = __builtin_amdgcn_cvt_pk_fp8_f32(x2[4 * q] * sc, x2[4 * q + 1] * sc, 0, false);
        v = __builtin_amdgcn_cvt_pk_fp8_f32(x2[4 * q + 2] * sc, x2[4 * q + 3] * sc, v, true); b[q] = (unsigned)v;
    }
    *(u32x4*)(dst + 16 * part) = a; *(u32x4*)(dst + 64 + 16 * part) = b;
}
__device__ __forceinline__ void store_f32_32(float* dst, int part, const float* x1, const float* x2) {
#pragma unroll
    for (int q = 0; q < 4; ++q) {
        f32x4 a = {x1[4 * q], x1[4 * q + 1], x1[4 * q + 2], x1[4 * q + 3]}, b = {x2[4 * q], x2[4 * q + 1], x2[4 * q + 2], x2[4 * q + 3]};
        *(f32x4*)(dst + 16 * part + 4 * q) = a; *(f32x4*)(dst + 64 + 16 * part + 4 * q) = b;
    }
}
__device__ __forceinline__ float quad_sum(float v) { v += __shfl_xor(v, 1); v += __shfl_xor(v, 2); return v; }

__device__ __forceinline__ void inproj_block(const Params& p, int cb, int tok, int part, float* x1, float* x2, const RopeRegs& rr) {
    if (cb < 8) {
        rope32r(x1, x2, rr); store_h16_32(p.RQ + (size_t)tok * 1024 + cb * 128, part, x1, x2);
    } else if (cb < 16) {
        rope32r(x1, x2, rr);
#pragma unroll
        for (int i = 0; i < 16; ++i) { x1[i] *= 0.08838834764831845f; x2[i] *= 0.08838834764831845f; }
        store_h16_32(p.RK + (size_t)tok * 1024 + (cb - 8) * 128, part, x1, x2);
    } else if (cb < 32) {
        store_h16_32(p.RV + (size_t)tok * 2048 + (cb - 16) * 128, part, x1, x2);
    } else if (cb < 48) {
#pragma unroll
        for (int i = 0; i < 16; ++i) { x1[i] = siluf_(x1[i]); x2[i] = siluf_(x2[i]); }
        store_h16_32(p.RG + (size_t)tok * 2048 + (cb - 32) * 128, part, x1, x2);
    } else if (cb < 68) {
        const bool isq = cb < 64;
        float ss = 0.f;
#pragma unroll
        for (int i = 0; i < 16; ++i) ss += x1[i] * x1[i] + x2[i] * x2[i];
        ss = quad_sum(ss);
        const float rs = rsqrtf(ss * (1.f / 128.f) + EPS);
        const float* nw = isq ? p.q_norm_w : p.k_norm_w;
#pragma unroll
        for (int i = 0; i < 16; ++i) { x1[i] *= rs * nw[16 * part + i]; x2[i] *= rs * nw[64 + 16 * part + i]; }
        rope32r(x1, x2, rr);
        if (isq) {
#pragma unroll
            for (int i = 0; i < 16; ++i) { x1[i] *= 0.08838834764831845f; x2[i] *= 0.08838834764831845f; }
            store_fp8_32(p.AQ8 + (size_t)tok * 2048 + (cb - 48) * 128, part, x1, x2, 16.f);
        } else {
            store_fp8_32(p.AK8 + (size_t)tok * 512 + (cb - 64) * 128, part, x1, x2, 1.f);
            store_f32_32(p.out + O_KP + (size_t)tok * 512 + (cb - 64) * 128, part, x1, x2);
        }
    } else if (cb < 72) {
        store_h16_32(p.AV + (size_t)tok * 512 + (cb - 68) * 128, part, x1, x2);
        store_f32_32(p.out + O_VP + (size_t)tok * 512 + (cb - 68) * 128, part, x1, x2);
    } else if (cb < 88) {
        rope32r(x1, x2, rr);
#pragma unroll
        for (int i = 0; i < 16; ++i) { x1[i] *= 0.08838834764831845f; x2[i] *= 0.08838834764831845f; }
        store_h16_32(p.IQ + (size_t)tok * 2048 + (cb - 72) * 128, part, x1, x2);
    } else if (cb == 88) {
        rope32r(x1, x2, rr);
        store_h16_32(p.IK + (size_t)tok * 128, part, x1, x2);
        store_f32_32(p.out + O_IKP + (size_t)tok * 128, part, x1, x2);
    } else if (cb < 121) {
#pragma unroll
        for (int i = 0; i < 16; ++i) { x1[i] = sigmoidf_(x1[i]); x2[i] = sigmoidf_(x2[i]); }
        h16* dst = (cb < 105) ? p.GR + (size_t)tok * 2048 + (cb - 89) * 128 : p.GA + (size_t)tok * 2048 + (cb - 105) * 128;
        store_h16_32(dst, part, x1, x2);
    } else {
        if (part == 0) {
#pragma unroll
            for (int q = 0; q < 4; ++q) { f32x4 a = {x1[4 * q] * 0.25f, x1[4 * q + 1] * 0.25f, x1[4 * q + 2] * 0.25f, x1[4 * q + 3] * 0.25f}; *(f32x4*)(p.IW + (size_t)tok * 16 + 4 * q) = a; }
        }
    }
}

template <int CB, class F>
__device__ __forceinline__ void gemv8_item(const float* A, const float* W, int N, int n0, char* smem, F f, const float* normw = nullptr, float* shn_out = nullptr) {
    constexpr int C4 = CB / 4, KG = 512 / C4, NL = 2048 / KG, OUT = 8 * CB, P = 512 / OUT;
    const int tid = otid();
    float* AT = (float*)smem;
    float* red = AT + 2048 * 8;
    float* rs8 = (float*)(smem + 131072);
    __syncthreads();
    if (normw) {
        float ssl[8];
#pragma unroll
        for (int t = 0; t < 8; ++t) ssl[t] = 0.f;
#pragma unroll
        for (int j = 0; j < 32; ++j) { const int i = tid + 512 * j, t = i >> 11, k = i & 2047; const float a = A[i]; AT[k * 8 + t] = a * normw[k]; ssl[j >> 2] += a * a; }
#pragma unroll
        for (int t = 0; t < 8; ++t) { const float s = wave_sum(ssl[t]); if ((tid & 63) == 0) rs8[8 + (tid >> 6) * 8 + t] = s; }
        __syncthreads();
        if (tid < 8) { float s = 0.f; for (int w = 0; w < 8; ++w) s += rs8[8 + w * 8 + tid]; rs8[tid] = rsqrtf(s * (1.f / 2048.f) + EPS); }
        __syncthreads();
        if (shn_out) for (int i = tid; i < 8 * 2048; i += 512) { const int t = i >> 11, k = i & 2047; shn_out[i] = AT[k * 8 + t] * rs8[t]; }
    } else {
        float av32[32];
#pragma unroll
        for (int j = 0; j < 32; ++j) av32[j] = A[tid + 512 * j];
#pragma unroll
        for (int j = 0; j < 32; ++j) { const int i = tid + 512 * j, t = i >> 11, k = i & 2047; AT[k * 8 + t] = av32[j]; }
        __syncthreads();
    }
    const int c4 = tid % C4, kg = tid / C4, n = n0 + 4 * c4;
    const bool ok = (n + 3) < N;
    float acc[8][4];
#pragma unroll
    for (int t = 0; t < 8; ++t)
#pragma unroll
        for (int c = 0; c < 4; ++c) acc[t][c] = 0.f;
    const float* wp = W + (size_t)kg * N + (ok ? n : 0);
#pragma unroll 16
    for (int j = 0; j < NL; ++j) {
        const int k = kg + KG * j;
        f32x4 w = *(const f32x4*)(wp + (size_t)(KG * j) * N);
        if (!ok) w = (f32x4){0.f, 0.f, 0.f, 0.f};
        const f32x4 a0 = *(const f32x4*)(AT + k * 8), a1 = *(const f32x4*)(AT + k * 8 + 4);
        const float av[8] = {a0.x, a0.y, a0.z, a0.w, a1.x, a1.y, a1.z, a1.w};
#pragma unroll
        for (int t = 0; t < 8; ++t) { acc[t][0] += av[t] * w.x; acc[t][1] += av[t] * w.y; acc[t][2] += av[t] * w.z; acc[t][3] += av[t] * w.w; }
    }
#pragma unroll
    for (int t = 0; t < 8; ++t) { f32x4 v = {acc[t][0], acc[t][1], acc[t][2], acc[t][3]}; *(f32x4*)(red + (kg * 8 + t) * CB + 4 * c4) = v; }
    __syncthreads();
    {
        const int o = tid % OUT, part = tid / OUT, t = o / CB, col = o % CB;
        float s = 0.f;
#pragma unroll 8
        for (int q = 0; q < 32; ++q) s += red[((part * 32 + q) * 8 + t) * CB + col];
        if (P > 1) {
            AT[part * OUT + o] = s;
            __syncthreads();
            if (tid < OUT) {
                s = 0.f;
#pragma unroll
                for (int q = 0; q < P; ++q) s += AT[q * OUT + o];
            }
        }
        if (tid < OUT && (n0 + col) < N) f(t, n0 + col, normw ? s * rs8[t] : s);
    }
}

__device__ __forceinline__ void late_weight_transposes(const Params& p, char* smem, int first) {
    const int t0 = otid(), lane = t0 & 63, wave = t0 >> 6;
    const int G = gridDim.x, gw = ((int)blockIdx.x - first) * 8 + wave, NGW = (G - first) * 8;
    float* scr = (float*)smem + wave * (64 * 33);
    constexpr int I_SQ = 32 * 64, I_WQ = 32 * 32, NIT = 3 * I_SQ + I_WQ;
    __syncthreads();
    for (int it = gw; it < NIT; it += NGW) {
        int r = it;
        if (r < I_SQ) { p0_transpose_item<false>(p.w_ret_o, D, D, p.WrT, scr, r, 64, lane); continue; } r -= I_SQ;
        if (r < I_SQ) { p0_transpose_item<false>(p.w_att_o, D, D, p.WaT, scr, r, 64, lane); continue; } r -= I_SQ;
        if (r < I_SQ) { p0_transpose_item<false>(p.w_out, D, D, p.WoT, scr, r, 64, lane); continue; } r -= I_SQ;
        p0_transpose_item<false>(p.peer_wq, D, 1024, p.WqT, scr, r, 32, lane, p.norm2_w);
    }
    __syncthreads();
}

__device__ __forceinline__ void phase1(const Params& p, char* smem) {
    const int tid = otid();
    for (int i = 0;; ++i) {
        int pm, pn; if (!unit_next(i, TP / 256, NWP / 256, pm, pn)) break;
        f32x4 acc[2][2][4][2] = {};
        gemm_core(p.XN, p.WinT, pm * 256, pn * 256, D, acc, (h16*)smem);
        epilogue_full(acc, smem, [&](int ai, int bj, int r, int part, float* x1, float* x2) {
            RopeRegs rr;
            rope_load(rr, p.ROPE + (size_t)((pm * 256 + ai * 128 + r) & (SEQ - 1)) * 64, part);
            inproj_block(p, pn * 2 + bj, pm * 256 + ai * 128 + r, part, x1, x2, rr);
        });
    }
    {
        const int G = gridDim.x, first = (G > 160) ? 160 : 0, nw = G - first;
        if ((int)blockIdx.x >= first) {
            for (int it = blockIdx.x - first; it < (NW0 + 63) / 64; it += nw) {
                float* ZS = p.ZS;
                gemv8_item<64>(p.XNS, p.w_in, NW0, it * 64, smem, [=](int t, int n, float v) { ZS[(size_t)t * NW0 + n] = v; });
            }
            late_weight_transposes(p, smem, first);
        }
    }
}

__device__ __forceinline__ void indexer_item(const Params& p, int b, int g, char* smem) {
    const int tid = otid(), lane = tid & 63, wave = tid >> 6, r16 = lane & 15, kq = lane >> 4;
    float* SC = (float*)smem;
    const int t0 = 8 * g, nkeys = 8 * g + 8, ntile = (nkeys + 15) >> 4;
    const size_t tb = (size_t)b * SEQ;
    {
        h16x8 af[2][4][4];
        float* WL = (float*)(smem + 8 * SCS * 4);
        if (tid < 128) WL[tid] = p.IW[(tb + t0) * 16 + tid];
#pragma unroll
        for (int Qg = 0; Qg < 2; ++Qg)
#pragma unroll
            for (int hg = 0; hg < 4; ++hg) {
                const h16* qp = p.IQ + (tb + t0 + Qg * 4 + (r16 >> 2)) * 2048 + (hg * 4 + (r16 & 3)) * 128 + kq * 8;
#pragma unroll
                for (int kk = 0; kk < 4; ++kk) af[Qg][hg][kk] = *(const h16x8*)(qp + kk * 32);
            }
        __syncthreads();
        f32x4 wv[2][4];
#pragma unroll
        for (int Qg = 0; Qg < 2; ++Qg)
#pragma unroll
            for (int hg = 0; hg < 4; ++hg) wv[Qg][hg] = *(const f32x4*)(WL + (Qg * 4 + kq) * 16 + hg * 4);
        const h16* kbase = p.IK + (tb + r16) * 128 + kq * 8;
        const int last = ntile - 1;
        h16x8 b0[4], b1[4], b2[4];
#define IDX_LOAD(dst, tl) { const int _t = (tl) < last ? (tl) : last; const h16* _kp = kbase + (size_t)_t * 16 * 128; \
    asm volatile("global_load_dwordx4 %0, %4, off\n\tglobal_load_dwordx4 %1, %4, off offset:64\n\tglobal_load_dwordx4 %2, %4, off offset:128\n\tglobal_load_dwordx4 %3, %4, off offset:192" \
                 : "=&v"(dst[0]), "=&v"(dst[1]), "=&v"(dst[2]), "=&v"(dst[3]) : "v"(_kp) : "memory"); }
#define IDX_WAIT8(bfr) asm volatile("s_waitcnt vmcnt(8)" : "+v"(bfr[0]), "+v"(bfr[1]), "+v"(bfr[2]), "+v"(bfr[3]) :: "memory")
#define IDX_TILE(bfr, tl) { const int _t = (tl) < last ? (tl) : last; \
    _Pragma("unroll") for (int Qg = 0; Qg < 2; ++Qg) { float sc = 0.f; \
        _Pragma("unroll") for (int hg = 0; hg < 4; ++hg) { f32x4 a = {0.f, 0.f, 0.f, 0.f}; \
            _Pragma("unroll") for (int kk = 0; kk < 4; ++kk) a = __builtin_amdgcn_mfma_f32_16x16x32_f16(af[Qg][hg][kk], bfr[kk], a, 0, 0, 0); \
            sc += wv[Qg][hg].x * fmaxf(a.x, 0.f) + wv[Qg][hg].y * fmaxf(a.y, 0.f) + wv[Qg][hg].z * fmaxf(a.z, 0.f) + wv[Qg][hg].w * fmaxf(a.w, 0.f); } \
        SC[(Qg * 4 + kq) * SCS + _t * 16 + r16] = sc; } }
#pragma unroll
        for (int Qg = 0; Qg < 2; ++Qg)
#pragma unroll
            for (int hg = 0; hg < 4; ++hg) asm volatile("" : "+v"(af[Qg][hg][0]), "+v"(af[Qg][hg][1]), "+v"(af[Qg][hg][2]), "+v"(af[Qg][hg][3]));
#pragma unroll
        for (int Qg = 0; Qg < 2; ++Qg) asm volatile("" : "+v"(wv[Qg][0]), "+v"(wv[Qg][1]), "+v"(wv[Qg][2]), "+v"(wv[Qg][3]));
        IDX_LOAD(b0, wave) IDX_LOAD(b1, wave + 8) IDX_LOAD(b2, wave + 16)
        for (int tile = wave; tile < ntile; tile += 24) {
            IDX_WAIT8(b0); IDX_TILE(b0, tile) IDX_LOAD(b0, tile + 24)
            IDX_WAIT8(b1); IDX_TILE(b1, tile + 8) IDX_LOAD(b1, tile + 32)
            IDX_WAIT8(b2); IDX_TILE(b2, tile + 16) IDX_LOAD(b2, tile + 40)
        }
        asm volatile("s_waitcnt vmcnt(0)" ::: "memory");
#undef IDX_WAIT8
#undef IDX_LOAD
#undef IDX_TILE
    }
    __syncthreads();
    {
        const int t = t0 + wave, nvalid = t + 1;
        int* outp = p.TOPI + (tb + t) * 256;
        if (nvalid <= 256) {
#pragma unroll
            for (int i = 0; i < 4; ++i) { const int j = lane + 64 * i; outp[j] = (j < nvalid) ? j : -1; }
        } else {
            unsigned u[64];
#pragma unroll
            for (int i = 0; i < 64; ++i) { const int s = i * 64 + lane; const unsigned o = f2ord(SC[wave * SCS + s]); u[i] = (s <= t) ? o : 0u; }
            unsigned tau; int need_eq;
            const int nreg = __builtin_amdgcn_readfirstlane((t >> 6) + 1);
            wave_kth_dyn<64>(u, (nreg + 7) >> 3, 256, tau, need_eq);
            const u64 lt = (1ull << lane) - 1ull;
            int base = 0, eqt = 0;
            unsigned tau2 = tau; asm volatile("" : "+v"(tau2));
            static_for<0, 16>([&](auto G4) {
                constexpr int g4 = decltype(G4)::value;
                if (g4 * 4 < nreg) {
#pragma unroll
                    for (int ii = 0; ii < 4; ++ii) {
                        constexpr int dummy = 0; (void)dummy;
                        const int i = g4 * 4 + ii;
                        const bool gt = u[i] > tau2, eq = u[i] == tau2;
                        const u64 meq = __ballot(eq);
                        const bool sel = gt || (eq && (eqt + __popcll(meq & lt)) < need_eq);
                        const u64 ms = __ballot(sel);
                        if (sel) outp[base + __popcll(ms & lt)] = i * 64 + lane;
                        base += __popcll(ms); eqt += __popcll(meq);
                    }
                    __builtin_amdgcn_sched_barrier(0);
                }
            });
        }
    }
    __syncthreads();
}

__device__ __forceinline__ void kv_item(const Params& p, int b, int h, int c, char* smem) {
    const int tid = otid(), lane = tid & 63, wave = tid >> 6;
    char* Kimg = smem;
    char* Vimg = smem + 32768;
    const size_t tok0 = (size_t)b * SEQ + c * 128;
    const float lg = ret_log_g(h);
#pragma unroll
    for (int i = 0; i < 4; ++i) {
        const int q = tid + 512 * i, tt = q >> 4, ch = q & 15;
        const u32x4 raw = *(const u32x4*)(p.RK + (tok0 + tt) * 1024 + h * 128 + ch * 8);
        float v[8]; unpk8(raw, v);
        const float dec = __expf((float)(127 - tt) * lg);
#pragma unroll
        for (int e = 0; e < 8; ++e) v[e] *= dec;
        *(u32x4*)(Kimg + (tt >> 5) * 8192 + off_b(tt & 31, ch)) = pk8(v);
    }
#pragma unroll
    for (int i = 0; i < 8; ++i) {
        const int q = tid + 512 * i, tt = q >> 5, c32 = q & 31;
        const u32x4 raw = *(const u32x4*)(p.RV + (tok0 + tt) * 2048 + h * 256 + c32 * 8);
        *(u32x4*)(Vimg + ((tt >> 5) * 2 + (c32 >> 4)) * 8192 + off_b(tt & 31, c32 & 15)) = raw;
    }
    __syncthreads();
    f32x4 acc[16];
#pragma unroll
    for (int nt = 0; nt < 16; ++nt) acc[nt] = (f32x4){0.f, 0.f, 0.f, 0.f};
    const unsigned z0 = lds_u32(smem) + tr_addr16(lane, 0, 0), z1 = lds_u32(smem) + tr_addr16(lane, 0, 1);
    static_for<0, 4>([&](auto KS) {
        constexpr int ks = decltype(KS)::value;
        const h16x8 af = tr_read8o<ks * 8192>(z0 ^ (32u * wave), z1 ^ (32u * wave));
        static_for<0, 16>([&](auto NT) {
            constexpr int nt = decltype(NT)::value;
            const h16x8 bf = tr_read8o<(ks * 2 + (nt >> 3)) * 8192>((z0 + 32768u) ^ (32u * (nt & 7)), (z1 + 32768u) ^ (32u * (nt & 7)));
            acc[nt] = __builtin_amdgcn_mfma_f32_16x16x32_f16(bf, af, acc[nt], 0, 0, 0);
        });
    });
    float* dst = p.KV + ((size_t)((b * 8 + h) * 32 + c) * 128) * 256;
#pragma unroll
    for (int nt = 0; nt < 16; ++nt) *(f32x4*)(dst + (size_t)(16 * wave + (lane & 15)) * 256 + 16 * nt + 4 * (lane >> 4)) = acc[nt];
    __syncthreads();
}

__device__ __forceinline__ void sample_post_item(const Params& p) {
    const int tid = otid();
    const float2* rp = p.ROPE + (size_t)4096 * 64;
    for (int q = tid; q < 8 * 122 * 4; q += 512) {
        const int part = q & 3, cb = (q >> 2) % 122, t = (q >> 2) / 122;
        const int col0 = (cb < 89) ? cb * 128 : (cb < 105) ? C_GR + (cb - 89) * 128 : (cb < 121) ? C_GA + (cb - 105) * 128 : C_IW;
        const float* z = p.ZS + (size_t)t * NW0 + col0;
        float x1[16], x2[16];
        if (cb < 121) {
#pragma unroll
            for (int i = 0; i < 16; ++i) { x1[i] = z[16 * part + i]; x2[i] = z[64 + 16 * part + i]; }
        } else {
#pragma unroll
            for (int i = 0; i < 16; ++i) { x1[i] = z[i]; x2[i] = 0.f; }
        }
        if (cb < 8) { rope32(x1, x2, rp, part); store_f32_32(p.SRQ + t * 1024 + cb * 128, part, x1, x2); }
        else if (cb < 16) {
            rope32(x1, x2, rp, part);
#pragma unroll
            for (int i = 0; i < 16; ++i) { x1[i] *= 0.08838834764831845f; x2[i] *= 0.08838834764831845f; }
            store_f32_32(p.SRK + t * 1024 + (cb - 8) * 128, part, x1, x2);
        } else if (cb < 32) store_f32_32(p.SRV + t * 2048 + (cb - 16) * 128, part, x1, x2);
        else if (cb < 48) {
#pragma unroll
            for (int i = 0; i < 16; ++i) { x1[i] = siluf_(x1[i]); x2[i] = siluf_(x2[i]); }
            store_f32_32(p.SRG + t * 2048 + (cb - 32) * 128, part, x1, x2);
        } else if (cb < 68) {
            const bool isq = cb < 64;
            float ss = 0.f;
#pragma unroll
            for (int i = 0; i < 16; ++i) ss += x1[i] * x1[i] + x2[i] * x2[i];
            ss = quad_sum(ss);
            const float rs = rsqrtf(ss * (1.f / 128.f) + EPS);
            const float* nw = isq ? p.q_norm_w : p.k_norm_w;
#pragma unroll
            for (int i = 0; i < 16; ++i) { x1[i] *= rs * nw[16 * part + i]; x2[i] *= rs * nw[64 + 16 * part + i]; }
            rope32(x1, x2, rp, part);
            if (isq) {
#pragma unroll
                for (int i = 0; i < 16; ++i) { x1[i] *= 0.08838834764831845f; x2[i] *= 0.08838834764831845f; }
                store_f32_32(p.SAQ + t * 2048 + (cb - 48) * 128, part, x1, x2);
            } else {
                store_f32_32(p.SAK + t * 512 + (cb - 64) * 128, part, x1, x2);
                store_f32_32(p.out + O_KS + t * 512 + (cb - 64) * 128, part, x1, x2);
            }
        } else if (cb < 72) {
            store_f32_32(p.SAV + t * 512 + (cb - 68) * 128, part, x1, x2);
            store_f32_32(p.out + O_VS + t * 512 + (cb - 68) * 128, part, x1, x2);
        } else if (cb < 88) {
        } else if (cb == 88) {
            rope32(x1, x2, rp, part);
            store_f32_32(p.SIK + t * 128, part, x1, x2);
            store_f32_32(p.out + O_IKS + t * 128, part, x1, x2);
        } else if (cb < 121) {
#pragma unroll
            for (int i = 0; i < 16; ++i) { x1[i] = sigmoidf_(x1[i]); x2[i] = sigmoidf_(x2[i]); }
            float* dst = (cb < 105) ? p.SGR + t * 2048 + (cb - 89) * 128 : p.SGA + t * 2048 + (cb - 105) * 128;
            store_f32_32(dst, part, x1, x2);
        }
    }
}

__device__ __forceinline__ void sample_indexer_item(const Params& p, int t, int kr, char* smem) {
    const int tid = otid();
    float* qs = (float*)smem;
    float* ws = qs + 2048;
    float* kself = ws + 16;
    float* tmp = kself + 128;
    const float2* rp = p.ROPE + (size_t)4096 * 64;
    const float* z = p.ZS + (size_t)t * NW0;
    __syncthreads();
#pragma unroll
    for (int i = 0; i < 2; ++i) {
        const int pr = tid + 512 * i, hh = pr >> 6, d = pr & 63;
        const float a = z[C_IQ + hh * 128 + d], b = z[C_IQ + hh * 128 + 64 + d];
        const float2 cs = rp[d];
        qs[hh * 128 + d] = (a * cs.x - b * cs.y) * 0.08838834764831845f;
        qs[hh * 128 + 64 + d] = (b * cs.x + a * cs.y) * 0.08838834764831845f;
    }
    if (tid < 16) ws[tid] = z[C_IW + tid] * 0.25f;
    if (tid < 64) { const float a = z[C_IK + tid], b = z[C_IK + 64 + tid]; const float2 cs = rp[tid]; kself[tid] = a * cs.x - b * cs.y; kself[64 + tid] = b * cs.x + a * cs.y; }
    __syncthreads();
    {
        const int lane = tid & 63, wave = tid >> 6, r16 = lane & 15, g = lane >> 4;
        h16x8 qhi[4], qlo[4];
#pragma unroll
        for (int kk = 0; kk < 4; ++kk) {
            const float* qp = qs + r16 * 128 + kk * 32 + g * 8;
            const f32x4 a = *(const f32x4*)qp, b = *(const f32x4*)(qp + 4);
            const float v[8] = {a.x, a.y, a.z, a.w, b.x, b.y, b.z, b.w};
#pragma unroll
            for (int e = 0; e < 8; ++e) { const h16 hv = (h16)v[e]; qhi[kk][e] = hv; qlo[kk][e] = (h16)(v[e] - (float)hv); }
        }
        f32x4 wv4 = *(const f32x4*)(ws + 4 * g);
        f32x4 kraw[4][4][2];
#pragma unroll
        for (int tl = 0; tl < 4; ++tl) {
            const int s = kr * 512 + (wave * 4 + tl) * 16 + r16;
            const int page = p.page_table[t * NPAGES + (s >> 7)];
            const float* kp = p.cache_kidx + ((size_t)page * PAGE + (s & 127)) * 128 + g * 8;
#pragma unroll
            for (int kk = 0; kk < 4; ++kk) { kraw[tl][kk][0] = *(const f32x4*)(kp + kk * 32); kraw[tl][kk][1] = *(const f32x4*)(kp + kk * 32 + 4); }
        }
#pragma unroll
        for (int tl = 0; tl < 4; ++tl) {
            f32x4 acc = {0.f, 0.f, 0.f, 0.f};
#pragma unroll
            for (int kk = 0; kk < 4; ++kk) {
                const f32x4 a = kraw[tl][kk][0], b = kraw[tl][kk][1];
                const float v[8] = {a.x, a.y, a.z, a.w, b.x, b.y, b.z, b.w};
                h16x8 khi, klo;
#pragma unroll
                for (int e = 0; e < 8; ++e) { const h16 hv = (h16)v[e]; khi[e] = hv; klo[e] = (h16)(v[e] - (float)hv); }
                acc = __builtin_amdgcn_mfma_f32_16x16x32_f16(qlo[kk], khi, acc, 0, 0, 0);
                acc = __builtin_amdgcn_mfma_f32_16x16x32_f16(qhi[kk], klo, acc, 0, 0, 0);
                acc = __builtin_amdgcn_mfma_f32_16x16x32_f16(qhi[kk], khi, acc, 0, 0, 0);
            }
            float sc = wv4.x * fmaxf(acc.x, 0.f) + wv4.y * fmaxf(acc.y, 0.f) + wv4.z * fmaxf(acc.z, 0.f) + wv4.w * fmaxf(acc.w, 0.f);
            sc += __shfl_xor(sc, 16); sc += __shfl_xor(sc, 32);
            if (g == 0) p.SSC[(size_t)t * SSCS + kr * 512 + (wave * 4 + tl) * 16 + r16] = sc;
        }
    }
    if (kr == 31) {
        if (tid < 16) { float d = 0.f;
#pragma unroll 4
            for (int i = 0; i < 128; ++i) d += qs[tid * 128 + i] * kself[i]; tmp[tid] = ws[tid] * fmaxf(d, 0.f); }
        __syncthreads();
        if (tid == 0) { float sc = 0.f; for (int i = 0; i < 16; ++i) sc += tmp[i]; p.SSC[(size_t)t * SSCS + PAST] = sc; }
    }
    __syncthreads();
}

__device__ __forceinline__ void phase2(const Params& p, char* smem) {
    const int c = blockIdx.x, G = gridDim.x;
    for (int k = 0;; ++k) {
        const int rr = (k >> 1) * 2 * G, r = (k & 1) ? rr + 2 * G - 1 - c : rr + c;
        if (rr >= 1024) break;
        if (r < 1024) indexer_item(p, r & 1, 511 - (r >> 1), smem);
    }
    for (int it = c; it < 512; it += G) kv_item(p, it >> 8, (it >> 5) & 7, it & 31, smem);
    for (int it = c; it < 256; it += G) sample_indexer_item(p, it >> 5, it & 31, smem);
    if (c == G - 1) sample_post_item(p);
}

__device__ __forceinline__ void scan_item(const Params& p, int item) {
    const int idx = item * 512 + otid();
    const int dv = idx & 255, dkb = (idx >> 8) & 15, h = (idx >> 12) & 7, b = idx >> 15;
    const float gC = __expf(128.f * ret_log_g(h));
    float S[8];
#pragma unroll
    for (int i = 0; i < 8; ++i) S[i] = 0.f;
    const size_t bh = (size_t)(b * 8 + h);
#pragma unroll 4
    for (int c = 0; c < 32; ++c) {
        *(u32x4*)(p.SPT + (((bh * 32 + c) * 256 + dv) * 128) + dkb * 8) = pk8(S);
        const float* kv = p.KV + ((bh * 32 + c) * 128 + dkb * 8) * 256 + dv;
#pragma unroll
        for (int i = 0; i < 8; ++i) S[i] = gC * S[i] + kv[(size_t)i * 256];
    }
#pragma unroll
    for (int i = 0; i < 8; ++i) p.out[O_SP + (bh * 128 + dkb * 8 + i) * 256 + dv] = S[i];
}

__device__ __forceinline__ void attn_item(const Params& p, int b, int n, int qg, char* smem) {
    const int tid = otid(), lane = tid & 63, wave = tid >> 6, r16 = lane & 15, g = lane >> 4;
    const int tt = 8 * qg + wave, t = b * SEQ + tt;
    const int cnt = (tt + 1 < 256) ? tt + 1 : 256;
    int* lidx = (int*)(smem + wave * 9216);
    char* img = smem + wave * 9216 + 1024;
    const unsigned az0 = lds_u32(img) + tr_addr16(lane, 0, 0), az1 = lds_u32(img) + tr_addr16(lane, 0, 1);
    const size_t tb = (size_t)b * SEQ;
#pragma unroll
    for (int i = 0; i < 4; ++i) { const int v = p.TOPI[(size_t)t * 256 + lane + 64 * i]; lidx[lane + 64 * i] = v < 0 ? 0 : v; }
    long qf[4];
    {
        const unsigned char* qp = p.AQ8 + (size_t)t * 2048 + (n * 4 + (r16 & 3)) * 128 + 16 * g;
        u32x4 c0 = *(const u32x4*)qp, c1 = *(const u32x4*)(qp + 64);
        if (r16 >= 4) { c0 = (u32x4){0u, 0u, 0u, 0u}; c1 = c0; }
        qf[0] = (long)(((u64)c0.y << 32) | c0.x); qf[1] = (long)(((u64)c0.w << 32) | c0.z);
        qf[2] = (long)(((u64)c1.y << 32) | c1.x); qf[3] = (long)(((u64)c1.w << 32) | c1.z);
    }
    const unsigned char* kbase = p.AK8 + tb * 512 + n * 128 + 16 * g;
    const h16* vbase = p.AV + tb * 512 + n * 128;
    f32x4 sacc[16];
    {
        u32x4 kf[16][2];
#pragma unroll
        for (int i = 0; i < 16; ++i) {
            const unsigned char* kp = kbase + (size_t)lidx[16 * i + r16] * 512;
            kf[i][0] = *(const u32x4*)kp; kf[i][1] = *(const u32x4*)(kp + 64);
        }
#pragma unroll
        for (int i = 0; i < 16; ++i) {
            const u32x4 k0 = kf[i][0], k1 = kf[i][1];
            f32x4 a = {0.f, 0.f, 0.f, 0.f};
            a = __builtin_amdgcn_mfma_f32_16x16x32_fp8_fp8((long)(((u64)k0.y << 32) | k0.x), qf[0], a, 0, 0, 0);
            a = __builtin_amdgcn_mfma_f32_16x16x32_fp8_fp8((long)(((u64)k0.w << 32) | k0.z), qf[1], a, 0, 0, 0);
            a = __builtin_amdgcn_mfma_f32_16x16x32_fp8_fp8((long)(((u64)k1.y << 32) | k1.x), qf[2], a, 0, 0, 0);
            a = __builtin_amdgcn_mfma_f32_16x16x32_fp8_fp8((long)(((u64)k1.w << 32) | k1.z), qf[3], a, 0, 0, 0);
#pragma unroll
            for (int j = 0; j < 4; ++j) sacc[i][j] = ((16 * i + 4 * g + j) < cnt) ? a[j] * (1.f / 16.f) : -3.0e38f;
        }
    }
    u32x4 vr[3][8];
#pragma unroll
    for (int b0 = 0; b0 < 3; ++b0)
#pragma unroll
        for (int i2 = 0; i2 < 8; ++i2) {
            const int q = lane + 64 * i2, s = q >> 4, ch = q & 15;
            const int slot = (2 * b0 + ((s >> 2) & 1)) * 16 + 4 * (s >> 3) + (s & 3);
            vr[b0][i2] = *(const u32x4*)(vbase + (size_t)lidx[slot] * 512 + ch * 8);
        }
    float mx = -3.0e38f;
#pragma unroll
    for (int i = 0; i < 16; ++i)
#pragma unroll
        for (int j = 0; j < 4; ++j) mx = fmaxf(mx, sacc[i][j]);
    mx = fmaxf(mx, __shfl_xor(mx, 16)); mx = fmaxf(mx, __shfl_xor(mx, 32));
    float sum = 0.f;
#pragma unroll
    for (int i = 0; i < 16; ++i)
#pragma unroll
        for (int j = 0; j < 4; ++j) { const float e = __expf(sacc[i][j] - mx); sacc[i][j] = e; sum += e; }
    sum += __shfl_xor(sum, 16); sum += __shfl_xor(sum, 32);
    f32x4 oacc[8];
#pragma unroll
    for (int c = 0; c < 8; ++c) oacc[c] = (f32x4){0.f, 0.f, 0.f, 0.f};
#pragma unroll
    for (int bI = 0; bI < 8; ++bI) {
#pragma unroll
        for (int i2 = 0; i2 < 8; ++i2) { const int q = lane + 64 * i2; *(u32x4*)(img + off_b(q >> 4, q & 15)) = vr[bI % 3][i2]; }
        if (bI + 3 < 8) {
#pragma unroll
            for (int i2 = 0; i2 < 8; ++i2) {
                const int q = lane + 64 * i2, s = q >> 4, ch = q & 15;
                const int slot = (2 * (bI + 3) + ((s >> 2) & 1)) * 16 + 4 * (s >> 3) + (s & 3);
                vr[bI % 3][i2] = *(const u32x4*)(vbase + (size_t)lidx[slot] * 512 + ch * 8);
            }
        }
        h16x8 pf;
        {
            const f32x4 a0 = sacc[2 * bI], a1 = sacc[2 * bI + 1];
            pf[0] = (h16)a0.x; pf[1] = (h16)a0.y; pf[2] = (h16)a0.z; pf[3] = (h16)a0.w;
            pf[4] = (h16)a1.x; pf[5] = (h16)a1.y; pf[6] = (h16)a1.z; pf[7] = (h16)a1.w;
        }
#pragma unroll
        for (int c0 = 0; c0 < 8; c0 += 4) {
            h16x8 vf[4];
            tr_read8x4(az0, az1, c0, vf);
#pragma unroll
            for (int c = 0; c < 4; ++c) oacc[c0 + c] = __builtin_amdgcn_mfma_f32_16x16x32_f16(pf, vf[c], oacc[c0 + c], 0, 0, 0);
        }
    }
    float inv[4];
#pragma unroll
    for (int j = 0; j < 4; ++j) inv[j] = 1.f / __shfl(sum, j);
    h16* ost = (h16*)img;
    if (g == 0) {
#pragma unroll
        for (int c = 0; c < 8; ++c)
#pragma unroll
            for (int j = 0; j < 4; ++j) ost[j * 128 + 16 * c + r16] = (h16)(oacc[c][j] * inv[j]);
    }
    asm volatile("s_waitcnt lgkmcnt(0)" ::: "memory");
    *(u32x4*)(p.ATT + (size_t)t * 2048 + n * 512 + lane * 8) = *(const u32x4*)(ost + lane * 8);
    asm volatile("s_waitcnt lgkmcnt(0)" ::: "memory");
}

__device__ __forceinline__ void sample_topk_item(const Params& p, int t, char* smem) {
    const int tid = otid(), lane = tid & 63, wave = tid >> 6;
    int* red = (int*)smem;
    int* cnts = red + 16;
    __syncthreads();
    unsigned u[33];
#pragma unroll
    for (int i = 0; i < 33; ++i) { const int s = i * 512 + tid; u[i] = (s < LS) ? f2ord(p.SSC[(size_t)t * SSCS + s]) : 0u; }
    unsigned tau = 0u;
    for (int bit = 31; bit >= 0; --bit) {
        const unsigned cand = tau | (1u << bit);
        int c = 0;
#pragma unroll
        for (int i = 0; i < 33; ++i) c += (u[i] >= cand) ? 1 : 0;
#pragma unroll
        for (int o = 32; o > 0; o >>= 1) c += __shfl_xor(c, o);
        if (lane == 0) red[wave] = c;
        __syncthreads();
        int tot = 0;
#pragma unroll
        for (int w = 0; w < 8; ++w) tot += red[w];
        __syncthreads();
        if (tot >= 256) tau = cand;
    }
    const u64 lt = (1ull << lane) - 1ull;
#pragma unroll
    for (int i = 0; i < 33; ++i) {
        const u64 mg = __ballot(u[i] > tau), me = __ballot(u[i] == tau);
        if (lane == 0) { cnts[i * 8 + wave] = __popcll(mg); cnts[264 + i * 8 + wave] = __popcll(me); }
        if ((i & 3) == 3) __builtin_amdgcn_sched_barrier(0);
    }
    __syncthreads();
    int cg_tot = 0;
#pragma unroll 8
    for (int i = 0; i < 264; ++i) cg_tot += cnts[i];
    const int need_eq = 256 - cg_tot;
    int eq_before = 0, sel_before = 0;
    int* outp = p.STOP + t * 256;
    unsigned tau2 = tau; asm volatile("" : "+v"(tau2));
#pragma unroll
    for (int i = 0; i < 33; ++i) {
        int eb = eq_before, sb = sel_before;
        for (int w = 0; w < wave; ++w) {
            const int ng = cnts[i * 8 + w], ne = cnts[264 + i * 8 + w];
            int take_e = need_eq - eb; take_e = take_e < 0 ? 0 : (take_e > ne ? ne : take_e);
            eb += ne; sb += ng + take_e;
        }
        const bool gt = u[i] > tau2, eq = u[i] == tau2;
        const u64 me = __ballot(eq);
        const bool sel = gt || (eq && (eb + __popcll(me & lt)) < need_eq);
        const u64 ms = __ballot(sel);
        if (sel) outp[sb + __popcll(ms & lt)] = i * 512 + tid;
        for (int w = 0; w < 8; ++w) {
            const int ng = cnts[i * 8 + w], ne = cnts[264 + i * 8 + w];
            int take_e = need_eq - eq_before; take_e = take_e < 0 ? 0 : (take_e > ne ? ne : take_e);
            eq_before += ne; sel_before += ng + take_e;
        }
        __builtin_amdgcn_sched_barrier(0);
    }
    __syncthreads();
}

__device__ __forceinline__ void phase3(const Params& p, char* smem, int rep) {
    const int c = blockIdx.x, G = gridDim.x;
    for (int it = c; it < 136; it += G) { if (it < 128) scan_item(p, it); else sample_topk_item(p, it - 128, smem); }
    volatile int* s_next = (volatile int*)(smem + LDS_BYTES - 64);
    const unsigned home = xb_xcc_id() & 7u;
    int dead = 0;
    for (;;) {
        __syncthreads();
        if (threadIdx.x == 0) {
            int it = -1;
            for (int qi = dead; qi < 8; ++qi) {
                const unsigned q = (home + qi) & 7u;
                const int v = (int)atomicAdd(&p.ctl[4096 + 512 * rep + 64 * q], 2u);
                if (v < 512) { it = (int)q * 512 + v; s_next[1] = qi; break; }
            }
            if (it < 0) s_next[1] = 8;
            s_next[0] = it;
        }
        __syncthreads();
        const int it = s_next[0];
        dead = s_next[1];
        if (it < 0) break;
        const int q = it >> 9;
        attn_item(p, q >> 2, q & 3, it & 511, smem);
        attn_item(p, q >> 2, q & 3, (it & 511) + 1, smem);
    }
}

__device__ __forceinline__ void retout_item(const Params& p, int b, int h, int c, char* smem) {
    const int tid = otid(), lane = tid & 63, wave = tid >> 6, r16 = lane & 15, g = lane >> 4;
    char* Vimg = smem;
    const size_t tok0 = (size_t)b * SEQ + c * 128;
    const float lg = ret_log_g(h);
#pragma unroll
    for (int i = 0; i < 8; ++i) {
        const int q = tid + 512 * i, sg = q >> 5, c32 = q & 31, bI = sg >> 5, s = sg & 31;
        const int tokl = bI * 32 + ((s >> 2) & 1) * 16 + 4 * (s >> 3) + (s & 3);
        const u32x4 raw = *(const u32x4*)(p.RV + (tok0 + tokl) * 2048 + h * 256 + c32 * 8);
        *(u32x4*)(Vimg + (bI * 2 + (c32 >> 4)) * 8192 + off_b(s, c32 & 15)) = raw;
    }
    __syncthreads();
    const int il = 16 * wave + r16;
    h16x8 qf[4], qd[4];
    {
        const h16* qp = p.RQ + (tok0 + il) * 1024 + h * 128 + g * 8;
        const float dq = __expf((float)(il + 1) * lg);
#pragma unroll
        for (int kk = 0; kk < 4; ++kk) {
            const u32x4 raw = *(const u32x4*)(qp + kk * 32);
            qf[kk] = __builtin_bit_cast(h16x8, raw);
            float v[8]; unpk8(raw, v);
#pragma unroll
            for (int e = 0; e < 8; ++e) v[e] *= dq;
            qd[kk] = __builtin_bit_cast(h16x8, pk8(v));
        }
    }
    f32x4 sacc[8];
#pragma unroll
    for (int jr = 0; jr < 2; ++jr) {
        h16x8 kf[4][4];
        if (4 * jr <= wave) {
#pragma unroll
            for (int q = 0; q < 4; ++q) {
                const int jt = 4 * jr + q, jc = jt <= wave ? jt : wave;
                const h16* kp = p.RK + (tok0 + 16 * jc + r16) * 1024 + h * 128 + g * 8;
#pragma unroll
                for (int kk = 0; kk < 4; ++kk) kf[q][kk] = *(const h16x8*)(kp + kk * 32);
            }
        }
#pragma unroll
        for (int q = 0; q < 4; ++q) {
            const int jt = 4 * jr + q;
            sacc[jt] = (f32x4){0.f, 0.f, 0.f, 0.f};
            if (jt <= wave) {
#pragma unroll
                for (int kk = 0; kk < 4; ++kk) sacc[jt] = __builtin_amdgcn_mfma_f32_16x16x32_f16(kf[q][kk], qf[kk], sacc[jt], 0, 0, 0);
#pragma unroll
                for (int j = 0; j < 4; ++j) { const int jl = 16 * jt + 4 * g + j; sacc[jt][j] = (il >= jl) ? sacc[jt][j] * __expf((float)(il - jl) * lg) : 0.f; }
            }
        }
        __builtin_amdgcn_sched_barrier(0);
    }
    f32x4 oacc[16];
    const h16* sp = p.SPT + ((size_t)((b * 8 + h) * 32 + c) * 256) * 128;
#pragma unroll
    for (int er = 0; er < 4; ++er) {
        h16x8 sf[4][4];
#pragma unroll
        for (int q = 0; q < 4; ++q) {
            const h16* sr = sp + (size_t)(16 * (4 * er + q) + r16) * 128 + g * 8;
#pragma unroll
            for (int kk = 0; kk < 4; ++kk) sf[q][kk] = *(const h16x8*)(sr + kk * 32);
        }
#pragma unroll
        for (int q = 0; q < 4; ++q) {
            const int et = 4 * er + q;
            oacc[et] = (f32x4){0.f, 0.f, 0.f, 0.f};
#pragma unroll
            for (int kk = 0; kk < 4; ++kk) oacc[et] = __builtin_amdgcn_mfma_f32_16x16x32_f16(sf[q][kk], qd[kk], oacc[et], 0, 0, 0);
        }
        __builtin_amdgcn_sched_barrier(0);
    }
    const unsigned rz0 = lds_u32(Vimg) + tr_addr16(lane, 0, 0), rz1 = lds_u32(Vimg) + tr_addr16(lane, 0, 1);
    static_for<0, 4>([&](auto BI) {
        constexpr int bI = decltype(BI)::value;
        if (2 * bI <= wave) {
            h16x8 pf;
            const f32x4 a0 = sacc[2 * bI], a1 = sacc[2 * bI + 1];
            pf[0] = (h16)a0.x; pf[1] = (h16)a0.y; pf[2] = (h16)a0.z; pf[3] = (h16)a0.w;
            pf[4] = (h16)a1.x; pf[5] = (h16)a1.y; pf[6] = (h16)a1.z; pf[7] = (h16)a1.w;
            static_for<0, 16>([&](auto ET) {
                constexpr int et = decltype(ET)::value;
                const h16x8 vf = tr_read8o<(bI * 2 + (et >> 3)) * 8192>(rz0 ^ (32u * (et & 7)), rz1 ^ (32u * (et & 7)));
                oacc[et] = __builtin_amdgcn_mfma_f32_16x16x32_f16(vf, pf, oacc[et], 0, 0, 0);
            });
        }
    });
    float s1 = 0.f;
#pragma unroll
    for (int et = 0; et < 16; ++et) s1 += oacc[et].x + oacc[et].y + oacc[et].z + oacc[et].w;
    s1 += __shfl_xor(s1, 16); s1 += __shfl_xor(s1, 32);
    const float mu = s1 * (1.f / 256.f);
    float s2 = 0.f;
#pragma unroll
    for (int et = 0; et < 16; ++et)
#pragma unroll
        for (int j = 0; j < 4; ++j) { const float d = oacc[et][j] - mu; s2 += d * d; }
    s2 += __shfl_xor(s2, 16); s2 += __shfl_xor(s2, 32);
    const float rs = rsqrtf(s2 * (1.f / 256.f) + EPS);
    const size_t tok = tok0 + il;
#pragma unroll
    for (int et = 0; et < 16; ++et) {
        const int e0 = h * 256 + 16 * et + 4 * g;
        const f32x4 gw = *(const f32x4*)(p.ret_gn_w + e0);
        const f32x2 rgraw = *(const f32x2*)(p.RG + tok * 2048 + e0);
        const float rgx = rgraw.x, rgy = rgraw.y;
        const h16x2 r0 = __builtin_bit_cast(h16x2, rgx), r1 = __builtin_bit_cast(h16x2, rgy);
        const float o0 = (oacc[et].x - mu) * rs * gw.x * (float)r0.x, o1 = (oacc[et].y - mu) * rs * gw.y * (float)r0.y;
        const float o2 = (oacc[et].z - mu) * rs * gw.z * (float)r1.x, o3 = (oacc[et].w - mu) * rs * gw.w * (float)r1.y;
        f32x2 o; o.x = __uint_as_float(pkh(o0, o1)); o.y = __uint_as_float(pkh(o2, o3));
        *(f32x2*)(p.RN + tok * 2048 + e0) = o;
    }
    __syncthreads();
}

__device__ __forceinline__ void sample_ret_item(const Params& p, int t, int h, char* smem) {
    const int tid = otid(), dv = tid & 255, half = tid >> 8;
    float* qs = (float*)smem;
    float* ks = qs + 128;
    float* part = ks + 128;
    float* red = part + 512;
    __syncthreads();
    if (tid < 128) { qs[tid] = p.SRQ[t * 1024 + h * 128 + tid]; ks[tid] = p.SRK[t * 1024 + h * 128 + tid]; }
    __syncthreads();
    const float gm = 1.f - exp2f(-5.f - (float)h);
    float qk = 0.f;
#pragma unroll 4
    for (int i = 0; i < 128; ++i) qk += qs[i] * ks[i];
    const float v = p.SRV[t * 2048 + h * 256 + dv];
    const float* Sin = p.state_ret + ((size_t)(t * 8 + h) * 128) * 256;
    float* Sout = p.out + O_SS + ((size_t)(t * 8 + h) * 128) * 256;
    float cross = 0.f;
#pragma unroll 8
    for (int i = 0; i < 64; ++i) {
        const int dk = half * 64 + i;
        const float s = Sin[(size_t)dk * 256 + dv];
        cross += qs[dk] * s;
        Sout[(size_t)dk * 256 + dv] = gm * s + ks[dk] * v;
    }
    part[half * 256 + dv] = cross;
    __syncthreads();
    float o = 0.f;
    if (tid < 256) o = qk * v + gm * (part[dv] + part[256 + dv]);
    float s1 = (tid < 256) ? o : 0.f;
    s1 = wave_sum(s1);
    if ((tid & 63) == 0) red[tid >> 6] = s1;
    __syncthreads();
    const float mu = (red[0] + red[1] + red[2] + red[3]) * (1.f / 256.f);
    float d = (tid < 256) ? (o - mu) : 0.f;
    float s2 = wave_sum(d * d);
    if ((tid & 63) == 0) red[8 + (tid >> 6)] = s2;
    __syncthreads();
    const float rs = rsqrtf((red[8] + red[9] + red[10] + red[11]) * (1.f / 256.f) + EPS);
    if (tid < 256) p.SRN[t * 2048 + h * 256 + dv] = d * rs * p.ret_gn_w[h * 256 + dv] * p.SRG[t * 2048 + h * 256 + dv];
    __syncthreads();
}

__device__ __forceinline__ void sample_attn_item(const Params& p, int t, int n, char* smem) {
    const int tid = otid(), lane = tid & 63, wave = tid >> 6;
    float* qs = (float*)smem;
    int* rowk = (int*)(smem + 2048);
    float* lg = (float*)(smem + 3072);
    float* part = (float*)(smem + 7168);
    float* sums = (float*)(smem + 23552);
    __syncthreads();
    qs[tid] = p.SAQ[t * 2048 + n * 512 + tid];
    if (tid < 256) { const int idx = p.STOP[t * 256 + tid]; rowk[tid] = (idx < PAST) ? p.page_table[t * NPAGES + (idx >> 7)] * PAGE + (idx & 127) : -1; }
    __syncthreads();
    {
        const int key = wave * 32 + (lane >> 1), dh = lane & 1, row = rowk[key];
        const float* kp = (row >= 0) ? p.cache_k + ((size_t)row * 4 + n) * 128 + dh * 64 : p.SAK + t * 512 + n * 128 + dh * 64;
        f32x4 kv[16];
#pragma unroll
        for (int i = 0; i < 16; ++i) kv[i] = *(const f32x4*)(kp + 4 * i);
#pragma unroll
        for (int h = 0; h < 4; ++h) {
            float d = 0.f;
#pragma unroll
            for (int i = 0; i < 16; ++i) { const f32x4 q = *(const f32x4*)(qs + h * 128 + dh * 64 + 4 * i); d += kv[i].x * q.x + kv[i].y * q.y + kv[i].z * q.z + kv[i].w * q.w; }
            d += __shfl_xor(d, 1);
            if (dh == 0) lg[h * 256 + key] = d;
        }
    }
    __syncthreads();
    if (wave < 4) {
        float v[4];
#pragma unroll
        for (int i = 0; i < 4; ++i) v[i] = lg[wave * 256 + lane + 64 * i];
        const float mx = wave_max(fmaxf(fmaxf(v[0], v[1]), fmaxf(v[2], v[3])));
        float s = 0.f;
#pragma unroll
        for (int i = 0; i < 4; ++i) { v[i] = __expf(v[i] - mx); s += v[i]; lg[wave * 256 + lane + 64 * i] = v[i]; }
        s = wave_sum(s);
        if (lane == 0) sums[wave] = s;
    }
    __syncthreads();
    {
        const int sub = lane >> 4, dc = lane & 15;
        float acc[4][8];
#pragma unroll
        for (int h = 0; h < 4; ++h)
#pragma unroll
            for (int e = 0; e < 8; ++e) acc[h][e] = 0.f;
        f32x4 va[8], vb[8];
#pragma unroll
        for (int j = 0; j < 8; ++j) {
            const int row = rowk[wave * 32 + sub * 8 + j];
            const float* vp = (row >= 0) ? p.cache_v + ((size_t)row * 4 + n) * 128 + dc * 8 : p.SAV + t * 512 + n * 128 + dc * 8;
            va[j] = *(const f32x4*)vp; vb[j] = *(const f32x4*)(vp + 4);
        }
#pragma unroll
        for (int j = 0; j < 8; ++j) {
            const int key = wave * 32 + sub * 8 + j;
#pragma unroll
            for (int h = 0; h < 4; ++h) {
                const float pk = lg[h * 256 + key];
                acc[h][0] += pk * va[j].x; acc[h][1] += pk * va[j].y; acc[h][2] += pk * va[j].z; acc[h][3] += pk * va[j].w;
                acc[h][4] += pk * vb[j].x; acc[h][5] += pk * vb[j].y; acc[h][6] += pk * vb[j].z; acc[h][7] += pk * vb[j].w;
            }
        }
#pragma unroll
        for (int h = 0; h < 4; ++h)
#pragma unroll
            for (int e = 0; e < 8; ++e) { float v = acc[h][e]; v += __shfl_xor(v, 16); v += __shfl_xor(v, 32); if (sub == 0) part[(wave * 4 + h) * 128 + dc * 8 + e] = v; }
    }
    __syncthreads();
    {
        const int h = tid >> 7, d = tid & 127;
        float o = 0.f;
#pragma unroll
        for (int w = 0; w < 8; ++w) o += part[(w * 4 + h) * 128 + d];
        p.SATT[t * 2048 + (n * 4 + h) * 128 + d] = o / sums[h];
    }
    __syncthreads();
}

__device__ __forceinline__ void phase4(const Params& p, char* smem) {
    const int c = blockIdx.x, G = gridDim.x;
    for (int it = G - 1 - c; it < 96; it += G) {
        if (it < 32) sample_attn_item(p, it >> 2, it & 3, smem);
        else sample_ret_item(p, (it - 32) >> 3, (it - 32) & 7, smem);
    }
    for (int it = c; it < 512; it += G) retout_item(p, it >> 8, (it >> 5) & 7, it & 31, smem);
}

__device__ __forceinline__ void phase5(const Params& p, char* smem) {
    const int tid = otid();
    for (int i = 0;; ++i) {
        int pm, pn; if (!unit_next(i, TP / 256, D / 256, pm, pn)) break;
        f32x4 acc[2][2][4][2] = {};
        gemm_core(p.RN, p.WrT, pm * 256, pn * 256, D, acc, (h16*)smem);
        {
            const int tz = otid(), wid = tz >> 6, lane = tz & 63, wr = wid >> 2, wc = wid & 3, fr = lane & 15, fq = lane >> 4;
            h16* R16 = (h16*)smem;
            __syncthreads();
#pragma unroll 4
            for (int i = 0; i < 16; ++i) {
                const int q = tz + 512 * i, row = q >> 5, ch = q & 31;
                const size_t off = (size_t)(pm * 256 + row) * D + pn * 256 + ch * 8;
                float gr[8], ga[8];
                unpk8(*(const u32x4*)(p.GR + off), gr); unpk8(*(const u32x4*)(p.GA + off), ga);
#pragma unroll
                for (int e = 0; e < 8; ++e) gr[e] *= __builtin_amdgcn_rcpf(fmaxf(ga[e], 1e-4f));
                *(u32x4*)(R16 + row * ES16 + ch * 8) = pk8(gr);
            }
            __syncthreads();
#pragma unroll
            for (int ai = 0; ai < 2; ++ai)
#pragma unroll
                for (int bj = 0; bj < 2; ++bj)
#pragma unroll
                    for (int m = 0; m < 4; ++m)
#pragma unroll
                        for (int n = 0; n < 2; ++n) {
                            const f32x2 rr = *(const f32x2*)(R16 + (ai * 128 + wr * 64 + m * 16 + fr) * ES16 + bj * 128 + wc * 32 + n * 16 + fq * 4);
                            const float rx = rr.x, ry = rr.y;
                            const h16x2 r0 = __builtin_bit_cast(h16x2, rx), r1 = __builtin_bit_cast(h16x2, ry);
                            acc[ai][bj][m][n].x *= (float)r0.x; acc[ai][bj][m][n].y *= (float)r0.y; acc[ai][bj][m][n].z *= (float)r1.x; acc[ai][bj][m][n].w *= (float)r1.y;
                        }
        }
        __syncthreads();
        gemm_core(p.ATT, p.WaT, pm * 256, pn * 256, D, acc, (h16*)smem);
        epilogue_full(acc, smem, [&](int ai, int bj, int r, int part, float* x1, float* x2) {
            const size_t rowoff = (size_t)(pm * 256 + ai * 128 + r) * D + pn * 256 + bj * 128;
            const h16* gp = p.GA + rowoff;
            float g1[16], g2[16];
            unpk8(*(const u32x4*)(gp + 16 * part), g1); unpk8(*(const u32x4*)(gp + 16 * part + 8), g1 + 8);
            unpk8(*(const u32x4*)(gp + 64 + 16 * part), g2); unpk8(*(const u32x4*)(gp + 64 + 16 * part + 8), g2 + 8);
#pragma unroll
            for (int e = 0; e < 16; ++e) { x1[e] *= fmaxf(g1[e], 1e-4f); x2[e] *= fmaxf(g2[e], 1e-4f); }
            store_h16_32(p.MIX + rowoff, part, x1, x2);
        });
    }
    for (int it = blockIdx.x; it < 256; it += gridDim.x) {
        float* SMIX = p.SMIX; const float* SGR = p.SGR; const float* SGA = p.SGA;
        gemv8_item<8>(p.SRN, p.w_ret_o, D, it * 8, smem, [=](int t, int n, float v) { SMIX[t * D + n] = SGR[t * D + n] * v; });
        gemv8_item<8>(p.SATT, p.w_att_o, D, it * 8, smem, [=](int t, int n, float v) { SMIX[t * D + n] += SGA[t * D + n] * v; });
    }
}

__device__ __forceinline__ void phase6(const Params& p, char* smem) {
    const int tid = otid();
    for (int i = 0;; ++i) {
        int pm, pn; if (!unit_next(i, TP / 256, D / 256, pm, pn)) break;
        f32x4 acc[2][2][4][2] = {};
#ifdef GEMM_TWICE
        gemm_core(p.MIX, p.WoT, pm * 256, pn * 256, D, acc, (h16*)smem);
        __syncthreads();
        for (int a = 0; a < 2; ++a) for (int b = 0; b < 2; ++b) for (int m = 0; m < 4; ++m) for (int n = 0; n < 2; ++n) acc[a][b][m][n] = acc[a][b][m][n] * 0.0f;
#endif
        gemm_core(p.MIX, p.WoT, pm * 256, pn * 256, D, acc, (h16*)smem);
        epilogue_full(acc, smem, [&](int ai, int bj, int r, int part, float* x1, float* x2) {
            const size_t rowoff = (size_t)(pm * 256 + ai * 128 + r) * D + pn * 256 + bj * 128;
            const float* xp = p.x_prompt + rowoff;
#pragma unroll
            for (int q = 0; q < 4; ++q) {
                const f32x4 a = *(const f32x4*)(xp + 16 * part + 4 * q), bq = *(const f32x4*)(xp + 64 + 16 * part + 4 * q);
                x1[4 * q] += a.x; x1[4 * q + 1] += a.y; x1[4 * q + 2] += a.z; x1[4 * q + 3] += a.w;
                x2[4 * q] += bq.x; x2[4 * q + 1] += bq.y; x2[4 * q + 2] += bq.z; x2[4 * q + 3] += bq.w;
            }
            store_h16_32(p.HN + rowoff, part, x1, x2);
            float ss = 0.f;
#pragma unroll
            for (int e = 0; e < 16; ++e) ss += x1[e] * x1[e] + x2[e] * x2[e];
            ss = quad_sum(ss);
            if (part == 0) atomicAdd(p.ROWSS + pm * 256 + ai * 128 + r, ss);
        });
    }
    for (int it = blockIdx.x; it < 256; it += gridDim.x) {
        float* out = p.out; const float* xs = p.x_sample;
        gemv8_item<8>(p.SMIX, p.w_out, D, it * 8, smem, [=](int t, int n, float v) { out[O_YS + t * D + n] = xs[t * D + n] + v; });
    }
}

__device__ __forceinline__ void phase7(const Params& p) {
    const int t0 = otid(), lane = t0 & 63, gw = blockIdx.x * 8 + (t0 >> 6), NGW = gridDim.x * 8;
    for (int r = gw; r < TT; r += NGW) {
        const float* x = (r < TP) ? p.out + O_YP + (size_t)r * D : p.out + O_YS + (size_t)(r - TP) * D;
        f32x4 v[8]; float ss = 0.f;
#pragma unroll
        for (int j = 0; j < 8; ++j) { v[j] = *(const f32x4*)(x + 4 * (lane + 64 * j)); ss += v[j].x * v[j].x + v[j].y * v[j].y + v[j].z * v[j].z + v[j].w * v[j].w; }
        ss = wave_sum(ss);
        const float rs = rsqrtf(ss * (1.f / D) + EPS);
#pragma unroll
        for (int j = 0; j < 8; ++j) {
            const f32x4 w = *(const f32x4*)(p.norm2_w + 4 * (lane + 64 * j));
            const float a = v[j].x * rs * w.x, b = v[j].y * rs * w.y, c = v[j].z * rs * w.z, d = v[j].w * rs * w.w;
            if (r < TP) { f32x2 o; o.x = __uint_as_float(pkh(a, b)); o.y = __uint_as_float(pkh(c, d)); *(f32x2*)(p.HN + (size_t)r * D + 4 * (lane + 64 * j)) = o; }
            else { f32x4 o = {a, b, c, d}; *(f32x4*)(p.SHN + (size_t)(r - TP) * D + 4 * (lane + 64 * j)) = o; }
        }
    }
}

constexpr int PCV_ITER = 4;
constexpr int PCV_UCH = (int)(((size_t)NEXP * D / 32) / (512 * PCV_ITER));
constexpr int PCV_VCH = PCV_UCH;
constexpr int PCV_CHUNKS = PCV_UCH + PCV_VCH;
__device__ __forceinline__ void peer_convert_chunk(const Params& p, int chunk) {
    const int tid = otid();
    const bool isu = chunk < PCV_UCH;
    const size_t base = (size_t)(isu ? chunk : chunk - PCV_UCH) * (512 * PCV_ITER) + tid;
    const float* tab = isu ? p.peer_u : p.peer_v;
    unsigned char* outp = (unsigned char*)(isu ? p.PU : p.PV);
    const float sc = isu ? 64.f : 16.f;
#pragma unroll 2
    for (int r = 0; r < PCV_ITER; ++r) {
        const float* src = tab + (base + (size_t)r * 512) * 32;
        f32x4 a[8];
#pragma unroll
        for (int q = 0; q < 8; ++q) a[q] = *(const f32x4*)(src + 4 * q);
        if (isu) {
            const float* wk = p.norm2_w + (int)(((base + (size_t)r * 512) & 63) * 32);
#pragma unroll
            for (int q = 0; q < 8; ++q) { const f32x4 w4 = *(const f32x4*)(wk + 4 * q); a[q].x *= w4.x; a[q].y *= w4.y; a[q].z *= w4.z; a[q].w *= w4.w; }
        }
        u32x4 o;
#pragma unroll
        for (int q = 0; q < 4; ++q) {
            unsigned w = 0u;
            w = __builtin_amdgcn_cvt_scalef32_pk_fp4_f32(w, a[2 * q].x * sc, a[2 * q].y * sc, 1.0f, 0);
            w = __builtin_amdgcn_cvt_scalef32_pk_fp4_f32(w, a[2 * q].z * sc, a[2 * q].w * sc, 1.0f, 1);
            w = __builtin_amdgcn_cvt_scalef32_pk_fp4_f32(w, a[2 * q + 1].x * sc, a[2 * q + 1].y * sc, 1.0f, 2);
            w = __builtin_amdgcn_cvt_scalef32_pk_fp4_f32(w, a[2 * q + 1].z * sc, a[2 * q + 1].w * sc, 1.0f, 3);
            o[q] = w;
        }
        *(u32x4*)(outp + (base + (size_t)r * 512) * 16) = o;
    }
}
__device__ __forceinline__ void peer_convert_pull(const Params& p, char* smem, int rep) {
    volatile int* s_next = (volatile int*)(smem + LDS_BYTES - 64);
    for (;;) {
        __syncthreads();
        if (threadIdx.x == 0) s_next[0] = (int)atomicAdd(&p.ctl[6144 + 64 * rep], 1u);
        __syncthreads();
        const int ch = s_next[0];
        if (ch >= PCV_CHUNKS) break;
        peer_convert_chunk(p, ch);
    }
}

__device__ __forceinline__ void phase8(const Params& p, char* smem, int rep) {
    const int tid = otid();
    for (int i = 0;; ++i) {
        int pm, pn; if (!unit_next(i, TP / 256, 1024 / 256, pm, pn)) break;
        f32x4 acc[2][2][4][2] = {};
        gemm_core(p.HN, p.WqT, pm * 256, pn * 256, D, acc, (h16*)smem);
        epilogue_full(acc, smem, [&](int ai, int bj, int r, int part, float* x1, float* x2) {
            const float rs = rsqrtf(p.ROWSS[pm * 256 + ai * 128 + r] * (1.f / D) + EPS);
#pragma unroll
            for (int e = 0; e < 16; ++e) { x1[e] *= rs; x2[e] *= rs; }
            store_h16_32((h16*)p.PQ + (size_t)(pm * 256 + ai * 128 + r) * 1024 + pn * 256 + bj * 128, part, x1, x2);
        });
    }
    {
        const int G = gridDim.x, first = (G > 144) ? 128 : 0;
        if ((int)blockIdx.x >= first)
            for (int it = blockIdx.x - first; it < 128; it += G - first) {
                float* SPQ = p.SPQ;
                gemv8_item<8>(p.out + O_YS, p.peer_wq, 1024, it * 8, smem, [=](int t, int n, float v) { SPQ[t * 1024 + n] = v; }, p.norm2_w, it == 0 ? p.SHN : nullptr);
            }
    }
    peer_convert_pull(p, smem, rep);
}

template <int NV, class EMIT>
__device__ __forceinline__ void wave_select(const unsigned (&u)[NV], int K, int lane, EMIT emit) {
    unsigned tau; int need_eq;
    if constexpr (NV < 8) wave_kth_r4<NV>(u, K, tau, need_eq); else wave_kth<NV>(u, K, tau, need_eq);
    const u64 lt = (1ull << lane) - 1ull;
    int base = 0, eqt = 0;
    unsigned tau2 = tau; asm volatile("" : "+v"(tau2));
#pragma unroll
    for (int i = 0; i < NV; ++i) {
        const bool gt = u[i] > tau2, eq = u[i] == tau2;
        const u64 meq = __ballot(eq);
        const bool sel = gt || (eq && (eqt + __popcll(meq & lt)) < need_eq);
        const u64 ms = __ballot(sel);
        if (sel) emit(i, base + __popcll(ms & lt));
        base += __popcll(ms); eqt += __popcll(meq);
    }
}

template <bool SAMPLE>
__device__ __forceinline__ void load_row8(const void* base, size_t row, int chunk, float* v) {
    if (SAMPLE) {
        const float* r = (const float*)base + row * D + chunk * 8;
        const f32x4 a = *(const f32x4*)r, b = *(const f32x4*)(r + 4);
        v[0] = a.x; v[1] = a.y; v[2] = a.z; v[3] = a.w; v[4] = b.x; v[5] = b.y; v[6] = b.z; v[7] = b.w;
    } else {
        unpk8(*(const u32x4*)((const h16*)base + row * D + chunk * 8), v);
    }
}

template <bool SAMPLE>
__device__ __forceinline__ void peer_item(const Params& p, int tk, char* smem) {
    const int tid = otid(), lane = tid & 63, h = tid >> 6;
    float* qsh = (float*)smem;
    int* route_e = (int*)(smem + 4096);
    float* route_g = (float*)(smem + 4608);
    float* l1v = (float*)(smem + 5120);
    int* l1i = (int*)(smem + 5632);
    float* l2v = (float*)(smem + 6144);
    int* l2i = (int*)(smem + 6656);
    float* parts = (float*)(smem + 8192);
    const int ts = tk - TP;
    __syncthreads();
    { const float* q = SAMPLE ? p.SPQ + (size_t)ts * 1024 : p.PQ + (size_t)tk * 1024; qsh[tid] = q[tid]; qsh[tid + 512] = q[tid + 512]; }
    __syncthreads();
    {
        float s1[2], s2[2];
#pragma unroll
        for (int i = 0; i < 2; ++i) {
            const int key = lane + 64 * i;
            float a = 0.f, b = 0.f;
            if constexpr (SAMPLE) {
                const float* k1 = p.peer_k1 + ((size_t)(h * 128 + key)) * 64;
                const float* k2 = p.peer_k2 + ((size_t)(h * 128 + key)) * 64;
#pragma unroll 4
                for (int c4 = 0; c4 < 16; ++c4) {
                    const f32x4 x = *(const f32x4*)(k1 + 4 * c4), y = *(const f32x4*)(k2 + 4 * c4);
                    const f32x4 q1 = *(const f32x4*)(qsh + h * 128 + 4 * c4), q2 = *(const f32x4*)(qsh + h * 128 + 64 + 4 * c4);
                    a += x.x * q1.x + x.y * q1.y + x.z * q1.z + x.w * q1.w;
                    b += y.x * q2.x + y.y * q2.y + y.z * q2.z + y.w * q2.w;
                }
            } else {
                const h16* k1 = p.K1H + ((size_t)(h * 128 + key)) * 64;
                const h16* k2 = p.K2H + ((size_t)(h * 128 + key)) * 64;
#pragma unroll 2
                for (int c8 = 0; c8 < 8; ++c8) {
                    float x[8], y[8]; unpk8(*(const u32x4*)(k1 + 8 * c8), x); unpk8(*(const u32x4*)(k2 + 8 * c8), y);
                    const f32x4 q1a = *(const f32x4*)(qsh + h * 128 + 8 * c8), q1b = *(const f32x4*)(qsh + h * 128 + 8 * c8 + 4);
                    const f32x4 q2a = *(const f32x4*)(qsh + h * 128 + 64 + 8 * c8), q2b = *(const f32x4*)(qsh + h * 128 + 64 + 8 * c8 + 4);
                    a += x[0] * q1a.x + x[1] * q1a.y + x[2] * q1a.z + x[3] * q1a.w + x[4] * q1b.x + x[5] * q1b.y + x[6] * q1b.z + x[7] * q1b.w;
                    b += y[0] * q2a.x + y[1] * q2a.y + y[2] * q2a.z + y[3] * q2a.w + y[4] * q2b.x + y[5] * q2b.y + y[6] * q2b.z + y[7] * q2b.w;
                }
            }
            s1[i] = a; s2[i] = b;
        }
        unsigned u[2];
        u[0] = f2ord(s1[0]); u[1] = f2ord(s1[1]);
        wave_select<2>(u, 16, lane, [&](int i, int pos) { l1v[h * 16 + pos] = s1[i]; l1i[h * 16 + pos] = lane + 64 * i; });
        u[0] = f2ord(s2[0]); u[1] = f2ord(s2[1]);
        wave_select<2>(u, 16, lane, [&](int i, int pos) { l2v[h * 16 + pos] = s2[i]; l2i[h * 16 + pos] = lane + 64 * i; });
        asm volatile("s_waitcnt lgkmcnt(0)" ::: "memory");
        float cv[4]; unsigned cu[4];
        const int a = lane >> 2;
#pragma unroll
        for (int i = 0; i < 4; ++i) { cv[i] = l1v[h * 16 + a] + l2v[h * 16 + (lane & 3) * 4 + i]; cu[i] = f2ord(cv[i]); }
        wave_select<4>(cu, 16, lane, [&](int i, int pos) { route_g[h * 16 + pos] = cv[i]; route_e[h * 16 + pos] = l1i[h * 16 + a] * 128 + l2i[h * 16 + (lane & 3) * 4 + i]; });
        asm volatile("s_waitcnt lgkmcnt(0)" ::: "memory");
        float sc = (lane < 16) ? route_g[h * 16 + lane] : -3.0e38f;
        const float mx = wave_max(sc);
        const float ex = (lane < 16) ? __expf(sc - mx) : 0.f;
        const float sm = wave_sum(ex);
        asm volatile("s_waitcnt lgkmcnt(0)" ::: "memory");
        if (lane < 16) route_g[h * 16 + lane] = ex / sm;
        asm volatile("s_waitcnt lgkmcnt(0)" ::: "memory");
    }
    {
        const void* hnb = SAMPLE ? (const void*)p.SHN : (const void*)p.HN;
        const void* ub = SAMPLE ? (const void*)p.peer_u : (const void*)p.PU;
        const void* vb = SAMPLE ? (const void*)p.peer_v : (const void*)p.PV;
        const size_t hrow = SAMPLE ? (size_t)ts : (size_t)tk;
        float hv[SAMPLE ? 32 : 1], facc[32];
        u32x4 hp[SAMPLE ? 1 : 4];
        if constexpr (SAMPLE) {
#pragma unroll
            for (int jj = 0; jj < 2; ++jj) { load_row8<true>(hnb, hrow, 2 * (lane + 64 * jj), hv + 16 * jj); load_row8<true>(hnb, hrow, 2 * (lane + 64 * jj) + 1, hv + 16 * jj + 8); }
        } else {
#pragma unroll
            for (int jj = 0; jj < 2; ++jj) { hp[2 * jj] = *(const u32x4*)((const h16*)hnb + hrow * D + (lane + 64 * jj) * 16); hp[2 * jj + 1] = *(const u32x4*)((const h16*)hnb + hrow * D + (lane + 64 * jj) * 16 + 8); }
        }
#pragma unroll
        for (int i = 0; i < 32; ++i) facc[i] = 0.f;
        if constexpr (SAMPLE) {
#pragma unroll 1
            for (int k = 0; k < 16; ++k) {
                const size_t e = (size_t)route_e[h * 16 + k];
                const float* up = (const float*)ub + e * D; const float* vp = (const float*)vb + e * D;
                f32x4 ur[8], vr[8];
#pragma unroll
                for (int jj = 0; jj < 2; ++jj)
#pragma unroll
                    for (int q = 0; q < 4; ++q) { ur[4 * jj + q] = *(const f32x4*)(up + (lane + 64 * jj) * 16 + 4 * q); vr[4 * jj + q] = *(const f32x4*)(vp + (lane + 64 * jj) * 16 + 4 * q); }
                float d = 0.f;
#pragma unroll
                for (int i = 0; i < 8; ++i) d += hv[4 * i] * ur[i].x + hv[4 * i + 1] * ur[i].y + hv[4 * i + 2] * ur[i].z + hv[4 * i + 3] * ur[i].w;
                d = wave_sum(d);
                const float cw = route_g[h * 16 + k] * gelu_exact(d);
#pragma unroll
                for (int i = 0; i < 8; ++i) { facc[4 * i] += cw * vr[i].x; facc[4 * i + 1] += cw * vr[i].y; facc[4 * i + 2] += cw * vr[i].z; facc[4 * i + 3] += cw * vr[i].w; }
            }
        } else {
            const unsigned char* u8 = (const unsigned char*)ub; const unsigned char* v8 = (const unsigned char*)vb;
#pragma unroll 1
            for (int k = 0; k < 16; k += 8) {
                u32x4 ur[8][2], vr[8][2];
#pragma unroll
                for (int x = 0; x < 8; ++x) {
                    const size_t e = (size_t)route_e[h * 16 + k + x];
#pragma unroll
                    for (int jj = 0; jj < 2; ++jj) { ur[x][jj] = *(const u32x4*)(u8 + e * D + (lane + 64 * jj) * 16); vr[x][jj] = *(const u32x4*)(v8 + e * D + (lane + 64 * jj) * 16); }
                }
#pragma unroll
                for (int x = 0; x < 8; ++x) {
                    float d = 0.f;
#pragma unroll
                    for (int jj = 0; jj < 2; ++jj)
#pragma unroll
                        for (int q = 0; q < 4; ++q) {
                            const int w = (int)ur[x][jj][q];
                            const f32x2 lo = __builtin_amdgcn_cvt_pk_f32_fp8(w, false), hi = __builtin_amdgcn_cvt_pk_f32_fp8(w, true);
                            const unsigned h0 = hp[2 * jj + (q >> 1)][2 * (q & 1)], h1 = hp[2 * jj + (q >> 1)][2 * (q & 1) + 1];
                            const h16x2 p0 = __builtin_bit_cast(h16x2, h0), p1 = __builtin_bit_cast(h16x2, h1);
                            d += (float)p0.x * lo.x + (float)p0.y * lo.y + (float)p1.x * hi.x + (float)p1.y * hi.y;
                        }
                    d = wave_sum(d) * (1.f / 64.f);
                    const float cw = route_g[h * 16 + k + x] * gelu_exact(d) * (1.f / 16.f);
#pragma unroll
                    for (int jj = 0; jj < 2; ++jj)
#pragma unroll
                        for (int q = 0; q < 4; ++q) {
                            const int w = (int)vr[x][jj][q];
                            const f32x2 lo = __builtin_amdgcn_cvt_pk_f32_fp8(w, false), hi = __builtin_amdgcn_cvt_pk_f32_fp8(w, true);
                            facc[16 * jj + 4 * q] += cw * lo.x; facc[16 * jj + 4 * q + 1] += cw * lo.y; facc[16 * jj + 4 * q + 2] += cw * hi.x; facc[16 * jj + 4 * q + 3] += cw * hi.y;
                        }
                }
            }
        }
#pragma unroll
        for (int jj = 0; jj < 2; ++jj) {
            float* dst = parts + h * 2048 + (lane + 64 * jj) * 16;
#pragma unroll
            for (int q = 0; q < 4; ++q) { f32x4 a = {facc[16 * jj + 4 * q], facc[16 * jj + 4 * q + 1], facc[16 * jj + 4 * q + 2], facc[16 * jj + 4 * q + 3]}; *(f32x4*)(dst + 4 * q) = a; }
        }
    }
    __syncthreads();
    {
        f32x4 f = {0.f, 0.f, 0.f, 0.f};
#pragma unroll
        for (int w = 0; w < 8; ++w) { const f32x4 a = *(const f32x4*)(parts + w * 2048 + tid * 4); f.x += a.x; f.y += a.y; f.z += a.z; f.w += a.w; }
        float* y = SAMPLE ? p.out + O_YS + (size_t)ts * D + tid * 4 : p.out + O_YP + (size_t)tk * D + tid * 4;
        f32x4 hh = *(const f32x4*)y;
        hh.x += f.x; hh.y += f.y; hh.z += f.z; hh.w += f.w;
        *(f32x4*)y = hh;
    }
}

static __device__ const unsigned char PAIR_LUT[64] = {0,1,2,3,4,5,6,7,8,9,10,11,12,13,14,15,16,17,18,19,20,21,22,23,32,33,34,35,36,48,49,50,51,64,65,66,80,81,96,97,112,113,128,144,160,176,192,208,224,240,0,0,0,0,0,0,0,0,0,0,0,0,0,0};
template <int J>
__device__ __forceinline__ unsigned bt_fetch(unsigned v) {
    if constexpr (J == 1) return (unsigned)__builtin_amdgcn_update_dpp(0, (int)v, 0xB1, 0xF, 0xF, true);
    else if constexpr (J == 2) return (unsigned)__builtin_amdgcn_update_dpp(0, (int)v, 0x4E, 0xF, 0xF, true);
    else if constexpr (J == 8) return (unsigned)__builtin_amdgcn_update_dpp(0, (int)v, 0x128, 0xF, 0xF, true);
    else if constexpr (J == 4) return (unsigned)__builtin_amdgcn_ds_swizzle((int)v, 0x101F);
    else if constexpr (J == 16) return (unsigned)__builtin_amdgcn_ds_swizzle((int)v, 0x401F);
    else return (unsigned)__shfl_xor((int)v, 32);
}
template <int J, u64 M>
__device__ __forceinline__ unsigned bt_cmpx(unsigned x) {
    const unsigned q = bt_fetch<J>(x);
    const unsigned mn = x < q ? x : q, mx = x < q ? q : x;
    unsigned r;
    asm("v_cndmask_b32 %0, %1, %2, %3" : "=v"(r) : "v"(mn), "v"(mx), "s"(M));
    return r;
}
template <int J, u64 M>
__device__ __forceinline__ unsigned bt_cmpx_n(unsigned x) {
    const unsigned q = bt_fetch<J>(x);
    const unsigned mn = x < q ? x : q, mx = x < q ? q : x;
    unsigned r;
    asm("v_cndmask_b32 %0, %1, %2, %3\n\ts_nop 1" : "=v"(r) : "v"(mn), "v"(mx), "s"(M));
    return r;
}
__device__ __forceinline__ unsigned bitonic_top16_x1(unsigned a) {
#define BT1(J, M0) a = bt_cmpx_n<J, M0>(a);
    BT1(1, 0x9999999999999999ull) BT1(2, 0xc3c3c3c3c3c3c3c3ull) BT1(1, 0xa5a5a5a5a5a5a5a5ull)
    BT1(4, 0xf00ff00ff00ff00full) BT1(2, 0xcc33cc33cc33cc33ull) BT1(1, 0xaa55aa55aa55aa55ull)
    BT1(8, 0xff0000ffff0000ffull) BT1(4, 0xf0f00f0ff0f00f0full) BT1(2, 0xcccc3333cccc3333ull) BT1(1, 0xaaaa5555aaaa5555ull)
    { const unsigned q = bt_fetch<16>(a); a = a > q ? a : q; }
    BT1(8, 0xff00ff0000ff00ffull) BT1(4, 0xf0f0f0f00f0f0f0full) BT1(2, 0xcccccccc33333333ull) BT1(1, 0xaaaaaaaa55555555ull)
    { const unsigned q = bt_fetch<32>(a); a = a > q ? a : q; }
    BT1(8, 0x00ff00ff00ff00ffull) BT1(4, 0x0f0f0f0f0f0f0f0full) BT1(2, 0x3333333333333333ull) BT1(1, 0x5555555555555555ull)
#undef BT1
    return a;
}
__device__ __forceinline__ void bitonic_top16_x2(unsigned& a0, unsigned& a1, unsigned& b0, unsigned& b1) {
#define BT4(J, M0, M1) a0 = bt_cmpx<J, M0>(a0); b0 = bt_cmpx<J, M0>(b0); a1 = bt_cmpx<J, M1>(a1); b1 = bt_cmpx<J, M1>(b1);
#define BT2(J, M0) a0 = bt_cmpx<J, M0>(a0); b0 = bt_cmpx<J, M0>(b0);
    BT4(1, 0x9999999999999999ull, 0x9999999999999999ull)
    BT4(2, 0xc3c3c3c3c3c3c3c3ull, 0xc3c3c3c3c3c3c3c3ull)
    BT4(1, 0xa5a5a5a5a5a5a5a5ull, 0xa5a5a5a5a5a5a5a5ull)
    BT4(4, 0xf00ff00ff00ff00full, 0xf00ff00ff00ff00full)
    BT4(2, 0xcc33cc33cc33cc33ull, 0xcc33cc33cc33cc33ull)
    BT4(1, 0xaa55aa55aa55aa55ull, 0xaa55aa55aa55aa55ull)
    BT4(8, 0xff0000ffff0000ffull, 0x00ffff0000ffff00ull)
    BT4(4, 0xf0f00f0ff0f00f0full, 0x0f0ff0f00f0ff0f0ull)
    BT4(2, 0xcccc3333cccc3333ull, 0x3333cccc3333ccccull)
    BT4(1, 0xaaaa5555aaaa5555ull, 0x5555aaaa5555aaaaull)
    a0 = a0 > a1 ? a0 : a1; b0 = b0 > b1 ? b0 : b1;
    BT2(8, 0xff0000ffff0000ffull) BT2(4, 0xf0f00f0ff0f00f0full) BT2(2, 0xcccc3333cccc3333ull) BT2(1, 0xaaaa5555aaaa5555ull)
    { const unsigned qa = bt_fetch<16>(a0), qb = bt_fetch<16>(b0); a0 = a0 > qa ? a0 : qa; b0 = b0 > qb ? b0 : qb; }
    BT2(8, 0xff00ff0000ff00ffull) BT2(4, 0xf0f0f0f00f0f0f0full) BT2(2, 0xcccccccc33333333ull) BT2(1, 0xaaaaaaaa55555555ull)
    { const unsigned qa = bt_fetch<32>(a0), qb = bt_fetch<32>(b0); a0 = a0 > qa ? a0 : qa; b0 = b0 > qb ? b0 : qb; }
    BT2(8, 0x00ff00ff00ff00ffull) BT2(4, 0x0f0f0f0f0f0f0f0full) BT2(2, 0x3333333333333333ull) BT2(1, 0x5555555555555555ull)
#undef BT4
#undef BT2
}

__device__ __forceinline__ void peer_route_wg(const Params& p, char* smem) {
    const int tid = otid(), lane = tid & 63, wave = tid >> 6;
    const int c = blockIdx.x, G = gridDim.x, h = c & 7;
    constexpr int KS = 144;
    char* K1 = smem; char* K2 = smem + 128 * KS;
    float* qw = (float*)(smem + 2 * 128 * KS) + wave * 128;
    float* lst = (float*)(smem + 2 * 128 * KS + 8 * 512) + wave * 160;
    float* l1v = lst; int* l1i = (int*)(lst + 16); float* l2v = lst + 32; int* l2i = (int*)(lst + 48); float* scv = lst + 64; int* eid = (int*)(lst + 80);
    __syncthreads();
    for (int i = tid; i < 2 * 128 * 8; i += 512) {
        const int tbl = i >> 10, r = (i >> 3) & 127, ch = i & 7;
        const h16* src = (tbl ? p.K2H : p.K1H) + ((size_t)(h * 128 + r)) * 64 + ch * 8;
        *(u32x4*)((tbl ? K2 : K1) + r * KS + ch * 16) = *(const u32x4*)src;
    }
    __syncthreads();
    const int nblk = TP / 64;
    volatile int* s_next = (volatile int*)(smem + LDS_BYTES - 64);
    for (;;) {
        __syncthreads();
        if (threadIdx.x == 0) s_next[0] = (int)atomicAdd(&p.ctl[6400 + 64 * h], 1u);
        __syncthreads();
        const int tb = s_next[0];
        if (tb >= nblk) break;
        float* SW = (float*)(smem + 65536) + wave * 2048;
        {
            const int r16 = lane & 15, g = lane >> 4;
            const h16* qrow = (const h16*)p.PQ + (size_t)(64 * tb + wave * 8 + (r16 & 7)) * 1024 + h * 128 + g * 8;
            h16x8 qa[2][2];
#pragma unroll
            for (int tb2 = 0; tb2 < 2; ++tb2)
#pragma unroll
                for (int kk = 0; kk < 2; ++kk) qa[tb2][kk] = *(const h16x8*)(qrow + tb2 * 64 + kk * 32);
#pragma unroll
            for (int tb2 = 0; tb2 < 2; ++tb2) {
                const char* KT = tb2 ? K2 : K1;
#pragma unroll
                for (int nt = 0; nt < 8; ++nt) {
                    f32x4 a = {0.f, 0.f, 0.f, 0.f};
#pragma unroll
                    for (int kk = 0; kk < 2; ++kk) {
                        const h16x8 kb = *(const h16x8*)(KT + (16 * nt + r16) * KS + (kk * 4 + g) * 16);
                        a = __builtin_amdgcn_mfma_f32_16x16x32_f16(qa[tb2][kk], kb, a, 0, 0, 0);
                    }
                    if (g < 2) {
#pragma unroll
                        for (int j = 0; j < 4; ++j) SW[(tb2 * 8 + 4 * g + j) * 128 + 16 * nt + r16] = a[j];
                    }
                }
            }
            asm volatile("s_waitcnt lgkmcnt(0)" ::: "memory");
        }
        for (int j = 0; j < 8; ++j) {
            const int tk = 64 * tb + wave * 8 + j;
            const float* sw1 = SW + j * 128; const float* sw2 = SW + (8 + j) * 128;
            unsigned ka0 = (f2ord(sw1[lane]) & ~127u) | (unsigned)(127 - lane), ka1 = (f2ord(sw1[64 + lane]) & ~127u) | (unsigned)(63 - lane);
            unsigned kb0 = (f2ord(sw2[lane]) & ~127u) | (unsigned)(127 - lane), kb1 = (f2ord(sw2[64 + lane]) & ~127u) | (unsigned)(63 - lane);
            bitonic_top16_x2(ka0, ka1, kb0, kb1);
            {
                const bool second = (lane & 16) != 0;
                const unsigned key = second ? kb0 : ka0;
                const int idx = 127 - (int)(key & 127u);
                const float val = (second ? sw2 : sw1)[idx];
                float* sv = lst + 96 + (second ? 32 : 0); int* si = (int*)sv + 16;
                if (lane < 32) { sv[lane & 15] = val; si[lane & 15] = idx; }
            }
            asm volatile("s_waitcnt lgkmcnt(0)" ::: "memory");
            float cv1; int e1;
            {
                const int ab = PAIR_LUT[lane], a = ab >> 4, b = ab & 15;
                const float* s1v = lst + 96; const int* s1i = (const int*)(lst + 112); const float* s2v = lst + 128; const int* s2i = (const int*)(lst + 144);
                cv1 = s1v[a] + s2v[b]; e1 = s1i[a] * 128 + s2i[b];
            }
            unsigned kc = (lane < 50) ? ((f2ord(cv1) & ~63u) | (unsigned)(63 - lane)) : 0u;
            kc = bitonic_top16_x1(kc);
            const int cl = 63 - (int)(kc & 63u);
            const float sc = __shfl(cv1, cl); const int ee = __shfl(e1, cl);
            const float mx = __int_as_float(__builtin_amdgcn_readfirstlane(__float_as_int(sc)));
            const float ex = __expf(sc - mx);
            float sm = ex;
            sm += __int_as_float(__builtin_amdgcn_update_dpp(0, __float_as_int(sm), 0x128, 0xF, 0xF, true));
            sm += __int_as_float(__builtin_amdgcn_update_dpp(0, __float_as_int(sm), 0x124, 0xF, 0xF, true));
            sm += __int_as_float(__builtin_amdgcn_update_dpp(0, __float_as_int(sm), 0x122, 0xF, 0xF, true));
            sm += __int_as_float(__builtin_amdgcn_update_dpp(0, __float_as_int(sm), 0x121, 0xF, 0xF, true));
            if (lane < 16) { int2 o; o.x = ee; o.y = __float_as_int(ex / sm); p.ROUTE[((size_t)tk * 8 + h) * 16 + lane] = o; }
            asm volatile("s_waitcnt lgkmcnt(0)" ::: "memory");
        }
    }
}

__device__ __forceinline__ void peer_gather_wave(const Params& p, int tk, char* smem) {
    const int lane = otid() & 63;
    const int2 r0 = p.ROUTE[(size_t)tk * 128 + lane], r1 = p.ROUTE[(size_t)tk * 128 + 64 + lane];
    f32x2 hv[16];
#pragma unroll
    for (int k = 0; k < 4; ++k) {
        float t8[8]; unpk8(*(const u32x4*)(p.HN + (size_t)tk * D + 32 * lane + 8 * k), t8);
#pragma unroll
        for (int e = 0; e < 4; ++e) hv[4 * k + e] = (f32x2){t8[2 * e], t8[2 * e + 1]};
    }
    f32x2 facc[16];
#pragma unroll
    for (int i = 0; i < 16; ++i) facc[i] = (f32x2){0.f, 0.f};
    const float rs64 = rsqrtf(p.ROWSS[tk] * (1.f / D) + EPS) * (1.f / 64.f);
    const unsigned char* u8 = (const unsigned char*)p.PU; const unsigned char* v8 = (const unsigned char*)p.PV;
    const int xl = ((lane >> 5) & 1) * 4 + ((lane >> 4) & 1) * 2 + ((lane >> 3) & 1);
    u32x4 uA[8], uB[8], vv[8];
#define PG_ISSUE_U(b, uu) { const int _es = ((b) < 8) ? r0.x : r1.x; \
    _Pragma("unroll") for (int x = 0; x < 8; ++x) { const size_t e = (size_t)(unsigned)__builtin_amdgcn_readlane(_es, 8 * ((b) & 7) + x); \
        uu[x] = *(const u32x4*)(u8 + e * (D / 2) + lane * 16); } }
#define PG_APPLY(b, uu) { const int _es = ((b) < 8) ? r0.x : r1.x; const int _gs = ((b) < 8) ? r0.y : r1.y; \
    _Pragma("unroll") for (int x = 0; x < 8; ++x) { const size_t e = (size_t)(unsigned)__builtin_amdgcn_readlane(_es, 8 * ((b) & 7) + x); \
        vv[x] = *(const u32x4*)(v8 + e * (D / 2) + lane * 16); } \
    const float gl = __int_as_float(__shfl(_gs, 8 * ((b) & 7) + xl)); \
    float d[8]; \
    _Pragma("unroll") for (int x = 0; x < 8; ++x) { f32x2 a2 = {0.f, 0.f}; \
        _Pragma("unroll") for (int q = 0; q < 4; ++q) { const unsigned w = uu[x][q]; \
            a2 += hv[4 * q] * __builtin_amdgcn_cvt_scalef32_pk_f32_fp4(w, 1.0f, 0); a2 += hv[4 * q + 1] * __builtin_amdgcn_cvt_scalef32_pk_f32_fp4(w, 1.0f, 1); \
            a2 += hv[4 * q + 2] * __builtin_amdgcn_cvt_scalef32_pk_f32_fp4(w, 1.0f, 2); a2 += hv[4 * q + 3] * __builtin_amdgcn_cvt_scalef32_pk_f32_fp4(w, 1.0f, 3); } \
        d[x] = a2.x + a2.y; } \
    float r4[4], r2[2], r1v; \
    { const bool hi = (lane & 32) != 0; \
      _Pragma("unroll") for (int k = 0; k < 4; ++k) { const float keep = hi ? d[k + 4] : d[k], send = hi ? d[k] : d[k + 4]; r4[k] = keep + __shfl_xor(send, 32); } } \
    { const bool hi = (lane & 16) != 0; \
      _Pragma("unroll") for (int k = 0; k < 2; ++k) { const float keep = hi ? r4[k + 2] : r4[k], send = hi ? r4[k] : r4[k + 2]; r2[k] = keep + __shfl_xor(send, 16); } } \
    { const bool hi = (lane & 8) != 0; const float keep = hi ? r2[1] : r2[0], send = hi ? r2[0] : r2[1]; r1v = keep + __shfl_xor(send, 8); } \
    r1v += __shfl_xor(r1v, 4); r1v += __shfl_xor(r1v, 2); r1v += __shfl_xor(r1v, 1); \
    const float cwv = gl * gelu_exact(r1v * rs64) * (1.f / 16.f); \
    _Pragma("unroll") for (int x = 0; x < 8; ++x) { const float cw = __int_as_float(__builtin_amdgcn_readlane(__float_as_int(cwv), 8 * x)); const f32x2 cw2 = {cw, cw}; \
        _Pragma("unroll") for (int q = 0; q < 4; ++q) { const unsigned w = vv[x][q]; \
            facc[4 * q] += cw2 * __builtin_amdgcn_cvt_scalef32_pk_f32_fp4(w, 1.0f, 0); facc[4 * q + 1] += cw2 * __builtin_amdgcn_cvt_scalef32_pk_f32_fp4(w, 1.0f, 1); \
            facc[4 * q + 2] += cw2 * __builtin_amdgcn_cvt_scalef32_pk_f32_fp4(w, 1.0f, 2); facc[4 * q + 3] += cw2 * __builtin_amdgcn_cvt_scalef32_pk_f32_fp4(w, 1.0f, 3); } } }
    PG_ISSUE_U(0, uA)
#pragma unroll 1
    for (int b = 0; b < 16; b += 2) {
        PG_ISSUE_U(b + 1, uB)
        __builtin_amdgcn_sched_barrier(0);
        PG_APPLY(b, uA)
        __builtin_amdgcn_sched_barrier(0);
        if (b + 2 < 16) PG_ISSUE_U(b + 2, uA)
        __builtin_amdgcn_sched_barrier(0);
        PG_APPLY(b + 1, uB)
        __builtin_amdgcn_sched_barrier(0);
    }
#undef PG_ISSUE_U
#undef PG_APPLY
    float* y = p.out + O_YP + (size_t)tk * D + 32 * lane;
#pragma unroll
    for (int q = 0; q < 8; ++q) {
        f32x4 hh = {hv[2 * q].x + facc[2 * q].x, hv[2 * q].y + facc[2 * q].y, hv[2 * q + 1].x + facc[2 * q + 1].x, hv[2 * q + 1].y + facc[2 * q + 1].y};
        *(f32x4*)(y + 4 * q) = hh;
    }
}

__device__ __forceinline__ void phase9(const Params& p, char* smem) {
    const int c = blockIdx.x, G = gridDim.x;
    for (int tk = TP + (G - 1 - c); tk < TT; tk += G) peer_item<true>(p, tk, smem);
    peer_route_wg(p, smem);
}
__device__ __forceinline__ void phase10(const Params& p, char* smem) {
    const int gw = blockIdx.x * 8 + (otid() >> 6), NGW = gridDim.x * 8;
    for (int tk = gw; tk < TP; tk += NGW) peer_gather_wave(p, tk, smem);
}

__global__ __launch_bounds__(512, 2) void fwd_kernel(KArgs ka) {
    extern __shared__ __attribute__((aligned(16))) char smem[];
    const Params p = make_params(ka);
    volatile LAS unsigned* st = (volatile LAS unsigned*)(smem + LDS_BYTES - 16);
    if (threadIdx.x == 0) { st[0] = 0u; st[1] = 0u; }
    __syncthreads();
    XcdBarrier bar = xcd_barrier_post(p.ctl, st);
#ifndef PHASE_MASK
#define PHASE_MASK 0x7ff
#endif
#ifndef REP_MASK
  #define REP_MASK 0
#endif
#define PH(k, call) if (((PHASE_MASK >> (k)) & 1) && ka.ph_lo <= (k) && (k) < ka.ph_hi) { \
    for (int rep = 0; rep < 1 + ((REP_MASK >> (k)) & 1); ++rep) { call; if (rep + 1 < 1 + ((REP_MASK >> (k)) & 1)) xcd_barrier(bar); } \
    if ((k) + 1 < ka.ph_hi) xcd_barrier(bar); }
    PH(0, phase0(p, smem))
    PH(1, phase1(p, smem))
    PH(2, phase2(p, smem))
    PH(3, phase3(p, smem, rep))
    PH(4, phase4(p, smem))
    PH(5, phase5(p, smem))
    PH(6, phase6(p, smem))
    PH(8, phase8(p, smem, rep))
    PH(9, phase9(p, smem))
    PH(10, phase10(p, smem))
#undef PH
}


#ifdef DBG_RET_NAIVE
__global__ void dbg_ret_naive(KArgs ka) {
    const Params p = make_params(ka);
    const int idx = blockIdx.x * blockDim.x + threadIdx.x;
    const int dv = idx & 255, dk = (idx >> 8) & 127, h = (idx >> 15) & 7, b = idx >> 18;
    const float g = 1.f - exp2f(-5.f - (float)h);
    float S = 0.f;
    for (int t = 0; t < SEQ; ++t) {
        const size_t tok = (size_t)b * SEQ + t;
        S = g * S + (float)p.RK[tok * 1024 + h * 128 + dk] * (float)p.RV[tok * 2048 + h * 256 + dv];
    }
    p.out[O_SP + ((size_t)((b * 8 + h) * 128 + dk)) * 256 + dv] = S;
}
#endif
#ifdef DBG_SCALES
__global__ void dbg_scale_kernel(float* out) {
    const float sc[10] = {DBG_SCALES};
    const size_t offs[11] = {O_YP, O_YS, O_KP, O_VP, O_IKP, O_SP, O_KS, O_VS, O_IKS, O_SS, 28861440};
    for (size_t i = (size_t)blockIdx.x * blockDim.x + threadIdx.x; i < 28861440; i += (size_t)gridDim.x * blockDim.x) {
        float s = 0.f;
#pragma unroll
        for (int k = 0; k < 10; ++k) if (i >= offs[k] && i < offs[k + 1]) s = sc[k];
        out[i] = (s == 0.f) ? 0.f : out[i] * s;
    }
}
#endif
#ifndef MK_MULTI
#define MK_MULTI 0
#endif
extern "C" void kernel_launch(void* const* d_in, const int* in_sizes, int n_in, void* d_out, int out_size, void* d_ws, size_t ws_size, hipStream_t stream) {
    static int grid = 0;
    if (grid == 0) {
        int dev = 0, cus = 0;
        (void)hipGetDevice(&dev); (void)hipDeviceGetAttribute(&cus, hipDeviceAttributeMultiprocessorCount, dev);
        (void)hipFuncSetAttribute((const void*)fwd_kernel, hipFuncAttributeMaxDynamicSharedMemorySize, LDS_BYTES);
        int per_cu = 0;
        (void)hipOccupancyMaxActiveBlocksPerMultiprocessor(&per_cu, (const void*)fwd_kernel, 512, LDS_BYTES);
        (void)hipGetLastError();
        grid = (cus > 0 ? cus : 256) * 1;
        if (per_cu < 1) fprintf(stderr, "kernel_launch: occupancy query reports %d blocks per CU\n", per_cu);
    }
    KArgs p;
    memset(&p, 0, sizeof(p));
    if (n_in < 21) { fprintf(stderr, "kernel_launch: expected 21 inputs, got %d\n", n_in); return; }
    for (int i = 0; i < 21; ++i) p.in[i] = d_in[i];
    p.out = (float*)d_out;
    p.ws = (char*)d_ws;
    if (WS_END > ws_size) { fprintf(stderr, "kernel_launch: workspace too small (%zu > %zu)\n", (size_t)WS_END, ws_size); return; }
    (void)hipMemsetAsync(d_ws, 0, 65536, stream);
#if MK_MULTI
    for (int k = 0; k < 11; ++k) {
        p.ph_lo = k; p.ph_hi = k + 1;
        hipLaunchKernelGGL(fwd_kernel, dim3(grid), dim3(512), LDS_BYTES, stream, p);
    }
#else
    p.ph_lo = 0; p.ph_hi = 11;
    hipLaunchKernelGGL(fwd_kernel, dim3(grid), dim3(512), LDS_BYTES, stream, p);
#endif
#ifdef DBG_RET_NAIVE
    hipLaunchKernelGGL(dbg_ret_naive, dim3(2 * 8 * 128 * 256 / 256), dim3(256), 0, stream, p);
#endif
#ifdef DBG_SCALES
    hipLaunchKernelGGL(dbg_scale_kernel, dim3(1024), dim3(256), 0, stream, (float*)d_out);
#endif
}
```

```cpp
#include <hip/hip_runtime.h>
#include <stdint.h>
#include <stdio.h>
#include <string.h>
#include <math.h>
#include <type_traits>

typedef _Float16 h16;
typedef _Float16 h16x8 __attribute__((ext_vector_type(8)));
typedef _Float16 h16x4 __attribute__((ext_vector_type(4)));
typedef _Float16 h16x2 __attribute__((ext_vector_type(2)));
typedef float f32x4 __attribute__((ext_vector_type(4)));
typedef float f32x2 __attribute__((ext_vector_type(2)));
typedef unsigned u32x4 __attribute__((ext_vector_type(4)));
typedef unsigned long long u64;

#define LAS __attribute__((address_space(3)))

constexpr int D = 2048, SEQ = 4096, TP = 8192, NS = 8, TT = TP + NS;
constexpr int NWP = 15616;
constexpr int NW0 = 15504;
constexpr int PAST = 16384, PAGE = 128, NPAGES = 128, LS = PAST + 1;
constexpr int NEXP = 16384;
constexpr float EPS = 1e-6f;
constexpr int C_RQ = 0, C_RK = 1024, C_RV = 2048, C_RG = 4096, C_AQ = 6144, C_AK = 8192, C_AV = 8704, C_IQ = 9216, C_IK = 11264, C_IW = 11392, C_GR = 11408, C_GA = 13456;
constexpr size_t O_YP = 0, O_YS = 16777216, O_KP = 16793600, O_VP = 20987904, O_IKP = 25182208, O_SP = 26230784,
                 O_KS = 26755072, O_VS = 26759168, O_IKS = 26763264, O_SS = 26764288;
constexpr int LDS_BYTES = 139264;
constexpr int SCS = 4112;
constexpr int SSCS = 16400;

#define XB_TMO      128
#define XB_XCNT(j)  (256  + 64 * (j))
#define XB_XSUB(j)  (1280 + 64 * (j))
#define XB_XGEN(j)  (2304 + 64 * (j))
#define XB_TOP      3328
#define XB_TOPGEN   3392
#define XCD_BAR_WORDS 3456
#define XB_SPIN_CAP (1u << 22)
__device__ __forceinline__ unsigned xb_ld(unsigned* p)              { return __hip_atomic_load(p, __ATOMIC_RELAXED, __HIP_MEMORY_SCOPE_AGENT); }
__device__ __forceinline__ unsigned xb_add(unsigned* p, unsigned v) { return __hip_atomic_fetch_add(p, v, __ATOMIC_RELAXED, __HIP_MEMORY_SCOPE_AGENT); }
__device__ __forceinline__ unsigned xb_xcc_id() { return (unsigned)__builtin_amdgcn_s_getreg((3 << 11) | 20) & 0xFu; }
#define XB_SPIN(cond, bar) do { unsigned _sp = 0; while (cond) { __builtin_amdgcn_s_sleep(1); \
    if ((++_sp & 255u) == 0u) { if (xb_ld(&(bar)[XB_TMO])) break; if (_sp > XB_SPIN_CAP) { atomicAdd(&(bar)[XB_TMO], 1u); break; } } } } while (0)
struct XcdBarrier { unsigned* bar; unsigned x; volatile LAS unsigned* st; };
__device__ __forceinline__ XcdBarrier xcd_barrier_post(unsigned* bar, volatile LAS unsigned* st) {
    XcdBarrier b; b.bar = bar; b.x = xb_xcc_id(); b.st = st;
    if (threadIdx.x == 0) (void)xb_add(&bar[XB_XCNT(b.x)], 1u);
    return b;
}
__device__ __forceinline__ void xcd_barrier_complete(unsigned* bar, unsigned x, unsigned& nloc, unsigned& nx) {
    const unsigned G = gridDim.x * gridDim.y * gridDim.z;
    unsigned sum, cnt, mine, sp = 0u;
    for (;;) {
        sum = 0u; cnt = 0u; mine = 0u;
#pragma unroll
        for (unsigned j = 0; j < 16; ++j) { const unsigned c = xb_ld(&bar[XB_XCNT(j)]); sum += c; cnt += (c > 0u) ? 1u : 0u; mine = (j == x) ? c : mine; }
        if (sum == G) break;
        __builtin_amdgcn_s_sleep(1);
        if ((++sp & 255u) == 0u) { if (xb_ld(&bar[XB_TMO])) break; if (sp > XB_SPIN_CAP) { atomicAdd(&bar[XB_TMO], 1u); break; } }
    }
    nloc = mine > 0u ? mine : 1u; nx = cnt > 0u ? cnt : 1u;
}
__device__ __forceinline__ void xcd_barrier(const XcdBarrier& b) {
    asm volatile("s_waitcnt vmcnt(0)" ::: "memory");
    __syncthreads();
    if (threadIdx.x == 0) {
        unsigned* bar = b.bar;
        __builtin_amdgcn_s_waitcnt(0);
        volatile LAS unsigned* stw = (volatile LAS unsigned*)(unsigned)(LDS_BYTES - 16);
        unsigned nloc = stw[0], nx = stw[1];
        if (nloc == 0u) { xcd_barrier_complete(bar, b.x, nloc, nx); stw[0] = nloc; stw[1] = nx; }
        const unsigned old = xb_add(&bar[XB_XSUB(b.x)], 1u);
        const unsigned gen = old / nloc;
        if (old + 1u == (gen + 1u) * nloc) {
            __builtin_amdgcn_fence(__ATOMIC_RELEASE, "agent");
            asm volatile("s_waitcnt vmcnt(0)" ::: "memory");
            const unsigned og = xb_add(&bar[XB_TOP], 1u);
            const unsigned tg = og / nx;
            if (og + 1u == (tg + 1u) * nx) xb_add(&bar[XB_TOPGEN], 1u);
            else XB_SPIN(xb_ld(&bar[XB_TOPGEN]) == tg, bar);
            __builtin_amdgcn_fence(__ATOMIC_ACQUIRE, "agent");
            xb_add(&bar[XB_XGEN(b.x)], 1u);
            asm volatile("s_waitcnt vmcnt(0)" ::: "memory");
        } else {
            XB_SPIN(xb_ld(&bar[XB_XGEN(b.x)]) == gen, bar);
            __builtin_amdgcn_fence(__ATOMIC_ACQUIRE, "agent");
            asm volatile("s_waitcnt vmcnt(0)" ::: "memory");
        }
    }
    __syncthreads();
}

struct Params {
    const float *x_prompt, *x_sample, *cache_k, *cache_v, *cache_kidx, *state_ret;
    const int* page_table;
    const float *norm1_w, *w_in, *q_norm_w, *k_norm_w, *ret_gn_w, *w_ret_o, *w_att_o, *w_out, *norm2_w, *peer_wq, *peer_k1, *peer_k2, *peer_u, *peer_v;
    float* out;
    unsigned* ctl;
    float* ROWSS;
    h16 *XN, *WinT, *WrT, *WaT, *WoT, *WqT, *PU, *PV, *K1H, *K2H;
    int2* ROUTE;
    unsigned char *AQ8, *AK8;
    h16 *RQ, *RK, *RV, *RG, *AQ, *AK, *AV, *IQ, *IK, *GR, *GA;
    float* IW;
    float* KV; h16* SPT; int* TOPI; h16 *RN, *ATT, *MIX, *HN; float* MIXF; float* PQ;
    float2* ROPE;
    float *XNS, *ZS, *SRQ, *SRK, *SRV, *SRG, *SAQ, *SAK, *SAV, *SIQ, *SIK, *SIW, *SGR, *SGA, *SSC;
    int* STOP;
    float *SRN, *SATT, *SMIX, *SHN, *SPQ;
};
struct KArgs {
    const void* in[21];
    float* out;
    char* ws;
    int ph_lo, ph_hi;
};
constexpr size_t al256(size_t x) { return (x + 255) & ~(size_t)255; }
constexpr size_t WS_CTL = 0;
constexpr size_t WS_XN = WS_CTL + 65536;
constexpr size_t WS_WINT = WS_XN + al256((size_t)TP * D * 2);
constexpr size_t WS_WRT = WS_WINT + al256((size_t)NWP * D * 2);
constexpr size_t WS_WAT = WS_WRT + al256((size_t)D * D * 2);
constexpr size_t WS_WOT = WS_WAT + al256((size_t)D * D * 2);
constexpr size_t WS_WQT = WS_WOT + al256((size_t)D * D * 2);
constexpr size_t WS_PU = WS_WQT + al256((size_t)1024 * D * 2);
constexpr size_t WS_PV = WS_PU + al256((size_t)NEXP * D * 2);
constexpr size_t WS_RQ = WS_PV + al256((size_t)NEXP * D * 2);
constexpr size_t WS_RK = WS_RQ + al256((size_t)TP * 1024 * 2);
constexpr size_t WS_RV = WS_RK + al256((size_t)TP * 1024 * 2);
constexpr size_t WS_RG = WS_RV + al256((size_t)TP * 2048 * 2);
constexpr size_t WS_AQ = WS_RG + al256((size_t)TP * 2048 * 2);
constexpr size_t WS_AK = WS_AQ + al256((size_t)TP * 2048 * 2);
constexpr size_t WS_AV = WS_AK + al256((size_t)TP * 512 * 2);
constexpr size_t WS_IQ = WS_AV + al256((size_t)TP * 512 * 2);
constexpr size_t WS_IK = WS_IQ + al256((size_t)TP * 2048 * 2);
constexpr size_t WS_GR = WS_IK + al256((size_t)TP * 128 * 2);
constexpr size_t WS_GA = WS_GR + al256((size_t)TP * 2048 * 2);
constexpr size_t WS_IW = WS_GA + al256((size_t)TP * 2048 * 2);
constexpr size_t WS_KV = WS_IW + al256((size_t)TP * 16 * 4);
constexpr size_t WS_SPT = WS_KV + al256((size_t)2 * 8 * 32 * 128 * 256 * 4);
constexpr size_t WS_TOPI = WS_SPT + al256((size_t)2 * 8 * 32 * 256 * 128 * 2);
constexpr size_t WS_RN = WS_TOPI + al256((size_t)TP * 256 * 4);
constexpr size_t WS_ATT = WS_RN + al256((size_t)TP * D * 2);
constexpr size_t WS_MIX = WS_ATT + al256((size_t)TP * D * 2);
constexpr size_t WS_HN = WS_MIX + al256((size_t)TP * D * 2);
constexpr size_t WS_MIXF = WS_HN + al256((size_t)TP * D * 2);
constexpr size_t WS_PQ = WS_MIXF + al256((size_t)TP * D * 4);
constexpr size_t WS_ROPE = WS_PQ + al256((size_t)TP * 1024 * 4);
constexpr size_t WS_XNS = WS_ROPE + al256((size_t)4097 * 64 * 8);
constexpr size_t WS_ZS = WS_XNS + al256(8 * D * 4);
constexpr size_t WS_SRQ = WS_ZS + al256((size_t)8 * NW0 * 4);
constexpr size_t WS_SRK = WS_SRQ + al256(8 * 1024 * 4);
constexpr size_t WS_SRV = WS_SRK + al256(8 * 1024 * 4);
constexpr size_t WS_SRG = WS_SRV + al256(8 * 2048 * 4);
constexpr size_t WS_SAQ = WS_SRG + al256(8 * 2048 * 4);
constexpr size_t WS_SAK = WS_SAQ + al256(8 * 2048 * 4);
constexpr size_t WS_SAV = WS_SAK + al256(8 * 512 * 4);
constexpr size_t WS_SIQ = WS_SAV + al256(8 * 512 * 4);
constexpr size_t WS_SIK = WS_SIQ + al256(8 * 2048 * 4);
constexpr size_t WS_SIW = WS_SIK + al256(8 * 128 * 4);
constexpr size_t WS_SGR = WS_SIW + al256(8 * 16 * 4);
constexpr size_t WS_SGA = WS_SGR + al256(8 * 2048 * 4);
constexpr size_t WS_SSC = WS_SGA + al256(8 * 2048 * 4);
constexpr size_t WS_STOP = WS_SSC + al256((size_t)8 * SSCS * 4);
constexpr size_t WS_SRN = WS_STOP + al256(8 * 256 * 4);
constexpr size_t WS_SATT = WS_SRN + al256(8 * 2048 * 4);
constexpr size_t WS_SMIX = WS_SATT + al256(8 * 2048 * 4);
constexpr size_t WS_SHN = WS_SMIX + al256(8 * 2048 * 4);
constexpr size_t WS_SPQ = WS_SHN + al256(8 * 2048 * 4);
constexpr size_t WS_K1H = WS_SPQ + al256(8 * 1024 * 4);
constexpr size_t WS_K2H = WS_K1H + al256(8 * 128 * 64 * 2);
constexpr size_t WS_ROUTE = WS_K2H + al256(8 * 128 * 64 * 2);
constexpr size_t WS_AQ8 = WS_ROUTE + al256((size_t)TP * 128 * 8);
constexpr size_t WS_AK8 = WS_AQ8 + al256((size_t)TP * 2048);
constexpr size_t WS_END = WS_AK8 + al256((size_t)TP * 512);
__device__ __forceinline__ Params make_params(const KArgs& a) {
    Params p;
    p.x_prompt = (const float*)a.in[0]; p.x_sample = (const float*)a.in[1]; p.cache_k = (const float*)a.in[2]; p.cache_v = (const float*)a.in[3];
    p.cache_kidx = (const float*)a.in[4]; p.state_ret = (const float*)a.in[5]; p.page_table = (const int*)a.in[6];
    p.norm1_w = (const float*)a.in[7]; p.w_in = (const float*)a.in[8]; p.q_norm_w = (const float*)a.in[9]; p.k_norm_w = (const float*)a.in[10];
    p.ret_gn_w = (const float*)a.in[11]; p.w_ret_o = (const float*)a.in[12]; p.w_att_o = (const float*)a.in[13]; p.w_out = (const float*)a.in[14];
    p.norm2_w = (const float*)a.in[15]; p.peer_wq = (const float*)a.in[16]; p.peer_k1 = (const float*)a.in[17]; p.peer_k2 = (const float*)a.in[18];
    p.peer_u = (const float*)a.in[19]; p.peer_v = (const float*)a.in[20];
    p.out = a.out;
    char* w = a.ws;
    p.ctl = (unsigned*)(w + WS_CTL); p.ROWSS = (float*)(w + WS_CTL + 32768);
    p.XN = (h16*)(w + WS_XN); p.WinT = (h16*)(w + WS_WINT); p.WrT = (h16*)(w + WS_WRT); p.WaT = (h16*)(w + WS_WAT); p.WoT = (h16*)(w + WS_WOT); p.WqT = (h16*)(w + WS_WQT);
    p.PU = (h16*)(w + WS_PU); p.PV = (h16*)(w + WS_PV); p.K1H = (h16*)(w + WS_K1H); p.K2H = (h16*)(w + WS_K2H); p.ROUTE = (int2*)(w + WS_ROUTE); p.AQ8 = (unsigned char*)(w + WS_AQ8); p.AK8 = (unsigned char*)(w + WS_AK8);
    p.RQ = (h16*)(w + WS_RQ); p.RK = (h16*)(w + WS_RK); p.RV = (h16*)(w + WS_RV); p.RG = (h16*)(w + WS_RG);
    p.AQ = (h16*)(w + WS_AQ); p.AK = (h16*)(w + WS_AK); p.AV = (h16*)(w + WS_AV); p.IQ = (h16*)(w + WS_IQ); p.IK = (h16*)(w + WS_IK);
    p.GR = (h16*)(w + WS_GR); p.GA = (h16*)(w + WS_GA); p.IW = (float*)(w + WS_IW);
    p.KV = (float*)(w + WS_KV); p.SPT = (h16*)(w + WS_SPT); p.TOPI = (int*)(w + WS_TOPI);
    p.RN = (h16*)(w + WS_RN); p.ATT = (h16*)(w + WS_ATT); p.MIX = (h16*)(w + WS_MIX); p.HN = (h16*)(w + WS_HN);
    p.MIXF = (float*)(w + WS_MIXF); p.PQ = (float*)(w + WS_PQ); p.ROPE = (float2*)(w + WS_ROPE);
    p.XNS = (float*)(w + WS_XNS); p.ZS = (float*)(w + WS_ZS);
    p.SRQ = (float*)(w + WS_SRQ); p.SRK = (float*)(w + WS_SRK); p.SRV = (float*)(w + WS_SRV); p.SRG = (float*)(w + WS_SRG);
    p.SAQ = (float*)(w + WS_SAQ); p.SAK = (float*)(w + WS_SAK); p.SAV = (float*)(w + WS_SAV);
    p.SIQ = (float*)(w + WS_SIQ); p.SIK = (float*)(w + WS_SIK); p.SIW = (float*)(w + WS_SIW);
    p.SGR = (float*)(w + WS_SGR); p.SGA = (float*)(w + WS_SGA); p.SSC = (float*)(w + WS_SSC); p.STOP = (int*)(w + WS_STOP);
    p.SRN = (float*)(w + WS_SRN); p.SATT = (float*)(w + WS_SATT); p.SMIX = (float*)(w + WS_SMIX); p.SHN = (float*)(w + WS_SHN); p.SPQ = (float*)(w + WS_SPQ);
    return p;
}

__device__ __forceinline__ float wave_sum(float v) {
#pragma unroll
    for (int o = 32; o > 0; o >>= 1) v += __shfl_xor(v, o);
    return v;
}
__device__ __forceinline__ float wave_max(float v) {
#pragma unroll
    for (int o = 32; o > 0; o >>= 1) v = fmaxf(v, __shfl_xor(v, o));
    return v;
}
__device__ __forceinline__ int otid() { int t = threadIdx.x; asm volatile("" : "+v"(t)); return t; }
__device__ __forceinline__ unsigned f2ord(float f) { unsigned b = __float_as_uint(f); return b ^ ((unsigned)((int)b >> 31) | 0x80000000u); }
__device__ __forceinline__ unsigned pkh(float lo, float hi) { h16x2 v; v.x = (h16)lo; v.y = (h16)hi; return __builtin_bit_cast(unsigned, v); }
__device__ __forceinline__ u32x4 pk8(const float* v) { u32x4 r; r.x = pkh(v[0], v[1]); r.y = pkh(v[2], v[3]); r.z = pkh(v[4], v[5]); r.w = pkh(v[6], v[7]); return r; }
__device__ __forceinline__ void unpk8(u32x4 r, float* v) {
    const unsigned rx = r.x, ry = r.y, rz = r.z, rw = r.w;
    h16x2 a = __builtin_bit_cast(h16x2, rx), b = __builtin_bit_cast(h16x2, ry), c = __builtin_bit_cast(h16x2, rz), d = __builtin_bit_cast(h16x2, rw);
    v[0] = (float)a.x; v[1] = (float)a.y; v[2] = (float)b.x; v[3] = (float)b.y; v[4] = (float)c.x; v[5] = (float)c.y; v[6] = (float)d.x; v[7] = (float)d.y;
}
__device__ __forceinline__ float sigmoidf_(float x) { return __builtin_amdgcn_rcpf(1.f + __expf(-x)); }
__device__ __forceinline__ float siluf_(float x) { return x * __builtin_amdgcn_rcpf(1.f + __expf(-x)); }
__device__ __forceinline__ float gelu_exact(float x) { return 0.5f * x * (1.f + erff(x * 0.70710678118654752f)); }
__device__ __forceinline__ float ret_log_g(int h) { return logf(1.f - exp2f(-5.f - (float)h)); }

__device__ __forceinline__ unsigned off_b(unsigned row, unsigned ch) { return 256u * row + 16u * (ch ^ (((row & 3) << 2) | ((row >> 2) & 3))); }
__device__ __forceinline__ unsigned tr_addr16(unsigned lane, unsigned c, unsigned t) {
    const unsigned g = lane >> 4, q = (lane & 15) >> 2, p = lane & 3;
    return off_b(8 * g + 4 * t + q, 2 * c + (p >> 1)) + 8 * (p & 1);
}
template <int IMM>
__device__ __forceinline__ h16x8 tr_read8o(unsigned a0, unsigned a1) {
    h16x4 r0, r1;
    asm volatile("ds_read_b64_tr_b16 %0, %2 offset:%4\n\tds_read_b64_tr_b16 %1, %3 offset:%4\n\ts_waitcnt lgkmcnt(0)" : "=&v"(r0), "=&v"(r1) : "v"(a0), "v"(a1), "n"(IMM) : "memory");
    h16x8 r; r[0] = r0[0]; r[1] = r0[1]; r[2] = r0[2]; r[3] = r0[3]; r[4] = r1[0]; r[5] = r1[1]; r[6] = r1[2]; r[7] = r1[3];
    return r;
}
__device__ __forceinline__ void tr_read8x4(unsigned z0, unsigned z1, unsigned c0, h16x8 (&out)[4]) {
    h16x4 r[8];
    const unsigned a0 = z0 ^ (32u * c0), a1 = z1 ^ (32u * c0), a2 = z0 ^ (32u * (c0 + 1)), a3 = z1 ^ (32u * (c0 + 1));
    const unsigned a4 = z0 ^ (32u * (c0 + 2)), a5 = z1 ^ (32u * (c0 + 2)), a6 = z0 ^ (32u * (c0 + 3)), a7 = z1 ^ (32u * (c0 + 3));
    asm volatile("ds_read_b64_tr_b16 %0, %8\n\tds_read_b64_tr_b16 %1, %9\n\tds_read_b64_tr_b16 %2, %10\n\tds_read_b64_tr_b16 %3, %11\n\t"
                 "ds_read_b64_tr_b16 %4, %12\n\tds_read_b64_tr_b16 %5, %13\n\tds_read_b64_tr_b16 %6, %14\n\tds_read_b64_tr_b16 %7, %15\n\ts_waitcnt lgkmcnt(0)"
                 : "=&v"(r[0]), "=&v"(r[1]), "=&v"(r[2]), "=&v"(r[3]), "=&v"(r[4]), "=&v"(r[5]), "=&v"(r[6]), "=&v"(r[7])
                 : "v"(a0), "v"(a1), "v"(a2), "v"(a3), "v"(a4), "v"(a5), "v"(a6), "v"(a7) : "memory");
#pragma unroll
    for (int i = 0; i < 4; ++i) { h16x8 v; v[0] = r[2 * i][0]; v[1] = r[2 * i][1]; v[2] = r[2 * i][2]; v[3] = r[2 * i][3]; v[4] = r[2 * i + 1][0]; v[5] = r[2 * i + 1][1]; v[6] = r[2 * i + 1][2]; v[7] = r[2 * i + 1][3]; out[i] = v; }
}
template <int I, int N, class F>
__device__ __forceinline__ void static_for(F&& f) { if constexpr (I < N) { f(std::integral_constant<int, I>{}); static_for<I + 1, N>(f); } }
__device__ __forceinline__ unsigned lds_u32(const void* p) { return (unsigned)(size_t)(const LAS char*)p; }

__device__ __forceinline__ int wave_sum_small(unsigned cnt) {
    int c = 0;
#pragma unroll
    for (int b = 0; b < 7; ++b) c += __popcll(__ballot((cnt >> b) & 1u)) << b;
    return c;
}
template <int NV>
__device__ __forceinline__ void wave_kth_r4(const unsigned (&u)[NV], int K, unsigned& tau, int& need_eq) {
    tau = 0u; bool exact = false;
    for (int bit = 30; bit >= 0; bit -= 2) {
        const unsigned c1 = tau | (1u << bit), c2 = tau | (2u << bit), c3 = tau | (3u << bit);
        int n1 = 0, n2 = 0, n3 = 0;
#pragma unroll
        for (int i = 0; i < NV; ++i) { n1 += __popcll(__ballot(u[i] >= c1)); n2 += __popcll(__ballot(u[i] >= c2)); n3 += __popcll(__ballot(u[i] >= c3)); }
        int n = -1;
        if (n3 >= K) { tau = c3; n = n3; } else if (n2 >= K) { tau = c2; n = n2; } else if (n1 >= K) { tau = c1; n = n1; }
        if (n == K) { exact = true; break; }
    }
    int cg = 0;
    if (!exact && tau != 0xFFFFFFFFu) {
#pragma unroll
        for (int i = 0; i < NV; ++i) cg += __popcll(__ballot(u[i] > tau));
    }
    need_eq = exact ? K : K - cg;
}
template <int NV>
__device__ __forceinline__ void wave_kth_dyn(const unsigned (&u)[NV], int ngrp, int K, unsigned& tau, int& need_eq) {
    tau = 0u; int cg = 0; bool exact = false;
    for (int bit = 31; bit >= -1; --bit) {
        const unsigned cand = (bit >= 0) ? (tau | (1u << bit)) : tau + 1u;
        unsigned cnt = 0u;
        static_for<0, NV / 8>([&](auto G8) {
            constexpr int g8 = decltype(G8)::value;
            if (g8 < ngrp) {
#pragma unroll
                for (int i = 0; i < 8; ++i) cnt += (u[g8 * 8 + i] >= cand) ? 1u : 0u;
            }
        });
        const int c = wave_sum_small(cnt);
        if (bit >= 0) { if (c >= K) tau = cand; if (c == K) { exact = true; break; } } else cg = (tau == 0xFFFFFFFFu) ? 0 : c;
    }
    need_eq = exact ? K : K - cg;
}
template <int NV>
__device__ __forceinline__ void wave_kth(const unsigned (&u)[NV], int K, unsigned& tau, int& need_eq) {
    tau = 0u; int cg = 0; bool exact = false;
    for (int bit = 31; bit >= -1; --bit) {
        const unsigned cand = (bit >= 0) ? (tau | (1u << bit)) : tau + 1u;
        int c = 0;
        if constexpr (NV >= 8) {
            unsigned cnt = 0u;
#pragma unroll
            for (int i = 0; i < NV; ++i) cnt += (u[i] >= cand) ? 1u : 0u;
            c = wave_sum_small(cnt);
        } else {
#pragma unroll
            for (int i = 0; i < NV; ++i) c += __popcll(__ballot(u[i] >= cand));
        }
        if (bit >= 0) { if (c >= K) tau = cand; if (c == K) { exact = true; break; } } else cg = (tau == 0xFFFFFFFFu) ? 0 : c;
    }
    need_eq = exact ? K : K - cg;
}

template <bool WIN>
__device__ __forceinline__ void p0_transpose_item(const float* W, int K, int N, h16* WT, float* scr, int item, int nblk, int lane, const float* kscale = nullptr) {
    const int kb = item / nblk, nb = item % nblk, k0 = 64 * kb, n0 = 32 * nb;
    float tv[32];
#pragma unroll
    for (int i = 0; i < 32; ++i) { const int kk = 2 * i + (lane >> 5), n = n0 + (lane & 31); tv[i] = (n < N) ? W[(size_t)(k0 + kk) * N + n] : 0.f; }
#pragma unroll
    for (int i = 0; i < 32; ++i) { const int kk = 2 * i + (lane >> 5); scr[kk * 33 + (lane & 31)] = tv[i]; }
    asm volatile("s_waitcnt lgkmcnt(0)" ::: "memory");
    const int c = lane & 7;
#pragma unroll
    for (int j = 0; j < 4; ++j) {
        const int nl = (lane >> 3) + 8 * j, n = n0 + nl;
        const float* s = scr + (8 * c) * 33 + nl;
        float v[8];
#pragma unroll
        for (int e = 0; e < 8; ++e) v[e] = s[e * 33];
        if (kscale) {
#pragma unroll
            for (int e = 0; e < 8; ++e) v[e] *= kscale[k0 + 8 * c + e];
        }
        int dst = n;
        if (WIN) { if (n >= C_GR) dst = n - 16; else if (n >= C_IW) dst = 15488 + (n - C_IW); }
        if (n < N) *(u32x4*)(WT + (size_t)dst * K + k0 + 8 * c) = pk8(v);
    }
    asm volatile("s_waitcnt lgkmcnt(0)" ::: "memory");
}

__device__ __forceinline__ void phase0(const Params& p, char* smem) {
    const int tid = otid(), lane = tid & 63, wave = tid >> 6;
    const int gw = blockIdx.x * 8 + wave, NGW = gridDim.x * 8;
    const int gt = blockIdx.x * 512 + tid, NGT = gridDim.x * 512;
    for (int r = gw; r < TT; r += NGW) {
        const float* x = (r < TP) ? p.x_prompt + (size_t)r * D : p.x_sample + (size_t)(r - TP) * D;
        f32x4 v[8]; float ss = 0.f;
#pragma unroll
        for (int j = 0; j < 8; ++j) { v[j] = *(const f32x4*)(x + 4 * (lane + 64 * j)); ss += v[j].x * v[j].x + v[j].y * v[j].y + v[j].z * v[j].z + v[j].w * v[j].w; }
        ss = wave_sum(ss);
        const float rs = rsqrtf(ss * (1.f / D) + EPS);
#pragma unroll
        for (int j = 0; j < 8; ++j) {
            const f32x4 w = *(const f32x4*)(p.norm1_w + 4 * (lane + 64 * j));
            const float a = v[j].x * rs * w.x, b = v[j].y * rs * w.y, c = v[j].z * rs * w.z, d = v[j].w * rs * w.w;
            if (r < TP) { f32x2 o; o.x = __uint_as_float(pkh(a, b)); o.y = __uint_as_float(pkh(c, d)); *(f32x2*)(p.XN + (size_t)r * D + 4 * (lane + 64 * j)) = o; }
            else { f32x4 o = {a, b, c, d}; *(f32x4*)(p.XNS + (size_t)(r - TP) * D + 4 * (lane + 64 * j)) = o; }
        }
    }
    {
        float* scr = (float*)smem + wave * (64 * 33);
        constexpr int NB_IN = (NW0 + 31) / 32;
        constexpr int I_IN = 32 * NB_IN;
        for (int it = gw; it < I_IN; it += NGW) p0_transpose_item<true>(p.w_in, D, NW0, p.WinT, scr, it, NB_IN, lane);
    }
    for (int i = gt; i < (NWP - NW0) * D / 8; i += NGT) { u32x4 z = {0u, 0u, 0u, 0u}; *(u32x4*)(p.WinT + (size_t)NW0 * D + (size_t)i * 8) = z; }
    for (int i = gt; i < 2 * 8 * 128 * 64 / 8; i += NGT) {
        const int half = 8 * 128 * 64 / 8;
        const float* src = (i < half) ? p.peer_k1 + (size_t)i * 8 : p.peer_k2 + (size_t)(i - half) * 8;
        h16* dst = (i < half) ? p.K1H + (size_t)i * 8 : p.K2H + (size_t)(i - half) * 8;
        const f32x4 a = *(const f32x4*)src, b = *(const f32x4*)(src + 4);
        u32x4 o; o.x = pkh(a.x, a.y); o.y = pkh(a.z, a.w); o.z = pkh(b.x, b.y); o.w = pkh(b.z, b.w);
        *(u32x4*)dst = o;
    }
    for (int i = gt; i < 4097 * 64; i += NGT) {
        const int pi = i >> 6, fi = i & 63;
        const double pos = (pi == 4096) ? 16384.0 : (double)pi;
        double fq = 1.0;
        if (fi & 1) fq *= 0.86596432336006535; if (fi & 2) fq *= 0.74989420933245583; if (fi & 4) fq *= 0.56234132519034908;
        if (fi & 8) fq *= 0.31622776601683794; if (fi & 16) fq *= 0.1; if (fi & 32) fq *= 0.01;
        const double rev = pos * fq * 0.15915494309189533577;
        const double fr = rev - __builtin_rint(rev);
        float2 cs; cs.x = __builtin_amdgcn_cosf((float)fr); cs.y = __builtin_amdgcn_sinf((float)fr);
        p.ROPE[i] = cs;
    }
}

constexpr int G_BK = 64, G_HALF = 128, G_HT = G_HALF * G_BK;
__device__ __forceinline__ int g_lds_byte(int r, int c) {
    int st = (r >> 4) * 2 + (c >> 5), rr = r & 15, cc = c & 31, ob = rr * 64 + cc * 2;
    return st * 1024 + (ob ^ (((ob >> 9) & 1) << 5));
}
__device__ __forceinline__ void g_stage_rc(int b, int& R, int& C) {
    int st = b / 1024, sb = b % 1024, swz = sb ^ (((sb >> 9) & 1) << 5);
    R = (st >> 1) * 16 + swz / 64; C = (st & 1) * 32 + (swz % 64) / 2;
}

__device__ __forceinline__ void gemm_core(const h16* A, const h16* Bt, const int brow, const int bcol, const int K, f32x4 (&acc)[2][2][4][2], h16* shm) {
  #define SA(b,h) (shm+((b)*2+(h))*G_HT)
  #define SB(b,h) (shm+(4+(b)*2+(h))*G_HT)
  #define STAGE_X(T,P,BASE,br,kt) do{const char* _ub=(const char*)(BASE)+((long)(br)*K+(long)(kt)*G_BK)*2; \
    for(int _i=0;_i<2;++_i){int _b=(T)*16+_i*8192;int _r,_c;g_stage_rc(_b,_r,_c); \
      const unsigned _vo=(unsigned)((_r*K+_c)*2); \
      __builtin_amdgcn_global_load_lds((const unsigned*)(_ub+_vo), \
        (unsigned*)((char*)(P)+_b),16,0,0);}}while(0)
  #define STAGE(P,BASE,br,kt) STAGE_X(t0,P,BASE,br,kt)
  #define LDA(dst,b,h) for(int m=0;m<4;++m)for(int k=0;k<2;++k) \
    dst[m][k]=*reinterpret_cast<const h16x8*>((char*)SA(b,h)+g_lds_byte(wr*64+m*16+fr,k*32+fq*8))
  #define LDB(dst,b,h) for(int n=0;n<2;++n)for(int k=0;k<2;++k) \
    dst[n][k]=*reinterpret_cast<const h16x8*>((char*)SB(b,h)+g_lds_byte(wc*32+n*16+fr,k*32+fq*8))
  #define MMA(ai,bj,At,Bx) do{__builtin_amdgcn_s_setprio(1); \
    for(int m=0;m<4;++m)for(int n=0;n<2;++n)for(int k=0;k<2;++k) \
      acc[ai][bj][m][n]=__builtin_amdgcn_mfma_f32_16x16x32_f16(Bx[n][k],At[m][k],acc[ai][bj][m][n],0,0,0); \
    __builtin_amdgcn_s_setprio(0);}while(0)
  #define WAIT_V(n) asm volatile("s_waitcnt vmcnt(" #n ")":::"memory")
  #define WAIT_L(n) asm volatile("s_waitcnt lgkmcnt(" #n ")":::"memory")
  #define BAR __builtin_amdgcn_s_barrier()
  #define SCHED __builtin_amdgcn_sched_barrier(0)
  const int t0=otid();
  int wid=t0>>6,lane=t0&63,wr=wid>>2,wc=wid&3,fr=lane&15,fq=lane>>4;
  h16x8 At[4][2],B0[2][2],B1[2][2];
  const int nt=K/G_BK;
  STAGE(SB(0,0),Bt,bcol,0); STAGE(SA(0,0),A,brow,0);
  STAGE(SB(0,1),Bt,bcol+G_HALF,0); STAGE(SA(0,1),A,brow+G_HALF,0);
  if(wr==1)BAR;
  WAIT_V(4); BAR;
  STAGE(SB(1,0),Bt,bcol,1); STAGE(SA(1,0),A,brow,1); STAGE(SB(1,1),Bt,bcol+G_HALF,1);
  WAIT_V(6); BAR;
  for(int t=0;t<nt-2;t+=2){
    LDB(B0,0,0); SCHED; LDA(At,0,0); STAGE(SA(1,1),A,brow+G_HALF,t+1);
    WAIT_L(8); BAR; WAIT_L(0); MMA(0,0,At,B0); BAR; SCHED;
    LDB(B1,0,1); STAGE(SB(0,0),Bt,bcol,t+2);
    BAR; WAIT_L(0); MMA(0,1,At,B1); BAR;
    LDA(At,0,1); STAGE(SA(0,0),A,brow,t+2);
    BAR; WAIT_L(0); MMA(1,0,At,B0); BAR; SCHED;
    STAGE(SB(0,1),Bt,bcol+G_HALF,t+2);
    WAIT_V(6); BAR; MMA(1,1,At,B1); BAR;
    LDB(B0,1,0); SCHED; LDA(At,1,0); STAGE(SA(0,1),A,brow+G_HALF,t+2);
    WAIT_L(8); BAR; WAIT_L(0); MMA(0,0,At,B0); BAR; SCHED;
    LDB(B1,1,1); STAGE(SB(1,0),Bt,bcol,t+3);
    BAR; WAIT_L(0); MMA(0,1,At,B1); BAR;
    LDA(At,1,1); STAGE(SA(1,0),A,brow,t+3);
    BAR; WAIT_L(0); MMA(1,0,At,B0); BAR; SCHED;
    STAGE(SB(1,1),Bt,bcol+G_HALF,t+3);
    WAIT_V(6); BAR; MMA(1,1,At,B1); BAR;
  }
  int tz=otid(); wid=tz>>6; lane=tz&63; wr=wid>>2; wc=wid&3; fr=lane&15; fq=lane>>4;
  { LDB(B0,0,0); WAIT_V(0); LDA(At,0,0); STAGE_X(tz,SA(1,1),A,brow+G_HALF,nt-1);
    BAR; WAIT_L(0); MMA(0,0,At,B0); BAR;
    LDB(B1,0,1); BAR; WAIT_L(0); MMA(0,1,At,B1); BAR;
    LDA(At,0,1); WAIT_V(4); BAR; WAIT_L(0); MMA(1,0,At,B0); MMA(1,1,At,B1); BAR; }
  { LDB(B0,1,0); LDA(At,1,0); WAIT_V(2); BAR; WAIT_L(0); MMA(0,0,At,B0); BAR;
    LDB(B1,1,1); WAIT_V(0); BAR; WAIT_L(0); MMA(0,1,At,B1); BAR;
    LDA(At,1,1); BAR; WAIT_L(0); MMA(1,0,At,B0); MMA(1,1,At,B1); BAR; }
  if(wr==0)BAR;
  #undef SA
  #undef SB
  #undef STAGE_X
  #undef STAGE
  #undef LDA
  #undef LDB
  #undef MMA
}

__device__ __forceinline__ bool unit_next(int i, int nM, int nN, int& pm, int& pn) {
    const int nwg = nM * nN; const long L = (long)i * gridDim.x + blockIdx.x; if (L >= nwg) return false;
    int wgid = (int)L; { const int q = nwg / 8, r = nwg % 8, xcd = wgid % 8, off = wgid / 8; wgid = (xcd < r ? xcd * (q + 1) : r * (q + 1) + (xcd - r) * q) + off; }
    const int nig = 8 * nN, gid = wgid / nig, fm = gid * 8, gsz = (nM - fm) < 8 ? (nM - fm) : 8;
    pm = fm + ((wgid % nig) % gsz); pn = (wgid % nig) / gsz; return true;
}

constexpr int ES = 132;
__device__ __forceinline__ void stage_quadrant(const f32x4 (&acc)[2][2][4][2], int ai, int bj, float* E, int tz) {
    const int wid = tz >> 6, lane = tz & 63, wr = wid >> 2, wc = wid & 3, fr = lane & 15, fq = lane >> 4;
#pragma unroll
    for (int m = 0; m < 4; ++m)
#pragma unroll
        for (int n = 0; n < 2; ++n) *(f32x4*)(E + (wr * 64 + m * 16 + fr) * ES + wc * 32 + n * 16 + fq * 4) = acc[ai][bj][m][n];
}
__device__ __forceinline__ void read_rowpart(const float* E, int r, int part, float* x1, float* x2) {
#pragma unroll
    for (int q = 0; q < 4; ++q) {
        const f32x4 a = *(const f32x4*)(E + r * ES + 16 * part + 4 * q), b = *(const f32x4*)(E + r * ES + 64 + 16 * part + 4 * q);
        x1[4 * q] = a.x; x1[4 * q + 1] = a.y; x1[4 * q + 2] = a.z; x1[4 * q + 3] = a.w;
        x2[4 * q] = b.x; x2[4 * q + 1] = b.y; x2[4 * q + 2] = b.z; x2[4 * q + 3] = b.w;
    }
}

constexpr int ES16 = 264;
__device__ __forceinline__ void stage_full16(const f32x4 (&acc)[2][2][4][2], h16* E16, int tz) {
    const int wid = tz >> 6, lane = tz & 63, wr = wid >> 2, wc = wid & 3, fr = lane & 15, fq = lane >> 4;
#pragma unroll
    for (int ai = 0; ai < 2; ++ai)
#pragma unroll
        for (int bj = 0; bj < 2; ++bj)
#pragma unroll
            for (int m = 0; m < 4; ++m)
#pragma unroll
                for (int n = 0; n < 2; ++n) {
                    const f32x4 a = acc[ai][bj][m][n];
                    f32x2 o; o.x = __uint_as_float(pkh(a.x, a.y)); o.y = __uint_as_float(pkh(a.z, a.w));
                    *(f32x2*)(E16 + (ai * 128 + wr * 64 + m * 16 + fr) * ES16 + bj * 128 + wc * 32 + n * 16 + fq * 4) = o;
                }
}
__device__ __forceinline__ void read_rowpart16(const h16* E16, int row, int bj, int part, float* x1, float* x2) {
    const h16* b = E16 + row * ES16 + bj * 128 + 16 * part;
    unpk8(*(const u32x4*)b, x1); unpk8(*(const u32x4*)(b + 8), x1 + 8);
    unpk8(*(const u32x4*)(b + 64), x2); unpk8(*(const u32x4*)(b + 72), x2 + 8);
}
template <class BODY>
__device__ __forceinline__ void epilogue_full(const f32x4 (&acc)[2][2][4][2], char* smem, BODY body) {
    h16* E16 = (h16*)smem;
    const int tz = otid();
    __syncthreads();
    stage_full16(acc, E16, tz);
    __syncthreads();
    const int r = tz >> 2, part = tz & 3;
#pragma unroll 1
    for (int q = 0; q < 4; ++q) {
        float x1[16], x2[16];
        read_rowpart16(E16, (q >> 1) * 128 + r, q & 1, part, x1, x2);
        body(q >> 1, q & 1, r, part, x1, x2);
    }
    __syncthreads();
}
__device__ __forceinline__ void rope32(float* x1, float* x2, const float2* rp, int part) {
#pragma unroll
    for (int i = 0; i < 16; ++i) { const float2 cs = rp[16 * part + i]; const float a = x1[i], b = x2[i]; x1[i] = a * cs.x - b * cs.y; x2[i] = b * cs.x + a * cs.y; }
}
struct RopeRegs { f32x4 v[8]; };
__device__ __forceinline__ void rope_load(RopeRegs& rr, const float2* rp, int part) {
#pragma unroll
    for (int k = 0; k < 8; ++k) rr.v[k] = *(const f32x4*)(rp + 16 * part + 2 * k);
}
__device__ __forceinline__ void rope32r(float* x1, float* x2, const RopeRegs& rr) {
#pragma unroll
    for (int k = 0; k < 8; ++k) {
        { const float c = rr.v[k].x, s = rr.v[k].y, a = x1[2 * k], b = x2[2 * k]; x1[2 * k] = a * c - b * s; x2[2 * k] = b * c + a * s; }
        { const float c = rr.v[k].z, s = rr.v[k].w, a = x1[2 * k + 1], b = x2[2 * k + 1]; x1[2 * k + 1] = a * c - b * s; x2[2 * k + 1] = b * c + a * s; }
    }
}
template <class BUF, class LD, class PR>
__device__ __forceinline__ void epilogue_pipe(const f32x4 (&acc)[2][2][4][2], float* E, int tz, LD ld, PR pr) {
    BUF b0, b1;
    const int r = tz >> 2, part = tz & 3;
    float x1[16], x2[16];
    ld(0, 0, r, part, b0);
    __syncthreads(); stage_quadrant(acc, 0, 0, E, tz); __syncthreads(); read_rowpart(E, r, part, x1, x2); ld(0, 1, r, part, b1); pr(0, 0, r, part, b0, x1, x2);
    __syncthreads(); stage_quadrant(acc, 0, 1, E, tz); __syncthreads(); read_rowpart(E, r, part, x1, x2); ld(1, 0, r, part, b0); pr(0, 1, r, part, b1, x1, x2);
    __syncthreads(); stage_quadrant(acc, 1, 0, E, tz); __syncthreads(); read_rowpart(E, r, part, x1, x2); ld(1, 1, r, part, b1); pr(1, 0, r, part, b0, x1, x2);
    __syncthreads(); stage_quadrant(acc, 1, 1, E, tz); __syncthreads(); read_rowpart(E, r, part, x1, x2); pr(1, 1, r, part, b1, x1, x2);
}
__device__ __forceinline__ void store_h16_32(h16* dst, int part, const float* x1, const float* x2) {
    *(u32x4*)(dst + 16 * part) = pk8(x1); *(u32x4*)(dst + 16 * part + 8) = pk8(x1 + 8);
    *(u32x4*)(dst + 64 + 16 * part) = pk8(x2); *(u32x4*)(dst + 64 + 16 * part + 8) = pk8(x2 + 8);
}
__device__ __forceinline__ void store_fp8_32(unsigned char* dst, int part, const float* x1, const float* x2, float sc) {
    u32x4 a, b;
#pragma unroll
    for (int q = 0; q < 4; ++q) {
        int w = __builtin_amdgcn_cvt_pk_fp8_f32(x1[4 * q] * sc, x1[4 * q + 1] * sc, 0, false);
        w = __builtin_amdgcn_cvt_pk_fp8_f32(x1[4 * q + 2] * sc, x1[4 * q + 3] * sc, w, true); a[q] = (unsigned)w;
        int v = __builtin_amdgcn_cvt_pk_fp8_f32(x2[4 * q] * sc, x2[4 * q + 1] * sc, 0, false);
        v = __builtin_amdgcn_cvt_pk_fp8_f32(x2[4 * q + 2] * sc, x2[4 * q + 3] * sc, v, true); b[q] = (unsigned)v;
    }
    *(u32x4*)(dst + 16 * part) = a; *(u32x4*)(dst + 64 + 16 * part) = b;
}
__device__ __forceinline__ void store_f32_32(float* dst, int part, const float* x1, const float* x2) {
#pragma unroll
    for (int q = 0; q < 4; ++q) {
        f32x4 a = {x1[4 * q], x1[4 * q + 1], x1[4 * q + 2], x1[4 * q + 3]}, b = {x2[4 * q], x2[4 * q + 1], x2[4 * q + 2], x2[4 * q + 3]};
        *(f32x4*)(dst + 16 * part + 4 * q) = a; *(f32x4*)(dst + 64 + 16 * part + 4 * q) = b;
    }
}
__device__ __forceinline__ float quad_sum(float v) { v += __shfl_xor(v, 1); v += __shfl_xor(v, 2); return v; }

__device__ __forceinline__ void inproj_block(const Params& p, int cb, int tok, int part, float* x1, float* x2, const RopeRegs& rr) {
    if (cb < 8) {
        rope32r(x1, x2, rr); store_h16_32(p.RQ + (size_t)tok * 1024 + cb * 128, part, x1, x2);
    } else if (cb < 16) {
        rope32r(x1, x2, rr);
#pragma unroll
        for (int i = 0; i < 16; ++i) { x1[i] *= 0.08838834764831845f; x2[i] *= 0.08838834764831845f; }
        store_h16_32(p.RK + (size_t)tok * 1024 + (cb - 8) * 128, part, x1, x2);
    } else if (cb < 32) {
        store_h16_32(p.RV + (size_t)tok * 2048 + (cb - 16) * 128, part, x1, x2);
    } else if (cb < 48) {
#pragma unroll
        for (int i = 0; i < 16; ++i) { x1[i] = siluf_(x1[i]); x2[i] = siluf_(x2[i]); }
        store_h16_32(p.RG + (size_t)tok * 2048 + (cb - 32) * 128, part, x1, x2);
    } else if (cb < 68) {
        const bool isq = cb < 64;
        float ss = 0.f;
#pragma unroll
        for (int i = 0; i < 16; ++i) ss += x1[i] * x1[i] + x2[i] * x2[i];
        ss = quad_sum(ss);
        const float rs = rsqrtf(ss * (1.f / 128.f) + EPS);
        const float* nw = isq ? p.q_norm_w : p.k_norm_w;
#pragma unroll
        for (int i = 0; i < 16; ++i) { x1[i] *= rs * nw[16 * part + i]; x2[i] *= rs * nw[64 + 16 * part + i]; }
        rope32r(x1, x2, rr);
        if (isq) {
#pragma unroll
            for (int i = 0; i < 16; ++i) { x1[i] *= 0.08838834764831845f; x2[i] *= 0.08838834764831845f; }
            store_fp8_32(p.AQ8 + (size_t)tok * 2048 + (cb - 48) * 128, part, x1, x2, 16.f);
        } else {
            store_fp8_32(p.AK8 + (size_t)tok * 512 + (cb - 64) * 128, part, x1, x2, 1.f);
            store_f32_32(p.out + O_KP + (size_t)tok * 512 + (cb - 64) * 128, part, x1, x2);
        }
    } else if (cb < 72) {
        store_h16_32(p.AV + (size_t)tok * 512 + (cb - 68) * 128, part, x1, x2);
        store_f32_32(p.out + O_VP + (size_t)tok * 512 + (cb - 68) * 128, part, x1, x2);
    } else if (cb < 88) {
        rope32r(x1, x2, rr);
#pragma unroll
        for (int i = 0; i < 16; ++i) { x1[i] *= 0.08838834764831845f; x2[i] *= 0.08838834764831845f; }
        store_h16_32(p.IQ + (size_t)tok * 2048 + (cb - 72) * 128, part, x1, x2);
    } else if (cb == 88) {
        rope32r(x1, x2, rr);
        store_h16_32(p.IK + (size_t)tok * 128, part, x1, x2);
        store_f32_32(p.out + O_IKP + (size_t)tok * 128, part, x1, x2);
    } else if (cb < 121) {
#pragma unroll
        for (int i = 0; i < 16; ++i) { x1[i] = sigmoidf_(x1[i]); x2[i] = sigmoidf_(x2[i]); }
        h16* dst = (cb < 105) ? p.GR + (size_t)tok * 2048 + (cb - 89) * 128 : p.GA + (size_t)tok * 2048 + (cb - 105) * 128;
        store_h16_32(dst, part, x1, x2);
    } else {
        if (part == 0) {
#pragma unroll
            for (int q = 0; q < 4; ++q) { f32x4 a = {x1[4 * q] * 0.25f, x1[4 * q + 1] * 0.25f, x1[4 * q + 2] * 0.25f, x1[4 * q + 3] * 0.25f}; *(f32x4*)(p.IW + (size_t)tok * 16 + 4 * q) = a; }
        }
    }
}

template <int CB, class F>
__device__ __forceinline__ void gemv8_item(const float* A, const float* W, int N, int n0, char* smem, F f, const float* normw = nullptr, float* shn_out = nullptr) {
    constexpr int C4 = CB / 4, KG = 512 / C4, NL = 2048 / KG, OUT = 8 * CB, P = 512 / OUT;
    const int tid = otid();
    float* AT = (float*)smem;
    float* red = AT + 2048 * 8;
    float* rs8 = (float*)(smem + 131072);
    __syncthreads();
    if (normw) {
        float ssl[8];
#pragma unroll
        for (int t = 0; t < 8; ++t) ssl[t] = 0.f;
#pragma unroll
        for (int j = 0; j < 32; ++j) { const int i = tid + 512 * j, t = i >> 11, k = i & 2047; const float a = A[i]; AT[k * 8 + t] = a * normw[k]; ssl[j >> 2] += a * a; }
#pragma unroll
        for (int t = 0; t < 8; ++t) { const float s = wave_sum(ssl[t]); if ((tid & 63) == 0) rs8[8 + (tid >> 6) * 8 + t] = s; }
        __syncthreads();
        if (tid < 8) { float s = 0.f; for (int w = 0; w < 8; ++w) s += rs8[8 + w * 8 + tid]; rs8[tid] = rsqrtf(s * (1.f / 2048.f) + EPS); }
        __syncthreads();
        if (shn_out) for (int i = tid; i < 8 * 2048; i += 512) { const int t = i >> 11, k = i & 2047; shn_out[i] = AT[k * 8 + t] * rs8[t]; }
    } else {
        float av32[32];
#pragma unroll
        for (int j = 0; j < 32; ++j) av32[j] = A[tid + 512 * j];
#pragma unroll
        for (int j = 0; j < 32; ++j) { const int i = tid + 512 * j, t = i >> 11, k = i & 2047; AT[k * 8 + t] = av32[j]; }
        __syncthreads();
    }
    const int c4 = tid % C4, kg = tid / C4, n = n0 + 4 * c4;
    const bool ok = (n + 3) < N;
    float acc[8][4];
#pragma unroll
    for (int t = 0; t < 8; ++t)
#pragma unroll
        for (int c = 0; c < 4; ++c) acc[t][c] = 0.f;
    const float* wp = W + (size_t)kg * N + (ok ? n : 0);
#pragma unroll 16
    for (int j = 0; j < NL; ++j) {
        const int k = kg + KG * j;
        f32x4 w = *(const f32x4*)(wp + (size_t)(KG * j) * N);
        if (!ok) w = (f32x4){0.f, 0.f, 0.f, 0.f};
        const f32x4 a0 = *(const f32x4*)(AT + k * 8), a1 = *(const f32x4*)(AT + k * 8 + 4);
        const float av[8] = {a0.x, a0.y, a0.z, a0.w, a1.x, a1.y, a1.z, a1.w};
#pragma unroll
        for (int t = 0; t < 8; ++t) { acc[t][0] += av[t] * w.x; acc[t][1] += av[t] * w.y; acc[t][2] += av[t] * w.z; acc[t][3] += av[t] * w.w; }
    }
#pragma unroll
    for (int t = 0; t < 8; ++t) { f32x4 v = {acc[t][0], acc[t][1], acc[t][2], acc[t][3]}; *(f32x4*)(red + (kg * 8 + t) * CB + 4 * c4) = v; }
    __syncthreads();
    {
        const int o = tid % OUT, part = tid / OUT, t = o / CB, col = o % CB;
        float s = 0.f;
#pragma unroll 8
        for (int q = 0; q < 32; ++q) s += red[((part * 32 + q) * 8 + t) * CB + col];
        if (P > 1) {
            AT[part * OUT + o] = s;
            __syncthreads();
            if (tid < OUT) {
                s = 0.f;
#pragma unroll
                for (int q = 0; q < P; ++q) s += AT[q * OUT + o];
            }
        }
        if (tid < OUT && (n0 + col) < N) f(t, n0 + col, normw ? s * rs8[t] : s);
    }
}

__device__ __forceinline__ void late_weight_transposes(const Params& p, char* smem, int first) {
    const int t0 = otid(), lane = t0 & 63, wave = t0 >> 6;
    const int G = gridDim.x, gw = ((int)blockIdx.x - first) * 8 + wave, NGW = (G - first) * 8;
    float* scr = (float*)smem + wave * (64 * 33);
    constexpr int I_SQ = 32 * 64, I_WQ = 32 * 32, NIT = 3 * I_SQ + I_WQ;
    __syncthreads();
    for (int it = gw; it < NIT; it += NGW) {
        int r = it;
        if (r < I_SQ) { p0_transpose_item<false>(p.w_ret_o, D, D, p.WrT, scr, r, 64, lane); continue; } r -= I_SQ;
        if (r < I_SQ) { p0_transpose_item<false>(p.w_att_o, D, D, p.WaT, scr, r, 64, lane); continue; } r -= I_SQ;
        if (r < I_SQ) { p0_transpose_item<false>(p.w_out, D, D, p.WoT, scr, r, 64, lane); continue; } r -= I_SQ;
        p0_transpose_item<false>(p.peer_wq, D, 1024, p.WqT, scr, r, 32, lane, p.norm2_w);
    }
    __syncthreads();
}

__device__ __forceinline__ void phase1(const Params& p, char* smem) {
    const int tid = otid();
    for (int i = 0;; ++i) {
        int pm, pn; if (!unit_next(i, TP / 256, NWP / 256, pm, pn)) break;
        f32x4 acc[2][2][4][2] = {};
        gemm_core(p.XN, p.WinT, pm * 256, pn * 256, D, acc, (h16*)smem);
        epilogue_full(acc, smem, [&](int ai, int bj, int r, int part, float* x1, float* x2) {
            RopeRegs rr;
            rope_load(rr, p.ROPE + (size_t)((pm * 256 + ai * 128 + r) & (SEQ - 1)) * 64, part);
            inproj_block(p, pn * 2 + bj, pm * 256 + ai * 128 + r, part, x1, x2, rr);
        });
    }
    {
        const int G = gridDim.x, first = (G > 160) ? 160 : 0, nw = G - first;
        if ((int)blockIdx.x >= first) {
            for (int it = blockIdx.x - first; it < (NW0 + 63) / 64; it += nw) {
                float* ZS = p.ZS;
                gemv8_item<64>(p.XNS, p.w_in, NW0, it * 64, smem, [=](int t, int n, float v) { ZS[(size_t)t * NW0 + n] = v; });
            }
            late_weight_transposes(p, smem, first);
        }
    }
}

__device__ __forceinline__ void indexer_item(const Params& p, int b, int g, char* smem) {
    const int tid = otid(), lane = tid & 63, wave = tid >> 6, r16 = lane & 15, kq = lane >> 4;
    float* SC = (float*)smem;
    const int t0 = 8 * g, nkeys = 8 * g + 8, ntile = (nkeys + 15) >> 4;
    const size_t tb = (size_t)b * SEQ;
    {
        h16x8 af[2][4][4];
        float* WL = (float*)(smem + 8 * SCS * 4);
        if (tid < 128) WL[tid] = p.IW[(tb + t0) * 16 + tid];
#pragma unroll
        for (int Qg = 0; Qg < 2; ++Qg)
#pragma unroll
            for (int hg = 0; hg < 4; ++hg) {
                const h16* qp = p.IQ + (tb + t0 + Qg * 4 + (r16 >> 2)) * 2048 + (hg * 4 + (r16 & 3)) * 128 + kq * 8;
#pragma unroll
                for (int kk = 0; kk < 4; ++kk) af[Qg][hg][kk] = *(const h16x8*)(qp + kk * 32);
            }
        __syncthreads();
        f32x4 wv[2][4];
#pragma unroll
        for (int Qg = 0; Qg < 2; ++Qg)
#pragma unroll
            for (int hg = 0; hg < 4; ++hg) wv[Qg][hg] = *(const f32x4*)(WL + (Qg * 4 + kq) * 16 + hg * 4);
        const h16* kbase = p.IK + (tb + r16) * 128 + kq * 8;
        const int last = ntile - 1;
        h16x8 b0[4], b1[4], b2[4];
#define IDX_LOAD(dst, tl) { const int _t = (tl) < last ? (tl) : last; const h16* _kp = kbase + (size_t)_t * 16 * 128; \
    asm volatile("global_load_dwordx4 %0, %4, off\n\tglobal_load_dwordx4 %1, %4, off offset:64\n\tglobal_load_dwordx4 %2, %4, off offset:128\n\tglobal_load_dwordx4 %3, %4, off offset:192" \
                 : "=&v"(dst[0]), "=&v"(dst[1]), "=&v"(dst[2]), "=&v"(dst[3]) : "v"(_kp) : "memory"); }
#define IDX_WAIT8(bfr) asm volatile("s_waitcnt vmcnt(8)" : "+v"(bfr[0]), "+v"(bfr[1]), "+v"(bfr[2]), "+v"(bfr[3]) :: "memory")
#define IDX_TILE(bfr, tl) { const int _t = (tl) < last ? (tl) : last; \
    _Pragma("unroll") for (int Qg = 0; Qg < 2; ++Qg) { float sc = 0.f; \
        _Pragma("unroll") for (int hg = 0; hg < 4; ++hg) { f32x4 a = {0.f, 0.f, 0.f, 0.f}; \
            _Pragma("unroll") for (int kk = 0; kk < 4; ++kk) a = __builtin_amdgcn_mfma_f32_16x16x32_f16(af[Qg][hg][kk], bfr[kk], a, 0, 0, 0); \
            sc += wv[Qg][hg].x * fmaxf(a.x, 0.f) + wv[Qg][hg].y * fmaxf(a.y, 0.f) + wv[Qg][hg].z * fmaxf(a.z, 0.f) + wv[Qg][hg].w * fmaxf(a.w, 0.f); } \
        SC[(Qg * 4 + kq) * SCS + _t * 16 + r16] = sc; } }
#pragma unroll
        for (int Qg = 0; Qg < 2; ++Qg)
#pragma unroll
            for (int hg = 0; hg < 4; ++hg) asm volatile("" : "+v"(af[Qg][hg][0]), "+v"(af[Qg][hg][1]), "+v"(af[Qg][hg][2]), "+v"(af[Qg][hg][3]));
#pragma unroll
        for (int Qg = 0; Qg < 2; ++Qg) asm volatile("" : "+v"(wv[Qg][0]), "+v"(wv[Qg][1]), "+v"(wv[Qg][2]), "+v"(wv[Qg][3]));
        IDX_LOAD(b0, wave) IDX_LOAD(b1, wave + 8) IDX_LOAD(b2, wave + 16)
        for (int tile = wave; tile < ntile; tile += 24) {
            IDX_WAIT8(b0); IDX_TILE(b0, tile) IDX_LOAD(b0, tile + 24)
            IDX_WAIT8(b1); IDX_TILE(b1, tile + 8) IDX_LOAD(b1, tile + 32)
            IDX_WAIT8(b2); IDX_TILE(b2, tile + 16) IDX_LOAD(b2, tile + 40)
        }
        asm volatile("s_waitcnt vmcnt(0)" ::: "memory");
#undef IDX_WAIT8
#undef IDX_LOAD
#undef IDX_TILE
    }
    __syncthreads();
    {
        const int t = t0 + wave, nvalid = t + 1;
        int* outp = p.TOPI + (tb + t) * 256;
        if (nvalid <= 256) {
#pragma unroll
            for (int i = 0; i < 4; ++i) { const int j = lane + 64 * i; outp[j] = (j < nvalid) ? j : -1; }
        } else {
            unsigned u[64];
#pragma unroll
            for (int i = 0; i < 64; ++i) { const int s = i * 64 + lane; const unsigned o = f2ord(SC[wave * SCS + s]); u[i] = (s <= t) ? o : 0u; }
            unsigned tau; int need_eq;
            const int nreg = __builtin_amdgcn_readfirstlane((t >> 6) + 1);
            wave_kth_dyn<64>(u, (nreg + 7) >> 3, 256, tau, need_eq);
            const u64 lt = (1ull << lane) - 1ull;
            int base = 0, eqt = 0;
            unsigned tau2 = tau; asm volatile("" : "+v"(tau2));
            static_for<0, 16>([&](auto G4) {
                constexpr int g4 = decltype(G4)::value;
                if (g4 * 4 < nreg) {
#pragma unroll
                    for (int ii = 0; ii < 4; ++ii) {
                        constexpr int dummy = 0; (void)dummy;
                        const int i = g4 * 4 + ii;
                        const bool gt = u[i] > tau2, eq = u[i] == tau2;
                        const u64 meq = __ballot(eq);
                        const bool sel = gt || (eq && (eqt + __popcll(meq & lt)) < need_eq);
                        const u64 ms = __ballot(sel);
                        if (sel) outp[base + __popcll(ms & lt)] = i * 64 + lane;
                        base += __popcll(ms); eqt += __popcll(meq);
                    }
                    __builtin_amdgcn_sched_barrier(0);
                }
            });
        }
    }
    __syncthreads();
}

__device__ __forceinline__ void kv_item(const Params& p, int b, int h, int c, char* smem) {
    const int tid = otid(), lane = tid & 63, wave = tid >> 6;
    char* Kimg = smem;
    char* Vimg = smem + 32768;
    const size_t tok0 = (size_t)b * SEQ + c * 128;
    const float lg = ret_log_g(h);
#pragma unroll
    for (int i = 0; i < 4; ++i) {
        const int q = tid + 512 * i, tt = q >> 4, ch = q & 15;
        const u32x4 raw = *(const u32x4*)(p.RK + (tok0 + tt) * 1024 + h * 128 + ch * 8);
        float v[8]; unpk8(raw, v);
        const float dec = __expf((float)(127 - tt) * lg);
#pragma unroll
        for (int e = 0; e < 8; ++e) v[e] *= dec;
        *(u32x4*)(Kimg + (tt >> 5) * 8192 + off_b(tt & 31, ch)) = pk8(v);
    }
#pragma unroll
    for (int i = 0; i < 8; ++i) {
        const int q = tid + 512 * i, tt = q >> 5, c32 = q & 31;
        const u32x4 raw = *(const u32x4*)(p.RV + (tok0 + tt) * 2048 + h * 256 + c32 * 8);
        *(u32x4*)(Vimg + ((tt >> 5) * 2 + (c32 >> 4)) * 8192 + off_b(tt & 31, c32 & 15)) = raw;
    }
    __syncthreads();
    f32x4 acc[16];
#pragma unroll
    for (int nt = 0; nt < 16; ++nt) acc[nt] = (f32x4){0.f, 0.f, 0.f, 0.f};
    const unsigned z0 = lds_u32(smem) + tr_addr16(lane, 0, 0), z1 = lds_u32(smem) + tr_addr16(lane, 0, 1);
    static_for<0, 4>([&](auto KS) {
        constexpr int ks = decltype(KS)::value;
        const h16x8 af = tr_read8o<ks * 8192>(z0 ^ (32u * wave), z1 ^ (32u * wave));
        static_for<0, 16>([&](auto NT) {
            constexpr int nt = decltype(NT)::value;
            const h16x8 bf = tr_read8o<(ks * 2 + (nt >> 3)) * 8192>((z0 + 32768u) ^ (32u * (nt & 7)), (z1 + 32768u) ^ (32u * (nt & 7)));
            acc[nt] = __builtin_amdgcn_mfma_f32_16x16x32_f16(bf, af, acc[nt], 0, 0, 0);
        });
    });
    float* dst = p.KV + ((size_t)((b * 8 + h) * 32 + c) * 128) * 256;
#pragma unroll
    for (int nt = 0; nt < 16; ++nt) *(f32x4*)(dst + (size_t)(16 * wave + (lane & 15)) * 256 + 16 * nt + 4 * (lane >> 4)) = acc[nt];
    __syncthreads();
}

__device__ __forceinline__ void sample_post_item(const Params& p) {
    const int tid = otid();
    const float2* rp = p.ROPE + (size_t)4096 * 64;
    for (int q = tid; q < 8 * 122 * 4; q += 512) {
        const int part = q & 3, cb = (q >> 2) % 122, t = (q >> 2) / 122;
        const int col0 = (cb < 89) ? cb * 128 : (cb < 105) ? C_GR + (cb - 89) * 128 : (cb < 121) ? C_GA + (cb - 105) * 128 : C_IW;
        const float* z = p.ZS + (size_t)t * NW0 + col0;
        float x1[16], x2[16];
        if (cb < 121) {
#pragma unroll
            for (int i = 0; i < 16; ++i) { x1[i] = z[16 * part + i]; x2[i] = z[64 + 16 * part + i]; }
        } else {
#pragma unroll
            for (int i = 0; i < 16; ++i) { x1[i] = z[i]; x2[i] = 0.f; }
        }
        if (cb < 8) { rope32(x1, x2, rp, part); store_f32_32(p.SRQ + t * 1024 + cb * 128, part, x1, x2); }
        else if (cb < 16) {
            rope32(x1, x2, rp, part);
#pragma unroll
            for (int i = 0; i < 16; ++i) { x1[i] *= 0.08838834764831845f; x2[i] *= 0.08838834764831845f; }
            store_f32_32(p.SRK + t * 1024 + (cb - 8) * 128, part, x1, x2);
        } else if (cb < 32) store_f32_32(p.SRV + t * 2048 + (cb - 16) * 128, part, x1, x2);
        else if (cb < 48) {
#pragma unroll
            for (int i = 0; i < 16; ++i) { x1[i] = siluf_(x1[i]); x2[i] = siluf_(x2[i]); }
            store_f32_32(p.SRG + t * 2048 + (cb - 32) * 128, part, x1, x2);
        } else if (cb < 68) {
            const bool isq = cb < 64;
            float ss = 0.f;
#pragma unroll
            for (int i = 0; i < 16; ++i) ss += x1[i] * x1[i] + x2[i] * x2[i];
            ss = quad_sum(ss);
            const float rs = rsqrtf(ss * (1.f / 128.f) + EPS);
            const float* nw = isq ? p.q_norm_w : p.k_norm_w;
#pragma unroll
            for (int i = 0; i < 16; ++i) { x1[i] *= rs * nw[16 * part + i]; x2[i] *= rs * nw[64 + 16 * part + i]; }
            rope32(x1, x2, rp, part);
            if (isq) {
#pragma unroll
                for (int i = 0; i < 16; ++i) { x1[i] *= 0.08838834764831845f; x2[i] *= 0.08838834764831845f; }
                store_f32_32(p.SAQ + t * 2048 + (cb - 48) * 128, part, x1, x2);
            } else {
                store_f32_32(p.SAK + t * 512 + (cb - 64) * 128, part, x1, x2);
                store_f32_32(p.out + O_KS + t * 512 + (cb - 64) * 128, part, x1, x2);
            }
        } else if (cb < 72) {
            store_f32_32(p.SAV + t * 512 + (cb - 68) * 128, part, x1, x2);
            store_f32_32(p.out + O_VS + t * 512 + (cb - 68) * 128, part, x1, x2);
        } else if (cb < 88) {
        } else if (cb == 88) {
            rope32(x1, x2, rp, part);
            store_f32_32(p.SIK + t * 128, part, x1, x2);
            store_f32_32(p.out + O_IKS + t * 128, part, x1, x2);
        } else if (cb < 121) {
#pragma unroll
            for (int i = 0; i < 16; ++i) { x1[i] = sigmoidf_(x1[i]); x2[i] = sigmoidf_(x2[i]); }
            float* dst = (cb < 105) ? p.SGR + t * 2048 + (cb - 89) * 128 : p.SGA + t * 2048 + (cb - 105) * 128;
            store_f32_32(dst, part, x1, x2);
        }
    }
}

__device__ __forceinline__ void sample_indexer_item(const Params& p, int t, int kr, char* smem) {
    const int tid = otid();
    float* qs = (float*)smem;
    float* ws = qs + 2048;
    float* kself = ws + 16;
    float* tmp = kself + 128;
    const float2* rp = p.ROPE + (size_t)4096 * 64;
    const float* z = p.ZS + (size_t)t * NW0;
    __syncthreads();
#pragma unroll
    for (int i = 0; i < 2; ++i) {
        const int pr = tid + 512 * i, hh = pr >> 6, d = pr & 63;
        const float a = z[C_IQ + hh * 128 + d], b = z[C_IQ + hh * 128 + 64 + d];
        const float2 cs = rp[d];
        qs[hh * 128 + d] = (a * cs.x - b * cs.y) * 0.08838834764831845f;
        qs[hh * 128 + 64 + d] = (b * cs.x + a * cs.y) * 0.08838834764831845f;
    }
    if (tid < 16) ws[tid] = z[C_IW + tid] * 0.25f;
    if (tid < 64) { const float a = z[C_IK + tid], b = z[C_IK + 64 + tid]; const float2 cs = rp[tid]; kself[tid] = a * cs.x - b * cs.y; kself[64 + tid] = b * cs.x + a * cs.y; }
    __syncthreads();
    {
        const int lane = tid & 63, wave = tid >> 6, r16 = lane & 15, g = lane >> 4;
        h16x8 qhi[4], qlo[4];
#pragma unroll
        for (int kk = 0; kk < 4; ++kk) {
            const float* qp = qs + r16 * 128 + kk * 32 + g * 8;
            const f32x4 a = *(const f32x4*)qp, b = *(const f32x4*)(qp + 4);
            const float v[8] = {a.x, a.y, a.z, a.w, b.x, b.y, b.z, b.w};
#pragma unroll
            for (int e = 0; e < 8; ++e) { const h16 hv = (h16)v[e]; qhi[kk][e] = hv; qlo[kk][e] = (h16)(v[e] - (float)hv); }
        }
        f32x4 wv4 = *(const f32x4*)(ws + 4 * g);
        f32x4 kraw[4][4][2];
#pragma unroll
        for (int tl = 0; tl < 4; ++tl) {
            const int s = kr * 512 + (wave * 4 + tl) * 16 + r16;
            const int page = p.page_table[t * NPAGES + (s >> 7)];
            const float* kp = p.cache_kidx + ((size_t)page * PAGE + (s & 127)) * 128 + g * 8;
#pragma unroll
            for (int kk = 0; kk < 4; ++kk) { kraw[tl][kk][0] = *(const f32x4*)(kp + kk * 32); kraw[tl][kk][1] = *(const f32x4*)(kp + kk * 32 + 4); }
        }
#pragma unroll
        for (int tl = 0; tl < 4; ++tl) {
            f32x4 acc = {0.f, 0.f, 0.f, 0.f};
#pragma unroll
            for (int kk = 0; kk < 4; ++kk) {
                const f32x4 a = kraw[tl][kk][0], b = kraw[tl][kk][1];
                const float v[8] = {a.x, a.y, a.z, a.w, b.x, b.y, b.z, b.w};
                h16x8 khi, klo;
#pragma unroll
                for (int e = 0; e < 8; ++e) { const h16 hv = (h16)v[e]; khi[e] = hv; klo[e] = (h16)(v[e] - (float)hv); }
                acc = __builtin_amdgcn_mfma_f32_16x16x32_f16(qlo[kk], khi, acc, 0, 0, 0);
                acc = __builtin_amdgcn_mfma_f32_16x16x32_f16(qhi[kk], klo, acc, 0, 0, 0);
                acc = __builtin_amdgcn_mfma_f32_16x16x32_f16(qhi[kk], khi, acc, 0, 0, 0);
            }
            float sc = wv4.x * fmaxf(acc.x, 0.f) + wv4.y * fmaxf(acc.y, 0.f) + wv4.z * fmaxf(acc.z, 0.f) + wv4.w * fmaxf(acc.w, 0.f);
            sc += __shfl_xor(sc, 16); sc += __shfl_xor(sc, 32);
            if (g == 0) p.SSC[(size_t)t * SSCS + kr * 512 + (wave * 4 + tl) * 16 + r16] = sc;
        }
    }
    if (kr == 31) {
        if (tid < 16) { float d = 0.f;
#pragma unroll 4
            for (int i = 0; i < 128; ++i) d += qs[tid * 128 + i] * kself[i]; tmp[tid] = ws[tid] * fmaxf(d, 0.f); }
        __syncthreads();
        if (tid == 0) { float sc = 0.f; for (int i = 0; i < 16; ++i) sc += tmp[i]; p.SSC[(size_t)t * SSCS + PAST] = sc; }
    }
    __syncthreads();
}

__device__ __forceinline__ void phase2(const Params& p, char* smem) {
    const int c = blockIdx.x, G = gridDim.x;
    for (int k = 0;; ++k) {
        const int rr = (k >> 1) * 2 * G, r = (k & 1) ? rr + 2 * G - 1 - c : rr + c;
        if (rr >= 1024) break;
        if (r < 1024) indexer_item(p, r & 1, 511 - (r >> 1), smem);
    }
    for (int it = c; it < 512; it += G) kv_item(p, it >> 8, (it >> 5) & 7, it & 31, smem);
    for (int it = c; it < 256; it += G) sample_indexer_item(p, it >> 5, it & 31, smem);
    if (c == G - 1) sample_post_item(p);
}

__device__ __forceinline__ void scan_item(const Params& p, int item) {
    const int idx = item * 512 + otid();
    const int dv = idx & 255, dkb = (idx >> 8) & 15, h = (idx >> 12) & 7, b = idx >> 15;
    const float gC = __expf(128.f * ret_log_g(h));
    float S[8];
#pragma unroll
    for (int i = 0; i < 8; ++i) S[i] = 0.f;
    const size_t bh = (size_t)(b * 8 + h);
#pragma unroll 4
    for (int c = 0; c < 32; ++c) {
        *(u32x4*)(p.SPT + (((bh * 32 + c) * 256 + dv) * 128) + dkb * 8) = pk8(S);
        const float* kv = p.KV + ((bh * 32 + c) * 128 + dkb * 8) * 256 + dv;
#pragma unroll
        for (int i = 0; i < 8; ++i) S[i] = gC * S[i] + kv[(size_t)i * 256];
    }
#pragma unroll
    for (int i = 0; i < 8; ++i) p.out[O_SP + (bh * 128 + dkb * 8 + i) * 256 + dv] = S[i];
}

__device__ __forceinline__ void attn_item(const Params& p, int b, int n, int qg, char* smem) {
    const int tid = otid(), lane = tid & 63, wave = tid >> 6, r16 = lane & 15, g = lane >> 4;
    const int tt = 8 * qg + wave, t = b * SEQ + tt;
    const int cnt = (tt + 1 < 256) ? tt + 1 : 256;
    int* lidx = (int*)(smem + wave * 9216);
    char* img = smem + wave * 9216 + 1024;
    const unsigned az0 = lds_u32(img) + tr_addr16(lane, 0, 0), az1 = lds_u32(img) + tr_addr16(lane, 0, 1);
    const size_t tb = (size_t)b * SEQ;
#pragma unroll
    for (int i = 0; i < 4; ++i) { const int v = p.TOPI[(size_t)t * 256 + lane + 64 * i]; lidx[lane + 64 * i] = v < 0 ? 0 : v; }
    long qf[4];
    {
        const unsigned char* qp = p.AQ8 + (size_t)t * 2048 + (n * 4 + (r16 & 3)) * 128 + 16 * g;
        u32x4 c0 = *(const u32x4*)qp, c1 = *(const u32x4*)(qp + 64);
        if (r16 >= 4) { c0 = (u32x4){0u, 0u, 0u, 0u}; c1 = c0; }
        qf[0] = (long)(((u64)c0.y << 32) | c0.x); qf[1] = (long)(((u64)c0.w << 32) | c0.z);
        qf[2] = (long)(((u64)c1.y << 32) | c1.x); qf[3] = (long)(((u64)c1.w << 32) | c1.z);
    }
    const unsigned char* kbase = p.AK8 + tb * 512 + n * 128 + 16 * g;
    const h16* vbase = p.AV + tb * 512 + n * 128;
    f32x4 sacc[16];
    {
        u32x4 kf[16][2];
#pragma unroll
        for (int i = 0; i < 16; ++i) {
            const unsigned char* kp = kbase + (size_t)lidx[16 * i + r16] * 512;
            kf[i][0] = *(const u32x4*)kp; kf[i][1] = *(const u32x4*)(kp + 64);
        }
#pragma unroll
        for (int i = 0; i < 16; ++i) {
            const u32x4 k0 = kf[i][0], k1 = kf[i][1];
            f32x4 a = {0.f, 0.f, 0.f, 0.f};
            a = __builtin_amdgcn_mfma_f32_16x16x32_fp8_fp8((long)(((u64)k0.y << 32) | k0.x), qf[0], a, 0, 0, 0);
            a = __builtin_amdgcn_mfma_f32_16x16x32_fp8_fp8((long)(((u64)k0.w << 32) | k0.z), qf[1], a, 0, 0, 0);
            a = __builtin_amdgcn_mfma_f32_16x16x32_fp8_fp8((long)(((u64)k1.y << 32) | k1.x), qf[2], a, 0, 0, 0);
            a = __builtin_amdgcn_mfma_f32_16x16x32_fp8_fp8((long)(((u64)k1.w << 32) | k1.z), qf[3], a, 0, 0, 0);
#pragma unroll
            for (int j = 0; j < 4; ++j) sacc[i][j] = ((16 * i + 4 * g + j) < cnt) ? a[j] * (1.f / 16.f) : -3.0e38f;
        }
    }
    u32x4 vr[3][8];
#pragma unroll
    for (int b0 = 0; b0 < 3; ++b0)
#pragma unroll
        for (int i2 = 0; i2 < 8; ++i2) {
            const int q = lane + 64 * i2, s = q >> 4, ch = q & 15;
            const int slot = (2 * b0 + ((s >> 2) & 1)) * 16 + 4 * (s >> 3) + (s & 3);
            vr[b0][i2] = *(const u32x4*)(vbase + (size_t)lidx[slot] * 512 + ch * 8);
        }
    float mx = -3.0e38f;
#pragma unroll
    for (int i = 0; i < 16; ++i)
#pragma unroll
        for (int j = 0; j < 4; ++j) mx = fmaxf(mx, sacc[i][j]);
    mx = fmaxf(mx, __shfl_xor(mx, 16)); mx = fmaxf(mx, __shfl_xor(mx, 32));
    float sum = 0.f;
#pragma unroll
    for (int i = 0; i < 16; ++i)
#pragma unroll
        for (int j = 0; j < 4; ++j) { const float e = __expf(sacc[i][j] - mx); sacc[i][j] = e; sum += e; }
    sum += __shfl_xor(sum, 16); sum += __shfl_xor(sum, 32);
    f32x4 oacc[8];
#pragma unroll
    for (int c = 0; c < 8; ++c) oacc[c] = (f32x4){0.f, 0.f, 0.f, 0.f};
#pragma unroll
    for (int bI = 0; bI < 8; ++bI) {
#pragma unroll
        for (int i2 = 0; i2 < 8; ++i2) { const int q = lane + 64 * i2; *(u32x4*)(img + off_b(q >> 4, q & 15)) = vr[bI % 3][i2]; }
        if (bI + 3 < 8) {
#pragma unroll
            for (int i2 = 0; i2 < 8; ++i2) {
                const int q = lane + 64 * i2, s = q >> 4, ch = q & 15;
                const int slot = (2 * (bI + 3) + ((s >> 2) & 1)) * 16 + 4 * (s >> 3) + (s & 3);
                vr[bI % 3][i2] = *(const u32x4*)(vbase + (size_t)lidx[slot] * 512 + ch * 8);
            }
        }
        h16x8 pf;
        {
            const f32x4 a0 = sacc[2 * bI], a1 = sacc[2 * bI + 1];
            pf[0] = (h16)a0.x; pf[1] = (h16)a0.y; pf[2] = (h16)a0.z; pf[3] = (h16)a0.w;
            pf[4] = (h16)a1.x; pf[5] = (h16)a1.y; pf[6] = (h16)a1.z; pf[7] = (h16)a1.w;
        }
#pragma unroll
        for (int c0 = 0; c0 < 8; c0 += 4) {
            h16x8 vf[4];
            tr_read8x4(az0, az1, c0, vf);
#pragma unroll
            for (int c = 0; c < 4; ++c) oacc[c0 + c] = __builtin_amdgcn_mfma_f32_16x16x32_f16(pf, vf[c], oacc[c0 + c], 0, 0, 0);
        }
    }
    float inv[4];
#pragma unroll
    for (int j = 0; j < 4; ++j) inv[j] = 1.f / __shfl(sum, j);
    h16* ost = (h16*)img;
    if (g == 0) {
#pragma unroll
        for (int c = 0; c < 8; ++c)
#pragma unroll
            for (int j = 0; j < 4; ++j) ost[j * 128 + 16 * c + r16] = (h16)(oacc[c][j] * inv[j]);
    }
    asm volatile("s_waitcnt lgkmcnt(0)" ::: "memory");
    *(u32x4*)(p.ATT + (size_t)t * 2048 + n * 512 + lane * 8) = *(const u32x4*)(ost + lane * 8);
    asm volatile("s_waitcnt lgkmcnt(0)" ::: "memory");
}

__device__ __forceinline__ void sample_topk_item(const Params& p, int t, char* smem) {
    const int tid = otid(), lane = tid & 63, wave = tid >> 6;
    int* red = (int*)smem;
    int* cnts = red + 16;
    __syncthreads();
    unsigned u[33];
#pragma unroll
    for (int i = 0; i < 33; ++i) { const int s = i * 512 + tid; u[i] = (s < LS) ? f2ord(p.SSC[(size_t)t * SSCS + s]) : 0u; }
    unsigned tau = 0u;
    for (int bit = 31; bit >= 0; --bit) {
        const unsigned cand = tau | (1u << bit);
        int c = 0;
#pragma unroll
        for (int i = 0; i < 33; ++i) c += (u[i] >= cand) ? 1 : 0;
#pragma unroll
        for (int o = 32; o > 0; o >>= 1) c += __shfl_xor(c, o);
        if (lane == 0) red[wave] = c;
        __syncthreads();
        int tot = 0;
#pragma unroll
        for (int w = 0; w < 8; ++w) tot += red[w];
        __syncthreads();
        if (tot >= 256) tau = cand;
    }
    const u64 lt = (1ull << lane) - 1ull;
#pragma unroll
    for (int i = 0; i < 33; ++i) {
        const u64 mg = __ballot(u[i] > tau), me = __ballot(u[i] == tau);
        if (lane == 0) { cnts[i * 8 + wave] = __popcll(mg); cnts[264 + i * 8 + wave] = __popcll(me); }
        if ((i & 3) == 3) __builtin_amdgcn_sched_barrier(0);
    }
    __syncthreads();
    int cg_tot = 0;
#pragma unroll 8
    for (int i = 0; i < 264; ++i) cg_tot += cnts[i];
    const int need_eq = 256 - cg_tot;
    int eq_before = 0, sel_before = 0;
    int* outp = p.STOP + t * 256;
    unsigned tau2 = tau; asm volatile("" : "+v"(tau2));
#pragma unroll
    for (int i = 0; i < 33; ++i) {
        int eb = eq_before, sb = sel_before;
        for (int w = 0; w < wave; ++w) {
            const int ng = cnts[i * 8 + w], ne = cnts[264 + i * 8 + w];
            int take_e = need_eq - eb; take_e = take_e < 0 ? 0 : (take_e > ne ? ne : take_e);
            eb += ne; sb += ng + take_e;
        }
        const bool gt = u[i] > tau2, eq = u[i] == tau2;
        const u64 me = __ballot(eq);
        const bool sel = gt || (eq && (eb + __popcll(me & lt)) < need_eq);
        const u64 ms = __ballot(sel);
        if (sel) outp[sb + __popcll(ms & lt)] = i * 512 + tid;
        for (int w = 0; w < 8; ++w) {
            const int ng = cnts[i * 8 + w], ne = cnts[264 + i * 8 + w];
            int take_e = need_eq - eq_before; take_e = take_e < 0 ? 0 : (take_e > ne ? ne : take_e);
            eq_before += ne; sel_before += ng + take_e;
        }
        __builtin_amdgcn_sched_barrier(0);
    }
    __syncthreads();
}

__device__ __forceinline__ void phase3(const Params& p, char* smem, int rep) {
    const int c = blockIdx.x, G = gridDim.x;
    for (int it = c; it < 136; it += G) { if (it < 128) scan_item(p, it); else sample_topk_item(p, it - 128, smem); }
    volatile int* s_next = (volatile int*)(smem + LDS_BYTES - 64);
    const unsigned home = xb_xcc_id() & 7u;
    int dead = 0;
    for (;;) {
        __syncthreads();
        if (threadIdx.x == 0) {
            int it = -1;
            for (int qi = dead; qi < 8; ++qi) {
                const unsigned q = (home + qi) & 7u;
                const int v = (int)atomicAdd(&p.ctl[4096 + 512 * rep + 64 * q], 2u);
                if (v < 512) { it = (int)q * 512 + v; s_next[1] = qi; break; }
            }
            if (it < 0) s_next[1] = 8;
            s_next[0] = it;
        }
        __syncthreads();
        const int it = s_next[0];
        dead = s_next[1];
        if (it < 0) break;
        const int q = it >> 9;
        attn_item(p, q >> 2, q & 3, it & 511, smem);
        attn_item(p, q >> 2, q & 3, (it & 511) + 1, smem);
    }
}

__device__ __forceinline__ void retout_item(const Params& p, int b, int h, int c, char* smem) {
    const int tid = otid(), lane = tid & 63, wave = tid >> 6, r16 = lane & 15, g = lane >> 4;
    char* Vimg = smem;
    const size_t tok0 = (size_t)b * SEQ + c * 128;
    const float lg = ret_log_g(h);
#pragma unroll
    for (int i = 0; i < 8; ++i) {
        const int q = tid + 512 * i, sg = q >> 5, c32 = q & 31, bI = sg >> 5, s = sg & 31;
        const int tokl = bI * 32 + ((s >> 2) & 1) * 16 + 4 * (s >> 3) + (s & 3);
        const u32x4 raw = *(const u32x4*)(p.RV + (tok0 + tokl) * 2048 + h * 256 + c32 * 8);
        *(u32x4*)(Vimg + (bI * 2 + (c32 >> 4)) * 8192 + off_b(s, c32 & 15)) = raw;
    }
    __syncthreads();
    const int il = 16 * wave + r16;
    h16x8 qf[4], qd[4];
    {
        const h16* qp = p.RQ + (tok0 + il) * 1024 + h * 128 + g * 8;
        const float dq = __expf((float)(il + 1) * lg);
#pragma unroll
        for (int kk = 0; kk < 4; ++kk) {
            const u32x4 raw = *(const u32x4*)(qp + kk * 32);
            qf[kk] = __builtin_bit_cast(h16x8, raw);
            float v[8]; unpk8(raw, v);
#pragma unroll
            for (int e = 0; e < 8; ++e) v[e] *= dq;
            qd[kk] = __builtin_bit_cast(h16x8, pk8(v));
        }
    }
    f32x4 sacc[8];
#pragma unroll
    for (int jr = 0; jr < 2; ++jr) {
        h16x8 kf[4][4];
        if (4 * jr <= wave) {
#pragma unroll
            for (int q = 0; q < 4; ++q) {
                const int jt = 4 * jr + q, jc = jt <= wave ? jt : wave;
                const h16* kp = p.RK + (tok0 + 16 * jc + r16) * 1024 + h * 128 + g * 8;
#pragma unroll
                for (int kk = 0; kk < 4; ++kk) kf[q][kk] = *(const h16x8*)(kp + kk * 32);
            }
        }
#pragma unroll
        for (int q = 0; q < 4; ++q) {
            const int jt = 4 * jr + q;
            sacc[jt] = (f32x4){0.f, 0.f, 0.f, 0.f};
            if (jt <= wave) {
#pragma unroll
                for (int kk = 0; kk < 4; ++kk) sacc[jt] = __builtin_amdgcn_mfma_f32_16x16x32_f16(kf[q][kk], qf[kk], sacc[jt], 0, 0, 0);
#pragma unroll
                for (int j = 0; j < 4; ++j) { const int jl = 16 * jt + 4 * g + j; sacc[jt][j] = (il >= jl) ? sacc[jt][j] * __expf((float)(il - jl) * lg) : 0.f; }
            }
        }
        __builtin_amdgcn_sched_barrier(0);
    }
    f32x4 oacc[16];
    const h16* sp = p.SPT + ((size_t)((b * 8 + h) * 32 + c) * 256) * 128;
#pragma unroll
    for (int er = 0; er < 4; ++er) {
        h16x8 sf[4][4];
#pragma unroll
        for (int q = 0; q < 4; ++q) {
            const h16* sr = sp + (size_t)(16 * (4 * er + q) + r16) * 128 + g * 8;
#pragma unroll
            for (int kk = 0; kk < 4; ++kk) sf[q][kk] = *(const h16x8*)(sr + kk * 32);
        }
#pragma unroll
        for (int q = 0; q < 4; ++q) {
            const int et = 4 * er + q;
            oacc[et] = (f32x4){0.f, 0.f, 0.f, 0.f};
#pragma unroll
            for (int kk = 0; kk < 4; ++kk) oacc[et] = __builtin_amdgcn_mfma_f32_16x16x32_f16(sf[q][kk], qd[kk], oacc[et], 0, 0, 0);
        }
        __builtin_amdgcn_sched_barrier(0);
    }
    const unsigned rz0 = lds_u32(Vimg) + tr_addr16(lane, 0, 0), rz1 = lds_u32(Vimg) + tr_addr16(lane, 0, 1);
    static_for<0, 4>([&](auto BI) {
        constexpr int bI = decltype(BI)::value;
        if (2 * bI <= wave) {
            h16x8 pf;
            const f32x4 a0 = sacc[2 * bI], a1 = sacc[2 * bI + 1];
            pf[0] = (h16)a0.x; pf[1] = (h16)a0.y; pf[2] = (h16)a0.z; pf[3] = (h16)a0.w;
            pf[4] = (h16)a1.x; pf[5] = (h16)a1.y; pf[6] = (h16)a1.z; pf[7] = (h16)a1.w;
            static_for<0, 16>([&](auto ET) {
                constexpr int et = decltype(ET)::value;
                const h16x8 vf = tr_read8o<(bI * 2 + (et >> 3)) * 8192>(rz0 ^ (32u * (et & 7)), rz1 ^ (32u * (et & 7)));
                oacc[et] = __builtin_amdgcn_mfma_f32_16x16x32_f16(vf, pf, oacc[et], 0, 0, 0);
            });
        }
    });
    float s1 = 0.f;
#pragma unroll
    for (int et = 0; et < 16; ++et) s1 += oacc[et].x + oacc[et].y + oacc[et].z + oacc[et].w;
    s1 += __shfl_xor(s1, 16); s1 += __shfl_xor(s1, 32);
    const float mu = s1 * (1.f / 256.f);
    float s2 = 0.f;
#pragma unroll
    for (int et = 0; et < 16; ++et)
#pragma unroll
        for (int j = 0; j < 4; ++j) { const float d = oacc[et][j] - mu; s2 += d * d; }
    s2 += __shfl_xor(s2, 16); s2 += __shfl_xor(s2, 32);
    const float rs = rsqrtf(s2 * (1.f / 256.f) + EPS);
    const size_t tok = tok0 + il;
#pragma unroll
    for (int et = 0; et < 16; ++et) {
        const int e0 = h * 256 + 16 * et + 4 * g;
        const f32x4 gw = *(const f32x4*)(p.ret_gn_w + e0);
        const f32x2 rgraw = *(const f32x2*)(p.RG + tok * 2048 + e0);
        const float rgx = rgraw.x, rgy = rgraw.y;
        const h16x2 r0 = __builtin_bit_cast(h16x2, rgx), r1 = __builtin_bit_cast(h16x2, rgy);
        const float o0 = (oacc[et].x - mu) * rs * gw.x * (float)r0.x, o1 = (oacc[et].y - mu) * rs * gw.y * (float)r0.y;
        const float o2 = (oacc[et].z - mu) * rs * gw.z * (float)r1.x, o3 = (oacc[et].w - mu) * rs * gw.w * (float)r1.y;
        f32x2 o; o.x = __uint_as_float(pkh(o0, o1)); o.y = __uint_as_float(pkh(o2, o3));
        *(f32x2*)(p.RN + tok * 2048 + e0) = o;
    }
    __syncthreads();
}

__device__ __forceinline__ void sample_ret_item(const Params& p, int t, int h, char* smem) {
    const int tid = otid(), dv = tid & 255, half = tid >> 8;
    float* qs = (float*)smem;
    float* ks = qs + 128;
    float* part = ks + 128;
    float* red = part + 512;
    __syncthreads();
    if (tid < 128) { qs[tid] = p.SRQ[t * 1024 + h * 128 + tid]; ks[tid] = p.SRK[t * 1024 + h * 128 + tid]; }
    __syncthreads();
    const float gm = 1.f - exp2f(-5.f - (float)h);
    float qk = 0.f;
#pragma unroll 4
    for (int i = 0; i < 128; ++i) qk += qs[i] * ks[i];
    const float v = p.SRV[t * 2048 + h * 256 + dv];
    const float* Sin = p.state_ret + ((size_t)(t * 8 + h) * 128) * 256;
    float* Sout = p.out + O_SS + ((size_t)(t * 8 + h) * 128) * 256;
    float cross = 0.f;
#pragma unroll 8
    for (int i = 0; i < 64; ++i) {
        const int dk = half * 64 + i;
        const float s = Sin[(size_t)dk * 256 + dv];
        cross += qs[dk] * s;
        Sout[(size_t)dk * 256 + dv] = gm * s + ks[dk] * v;
    }
    part[half * 256 + dv] = cross;
    __syncthreads();
    float o = 0.f;
    if (tid < 256) o = qk * v + gm * (part[dv] + part[256 + dv]);
    float s1 = (tid < 256) ? o : 0.f;
    s1 = wave_sum(s1);
    if ((tid & 63) == 0) red[tid >> 6] = s1;
    __syncthreads();
    const float mu = (red[0] + red[1] + red[2] + red[3]) * (1.f / 256.f);
    float d = (tid < 256) ? (o - mu) : 0.f;
    float s2 = wave_sum(d * d);
    if ((tid & 63) == 0) red[8 + (tid >> 6)] = s2;
    __syncthreads();
    const float rs = rsqrtf((red[8] + red[9] + red[10] + red[11]) * (1.f / 256.f) + EPS);
    if (tid < 256) p.SRN[t * 2048 + h * 256 + dv] = d * rs * p.ret_gn_w[h * 256 + dv] * p.SRG[t * 2048 + h * 256 + dv];
    __syncthreads();
}

__device__ __forceinline__ void sample_attn_item(const Params& p, int t, int n, char* smem) {
    const int tid = otid(), lane = tid & 63, wave = tid >> 6;
    float* qs = (float*)smem;
    int* rowk = (int*)(smem + 2048);
    float* lg = (float*)(smem + 3072);
    float* part = (float*)(smem + 7168);
    float* sums = (float*)(smem + 23552);
    __syncthreads();
    qs[tid] = p.SAQ[t * 2048 + n * 512 + tid];
    if (tid < 256) { const int idx = p.STOP[t * 256 + tid]; rowk[tid] = (idx < PAST) ? p.page_table[t * NPAGES + (idx >> 7)] * PAGE + (idx & 127) : -1; }
    __syncthreads();
    {
        const int key = wave * 32 + (lane >> 1), dh = lane & 1, row = rowk[key];
        const float* kp = (row >= 0) ? p.cache_k + ((size_t)row * 4 + n) * 128 + dh * 64 : p.SAK + t * 512 + n * 128 + dh * 64;
        f32x4 kv[16];
#pragma unroll
        for (int i = 0; i < 16; ++i) kv[i] = *(const f32x4*)(kp + 4 * i);
#pragma unroll
        for (int h = 0; h < 4; ++h) {
            float d = 0.f;
#pragma unroll
            for (int i = 0; i < 16; ++i) { const f32x4 q = *(const f32x4*)(qs + h * 128 + dh * 64 + 4 * i); d += kv[i].x * q.x + kv[i].y * q.y + kv[i].z * q.z + kv[i].w * q.w; }
            d += __shfl_xor(d, 1);
            if (dh == 0) lg[h * 256 + key] = d;
        }
    }
    __syncthreads();
    if (wave < 4) {
        float v[4];
#pragma unroll
        for (int i = 0; i < 4; ++i) v[i] = lg[wave * 256 + lane + 64 * i];
        const float mx = wave_max(fmaxf(fmaxf(v[0], v[1]), fmaxf(v[2], v[3])));
        float s = 0.f;
#pragma unroll
        for (int i = 0; i < 4; ++i) { v[i] = __expf(v[i] - mx); s += v[i]; lg[wave * 256 + lane + 64 * i] = v[i]; }
        s = wave_sum(s);
        if (lane == 0) sums[wave] = s;
    }
    __syncthreads();
    {
        const int sub = lane >> 4, dc = lane & 15;
        float acc[4][8];
#pragma unroll
        for (int h = 0; h < 4; ++h)
#pragma unroll
            for (int e = 0; e < 8; ++e) acc[h][e] = 0.f;
        f32x4 va[8], vb[8];
#pragma unroll
        for (int j = 0; j < 8; ++j) {
            const int row = rowk[wave * 32 + sub * 8 + j];
            const float* vp = (row >= 0) ? p.cache_v + ((size_t)row * 4 + n) * 128 + dc * 8 : p.SAV + t * 512 + n * 128 + dc * 8;
            va[j] = *(const f32x4*)vp; vb[j] = *(const f32x4*)(vp + 4);
        }
#pragma unroll
        for (int j = 0; j < 8; ++j) {
            const int key = wave * 32 + sub * 8 + j;
#pragma unroll
            for (int h = 0; h < 4; ++h) {
                const float pk = lg[h * 256 + key];
                acc[h][0] += pk * va[j].x; acc[h][1] += pk * va[j].y; acc[h][2] += pk * va[j].z; acc[h][3] += pk * va[j].w;
                acc[h][4] += pk * vb[j].x; acc[h][5] += pk * vb[j].y; acc[h][6] += pk * vb[j].z; acc[h][7] += pk * vb[j].w;
            }
        }
#pragma unroll
        for (int h = 0; h < 4; ++h)
#pragma unroll
            for (int e = 0; e < 8; ++e) { float v = acc[h][e]; v += __shfl_xor(v, 16); v += __shfl_xor(v, 32); if (sub == 0) part[(wave * 4 + h) * 128 + dc * 8 + e] = v; }
    }
    __syncthreads();
    {
        const int h = tid >> 7, d = tid & 127;
        float o = 0.f;
#pragma unroll
        for (int w = 0; w < 8; ++w) o += part[(w * 4 + h) * 128 + d];
        p.SATT[t * 2048 + (n * 4 + h) * 128 + d] = o / sums[h];
    }
    __syncthreads();
}

__device__ __forceinline__ void phase4(const Params& p, char* smem) {
    const int c = blockIdx.x, G = gridDim.x;
    for (int it = G - 1 - c; it < 96; it += G) {
        if (it < 32) sample_attn_item(p, it >> 2, it & 3, smem);
        else sample_ret_item(p, (it - 32) >> 3, (it - 32) & 7, smem);
    }
    for (int it = c; it < 512; it += G) retout_item(p, it >> 8, (it >> 5) & 7, it & 31, smem);
}

__device__ __forceinline__ void phase5(const Params& p, char* smem) {
    const int tid = otid();
    for (int i = 0;; ++i) {
        int pm, pn; if (!unit_next(i, TP / 256, D / 256, pm, pn)) break;
        f32x4 acc[2][2][4][2] = {};
        gemm_core(p.RN, p.WrT, pm * 256, pn * 256, D, acc, (h16*)smem);
        {
            const int tz = otid(), wid = tz >> 6, lane = tz & 63, wr = wid >> 2, wc = wid & 3, fr = lane & 15, fq = lane >> 4;
            h16* R16 = (h16*)smem;
            __syncthreads();
#pragma unroll 4
            for (int i = 0; i < 16; ++i) {
                const int q = tz + 512 * i, row = q >> 5, ch = q & 31;
                const size_t off = (size_t)(pm * 256 + row) * D + pn * 256 + ch * 8;
                float gr[8], ga[8];
                unpk8(*(const u32x4*)(p.GR + off), gr); unpk8(*(const u32x4*)(p.GA + off), ga);
#pragma unroll
                for (int e = 0; e < 8; ++e) gr[e] *= __builtin_amdgcn_rcpf(fmaxf(ga[e], 1e-4f));
                *(u32x4*)(R16 + row * ES16 + ch * 8) = pk8(gr);
            }
            __syncthreads();
#pragma unroll
            for (int ai = 0; ai < 2; ++ai)
#pragma unroll
                for (int bj = 0; bj < 2; ++bj)
#pragma unroll
                    for (int m = 0; m < 4; ++m)
#pragma unroll
                        for (int n = 0; n < 2; ++n) {
                            const f32x2 rr = *(const f32x2*)(R16 + (ai * 128 + wr * 64 + m * 16 + fr) * ES16 + bj * 128 + wc * 32 + n * 16 + fq * 4);
                            const float rx = rr.x, ry = rr.y;
                            const h16x2 r0 = __builtin_bit_cast(h16x2, rx), r1 = __builtin_bit_cast(h16x2, ry);
                            acc[ai][bj][m][n].x *= (float)r0.x; acc[ai][bj][m][n].y *= (float)r0.y; acc[ai][bj][m][n].z *= (float)r1.x; acc[ai][bj][m][n].w *= (float)r1.y;
                        }
        }
        __syncthreads();
        gemm_core(p.ATT, p.WaT, pm * 256, pn * 256, D, acc, (h16*)smem);
        epilogue_full(acc, smem, [&](int ai, int bj, int r, int part, float* x1, float* x2) {
            const size_t rowoff = (size_t)(pm * 256 + ai * 128 + r) * D + pn * 256 + bj * 128;
            const h16* gp = p.GA + rowoff;
            float g1[16], g2[16];
            unpk8(*(const u32x4*)(gp + 16 * part), g1); unpk8(*(const u32x4*)(gp + 16 * part + 8), g1 + 8);
            unpk8(*(const u32x4*)(gp + 64 + 16 * part), g2); unpk8(*(const u32x4*)(gp + 64 + 16 * part + 8), g2 + 8);
#pragma unroll
            for (int e = 0; e < 16; ++e) { x1[e] *= fmaxf(g1[e], 1e-4f); x2[e] *= fmaxf(g2[e], 1e-4f); }
            store_h16_32(p.MIX + rowoff, part, x1, x2);
        });
    }
    for (int it = blockIdx.x; it < 256; it += gridDim.x) {
        float* SMIX = p.SMIX; const float* SGR = p.SGR; const float* SGA = p.SGA;
        gemv8_item<8>(p.SRN, p.w_ret_o, D, it * 8, smem, [=](int t, int n, float v) { SMIX[t * D + n] = SGR[t * D + n] * v; });
        gemv8_item<8>(p.SATT, p.w_att_o, D, it * 8, smem, [=](int t, int n, float v) { SMIX[t * D + n] += SGA[t * D + n] * v; });
    }
}

__device__ __forceinline__ void phase6(const Params& p, char* smem) {
    const int tid = otid();
    for (int i = 0;; ++i) {
        int pm, pn; if (!unit_next(i, TP / 256, D / 256, pm, pn)) break;
        f32x4 acc[2][2][4][2] = {};
#ifdef GEMM_TWICE
        gemm_core(p.MIX, p.WoT, pm * 256, pn * 256, D, acc, (h16*)smem);
        __syncthreads();
        for (int a = 0; a < 2; ++a) for (int b = 0; b < 2; ++b) for (int m = 0; m < 4; ++m) for (int n = 0; n < 2; ++n) acc[a][b][m][n] = acc[a][b][m][n] * 0.0f;
#endif
        gemm_core(p.MIX, p.WoT, pm * 256, pn * 256, D, acc, (h16*)smem);
        epilogue_full(acc, smem, [&](int ai, int bj, int r, int part, float* x1, float* x2) {
            const size_t rowoff = (size_t)(pm * 256 + ai * 128 + r) * D + pn * 256 + bj * 128;
            const float* xp = p.x_prompt + rowoff;
#pragma unroll
            for (int q = 0; q < 4; ++q) {
                const f32x4 a = *(const f32x4*)(xp + 16 * part + 4 * q), bq = *(const f32x4*)(xp + 64 + 16 * part + 4 * q);
                x1[4 * q] += a.x; x1[4 * q + 1] += a.y; x1[4 * q + 2] += a.z; x1[4 * q + 3] += a.w;
                x2[4 * q] += bq.x; x2[4 * q + 1] += bq.y; x2[4 * q + 2] += bq.z; x2[4 * q + 3] += bq.w;
            }
            store_h16_32(p.HN + rowoff, part, x1, x2);
            float ss = 0.f;
#pragma unroll
            for (int e = 0; e < 16; ++e) ss += x1[e] * x1[e] + x2[e] * x2[e];
            ss = quad_sum(ss);
            if (part == 0) atomicAdd(p.ROWSS + pm * 256 + ai * 128 + r, ss);
        });
    }
    for (int it = blockIdx.x; it < 256; it += gridDim.x) {
        float* out = p.out; const float* xs = p.x_sample;
        gemv8_item<8>(p.SMIX, p.w_out, D, it * 8, smem, [=](int t, int n, float v) { out[O_YS + t * D + n] = xs[t * D + n] + v; });
    }
}

__device__ __forceinline__ void phase7(const Params& p) {
    const int t0 = otid(), lane = t0 & 63, gw = blockIdx.x * 8 + (t0 >> 6), NGW = gridDim.x * 8;
    for (int r = gw; r < TT; r += NGW) {
        const float* x = (r < TP) ? p.out + O_YP + (size_t)r * D : p.out + O_YS + (size_t)(r - TP) * D;
        f32x4 v[8]; float ss = 0.f;
#pragma unroll
        for (int j = 0; j < 8; ++j) { v[j] = *(const f32x4*)(x + 4 * (lane + 64 * j)); ss += v[j].x * v[j].x + v[j].y * v[j].y + v[j].z * v[j].z + v[j].w * v[j].w; }
        ss = wave_sum(ss);
        const float rs = rsqrtf(ss * (1.f / D) + EPS);
#pragma unroll
        for (int j = 0; j < 8; ++j) {
            const f32x4 w = *(const f32x4*)(p.norm2_w + 4 * (lane + 64 * j));
            const float a = v[j].x * rs * w.x, b = v[j].y * rs * w.y, c = v[j].z * rs * w.z, d = v[j].w * rs * w.w;
            if (r < TP) { f32x2 o; o.x = __uint_as_float(pkh(a, b)); o.y = __uint_as_float(pkh(c, d)); *(f32x2*)(p.HN + (size_t)r * D + 4 * (lane + 64 * j)) = o; }
            else { f32x4 o = {a, b, c, d}; *(f32x4*)(p.SHN + (size_t)(r - TP) * D + 4 * (lane + 64 * j)) = o; }
        }
    }
}

constexpr int PCV_ITER = 4;
constexpr int PCV_UCH = (int)(((size_t)NEXP * D / 32) / (512 * PCV_ITER));
constexpr int PCV_VCH = PCV_UCH;
constexpr int PCV_CHUNKS = PCV_UCH + PCV_VCH;
__device__ __forceinline__ void peer_convert_chunk(const Params& p, int chunk) {
    const int tid = otid();
    const bool isu = chunk < PCV_UCH;
    const size_t base = (size_t)(isu ? chunk : chunk - PCV_UCH) * (512 * PCV_ITER) + tid;
    const float* tab = isu ? p.peer_u : p.peer_v;
    unsigned char* outp = (unsigned char*)(isu ? p.PU : p.PV);
    const float sc = isu ? 64.f : 16.f;
#pragma unroll 2
    for (int r = 0; r < PCV_ITER; ++r) {
        const float* src = tab + (base + (size_t)r * 512) * 32;
        f32x4 a[8];
#pragma unroll
        for (int q = 0; q < 8; ++q) a[q] = *(const f32x4*)(src + 4 * q);
        if (isu) {
            const float* wk = p.norm2_w + (int)(((base + (size_t)r * 512) & 63) * 32);
#pragma unroll
            for (int q = 0; q < 8; ++q) { const f32x4 w4 = *(const f32x4*)(wk + 4 * q); a[q].x *= w4.x; a[q].y *= w4.y; a[q].z *= w4.z; a[q].w *= w4.w; }
        }
        u32x4 o;
#pragma unroll
        for (int q = 0; q < 4; ++q) {
            unsigned w = 0u;
            w = __builtin_amdgcn_cvt_scalef32_pk_fp4_f32(w, a[2 * q].x * sc, a[2 * q].y * sc, 1.0f, 0);
            w = __builtin_amdgcn_cvt_scalef32_pk_fp4_f32(w, a[2 * q].z * sc, a[2 * q].w * sc, 1.0f, 1);
            w = __builtin_amdgcn_cvt_scalef32_pk_fp4_f32(w, a[2 * q + 1].x * sc, a[2 * q + 1].y * sc, 1.0f, 2);
            w = __builtin_amdgcn_cvt_scalef32_pk_fp4_f32(w, a[2 * q + 1].z * sc, a[2 * q + 1].w * sc, 1.0f, 3);
            o[q] = w;
        }
        *(u32x4*)(outp + (base + (size_t)r * 512) * 16) = o;
    }
}
__device__ __forceinline__ void peer_convert_pull(const Params& p, char* smem, int rep) {
    volatile int* s_next = (volatile int*)(smem + LDS_BYTES - 64);
    for (;;) {
        __syncthreads();
        if (threadIdx.x == 0) s_next[0] = (int)atomicAdd(&p.ctl[6144 + 64 * rep], 1u);
        __syncthreads();
        const int ch = s_next[0];
        if (ch >= PCV_CHUNKS) break;
        peer_convert_chunk(p, ch);
    }
}

__device__ __forceinline__ void phase8(const Params& p, char* smem, int rep) {
    const int tid = otid();
    for (int i = 0;; ++i) {
        int pm, pn; if (!unit_next(i, TP / 256, 1024 / 256, pm, pn)) break;
        f32x4 acc[2][2][4][2] = {};
        gemm_core(p.HN, p.WqT, pm * 256, pn * 256, D, acc, (h16*)smem);
        epilogue_full(acc, smem, [&](int ai, int bj, int r, int part, float* x1, float* x2) {
            const float rs = rsqrtf(p.ROWSS[pm * 256 + ai * 128 + r] * (1.f / D) + EPS);
#pragma unroll
            for (int e = 0; e < 16; ++e) { x1[e] *= rs; x2[e] *= rs; }
            store_h16_32((h16*)p.PQ + (size_t)(pm * 256 + ai * 128 + r) * 1024 + pn * 256 + bj * 128, part, x1, x2);
        });
    }
    {
        const int G = gridDim.x, first = (G > 144) ? 128 : 0;
        if ((int)blockIdx.x >= first)
            for (int it = blockIdx.x - first; it < 128; it += G - first) {
                float* SPQ = p.SPQ;
                gemv8_item<8>(p.out + O_YS, p.peer_wq, 1024, it * 8, smem, [=](int t, int n, float v) { SPQ[t * 1024 + n] = v; }, p.norm2_w, it == 0 ? p.SHN : nullptr);
            }
    }
    peer_convert_pull(p, smem, rep);
}

template <int NV, class EMIT>
__device__ __forceinline__ void wave_select(const unsigned (&u)[NV], int K, int lane, EMIT emit) {
    unsigned tau; int need_eq;
    if constexpr (NV < 8) wave_kth_r4<NV>(u, K, tau, need_eq); else wave_kth<NV>(u, K, tau, need_eq);
    const u64 lt = (1ull << lane) - 1ull;
    int base = 0, eqt = 0;
    unsigned tau2 = tau; asm volatile("" : "+v"(tau2));
#pragma unroll
    for (int i = 0; i < NV; ++i) {
        const bool gt = u[i] > tau2, eq = u[i] == tau2;
        const u64 meq = __ballot(eq);
        const bool sel = gt || (eq && (eqt + __popcll(meq & lt)) < need_eq);
        const u64 ms = __ballot(sel);
        if (sel) emit(i, base + __popcll(ms & lt));
        base += __popcll(ms); eqt += __popcll(meq);
    }
}

template <bool SAMPLE>
__device__ __forceinline__ void load_row8(const void* base, size_t row, int chunk, float* v) {
    if (SAMPLE) {
        const float* r = (const float*)base + row * D + chunk * 8;
        const f32x4 a = *(const f32x4*)r, b = *(const f32x4*)(r + 4);
        v[0] = a.x; v[1] = a.y; v[2] = a.z; v[3] = a.w; v[4] = b.x; v[5] = b.y; v[6] = b.z; v[7] = b.w;
    } else {
        unpk8(*(const u32x4*)((const h16*)base + row * D + chunk * 8), v);
    }
}

template <bool SAMPLE>
__device__ __forceinline__ void peer_item(const Params& p, int tk, char* smem) {
    const int tid = otid(), lane = tid & 63, h = tid >> 6;
    float* qsh = (float*)smem;
    int* route_e = (int*)(smem + 4096);
    float* route_g = (float*)(smem + 4608);
    float* l1v = (float*)(smem + 5120);
    int* l1i = (int*)(smem + 5632);
    float* l2v = (float*)(smem + 6144);
    int* l2i = (int*)(smem + 6656);
    float* parts = (float*)(smem + 8192);
    const int ts = tk - TP;
    __syncthreads();
    { const float* q = SAMPLE ? p.SPQ + (size_t)ts * 1024 : p.PQ + (size_t)tk * 1024; qsh[tid] = q[tid]; qsh[tid + 512] = q[tid + 512]; }
    __syncthreads();
    {
        float s1[2], s2[2];
#pragma unroll
        for (int i = 0; i < 2; ++i) {
            const int key = lane + 64 * i;
            float a = 0.f, b = 0.f;
            if constexpr (SAMPLE) {
                const float* k1 = p.peer_k1 + ((size_t)(h * 128 + key)) * 64;
                const float* k2 = p.peer_k2 + ((size_t)(h * 128 + key)) * 64;
#pragma unroll 4
                for (int c4 = 0; c4 < 16; ++c4) {
                    const f32x4 x = *(const f32x4*)(k1 + 4 * c4), y = *(const f32x4*)(k2 + 4 * c4);
                    const f32x4 q1 = *(const f32x4*)(qsh + h * 128 + 4 * c4), q2 = *(const f32x4*)(qsh + h * 128 + 64 + 4 * c4);
                    a += x.x * q1.x + x.y * q1.y + x.z * q1.z + x.w * q1.w;
                    b += y.x * q2.x + y.y * q2.y + y.z * q2.z + y.w * q2.w;
                }
            } else {
                const h16* k1 = p.K1H + ((size_t)(h * 128 + key)) * 64;
                const h16* k2 = p.K2H + ((size_t)(h * 128 + key)) * 64;
#pragma unroll 2
                for (int c8 = 0; c8 < 8; ++c8) {
                    float x[8], y[8]; unpk8(*(const u32x4*)(k1 + 8 * c8), x); unpk8(*(const u32x4*)(k2 + 8 * c8), y);
                    const f32x4 q1a = *(const f32x4*)(qsh + h * 128 + 8 * c8), q1b = *(const f32x4*)(qsh + h * 128 + 8 * c8 + 4);
                    const f32x4 q2a = *(const f32x4*)(qsh + h * 128 + 64 + 8 * c8), q2b = *(const f32x4*)(qsh + h * 128 + 64 + 8 * c8 + 4);
                    a += x[0] * q1a.x + x[1] * q1a.y + x[2] * q1a.z + x[3] * q1a.w + x[4] * q1b.x + x[5] * q1b.y + x[6] * q1b.z + x[7] * q1b.w;
                    b += y[0] * q2a.x + y[1] * q2a.y + y[2] * q2a.z + y[3] * q2a.w + y[4] * q2b.x + y[5] * q2b.y + y[6] * q2b.z + y[7] * q2b.w;
                }
            }
            s1[i] = a; s2[i] = b;
        }
        unsigned u[2];
        u[0] = f2ord(s1[0]); u[1] = f2ord(s1[1]);
        wave_select<2>(u, 16, lane, [&](int i, int pos) { l1v[h * 16 + pos] = s1[i]; l1i[h * 16 + pos] = lane + 64 * i; });
        u[0] = f2ord(s2[0]); u[1] = f2ord(s2[1]);
        wave_select<2>(u, 16, lane, [&](int i, int pos) { l2v[h * 16 + pos] = s2[i]; l2i[h * 16 + pos] = lane + 64 * i; });
        asm volatile("s_waitcnt lgkmcnt(0)" ::: "memory");
        float cv[4]; unsigned cu[4];
        const int a = lane >> 2;
#pragma unroll
        for (int i = 0; i < 4; ++i) { cv[i] = l1v[h * 16 + a] + l2v[h * 16 + (lane & 3) * 4 + i]; cu[i] = f2ord(cv[i]); }
        wave_select<4>(cu, 16, lane, [&](int i, int pos) { route_g[h * 16 + pos] = cv[i]; route_e[h * 16 + pos] = l1i[h * 16 + a] * 128 + l2i[h * 16 + (lane & 3) * 4 + i]; });
        asm volatile("s_waitcnt lgkmcnt(0)" ::: "memory");
        float sc = (lane < 16) ? route_g[h * 16 + lane] : -3.0e38f;
        const float mx = wave_max(sc);
        const float ex = (lane < 16) ? __expf(sc - mx) : 0.f;
        const float sm = wave_sum(ex);
        asm volatile("s_waitcnt lgkmcnt(0)" ::: "memory");
        if (lane < 16) route_g[h * 16 + lane] = ex / sm;
        asm volatile("s_waitcnt lgkmcnt(0)" ::: "memory");
    }
    {
        const void* hnb = SAMPLE ? (const void*)p.SHN : (const void*)p.HN;
        const void* ub = SAMPLE ? (const void*)p.peer_u : (const void*)p.PU;
        const void* vb = SAMPLE ? (const void*)p.peer_v : (const void*)p.PV;
        const size_t hrow = SAMPLE ? (size_t)ts : (size_t)tk;
        float hv[SAMPLE ? 32 : 1], facc[32];
        u32x4 hp[SAMPLE ? 1 : 4];
        if constexpr (SAMPLE) {
#pragma unroll
            for (int jj = 0; jj < 2; ++jj) { load_row8<true>(hnb, hrow, 2 * (lane + 64 * jj), hv + 16 * jj); load_row8<true>(hnb, hrow, 2 * (lane + 64 * jj) + 1, hv + 16 * jj + 8); }
        } else {
#pragma unroll
            for (int jj = 0; jj < 2; ++jj) { hp[2 * jj] = *(const u32x4*)((const h16*)hnb + hrow * D + (lane + 64 * jj) * 16); hp[2 * jj + 1] = *(const u32x4*)((const h16*)hnb + hrow * D + (lane + 64 * jj) * 16 + 8); }
        }
#pragma unroll
        for (int i = 0; i < 32; ++i) facc[i] = 0.f;
        if constexpr (SAMPLE) {
#pragma unroll 1
            for (int k = 0; k < 16; ++k) {
                const size_t e = (size_t)route_e[h * 16 + k];
                const float* up = (const float*)ub + e * D; const float* vp = (const float*)vb + e * D;
                f32x4 ur[8], vr[8];
#pragma unroll
                for (int jj = 0; jj < 2; ++jj)
#pragma unroll
                    for (int q = 0; q < 4; ++q) { ur[4 * jj + q] = *(const f32x4*)(up + (lane + 64 * jj) * 16 + 4 * q); vr[4 * jj + q] = *(const f32x4*)(vp + (lane + 64 * jj) * 16 + 4 * q); }
                float d = 0.f;
#pragma unroll
                for (int i = 0; i < 8; ++i) d += hv[4 * i] * ur[i].x + hv[4 * i + 1] * ur[i].y + hv[4 * i + 2] * ur[i].z + hv[4 * i + 3] * ur[i].w;
                d = wave_sum(d);
                const float cw = route_g[h * 16 + k] * gelu_exact(d);
#pragma unroll
                for (int i = 0; i < 8; ++i) { facc[4 * i] += cw * vr[i].x; facc[4 * i + 1] += cw * vr[i].y; facc[4 * i + 2] += cw * vr[i].z; facc[4 * i + 3] += cw * vr[i].w; }
            }
        } else {
            const unsigned char* u8 = (const unsigned char*)ub; const unsigned char* v8 = (const unsigned char*)vb;
#pragma unroll 1
            for (int k = 0; k < 16; k += 8) {
                u32x4 ur[8][2], vr[8][2];
#pragma unroll
                for (int x = 0; x < 8; ++x) {
                    const size_t e = (size_t)route_e[h * 16 + k + x];
#pragma unroll
                    for (int jj = 0; jj < 2; ++jj) { ur[x][jj] = *(const u32x4*)(u8 + e * D + (lane + 64 * jj) * 16); vr[x][jj] = *(const u32x4*)(v8 + e * D + (lane + 64 * jj) * 16); }
                }
#pragma unroll
                for (int x = 0; x < 8; ++x) {
                    float d = 0.f;
#pragma unroll
                    for (int jj = 0; jj < 2; ++jj)
#pragma unroll
                        for (int q = 0; q < 4; ++q) {
                            const int w = (int)ur[x][jj][q];
                            const f32x2 lo = __builtin_amdgcn_cvt_pk_f32_fp8(w, false), hi = __builtin_amdgcn_cvt_pk_f32_fp8(w, true);
                            const unsigned h0 = hp[2 * jj + (q >> 1)][2 * (q & 1)], h1 = hp[2 * jj + (q >> 1)][2 * (q & 1) + 1];
                            const h16x2 p0 = __builtin_bit_cast(h16x2, h0), p1 = __builtin_bit_cast(h16x2, h1);
                            d += (float)p0.x * lo.x + (float)p0.y * lo.y + (float)p1.x * hi.x + (float)p1.y * hi.y;
                        }
                    d = wave_sum(d) * (1.f / 64.f);
                    const float cw = route_g[h * 16 + k + x] * gelu_exact(d) * (1.f / 16.f);
#pragma unroll
                    for (int jj = 0; jj < 2; ++jj)
#pragma unroll
                        for (int q = 0; q < 4; ++q) {
                            const int w = (int)vr[x][jj][q];
                            const f32x2 lo = __builtin_amdgcn_cvt_pk_f32_fp8(w, false), hi = __builtin_amdgcn_cvt_pk_f32_fp8(w, true);
                            facc[16 * jj + 4 * q] += cw * lo.x; facc[16 * jj + 4 * q + 1] += cw * lo.y; facc[16 * jj + 4 * q + 2] += cw * hi.x; facc[16 * jj + 4 * q + 3] += cw * hi.y;
                        }
                }
            }
        }
#pragma unroll
        for (int jj = 0; jj < 2; ++jj) {
            float* dst = parts + h * 2048 + (lane + 64 * jj) * 16;
#pragma unroll
            for (int q = 0; q < 4; ++q) { f32x4 a = {facc[16 * jj + 4 * q], facc[16 * jj + 4 * q + 1], facc[16 * jj + 4 * q + 2], facc[16 * jj + 4 * q + 3]}; *(f32x4*)(dst + 4 * q) = a; }
        }
    }
    __syncthreads();
    {
        f32x4 f = {0.f, 0.f, 0.f, 0.f};
#pragma unroll
        for (int w = 0; w < 8; ++w) { const f32x4 a = *(const f32x4*)(parts + w * 2048 + tid * 4); f.x += a.x; f.y += a.y; f.z += a.z; f.w += a.w; }
        float* y = SAMPLE ? p.out + O_YS + (size_t)ts * D + tid * 4 : p.out + O_YP + (size_t)tk * D + tid * 4;
        f32x4 hh = *(const f32x4*)y;
        hh.x += f.x; hh.y += f.y; hh.z += f.z; hh.w += f.w;
        *(f32x4*)y = hh;
    }
}

static __device__ const unsigned char PAIR_LUT[64] = {0,1,2,3,4,5,6,7,8,9,10,11,12,13,14,15,16,17,18,19,20,21,22,23,32,33,34,35,36,48,49,50,51,64,65,66,80,81,96,97,112,113,128,144,160,176,192,208,224,240,0,0,0,0,0,0,0,0,0,0,0,0,0,0};
template <int J>
__device__ __forceinline__ unsigned bt_fetch(unsigned v) {
    if constexpr (J == 1) return (unsigned)__builtin_amdgcn_update_dpp(0, (int)v, 0xB1, 0xF, 0xF, true);
    else if constexpr (J == 2) return (unsigned)__builtin_amdgcn_update_dpp(0, (int)v, 0x4E, 0xF, 0xF, true);
    else if constexpr (J == 8) return (unsigned)__builtin_amdgcn_update_dpp(0, (int)v, 0x128, 0xF, 0xF, true);
    else if constexpr (J == 4) return (unsigned)__builtin_amdgcn_ds_swizzle((int)v, 0x101F);
    else if constexpr (J == 16) return (unsigned)__builtin_amdgcn_ds_swizzle((int)v, 0x401F);
    else return (unsigned)__shfl_xor((int)v, 32);
}
template <int J, u64 M>
__device__ __forceinline__ unsigned bt_cmpx(unsigned x) {
    const unsigned q = bt_fetch<J>(x);
    const unsigned mn = x < q ? x : q, mx = x < q ? q : x;
    unsigned r;
    asm("v_cndmask_b32 %0, %1, %2, %3\n\ts_nop 1" : "=v"(r) : "v"(mn), "v"(mx), "s"(M));
    return r;
}
template <int J, u64 M>
__device__ __forceinline__ unsigned bt_cmpx_n(unsigned x) {
    const unsigned q = bt_fetch<J>(x);
    const unsigned mn = x < q ? x : q, mx = x < q ? q : x;
    unsigned r;
    asm("v_cndmask_b32 %0, %1, %2, %3\n\ts_nop 1" : "=v"(r) : "v"(mn), "v"(mx), "s"(M));
    return r;
}
__device__ __forceinline__ unsigned bitonic_top16_x1(unsigned a) {
#define BT1(J, M0) a = bt_cmpx_n<J, M0>(a);
    BT1(1, 0x9999999999999999ull) BT1(2, 0xc3c3c3c3c3c3c3c3ull) BT1(1, 0xa5a5a5a5a5a5a5a5ull)
    BT1(4, 0xf00ff00ff00ff00full) BT1(2, 0xcc33cc33cc33cc33ull) BT1(1, 0xaa55aa55aa55aa55ull)
    BT1(8, 0xff0000ffff0000ffull) BT1(4, 0xf0f00f0ff0f00f0full) BT1(2, 0xcccc3333cccc3333ull) BT1(1, 0xaaaa5555aaaa5555ull)
    { const unsigned q = bt_fetch<16>(a); a = a > q ? a : q; }
    BT1(8, 0xff00ff0000ff00ffull) BT1(4, 0xf0f0f0f00f0f0f0full) BT1(2, 0xcccccccc33333333ull) BT1(1, 0xaaaaaaaa55555555ull)
    { const unsigned q = bt_fetch<32>(a); a = a > q ? a : q; }
    BT1(8, 0x00ff00ff00ff00ffull) BT1(4, 0x0f0f0f0f0f0f0f0full) BT1(2, 0x3333333333333333ull) BT1(1, 0x5555555555555555ull)
#undef BT1
    return a;
}
__device__ __forceinline__ void bitonic_top16_x2(unsigned& a0, unsigned& a1, unsigned& b0, unsigned& b1) {
#define BT4(J, M0, M1) a0 = bt_cmpx<J, M0>(a0); b0 = bt_cmpx<J, M0>(b0); a1 = bt_cmpx<J, M1>(a1); b1 = bt_cmpx<J, M1>(b1);
#define BT2(J, M0) a0 = bt_cmpx<J, M0>(a0); b0 = bt_cmpx<J, M0>(b0);
    BT4(1, 0x9999999999999999ull, 0x9999999999999999ull)
    BT4(2, 0xc3c3c3c3c3c3c3c3ull, 0xc3c3c3c3c3c3c3c3ull)
    BT4(1, 0xa5a5a5a5a5a5a5a5ull, 0xa5a5a5a5a5a5a5a5ull)
    BT4(4, 0xf00ff00ff00ff00full, 0xf00ff00ff00ff00full)
    BT4(2, 0xcc33cc33cc33cc33ull, 0xcc33cc33cc33cc33ull)
    BT4(1, 0xaa55aa55aa55aa55ull, 0xaa55aa55aa55aa55ull)
    BT4(8, 0xff0000ffff0000ffull, 0x00ffff0000ffff00ull)
    BT4(4, 0xf0f00f0ff0f00f0full, 0x0f0ff0f00f0ff0f0ull)
    BT4(2, 0xcccc3333cccc3333ull, 0x3333cccc3333ccccull)
    BT4(1, 0xaaaa5555aaaa5555ull, 0x5555aaaa5555aaaaull)
    a0 = a0 > a1 ? a0 : a1; b0 = b0 > b1 ? b0 : b1;
    BT2(8, 0xff0000ffff0000ffull) BT2(4, 0xf0f00f0ff0f00f0full) BT2(2, 0xcccc3333cccc3333ull) BT2(1, 0xaaaa5555aaaa5555ull)
    { const unsigned qa = bt_fetch<16>(a0), qb = bt_fetch<16>(b0); a0 = a0 > qa ? a0 : qa; b0 = b0 > qb ? b0 : qb; }
    BT2(8, 0xff00ff0000ff00ffull) BT2(4, 0xf0f0f0f00f0f0f0full) BT2(2, 0xcccccccc33333333ull) BT2(1, 0xaaaaaaaa55555555ull)
    { const unsigned qa = bt_fetch<32>(a0), qb = bt_fetch<32>(b0); a0 = a0 > qa ? a0 : qa; b0 = b0 > qb ? b0 : qb; }
    BT2(8, 0x00ff00ff00ff00ffull) BT2(4, 0x0f0f0f0f0f0f0f0full) BT2(2, 0x3333333333333333ull) BT2(1, 0x5555555555555555ull)
#undef BT4
#undef BT2
}

__device__ __forceinline__ void peer_route_wg(const Params& p, char* smem) {
    const int tid = otid(), lane = tid & 63, wave = tid >> 6;
    const int c = blockIdx.x, G = gridDim.x, h = c & 7;
    constexpr int KS = 144;
    char* K1 = smem; char* K2 = smem + 128 * KS;
    float* qw = (float*)(smem + 2 * 128 * KS) + wave * 128;
    float* lst = (float*)(smem + 2 * 128 * KS + 8 * 512) + wave * 160;
    float* l1v = lst; int* l1i = (int*)(lst + 16); float* l2v = lst + 32; int* l2i = (int*)(lst + 48); float* scv = lst + 64; int* eid = (int*)(lst + 80);
    __syncthreads();
    for (int i = tid; i < 2 * 128 * 8; i += 512) {
        const int tbl = i >> 10, r = (i >> 3) & 127, ch = i & 7;
        const h16* src = (tbl ? p.K2H : p.K1H) + ((size_t)(h * 128 + r)) * 64 + ch * 8;
        *(u32x4*)((tbl ? K2 : K1) + r * KS + ch * 16) = *(const u32x4*)src;
    }
    __syncthreads();
    const int nblk = TP / 64;
    volatile int* s_next = (volatile int*)(smem + LDS_BYTES - 64);
    for (;;) {
        __syncthreads();
        if (threadIdx.x == 0) s_next[0] = (int)atomicAdd(&p.ctl[6400 + 64 * h], 1u);
        __syncthreads();
        const int tb = s_next[0];
        if (tb >= nblk) break;
        float* SW = (float*)(smem + 65536) + wave * 2048;
        {
            const int r16 = lane & 15, g = lane >> 4;
            const h16* qrow = (const h16*)p.PQ + (size_t)(64 * tb + wave * 8 + (r16 & 7)) * 1024 + h * 128 + g * 8;
            h16x8 qa[2][2];
#pragma unroll
            for (int tb2 = 0; tb2 < 2; ++tb2)
#pragma unroll
                for (int kk = 0; kk < 2; ++kk) qa[tb2][kk] = *(const h16x8*)(qrow + tb2 * 64 + kk * 32);
#pragma unroll
            for (int tb2 = 0; tb2 < 2; ++tb2) {
                const char* KT = tb2 ? K2 : K1;
#pragma unroll
                for (int nt = 0; nt < 8; ++nt) {
                    f32x4 a = {0.f, 0.f, 0.f, 0.f};
#pragma unroll
                    for (int kk = 0; kk < 2; ++kk) {
                        const h16x8 kb = *(const h16x8*)(KT + (16 * nt + r16) * KS + (kk * 4 + g) * 16);
                        a = __builtin_amdgcn_mfma_f32_16x16x32_f16(qa[tb2][kk], kb, a, 0, 0, 0);
                    }
                    if (g < 2) {
#pragma unroll
                        for (int j = 0; j < 4; ++j) SW[(tb2 * 8 + 4 * g + j) * 128 + 16 * nt + r16] = a[j];
                    }
                }
            }
            asm volatile("s_waitcnt lgkmcnt(0)" ::: "memory");
        }
        for (int j = 0; j < 8; ++j) {
            const int tk = 64 * tb + wave * 8 + j;
            const float* sw1 = SW + j * 128; const float* sw2 = SW + (8 + j) * 128;
            unsigned ka0 = (f2ord(sw1[lane]) & ~127u) | (unsigned)(127 - lane), ka1 = (f2ord(sw1[64 + lane]) & ~127u) | (unsigned)(63 - lane);
            unsigned kb0 = (f2ord(sw2[lane]) & ~127u) | (unsigned)(127 - lane), kb1 = (f2ord(sw2[64 + lane]) & ~127u) | (unsigned)(63 - lane);
            bitonic_top16_x2(ka0, ka1, kb0, kb1);
            {
                const bool second = (lane & 16) != 0;
                const unsigned key = second ? kb0 : ka0;
                const int idx = 127 - (int)(key & 127u);
                const float val = (second ? sw2 : sw1)[idx];
                float* sv = lst + 96 + (second ? 32 : 0); int* si = (int*)sv + 16;
                if (lane < 32) { sv[lane & 15] = val; si[lane & 15] = idx; }
            }
            asm volatile("s_waitcnt lgkmcnt(0)" ::: "memory");
            float cv1; int e1;
            {
                const int ab = PAIR_LUT[lane], a = ab >> 4, b = ab & 15;
                const float* s1v = lst + 96; const int* s1i = (const int*)(lst + 112); const float* s2v = lst + 128; const int* s2i = (const int*)(lst + 144);
                cv1 = s1v[a] + s2v[b]; e1 = s1i[a] * 128 + s2i[b];
            }
            unsigned kc = (lane < 50) ? ((f2ord(cv1) & ~63u) | (unsigned)(63 - lane)) : 0u;
            kc = bitonic_top16_x1(kc);
            const int cl = 63 - (int)(kc & 63u);
            const float sc = __shfl(cv1, cl); const int ee = __shfl(e1, cl);
            const float mx = __int_as_float(__builtin_amdgcn_readfirstlane(__float_as_int(sc)));
            const float ex = __expf(sc - mx);
            float sm = ex;
            sm += __int_as_float(__builtin_amdgcn_update_dpp(0, __float_as_int(sm), 0x128, 0xF, 0xF, true));
            sm += __int_as_float(__builtin_amdgcn_update_dpp(0, __float_as_int(sm), 0x124, 0xF, 0xF, true));
            sm += __int_as_float(__builtin_amdgcn_update_dpp(0, __float_as_int(sm), 0x122, 0xF, 0xF, true));
            sm += __int_as_float(__builtin_amdgcn_update_dpp(0, __float_as_int(sm), 0x121, 0xF, 0xF, true));
            if (lane < 16) { int2 o; o.x = ee; o.y = __float_as_int(ex / sm); p.ROUTE[((size_t)tk * 8 + h) * 16 + lane] = o; }
            asm volatile("s_waitcnt lgkmcnt(0)" ::: "memory");
        }
    }
}

__device__ __forceinline__ void peer_gather_wave(const Params& p, int tk, char* smem) {
    const int lane = otid() & 63;
    const int2 r0 = p.ROUTE[(size_t)tk * 128 + lane], r1 = p.ROUTE[(size_t)tk * 128 + 64 + lane];
    f32x2 hv[16];
#pragma unroll
    for (int k = 0; k < 4; ++k) {
        float t8[8]; unpk8(*(const u32x4*)(p.HN + (size_t)tk * D + 32 * lane + 8 * k), t8);
#pragma unroll
        for (int e = 0; e < 4; ++e) hv[4 * k + e] = (f32x2){t8[2 * e], t8[2 * e + 1]};
    }
    f32x2 facc[16];
#pragma unroll
    for (int i = 0; i < 16; ++i) facc[i] = (f32x2){0.f, 0.f};
    const float rs64 = rsqrtf(p.ROWSS[tk] * (1.f / D) + EPS) * (1.f / 64.f);
    const unsigned char* u8 = (const unsigned char*)p.PU; const unsigned char* v8 = (const unsigned char*)p.PV;
    const int xl = ((lane >> 5) & 1) * 4 + ((lane >> 4) & 1) * 2 + ((lane >> 3) & 1);
    u32x4 uA[8], uB[8], vv[8];
#define PG_ISSUE_U(b, uu) { const int _es = ((b) < 8) ? r0.x : r1.x; \
    _Pragma("unroll") for (int x = 0; x < 8; ++x) { const size_t e = (size_t)(unsigned)__builtin_amdgcn_readlane(_es, 8 * ((b) & 7) + x); \
        uu[x] = *(const u32x4*)(u8 + e * (D / 2) + lane * 16); } }
#define PG_APPLY(b, uu) { const int _es = ((b) < 8) ? r0.x : r1.x; const int _gs = ((b) < 8) ? r0.y : r1.y; \
    _Pragma("unroll") for (int x = 0; x < 8; ++x) { const size_t e = (size_t)(unsigned)__builtin_amdgcn_readlane(_es, 8 * ((b) & 7) + x); \
        vv[x] = *(const u32x4*)(v8 + e * (D / 2) + lane * 16); } \
    const float gl = __int_as_float(__shfl(_gs, 8 * ((b) & 7) + xl)); \
    float d[8]; \
    _Pragma("unroll") for (int x = 0; x < 8; ++x) { f32x2 a2 = {0.f, 0.f}; \
        _Pragma("unroll") for (int q = 0; q < 4; ++q) { const unsigned w = uu[x][q]; \
            a2 += hv[4 * q] * __builtin_amdgcn_cvt_scalef32_pk_f32_fp4(w, 1.0f, 0); a2 += hv[4 * q + 1] * __builtin_amdgcn_cvt_scalef32_pk_f32_fp4(w, 1.0f, 1); \
            a2 += hv[4 * q + 2] * __builtin_amdgcn_cvt_scalef32_pk_f32_fp4(w, 1.0f, 2); a2 += hv[4 * q + 3] * __builtin_amdgcn_cvt_scalef32_pk_f32_fp4(w, 1.0f, 3); } \
        d[x] = a2.x + a2.y; } \
    float r4[4], r2[2], r1v; \
    { const bool hi = (lane & 32) != 0; \
      _Pragma("unroll") for (int k = 0; k < 4; ++k) { const float keep = hi ? d[k + 4] : d[k], send = hi ? d[k] : d[k + 4]; r4[k] = keep + __shfl_xor(send, 32); } } \
    { const bool hi = (lane & 16) != 0; \
      _Pragma("unroll") for (int k = 0; k < 2; ++k) { const float keep = hi ? r4[k + 2] : r4[k], send = hi ? r4[k] : r4[k + 2]; r2[k] = keep + __shfl_xor(send, 16); } } \
    { const bool hi = (lane & 8) != 0; const float keep = hi ? r2[1] : r2[0], send = hi ? r2[0] : r2[1]; r1v = keep + __shfl_xor(send, 8); } \
    r1v += __shfl_xor(r1v, 4); r1v += __shfl_xor(r1v, 2); r1v += __shfl_xor(r1v, 1); \
    const float cwv = gl * gelu_exact(r1v * rs64) * (1.f / 16.f); \
    _Pragma("unroll") for (int x = 0; x < 8; ++x) { const float cw = __int_as_float(__builtin_amdgcn_readlane(__float_as_int(cwv), 8 * x)); const f32x2 cw2 = {cw, cw}; \
        _Pragma("unroll") for (int q = 0; q < 4; ++q) { const unsigned w = vv[x][q]; \
            facc[4 * q] += cw2 * __builtin_amdgcn_cvt_scalef32_pk_f32_fp4(w, 1.0f, 0); facc[4 * q + 1] += cw2 * __builtin_amdgcn_cvt_scalef32_pk_f32_fp4(w, 1.0f, 1); \
            facc[4 * q + 2] += cw2 * __builtin_amdgcn_cvt_scalef32_pk_f32_fp4(w, 1.0f, 2); facc[4 * q + 3] += cw2 * __builtin_amdgcn_cvt_scalef32_pk_f32_fp4(w, 1.0f, 3); } } }
    PG_ISSUE_U(0, uA)
#pragma unroll 1
    for (int b = 0; b < 16; b += 2) {
        PG_ISSUE_U(b + 1, uB)
        __builtin_amdgcn_sched_barrier(0);
        PG_APPLY(b, uA)
        __builtin_amdgcn_sched_barrier(0);
        if (b + 2 < 16) PG_ISSUE_U(b + 2, uA)
        __builtin_amdgcn_sched_barrier(0);
        PG_APPLY(b + 1, uB)
        __builtin_amdgcn_sched_barrier(0);
    }
#undef PG_ISSUE_U
#undef PG_APPLY
    float* y = p.out + O_YP + (size_t)tk * D + 32 * lane;
#pragma unroll
    for (int q = 0; q < 8; ++q) {
        f32x4 hh = {hv[2 * q].x + facc[2 * q].x, hv[2 * q].y + facc[2 * q].y, hv[2 * q + 1].x + facc[2 * q + 1].x, hv[2 * q + 1].y + facc[2 * q + 1].y};
        *(f32x4*)(y + 4 * q) = hh;
    }
}

__device__ __forceinline__ void phase9(const Params& p, char* smem) {
    const int c = blockIdx.x, G = gridDim.x;
    for (int tk = TP + (G - 1 - c); tk < TT; tk += G) peer_item<true>(p, tk, smem);
    peer_route_wg(p, smem);
}
__device__ __forceinline__ void phase10(const Params& p, char* smem) {
    const int gw = blockIdx.x * 8 + (otid() >> 6), NGW = gridDim.x * 8;
    for (int tk = gw; tk < TP; tk += NGW) peer_gather_wave(p, tk, smem);
}

__global__ __launch_bounds__(512, 2) void fwd_kernel(KArgs ka) {
    extern __shared__ __attribute__((aligned(16))) char smem[];
    const Params p = make_params(ka);
    volatile LAS unsigned* st = (volatile LAS unsigned*)(smem + LDS_BYTES - 16);
    if (threadIdx.x == 0) { st[0] = 0u; st[1] = 0u; }
    __syncthreads();
    XcdBarrier bar = xcd_barrier_post(p.ctl, st);
#ifndef PHASE_MASK
#define PHASE_MASK 0x7ff
#endif
#ifndef REP_MASK
  #define REP_MASK 0
#endif
#define PH(k, call) if (((PHASE_MASK >> (k)) & 1) && ka.ph_lo <= (k) && (k) < ka.ph_hi) { \
    for (int rep = 0; rep < 1 + ((REP_MASK >> (k)) & 1); ++rep) { call; if (rep + 1 < 1 + ((REP_MASK >> (k)) & 1)) xcd_barrier(bar); } \
    if ((k) + 1 < ka.ph_hi) xcd_barrier(bar); }
    PH(0, phase0(p, smem))
    PH(1, phase1(p, smem))
    PH(2, phase2(p, smem))
    PH(3, phase3(p, smem, rep))
    PH(4, phase4(p, smem))
    PH(5, phase5(p, smem))
    PH(6, phase6(p, smem))
    PH(8, phase8(p, smem, rep))
    PH(9, phase9(p, smem))
    PH(10, phase10(p, smem))
#undef PH
}


#ifdef DBG_RET_NAIVE
__global__ void dbg_ret_naive(KArgs ka) {
    const Params p = make_params(ka);
    const int idx = blockIdx.x * blockDim.x + threadIdx.x;
    const int dv = idx & 255, dk = (idx >> 8) & 127, h = (idx >> 15) & 7, b = idx >> 18;
    const float g = 1.f - exp2f(-5.f - (float)h);
    float S = 0.f;
    for (int t = 0; t < SEQ; ++t) {
        const size_t tok = (size_t)b * SEQ + t;
        S = g * S + (float)p.RK[tok * 1024 + h * 128 + dk] * (float)p.RV[tok * 2048 + h * 256 + dv];
    }
    p.out[O_SP + ((size_t)((b * 8 + h) * 128 + dk)) * 256 + dv] = S;
}
#endif
#ifdef DBG_SCALES
__global__ void dbg_scale_kernel(float* out) {
    const float sc[10] = {DBG_SCALES};
    const size_t offs[11] = {O_YP, O_YS, O_KP, O_VP, O_IKP, O_SP, O_KS, O_VS, O_IKS, O_SS, 28861440};
    for (size_t i = (size_t)blockIdx.x * blockDim.x + threadIdx.x; i < 28861440; i += (size_t)gridDim.x * blockDim.x) {
        float s = 0.f;
#pragma unroll
        for (int k = 0; k < 10; ++k) if (i >= offs[k] && i < offs[k + 1]) s = sc[k];
        out[i] = (s == 0.f) ? 0.f : out[i] * s;
    }
}
#endif
#ifndef MK_MULTI
#define MK_MULTI 0
#endif
extern "C" void kernel_launch(void* const* d_in, const int* in_sizes, int n_in, void* d_out, int out_size, void* d_ws, size_t ws_size, hipStream_t stream) {
    static int grid = 0;
    if (grid == 0) {
        int dev = 0, cus = 0;
        (void)hipGetDevice(&dev); (void)hipDeviceGetAttribute(&cus, hipDeviceAttributeMultiprocessorCount, dev);
        (void)hipFuncSetAttribute((const void*)fwd_kernel, hipFuncAttributeMaxDynamicSharedMemorySize, LDS_BYTES);
        int per_cu = 0;
        (void)hipOccupancyMaxActiveBlocksPerMultiprocessor(&per_cu, (const void*)fwd_kernel, 512, LDS_BYTES);
        (void)hipGetLastError();
        grid = (cus > 0 ? cus : 256) * 1;
        if (per_cu < 1) fprintf(stderr, "kernel_launch: occupancy query reports %d blocks per CU\n", per_cu);
    }
    KArgs p;
    memset(&p, 0, sizeof(p));
    if (n_in < 21) { fprintf(stderr, "kernel_launch: expected 21 inputs, got %d\n", n_in); return; }
    for (int i = 0; i < 21; ++i) p.in[i] = d_in[i];
    p.out = (float*)d_out;
    p.ws = (char*)d_ws;
    if (WS_END > ws_size) { fprintf(stderr, "kernel_launch: workspace too small (%zu > %zu)\n", (size_t)WS_END, ws_size); return; }
    (void)hipMemsetAsync(d_ws, 0, 65536, stream);
#if MK_MULTI
    for (int k = 0; k < 11; ++k) {
        p.ph_lo = k; p.ph_hi = k + 1;
        hipLaunchKernelGGL(fwd_kernel, dim3(grid), dim3(512), LDS_BYTES, stream, p);
    }
#else
    p.ph_lo = 0; p.ph_hi = 11;
    hipLaunchKernelGGL(fwd_kernel, dim3(grid), dim3(512), LDS_BYTES, stream, p);
#endif
#ifdef DBG_RET_NAIVE
    hipLaunchKernelGGL(dbg_ret_naive, dim3(2 * 8 * 128 * 256 / 256), dim3(256), 0, stream, p);
#endif
#ifdef DBG_SCALES
    hipLaunchKernelGGL(dbg_scale_kernel, dim3(1024), dim3(256), 0, stream, (float*)d_out);
#endif
}
```

```cpp
#include <hip/hip_runtime.h>
#include <stdint.h>
#include <stdio.h>
#include <string.h>
#include <math.h>
#include <type_traits>

typedef _Float16 h16;
typedef _Float16 h16x8 __attribute__((ext_vector_type(8)));
typedef _Float16 h16x4 __attribute__((ext_vector_type(4)));
typedef _Float16 h16x2 __attribute__((ext_vector_type(2)));
typedef float f32x4 __attribute__((ext_vector_type(4)));
typedef float f32x2 __attribute__((ext_vector_type(2)));
typedef unsigned u32x4 __attribute__((ext_vector_type(4)));
typedef unsigned long long u64;

#define LAS __attribute__((address_space(3)))

constexpr int D = 2048, SEQ = 4096, TP = 8192, NS = 8, TT = TP + NS;
constexpr int NWP = 15616;
constexpr int NW0 = 15504;
constexpr int PAST = 16384, PAGE = 128, NPAGES = 128, LS = PAST + 1;
constexpr int NEXP = 16384;
constexpr float EPS = 1e-6f;
constexpr int C_RQ = 0, C_RK = 1024, C_RV = 2048, C_RG = 4096, C_AQ = 6144, C_AK = 8192, C_AV = 8704, C_IQ = 9216, C_IK = 11264, C_IW = 11392, C_GR = 11408, C_GA = 13456;
constexpr size_t O_YP = 0, O_YS = 16777216, O_KP = 16793600, O_VP = 20987904, O_IKP = 25182208, O_SP = 26230784,
                 O_KS = 26755072, O_VS = 26759168, O_IKS = 26763264, O_SS = 26764288;
constexpr int LDS_BYTES = 139264;
constexpr int SCS = 4112;
constexpr int SSCS = 16400;

#define XB_TMO      128
#define XB_XCNT(j)  (256  + 64 * (j))
#define XB_XSUB(j)  (1280 + 64 * (j))
#define XB_XGEN(j)  (2304 + 64 * (j))
#define XB_TOP      3328
#define XB_TOPGEN   3392
#define XCD_BAR_WORDS 3456
#define XB_SPIN_CAP (1u << 22)
__device__ __forceinline__ unsigned xb_ld(unsigned* p)              { return __hip_atomic_load(p, __ATOMIC_RELAXED, __HIP_MEMORY_SCOPE_AGENT); }
__device__ __forceinline__ unsigned xb_add(unsigned* p, unsigned v) { return __hip_atomic_fetch_add(p, v, __ATOMIC_RELAXED, __HIP_MEMORY_SCOPE_AGENT); }
__device__ __forceinline__ unsigned xb_xcc_id() { return (unsigned)__builtin_amdgcn_s_getreg((3 << 11) | 20) & 0xFu; }
#define XB_SPIN(cond, bar) do { unsigned _sp = 0; while (cond) { __builtin_amdgcn_s_sleep(1); \
    if ((++_sp & 255u) == 0u) { if (xb_ld(&(bar)[XB_TMO])) break; if (_sp > XB_SPIN_CAP) { atomicAdd(&(bar)[XB_TMO], 1u); break; } } } } while (0)
struct XcdBarrier { unsigned* bar; unsigned x; volatile LAS unsigned* st; };
__device__ __forceinline__ XcdBarrier xcd_barrier_post(unsigned* bar, volatile LAS unsigned* st) {
    XcdBarrier b; b.bar = bar; b.x = xb_xcc_id(); b.st = st;
    if (threadIdx.x == 0) (void)xb_add(&bar[XB_XCNT(b.x)], 1u);
    return b;
}
__device__ __forceinline__ void xcd_barrier_complete(unsigned* bar, unsigned x, unsigned& nloc, unsigned& nx) {
    const unsigned G = gridDim.x * gridDim.y * gridDim.z;
    unsigned sum, cnt, mine, sp = 0u;
    for (;;) {
        sum = 0u; cnt = 0u; mine = 0u;
#pragma unroll
        for (unsigned j = 0; j < 16; ++j) { const unsigned c = xb_ld(&bar[XB_XCNT(j)]); sum += c; cnt += (c > 0u) ? 1u : 0u; mine = (j == x) ? c : mine; }
        if (sum == G) break;
        __builtin_amdgcn_s_sleep(1);
        if ((++sp & 255u) == 0u) { if (xb_ld(&bar[XB_TMO])) break; if (sp > XB_SPIN_CAP) { atomicAdd(&bar[XB_TMO], 1u); break; } }
    }
    nloc = mine > 0u ? mine : 1u; nx = cnt > 0u ? cnt : 1u;
}
__device__ __forceinline__ void xcd_barrier(const XcdBarrier& b) {
    asm volatile("s_waitcnt vmcnt(0)" ::: "memory");
    __syncthreads();
    if (threadIdx.x == 0) {
        unsigned* bar = b.bar;
        __builtin_amdgcn_s_waitcnt(0);
        volatile LAS unsigned* stw = (volatile LAS unsigned*)(unsigned)(LDS_BYTES - 16);
        unsigned nloc = stw[0], nx = stw[1];
        if (nloc == 0u) { xcd_barrier_complete(bar, b.x, nloc, nx); stw[0] = nloc; stw[1] = nx; }
        const unsigned old = xb_add(&bar[XB_XSUB(b.x)], 1u);
        const unsigned gen = old / nloc;
        if (old + 1u == (gen + 1u) * nloc) {
            __builtin_amdgcn_fence(__ATOMIC_RELEASE, "agent");
            asm volatile("s_waitcnt vmcnt(0)" ::: "memory");
            const unsigned og = xb_add(&bar[XB_TOP], 1u);
            const unsigned tg = og / nx;
            if (og + 1u == (tg + 1u) * nx) xb_add(&bar[XB_TOPGEN], 1u);
            else XB_SPIN(xb_ld(&bar[XB_TOPGEN]) == tg, bar);
            __builtin_amdgcn_fence(__ATOMIC_ACQUIRE, "agent");
            xb_add(&bar[XB_XGEN(b.x)], 1u);
            asm volatile("s_waitcnt vmcnt(0)" ::: "memory");
        } else {
            XB_SPIN(xb_ld(&bar[XB_XGEN(b.x)]) == gen, bar);
            __builtin_amdgcn_fence(__ATOMIC_ACQUIRE, "agent");
            asm volatile("s_waitcnt vmcnt(0)" ::: "memory");
        }
    }
    __syncthreads();
}

struct Params {
    const float *x_prompt, *x_sample, *cache_k, *cache_v, *cache_kidx, *state_ret;
    const int* page_table;
    const float *norm1_w, *w_in, *q_norm_w, *k_norm_w, *ret_gn_w, *w_ret_o, *w_att_o, *w_out, *norm2_w, *peer_wq, *peer_k1, *peer_k2, *peer_u, *peer_v;
    float* out;
    unsigned* ctl;
    float* ROWSS;
    h16 *XN, *WinT, *WrT, *WaT, *WoT, *WqT, *PU, *PV, *K1H, *K2H;
    int2* ROUTE;
    unsigned char *AQ8, *AK8;
    h16 *RQ, *RK, *RV, *RG, *AQ, *AK, *AV, *IQ, *IK, *GR, *GA;
    float* IW;
    float* KV; h16* SPT; int* TOPI; h16 *RN, *ATT, *MIX, *HN; float* MIXF; float* PQ;
    float2* ROPE;
    float *XNS, *ZS, *SRQ, *SRK, *SRV, *SRG, *SAQ, *SAK, *SAV, *SIQ, *SIK, *SIW, *SGR, *SGA, *SSC;
    int* STOP;
    float *SRN, *SATT, *SMIX, *SHN, *SPQ;
};
struct KArgs {
    const void* in[21];
    float* out;
    char* ws;
    int ph_lo, ph_hi;
};
constexpr size_t al256(size_t x) { return (x + 255) & ~(size_t)255; }
constexpr size_t WS_CTL = 0;
constexpr size_t WS_XN = WS_CTL + 65536;
constexpr size_t WS_WINT = WS_XN + al256((size_t)TP * D * 2);
constexpr size_t WS_WRT = WS_WINT + al256((size_t)NWP * D * 2);
constexpr size_t WS_WAT = WS_WRT + al256((size_t)D * D * 2);
constexpr size_t WS_WOT = WS_WAT + al256((size_t)D * D * 2);
constexpr size_t WS_WQT = WS_WOT + al256((size_t)D * D * 2);
constexpr size_t WS_PU = WS_WQT + al256((size_t)1024 * D * 2);
constexpr size_t WS_PV = WS_PU + al256((size_t)NEXP * D * 2);
constexpr size_t WS_RQ = WS_PV + al256((size_t)NEXP * D * 2);
constexpr size_t WS_RK = WS_RQ + al256((size_t)TP * 1024 * 2);
constexpr size_t WS_RV = WS_RK + al256((size_t)TP * 1024 * 2);
constexpr size_t WS_RG = WS_RV + al256((size_t)TP * 2048 * 2);
constexpr size_t WS_AQ = WS_RG + al256((size_t)TP * 2048 * 2);
constexpr size_t WS_AK = WS_AQ + al256((size_t)TP * 2048 * 2);
constexpr size_t WS_AV = WS_AK + al256((size_t)TP * 512 * 2);
constexpr size_t WS_IQ = WS_AV + al256((size_t)TP * 512 * 2);
constexpr size_t WS_IK = WS_IQ + al256((size_t)TP * 2048 * 2);
constexpr size_t WS_GR = WS_IK + al256((size_t)TP * 128 * 2);
constexpr size_t WS_GA = WS_GR + al256((size_t)TP * 2048 * 2);
constexpr size_t WS_IW = WS_GA + al256((size_t)TP * 2048 * 2);
constexpr size_t WS_KV = WS_IW + al256((size_t)TP * 16 * 4);
constexpr size_t WS_SPT = WS_KV + al256((size_t)2 * 8 * 32 * 128 * 256 * 4);
constexpr size_t WS_TOPI = WS_SPT + al256((size_t)2 * 8 * 32 * 256 * 128 * 2);
constexpr size_t WS_RN = WS_TOPI + al256((size_t)TP * 256 * 4);
constexpr size_t WS_ATT = WS_RN + al256((size_t)TP * D * 2);
constexpr size_t WS_MIX = WS_ATT + al256((size_t)TP * D * 2);
constexpr size_t WS_HN = WS_MIX + al256((size_t)TP * D * 2);
constexpr size_t WS_MIXF = WS_HN + al256((size_t)TP * D * 2);
constexpr size_t WS_PQ = WS_MIXF + al256((size_t)TP * D * 4);
constexpr size_t WS_ROPE = WS_PQ + al256((size_t)TP * 1024 * 4);
constexpr size_t WS_XNS = WS_ROPE + al256((size_t)4097 * 64 * 8);
constexpr size_t WS_ZS = WS_XNS + al256(8 * D * 4);
constexpr size_t WS_SRQ = WS_ZS + al256((size_t)8 * NW0 * 4);
constexpr size_t WS_SRK = WS_SRQ + al256(8 * 1024 * 4);
constexpr size_t WS_SRV = WS_SRK + al256(8 * 1024 * 4);
constexpr size_t WS_SRG = WS_SRV + al256(8 * 2048 * 4);
constexpr size_t WS_SAQ = WS_SRG + al256(8 * 2048 * 4);
constexpr size_t WS_SAK = WS_SAQ + al256(8 * 2048 * 4);
constexpr size_t WS_SAV = WS_SAK + al256(8 * 512 * 4);
constexpr size_t WS_SIQ = WS_SAV + al256(8 * 512 * 4);
constexpr size_t WS_SIK = WS_SIQ + al256(8 * 2048 * 4);
constexpr size_t WS_SIW = WS_SIK + al256(8 * 128 * 4);
constexpr size_t WS_SGR = WS_SIW + al256(8 * 16 * 4);
constexpr size_t WS_SGA = WS_SGR + al256(8 * 2048 * 4);
constexpr size_t WS_SSC = WS_SGA + al256(8 * 2048 * 4);
constexpr size_t WS_STOP = WS_SSC + al256((size_t)8 * SSCS * 4);
constexpr size_t WS_SRN = WS_STOP + al256(8 * 256 * 4);
constexpr size_t WS_SATT = WS_SRN + al256(8 * 2048 * 4);
constexpr size_t WS_SMIX = WS_SATT + al256(8 * 2048 * 4);
constexpr size_t WS_SHN = WS_SMIX + al256(8 * 2048 * 4);
constexpr size_t WS_SPQ = WS_SHN + al256(8 * 2048 * 4);
constexpr size_t WS_K1H = WS_SPQ + al256(8 * 1024 * 4);
constexpr size_t WS_K2H = WS_K1H + al256(8 * 128 * 64 * 2);
constexpr size_t WS_ROUTE = WS_K2H + al256(8 * 128 * 64 * 2);
constexpr size_t WS_AQ8 = WS_ROUTE + al256((size_t)TP * 128 * 8);
constexpr size_t WS_AK8 = WS_AQ8 + al256((size_t)TP * 2048);
constexpr size_t WS_END = WS_AK8 + al256((size_t)TP * 512);
__device__ __forceinline__ Params make_params(const KArgs& a) {
    Params p;
    p.x_prompt = (const float*)a.in[0]; p.x_sample = (const float*)a.in[1]; p.cache_k = (const float*)a.in[2]; p.cache_v = (const float*)a.in[3];
    p.cache_kidx = (const float*)a.in[4]; p.state_ret = (const float*)a.in[5]; p.page_table = (const int*)a.in[6];
    p.norm1_w = (const float*)a.in[7]; p.w_in = (const float*)a.in[8]; p.q_norm_w = (const float*)a.in[9]; p.k_norm_w = (const float*)a.in[10];
    p.ret_gn_w = (const float*)a.in[11]; p.w_ret_o = (const float*)a.in[12]; p.w_att_o = (const float*)a.in[13]; p.w_out = (const float*)a.in[14];
    p.norm2_w = (const float*)a.in[15]; p.peer_wq = (const float*)a.in[16]; p.peer_k1 = (const float*)a.in[17]; p.peer_k2 = (const float*)a.in[18];
    p.peer_u = (const float*)a.in[19]; p.peer_v = (const float*)a.in[20];
    p.out = a.out;
    char* w = a.ws;
    p.ctl = (unsigned*)(w + WS_CTL); p.ROWSS = (float*)(w + WS_CTL + 32768);
    p.XN = (h16*)(w + WS_XN); p.WinT = (h16*)(w + WS_WINT); p.WrT = (h16*)(w + WS_WRT); p.WaT = (h16*)(w + WS_WAT); p.WoT = (h16*)(w + WS_WOT); p.WqT = (h16*)(w + WS_WQT);
    p.PU = (h16*)(w + WS_PU); p.PV = (h16*)(w + WS_PV); p.K1H = (h16*)(w + WS_K1H); p.K2H = (h16*)(w + WS_K2H); p.ROUTE = (int2*)(w + WS_ROUTE); p.AQ8 = (unsigned char*)(w + WS_AQ8); p.AK8 = (unsigned char*)(w + WS_AK8);
    p.RQ = (h16*)(w + WS_RQ); p.RK = (h16*)(w + WS_RK); p.RV = (h16*)(w + WS_RV); p.RG = (h16*)(w + WS_RG);
    p.AQ = (h16*)(w + WS_AQ); p.AK = (h16*)(w + WS_AK); p.AV = (h16*)(w + WS_AV); p.IQ = (h16*)(w + WS_IQ); p.IK = (h16*)(w + WS_IK);
    p.GR = (h16*)(w + WS_GR); p.GA = (h16*)(w + WS_GA); p.IW = (float*)(w + WS_IW);
    p.KV = (float*)(w + WS_KV); p.SPT = (h16*)(w + WS_SPT); p.TOPI = (int*)(w + WS_TOPI);
    p.RN = (h16*)(w + WS_RN); p.ATT = (h16*)(w + WS_ATT); p.MIX = (h16*)(w + WS_MIX); p.HN = (h16*)(w + WS_HN);
    p.MIXF = (float*)(w + WS_MIXF); p.PQ = (float*)(w + WS_PQ); p.ROPE = (float2*)(w + WS_ROPE);
    p.XNS = (float*)(w + WS_XNS); p.ZS = (float*)(w + WS_ZS);
    p.SRQ = (float*)(w + WS_SRQ); p.SRK = (float*)(w + WS_SRK); p.SRV = (float*)(w + WS_SRV); p.SRG = (float*)(w + WS_SRG);
    p.SAQ = (float*)(w + WS_SAQ); p.SAK = (float*)(w + WS_SAK); p.SAV = (float*)(w + WS_SAV);
    p.SIQ = (float*)(w + WS_SIQ); p.SIK = (float*)(w + WS_SIK); p.SIW = (float*)(w + WS_SIW);
    p.SGR = (float*)(w + WS_SGR); p.SGA = (float*)(w + WS_SGA); p.SSC = (float*)(w + WS_SSC); p.STOP = (int*)(w + WS_STOP);
    p.SRN = (float*)(w + WS_SRN); p.SATT = (float*)(w + WS_SATT); p.SMIX = (float*)(w + WS_SMIX); p.SHN = (float*)(w + WS_SHN); p.SPQ = (float*)(w + WS_SPQ);
    return p;
}

__device__ __forceinline__ float wave_sum(float v) {
#pragma unroll
    for (int o = 32; o > 0; o >>= 1) v += __shfl_xor(v, o);
    return v;
}
__device__ __forceinline__ float wave_max(float v) {
#pragma unroll
    for (int o = 32; o > 0; o >>= 1) v = fmaxf(v, __shfl_xor(v, o));
    return v;
}
__device__ __forceinline__ int otid() { int t = threadIdx.x; asm volatile("" : "+v"(t)); return t; }
__device__ __forceinline__ unsigned f2ord(float f) { unsigned b = __float_as_uint(f); return b ^ ((unsigned)((int)b >> 31) | 0x80000000u); }
__device__ __forceinline__ unsigned pkh(float lo, float hi) { h16x2 v; v.x = (h16)lo; v.y = (h16)hi; return __builtin_bit_cast(unsigned, v); }
__device__ __forceinline__ u32x4 pk8(const float* v) { u32x4 r; r.x = pkh(v[0], v[1]); r.y = pkh(v[2], v[3]); r.z = pkh(v[4], v[5]); r.w = pkh(v[6], v[7]); return r; }
__device__ __forceinline__ void unpk8(u32x4 r, float* v) {
    const unsigned rx = r.x, ry = r.y, rz = r.z, rw = r.w;
    h16x2 a = __builtin_bit_cast(h16x2, rx), b = __builtin_bit_cast(h16x2, ry), c = __builtin_bit_cast(h16x2, rz), d = __builtin_bit_cast(h16x2, rw);
    v[0] = (float)a.x; v[1] = (float)a.y; v[2] = (float)b.x; v[3] = (float)b.y; v[4] = (float)c.x; v[5] = (float)c.y; v[6] = (float)d.x; v[7] = (float)d.y;
}
__device__ __forceinline__ float sigmoidf_(float x) { return __builtin_amdgcn_rcpf(1.f + __expf(-x)); }
__device__ __forceinline__ float siluf_(float x) { return x * __builtin_amdgcn_rcpf(1.f + __expf(-x)); }
__device__ __forceinline__ float gelu_exact(float x) { return 0.5f * x * (1.f + erff(x * 0.70710678118654752f)); }
__device__ __forceinline__ float ret_log_g(int h) { return logf(1.f - exp2f(-5.f - (float)h)); }

__device__ __forceinline__ unsigned off_b(unsigned row, unsigned ch) { return 256u * row + 16u * (ch ^ (((row & 3) << 2) | ((row >> 2) & 3))); }
__device__ __forceinline__ unsigned tr_addr16(unsigned lane, unsigned c, unsigned t) {
    const unsigned g = lane >> 4, q = (lane & 15) >> 2, p = lane & 3;
    return off_b(8 * g + 4 * t + q, 2 * c + (p >> 1)) + 8 * (p & 1);
}
template <int IMM>
__device__ __forceinline__ h16x8 tr_read8o(unsigned a0, unsigned a1) {
    h16x4 r0, r1;
    asm volatile("ds_read_b64_tr_b16 %0, %2 offset:%4\n\tds_read_b64_tr_b16 %1, %3 offset:%4\n\ts_waitcnt lgkmcnt(0)" : "=&v"(r0), "=&v"(r1) : "v"(a0), "v"(a1), "n"(IMM) : "memory");
    h16x8 r; r[0] = r0[0]; r[1] = r0[1]; r[2] = r0[2]; r[3] = r0[3]; r[4] = r1[0]; r[5] = r1[1]; r[6] = r1[2]; r[7] = r1[3];
    return r;
}
__device__ __forceinline__ void tr_read8x4(unsigned z0, unsigned z1, unsigned c0, h16x8 (&out)[4]) {
    h16x4 r[8];
    const unsigned a0 = z0 ^ (32u * c0), a1 = z1 ^ (32u * c0), a2 = z0 ^ (32u * (c0 + 1)), a3 = z1 ^ (32u * (c0 + 1));
    const unsigned a4 = z0 ^ (32u * (c0 + 2)), a5 = z1 ^ (32u * (c0 + 2)), a6 = z0 ^ (32u * (c0 + 3)), a7 = z1 ^ (32u * (c0 + 3));
    asm volatile("ds_read_b64_tr_b16 %0, %8\n\tds_read_b64_tr_b16 %1, %9\n\tds_read_b64_tr_b16 %2, %10\n\tds_read_b64_tr_b16 %3, %11\n\t"
                 "ds_read_b64_tr_b16 %4, %12\n\tds_read_b64_tr_b16 %5, %13\n\tds_read_b64_tr_b16 %6, %14\n\tds_read_b64_tr_b16 %7, %15\n\ts_waitcnt lgkmcnt(0)"
                 : "=&v"(r[0]), "=&v"(r[1]), "=&v"(r[2]), "=&v"(r[3]), "=&v"(r[4]), "=&v"(r[5]), "=&v"(r[6]), "=&v"(r[7])
                 : "v"(a0), "v"(a1), "v"(a2), "v"(a3), "v"(a4), "v"(a5), "v"(a6), "v"(a7) : "memory");
#pragma unroll
    for (int i = 0; i < 4; ++i) { h16x8 v; v[0] = r[2 * i][0]; v[1] = r[2 * i][1]; v[2] = r[2 * i][2]; v[3] = r[2 * i][3]; v[4] = r[2 * i + 1][0]; v[5] = r[2 * i + 1][1]; v[6] = r[2 * i + 1][2]; v[7] = r[2 * i + 1][3]; out[i] = v; }
}
template <int I, int N, class F>
__device__ __forceinline__ void static_for(F&& f) { if constexpr (I < N) { f(std::integral_constant<int, I>{}); static_for<I + 1, N>(f); } }
__device__ __forceinline__ unsigned lds_u32(const void* p) { return (unsigned)(size_t)(const LAS char*)p; }

__device__ __forceinline__ int wave_sum_small(unsigned cnt) {
    int c = 0;
#pragma unroll
    for (int b = 0; b < 7; ++b) c += __popcll(__ballot((cnt >> b) & 1u)) << b;
    return c;
}
template <int NV>
__device__ __forceinline__ void wave_kth_r4(const unsigned (&u)[NV], int K, unsigned& tau, int& need_eq) {
    tau = 0u; bool exact = false;
    for (int bit = 30; bit >= 0; bit -= 2) {
        const unsigned c1 = tau | (1u << bit), c2 = tau | (2u << bit), c3 = tau | (3u << bit);
        int n1 = 0, n2 = 0, n3 = 0;
#pragma unroll
        for (int i = 0; i < NV; ++i) { n1 += __popcll(__ballot(u[i] >= c1)); n2 += __popcll(__ballot(u[i] >= c2)); n3 += __popcll(__ballot(u[i] >= c3)); }
        int n = -1;
        if (n3 >= K) { tau = c3; n = n3; } else if (n2 >= K) { tau = c2; n = n2; } else if (n1 >= K) { tau = c1; n = n1; }
        if (n == K) { exact = true; break; }
    }
    int cg = 0;
    if (!exact && tau != 0xFFFFFFFFu) {
#pragma unroll
        for (int i = 0; i < NV; ++i) cg += __popcll(__ballot(u[i] > tau));
    }
    need_eq = exact ? K : K - cg;
}
template <int NV>
__device__ __forceinline__ void wave_kth_dyn(const unsigned (&u)[NV], int ngrp, int K, unsigned& tau, int& need_eq) {
    tau = 0u; int cg = 0; bool exact = false;
    for (int bit = 31; bit >= -1; --bit) {
        const unsigned cand = (bit >= 0) ? (tau | (1u << bit)) : tau + 1u;
        unsigned cnt = 0u;
        static_for<0, NV / 8>([&](auto G8) {
            constexpr int g8 = decltype(G8)::value;
            if (g8 < ngrp) {
#pragma unroll
                for (int i = 0; i < 8; ++i) cnt += (u[g8 * 8 + i] >= cand) ? 1u : 0u;
            }
        });
        const int c = wave_sum_small(cnt);
        if (bit >= 0) { if (c >= K) tau = cand; if (c == K) { exact = true; break; } } else cg = (tau == 0xFFFFFFFFu) ? 0 : c;
    }
    need_eq = exact ? K : K - cg;
}
template <int NV>
__device__ __forceinline__ void wave_kth(const unsigned (&u)[NV], int K, unsigned& tau, int& need_eq) {
    tau = 0u; int cg = 0; bool exact = false;
    for (int bit = 31; bit >= -1; --bit) {
        const unsigned cand = (bit >= 0) ? (tau | (1u << bit)) : tau + 1u;
        int c = 0;
        if constexpr (NV >= 8) {
            unsigned cnt = 0u;
#pragma unroll
            for (int i = 0; i < NV; ++i) cnt += (u[i] >= cand) ? 1u : 0u;
            c = wave_sum_small(cnt);
        } else {
#pragma unroll
            for (int i = 0; i < NV; ++i) c += __popcll(__ballot(u[i] >= cand));
        }
        if (bit >= 0) { if (c >= K) tau = cand; if (c == K) { exact = true; break; } } else cg = (tau == 0xFFFFFFFFu) ? 0 : c;
    }
    need_eq = exact ? K : K - cg;
}

template <bool WIN>
__device__ __forceinline__ void p0_transpose_item(const float* W, int K, int N, h16* WT, float* scr, int item, int nblk, int lane, const float* kscale = nullptr) {
    const int kb = item / nblk, nb = item % nblk, k0 = 64 * kb, n0 = 32 * nb;
    float tv[32];
#pragma unroll
    for (int i = 0; i < 32; ++i) { const int kk = 2 * i + (lane >> 5), n = n0 + (lane & 31); tv[i] = (n < N) ? W[(size_t)(k0 + kk) * N + n] : 0.f; }
#pragma unroll
    for (int i = 0; i < 32; ++i) { const int kk = 2 * i + (lane >> 5); scr[kk * 33 + (lane & 31)] = tv[i]; }
    asm volatile("s_waitcnt lgkmcnt(0)" ::: "memory");
    const int c = lane & 7;
#pragma unroll
    for (int j = 0; j < 4; ++j) {
        const int nl = (lane >> 3) + 8 * j, n = n0 + nl;
        const float* s = scr + (8 * c) * 33 + nl;
        float v[8];
#pragma unroll
        for (int e = 0; e < 8; ++e) v[e] = s[e * 33];
        if (kscale) {
#pragma unroll
            for (int e = 0; e < 8; ++e) v[e] *= kscale[k0 + 8 * c + e];
        }
        int dst = n;
        if (WIN) { if (n >= C_GR) dst = n - 16; else if (n >= C_IW) dst = 15488 + (n - C_IW); }
        if (n < N) *(u32x4*)(WT + (size_t)dst * K + k0 + 8 * c) = pk8(v);
    }
    asm volatile("s_waitcnt lgkmcnt(0)" ::: "memory");
}

__device__ __forceinline__ void phase0(const Params& p, char* smem) {
    const int tid = otid(), lane = tid & 63, wave = tid >> 6;
    const int gw = blockIdx.x * 8 + wave, NGW = gridDim.x * 8;
    const int gt = blockIdx.x * 512 + tid, NGT = gridDim.x * 512;
    for (int r = gw; r < TT; r += NGW) {
        const float* x = (r < TP) ? p.x_prompt + (size_t)r * D : p.x_sample + (size_t)(r - TP) * D;
        f32x4 v[8]; float ss = 0.f;
#pragma unroll
        for (int j = 0; j < 8; ++j) { v[j] = *(const f32x4*)(x + 4 * (lane + 64 * j)); ss += v[j].x * v[j].x + v[j].y * v[j].y + v[j].z * v[j].z + v[j].w * v[j].w; }
        ss = wave_sum(ss);
        const float rs = rsqrtf(ss * (1.f / D) + EPS);
#pragma unroll
        for (int j = 0; j < 8; ++j) {
            const f32x4 w = *(const f32x4*)(p.norm1_w + 4 * (lane + 64 * j));
            const float a = v[j].x * rs * w.x, b = v[j].y * rs * w.y, c = v[j].z * rs * w.z, d = v[j].w * rs * w.w;
            if (r < TP) { f32x2 o; o.x = __uint_as_float(pkh(a, b)); o.y = __uint_as_float(pkh(c, d)); *(f32x2*)(p.XN + (size_t)r * D + 4 * (lane + 64 * j)) = o; }
            else { f32x4 o = {a, b, c, d}; *(f32x4*)(p.XNS + (size_t)(r - TP) * D + 4 * (lane + 64 * j)) = o; }
        }
    }
    {
        float* scr = (float*)smem + wave * (64 * 33);
        constexpr int NB_IN = (NW0 + 31) / 32;
        constexpr int I_IN = 32 * NB_IN;
        for (int it = gw; it < I_IN; it += NGW) p0_transpose_item<true>(p.w_in, D, NW0, p.WinT, scr, it, NB_IN, lane);
    }
    for (int i = gt; i < (NWP - NW0) * D / 8; i += NGT) { u32x4 z = {0u, 0u, 0u, 0u}; *(u32x4*)(p.WinT + (size_t)NW0 * D + (size_t)i * 8) = z; }
    for (int i = gt; i < 2 * 8 * 128 * 64 / 8; i += NGT) {
        const int half = 8 * 128 * 64 / 8;
        const float* src = (i < half) ? p.peer_k1 + (size_t)i * 8 : p.peer_k2 + (size_t)(i - half) * 8;
        h16* dst = (i < half) ? p.K1H + (size_t)i * 8 : p.K2H + (size_t)(i - half) * 8;
        const f32x4 a = *(const f32x4*)src, b = *(const f32x4*)(src + 4);
        u32x4 o; o.x = pkh(a.x, a.y); o.y = pkh(a.z, a.w); o.z = pkh(b.x, b.y); o.w = pkh(b.z, b.w);
        *(u32x4*)dst = o;
    }
    for (int i = gt; i < 4097 * 64; i += NGT) {
        const int pi = i >> 6, fi = i & 63;
        const double pos = (pi == 4096) ? 16384.0 : (double)pi;
        double fq = 1.0;
        if (fi & 1) fq *= 0.86596432336006535; if (fi & 2) fq *= 0.74989420933245583; if (fi & 4) fq *= 0.56234132519034908;
        if (fi & 8) fq *= 0.31622776601683794; if (fi & 16) fq *= 0.1; if (fi & 32) fq *= 0.01;
        const double rev = pos * fq * 0.15915494309189533577;
        const double fr = rev - __builtin_rint(rev);
        float2 cs; cs.x = __builtin_amdgcn_cosf((float)fr); cs.y = __builtin_amdgcn_sinf((float)fr);
        p.ROPE[i] = cs;
    }
}

constexpr int G_BK = 64, G_HALF = 128, G_HT = G_HALF * G_BK;
__device__ __forceinline__ int g_lds_byte(int r, int c) {
    int st = (r >> 4) * 2 + (c >> 5), rr = r & 15, cc = c & 31, ob = rr * 64 + cc * 2;
    return st * 1024 + (ob ^ (((ob >> 9) & 1) << 5));
}
__device__ __forceinline__ void g_stage_rc(int b, int& R, int& C) {
    int st = b / 1024, sb = b % 1024, swz = sb ^ (((sb >> 9) & 1) << 5);
    R = (st >> 1) * 16 + swz / 64; C = (st & 1) * 32 + (swz % 64) / 2;
}

__device__ __forceinline__ void gemm_core(const h16* A, const h16* Bt, const int brow, const int bcol, const int K, f32x4 (&acc)[2][2][4][2], h16* shm) {
  #define SA(b,h) (shm+((b)*2+(h))*G_HT)
  #define SB(b,h) (shm+(4+(b)*2+(h))*G_HT)
  #define STAGE_X(T,P,BASE,br,kt) do{const char* _ub=(const char*)(BASE)+((long)(br)*K+(long)(kt)*G_BK)*2; \
    for(int _i=0;_i<2;++_i){int _b=(T)*16+_i*8192;int _r,_c;g_stage_rc(_b,_r,_c); \
      const unsigned _vo=(unsigned)((_r*K+_c)*2); \
      __builtin_amdgcn_global_load_lds((const unsigned*)(_ub+_vo), \
        (unsigned*)((char*)(P)+_b),16,0,0);}}while(0)
  #define STAGE(P,BASE,br,kt) STAGE_X(t0,P,BASE,br,kt)
  #define LDA(dst,b,h) for(int m=0;m<4;++m)for(int k=0;k<2;++k) \
    dst[m][k]=*reinterpret_cast<const h16x8*>((char*)SA(b,h)+g_lds_byte(wr*64+m*16+fr,k*32+fq*8))
  #define LDB(dst,b,h) for(int n=0;n<2;++n)for(int k=0;k<2;++k) \
    dst[n][k]=*reinterpret_cast<const h16x8*>((char*)SB(b,h)+g_lds_byte(wc*32+n*16+fr,k*32+fq*8))
  #define MMA(ai,bj,At,Bx) do{__builtin_amdgcn_s_setprio(1); \
    for(int m=0;m<4;++m)for(int n=0;n<2;++n)for(int k=0;k<2;++k) \
      acc[ai][bj][m][n]=__builtin_amdgcn_mfma_f32_16x16x32_f16(Bx[n][k],At[m][k],acc[ai][bj][m][n],0,0,0); \
    __builtin_amdgcn_s_setprio(0);}while(0)
  #define WAIT_V(n) asm volatile("s_waitcnt vmcnt(" #n ")":::"memory")
  #define WAIT_L(n) asm volatile("s_waitcnt lgkmcnt(" #n ")":::"memory")
  #define BAR __builtin_amdgcn_s_barrier()
  #define SCHED __builtin_amdgcn_sched_barrier(0)
  const int t0=otid();
  int wid=t0>>6,lane=t0&63,wr=wid>>2,wc=wid&3,fr=lane&15,fq=lane>>4;
  h16x8 At[4][2],B0[2][2],B1[2][2];
  const int nt=K/G_BK;
  STAGE(SB(0,0),Bt,bcol,0); STAGE(SA(0,0),A,brow,0);
  STAGE(SB(0,1),Bt,bcol+G_HALF,0); STAGE(SA(0,1),A,brow+G_HALF,0);
  if(wr==1)BAR;
  WAIT_V(4); BAR;
  STAGE(SB(1,0),Bt,bcol,1); STAGE(SA(1,0),A,brow,1); STAGE(SB(1,1),Bt,bcol+G_HALF,1);
  WAIT_V(6); BAR;
  for(int t=0;t<nt-2;t+=2){
    LDB(B0,0,0); SCHED; LDA(At,0,0); STAGE(SA(1,1),A,brow+G_HALF,t+1);
    WAIT_L(8); BAR; WAIT_L(0); MMA(0,0,At,B0); BAR; SCHED;
    LDB(B1,0,1); STAGE(SB(0,0),Bt,bcol,t+2);
    BAR; WAIT_L(0); MMA(0,1,At,B1); BAR;
    LDA(At,0,1); STAGE(SA(0,0),A,brow,t+2);
    BAR; WAIT_L(0); MMA(1,0,At,B0); BAR; SCHED;
    STAGE(SB(0,1),Bt,bcol+G_HALF,t+2);
    WAIT_V(6); BAR; MMA(1,1,At,B1); BAR;
    LDB(B0,1,0); SCHED; LDA(At,1,0); STAGE(SA(0,1),A,brow+G_HALF,t+2);
    WAIT_L(8); BAR; WAIT_L(0); MMA(0,0,At,B0); BAR; SCHED;
    LDB(B1,1,1); STAGE(SB(1,0),Bt,bcol,t+3);
    BAR; WAIT_L(0); MMA(0,1,At,B1); BAR;
    LDA(At,1,1); STAGE(SA(1,0),A,brow,t+3);
    BAR; WAIT_L(0); MMA(1,0,At,B0); BAR; SCHED;
    STAGE(SB(1,1),Bt,bcol+G_HALF,t+3);
    WAIT_V(6); BAR; MMA(1,1,At,B1); BAR;
  }
  int tz=otid(); wid=tz>>6; lane=tz&63; wr=wid>>2; wc=wid&3; fr=lane&15; fq=lane>>4;
  { LDB(B0,0,0); WAIT_V(0); LDA(At,0,0); STAGE_X(tz,SA(1,1),A,brow+G_HALF,nt-1);
    BAR; WAIT_L(0); MMA(0,0,At,B0); BAR;
    LDB(B1,0,1); BAR; WAIT_L(0); MMA(0,1,At,B1); BAR;
    LDA(At,0,1); WAIT_V(4); BAR; WAIT_L(0); MMA(1,0,At,B0); MMA(1,1,At,B1); BAR; }
  { LDB(B0,1,0); LDA(At,1,0); WAIT_V(2); BAR; WAIT_L(0); MMA(0,0,At,B0); BAR;
    LDB(B1,1,1); WAIT_V(0); BAR; WAIT_L(0); MMA(0,1,At,B1); BAR;
    LDA(At,1,1); BAR; WAIT_L(0); MMA(1,0,At,B0); MMA(1,1,At,B1); BAR; }
  if(wr==0)BAR;
  #undef SA
  #undef SB
  #undef STAGE_X
  #undef STAGE
  #undef LDA
  #undef LDB
  #undef MMA
}

__device__ __forceinline__ bool unit_next(int i, int nM, int nN, int& pm, int& pn) {
    const int nwg = nM * nN; const long L = (long)i * gridDim.x + blockIdx.x; if (L >= nwg) return false;
    int wgid = (int)L; { const int q = nwg / 8, r = nwg % 8, xcd = wgid % 8, off = wgid / 8; wgid = (xcd < r ? xcd * (q + 1) : r * (q + 1) + (xcd - r) * q) + off; }
    const int nig = 8 * nN, gid = wgid / nig, fm = gid * 8, gsz = (nM - fm) < 8 ? (nM - fm) : 8;
    pm = fm + ((wgid % nig) % gsz); pn = (wgid % nig) / gsz; return true;
}

constexpr int ES = 132;
__device__ __forceinline__ void stage_quadrant(const f32x4 (&acc)[2][2][4][2], int ai, int bj, float* E, int tz) {
    const int wid = tz >> 6, lane = tz & 63, wr = wid >> 2, wc = wid & 3, fr = lane & 15, fq = lane >> 4;
#pragma unroll
    for (int m = 0; m < 4; ++m)
#pragma unroll
        for (int n = 0; n < 2; ++n) *(f32x4*)(E + (wr * 64 + m * 16 + fr) * ES + wc * 32 + n * 16 + fq * 4) = acc[ai][bj][m][n];
}
__device__ __forceinline__ void read_rowpart(const float* E, int r, int part, float* x1, float* x2) {
#pragma unroll
    for (int q = 0; q < 4; ++q) {
        const f32x4 a = *(const f32x4*)(E + r * ES + 16 * part + 4 * q), b = *(const f32x4*)(E + r * ES + 64 + 16 * part + 4 * q);
        x1[4 * q] = a.x; x1[4 * q + 1] = a.y; x1[4 * q + 2] = a.z; x1[4 * q + 3] = a.w;
        x2[4 * q] = b.x; x2[4 * q + 1] = b.y; x2[4 * q + 2] = b.z; x2[4 * q + 3] = b.w;
    }
}

constexpr int ES16 = 264;
__device__ __forceinline__ void stage_full16(const f32x4 (&acc)[2][2][4][2], h16* E16, int tz) {
    const int wid = tz >> 6, lane = tz & 63, wr = wid >> 2, wc = wid & 3, fr = lane & 15, fq = lane >> 4;
#pragma unroll
    for (int ai = 0; ai < 2; ++ai)
#pragma unroll
        for (int bj = 0; bj < 2; ++bj)
#pragma unroll
            for (int m = 0; m < 4; ++m)
#pragma unroll
                for (int n = 0; n < 2; ++n) {
                    const f32x4 a = acc[ai][bj][m][n];
                    f32x2 o; o.x = __uint_as_float(pkh(a.x, a.y)); o.y = __uint_as_float(pkh(a.z, a.w));
                    *(f32x2*)(E16 + (ai * 128 + wr * 64 + m * 16 + fr) * ES16 + bj * 128 + wc * 32 + n * 16 + fq * 4) = o;
                }
}
__device__ __forceinline__ void read_rowpart16(const h16* E16, int row, int bj, int part, float* x1, float* x2) {
    const h16* b = E16 + row * ES16 + bj * 128 + 16 * part;
    unpk8(*(const u32x4*)b, x1); unpk8(*(const u32x4*)(b + 8), x1 + 8);
    unpk8(*(const u32x4*)(b + 64), x2); unpk8(*(const u32x4*)(b + 72), x2 + 8);
}
template <class BODY>
__device__ __forceinline__ void epilogue_full(const f32x4 (&acc)[2][2][4][2], char* smem, BODY body) {
    h16* E16 = (h16*)smem;
    const int tz = otid();
    __syncthreads();
    stage_full16(acc, E16, tz);
    __syncthreads();
    const int r = tz >> 2, part = tz & 3;
#pragma unroll 1
    for (int q = 0; q < 4; ++q) {
        float x1[16], x2[16];
        read_rowpart16(E16, (q >> 1) * 128 + r, q & 1, part, x1, x2);
        body(q >> 1, q & 1, r, part, x1, x2);
    }
    __syncthreads();
}
__device__ __forceinline__ void rope32(float* x1, float* x2, const float2* rp, int part) {
#pragma unroll
    for (int i = 0; i < 16; ++i) { const float2 cs = rp[16 * part + i]; const float a = x1[i], b = x2[i]; x1[i] = a * cs.x - b * cs.y; x2[i] = b * cs.x + a * cs.y; }
}
struct RopeRegs { f32x4 v[8]; };
__device__ __forceinline__ void rope_load(RopeRegs& rr, const float2* rp, int part) {
#pragma unroll
    for (int k = 0; k < 8; ++k) rr.v[k] = *(const f32x4*)(rp + 16 * part + 2 * k);
}
__device__ __forceinline__ void rope32r(float* x1, float* x2, const RopeRegs& rr) {
#pragma unroll
    for (int k = 0; k < 8; ++k) {
        { const float c = rr.v[k].x, s = rr.v[k].y, a = x1[2 * k], b = x2[2 * k]; x1[2 * k] = a * c - b * s; x2[2 * k] = b * c + a * s; }
        { const float c = rr.v[k].z, s = rr.v[k].w, a = x1[2 * k + 1], b = x2[2 * k + 1]; x1[2 * k + 1] = a * c - b * s; x2[2 * k + 1] = b * c + a * s; }
    }
}
template <class BUF, class LD, class PR>
__device__ __forceinline__ void epilogue_pipe(const f32x4 (&acc)[2][2][4][2], float* E, int tz, LD ld, PR pr) {
    BUF b0, b1;
    const int r = tz >> 2, part = tz & 3;
    float x1[16], x2[16];
    ld(0, 0, r, part, b0);
    __syncthreads(); stage_quadrant(acc, 0, 0, E, tz); __syncthreads(); read_rowpart(E, r, part, x1, x2); ld(0, 1, r, part, b1); pr(0, 0, r, part, b0, x1, x2);
    __syncthreads(); stage_quadrant(acc, 0, 1, E, tz); __syncthreads(); read_rowpart(E, r, part, x1, x2); ld(1, 0, r, part, b0); pr(0, 1, r, part, b1, x1, x2);
    __syncthreads(); stage_quadrant(acc, 1, 0, E, tz); __syncthreads(); read_rowpart(E, r, part, x1, x2); ld(1, 1, r, part, b1); pr(1, 0, r, part, b0, x1, x2);
    __syncthreads(); stage_quadrant(acc, 1, 1, E, tz); __syncthreads(); read_rowpart(E, r, part, x1, x2); pr(1, 1, r, part, b1, x1, x2);
}
__device__ __forceinline__ void store_h16_32(h16* dst, int part, const float* x1, const float* x2) {
    *(u32x4*)(dst + 16 * part) = pk8(x1); *(u32x4*)(dst + 16 * part + 8) = pk8(x1 + 8);
    *(u32x4*)(dst + 64 + 16 * part) = pk8(x2); *(u32x4*)(dst + 64 + 16 * part + 8) = pk8(x2 + 8);
}
__device__ __forceinline__ void store_fp8_32(unsigned char* dst, int part, const float* x1, const float* x2, float sc) {
    u32x4 a, b;
#pragma unroll
    for (int q = 0; q < 4; ++q) {
        int w = __builtin_amdgcn_cvt_pk_fp8_f32(x1[4 * q] * sc, x1[4 * q + 1] * sc, 0, false);
        w = __builtin_amdgcn_cvt_pk_fp8_f32(x1[4 * q + 2] * sc, x1[4 * q + 3] * sc, w, true); a[q] = (unsigned)w;
        int v = __builtin_amdgcn_cvt_pk_fp8_f32(x2[4 * q] * sc, x2[4 * q + 1] * sc, 0, false);
        v = __builtin_amdgcn_cvt_pk_fp8_f32(x2[4 * q + 2] * sc, x2[4 * q + 3] * sc, v, true); b[q] = (unsigned)v;
    }
    *(u32x4*)(dst + 16 * part) = a; *(u32x4*)(dst + 64 + 16 * part) = b;
}
__device__ __forceinline__ void store_f32_32(float* dst, int part, const float* x1, const float* x2) {
#pragma unroll
    for (int q = 0; q < 4; ++q) {
        f32x4 a = {x1[4 * q], x1[4 * q + 1], x1[4 * q + 2], x1[4 * q + 3]}, b = {x2[4 * q], x2[4 * q + 1], x2[4 * q + 2], x2[4 * q + 3]};
        *(f32x4*)(dst + 16 * part + 4 * q) = a; *(f32x4*)(dst + 64 + 16 * part + 4 * q) = b;
    }
}
__device__ __forceinline__ float quad_sum(float v) { v += __shfl_xor(v, 1); v += __shfl_xor(v, 2); return v; }

__device__ __forceinline__ void inproj_block(const Params& p, int cb, int tok, int part, float* x1, float* x2, const RopeRegs& rr) {
    if (cb < 8) {
        rope32r(x1, x2, rr); store_h16_32(p.RQ + (size_t)tok * 1024 + cb * 128, part, x1, x2);
    } else if (cb < 16) {
        rope32r(x1, x2, rr);
#pragma unroll
        for (int i = 0; i < 16; ++i) { x1[i] *= 0.08838834764831845f; x2[i] *= 0.08838834764831845f; }
        store_h16_32(p.RK + (size_t)tok * 1024 + (cb - 8) * 128, part, x1, x2);
    } else if (cb < 32) {
        store_h16_32(p.RV + (size_t)tok * 2048 + (cb - 16) * 128, part, x1, x2);
    } else if (cb < 48) {
#pragma unroll
        for (int i = 0; i < 16; ++i) { x1[i] = siluf_(x1[i]); x2[i] = siluf_(x2[i]); }
        store_h16_32(p.RG + (size_t)tok * 2048 + (cb - 32) * 128, part, x1, x2);
    } else if (cb < 68) {
        const bool isq = cb < 64;
        float ss = 0.f;
#pragma unroll
        for (int i = 0; i < 16; ++i) ss += x1[i] * x1[i] + x2[i] * x2[i];
        ss = quad_sum(ss);
        const float rs = rsqrtf(ss * (1.f / 128.f) + EPS);
        const float* nw = isq ? p.q_norm_w : p.k_norm_w;
#pragma unroll
        for (int i = 0; i < 16; ++i) { x1[i] *= rs * nw[16 * part + i]; x2[i] *= rs * nw[64 + 16 * part + i]; }
        rope32r(x1, x2, rr);
        if (isq) {
#pragma unroll
            for (int i = 0; i < 16; ++i) { x1[i] *= 0.08838834764831845f; x2[i] *= 0.08838834764831845f; }
            store_fp8_32(p.AQ8 + (size_t)tok * 2048 + (cb - 48) * 128, part, x1, x2, 16.f);
        } else {
            store_fp8_32(p.AK8 + (size_t)tok * 512 + (cb - 64) * 128, part, x1, x2, 1.f);
            store_f32_32(p.out + O_KP + (size_t)tok * 512 + (cb - 64) * 128, part, x1, x2);
        }
    } else if (cb < 72) {
        store_h16_32(p.AV + (size_t)tok * 512 + (cb - 68) * 128, part, x1, x2);
        store_f32_32(p.out + O_VP + (size_t)tok * 512 + (cb - 68) * 128, part, x1, x2);
    } else if (cb < 88) {
        rope32r(x1, x2, rr);
#pragma unroll
        for (int i = 0; i < 16; ++i) { x1[i] *= 0.08838834764831845f; x2[i] *= 0.08838834764831845f; }
        store_h16_32(p.IQ + (size_t)tok * 2048 + (cb - 72) * 128, part, x1, x2);
    } else if (cb == 88) {
        rope32r(x1, x2, rr);
        {
            h16* kb = p.IK + (size_t)(tok >> 4) * 2048 + (tok & 15) * 8;
            *(u32x4*)(kb + (2 * part) * 128) = pk8(x1); *(u32x4*)(kb + (2 * part + 1) * 128) = pk8(x1 + 8);
            *(u32x4*)(kb + (8 + 2 * part) * 128) = pk8(x2); *(u32x4*)(kb + (9 + 2 * part) * 128) = pk8(x2 + 8);
        }
        store_f32_32(p.out + O_IKP + (size_t)tok * 128, part, x1, x2);
    } else if (cb < 121) {
#pragma unroll
        for (int i = 0; i < 16; ++i) { x1[i] = sigmoidf_(x1[i]); x2[i] = sigmoidf_(x2[i]); }
        h16* dst = (cb < 105) ? p.GR + (size_t)tok * 2048 + (cb - 89) * 128 : p.GA + (size_t)tok * 2048 + (cb - 105) * 128;
        store_h16_32(dst, part, x1, x2);
    } else {
        if (part == 0) {
#pragma unroll
            for (int q = 0; q < 4; ++q) { f32x4 a = {x1[4 * q] * 0.25f, x1[4 * q + 1] * 0.25f, x1[4 * q + 2] * 0.25f, x1[4 * q + 3] * 0.25f}; *(f32x4*)(p.IW + (size_t)tok * 16 + 4 * q) = a; }
        }
    }
}

template <int CB, class F>
__device__ __forceinline__ void gemv8_item(const float* A, const float* W, int N, int n0, char* smem, F f, const float* normw = nullptr, float* shn_out = nullptr) {
    constexpr int C4 = CB / 4, KG = 512 / C4, NL = 2048 / KG, OUT = 8 * CB, P = 512 / OUT;
    const int tid = otid();
    float* AT = (float*)smem;
    float* red = AT + 2048 * 8;
    float* rs8 = (float*)(smem + 131072);
    __syncthreads();
    if (normw) {
        float ssl[8];
#pragma unroll
        for (int t = 0; t < 8; ++t) ssl[t] = 0.f;
#pragma unroll
        for (int j = 0; j < 32; ++j) { const int i = tid + 512 * j, t = i >> 11, k = i & 2047; const float a = A[i]; AT[k * 8 + t] = a * normw[k]; ssl[j >> 2] += a * a; }
#pragma unroll
        for (int t = 0; t < 8; ++t) { const float s = wave_sum(ssl[t]); if ((tid & 63) == 0) rs8[8 + (tid >> 6) * 8 + t] = s; }
        __syncthreads();
        if (tid < 8) { float s = 0.f; for (int w = 0; w < 8; ++w) s += rs8[8 + w * 8 + tid]; rs8[tid] = rsqrtf(s * (1.f / 2048.f) + EPS); }
        __syncthreads();
        if (shn_out) for (int i = tid; i < 8 * 2048; i += 512) { const int t = i >> 11, k = i & 2047; shn_out[i] = AT[k * 8 + t] * rs8[t]; }
    } else {
        float av32[32];
#pragma unroll
        for (int j = 0; j < 32; ++j) av32[j] = A[tid + 512 * j];
#pragma unroll
        for (int j = 0; j < 32; ++j) { const int i = tid + 512 * j, t = i >> 11, k = i & 2047; AT[k * 8 + t] = av32[j]; }
        __syncthreads();
    }
    const int c4 = tid % C4, kg = tid / C4, n = n0 + 4 * c4;
    const bool ok = (n + 3) < N;
    float acc[8][4];
#pragma unroll
    for (int t = 0; t < 8; ++t)
#pragma unroll
        for (int c = 0; c < 4; ++c) acc[t][c] = 0.f;
    const float* wp = W + (size_t)kg * N + (ok ? n : 0);
#pragma unroll 16
    for (int j = 0; j < NL; ++j) {
        const int k = kg + KG * j;
        f32x4 w = *(const f32x4*)(wp + (size_t)(KG * j) * N);
        if (!ok) w = (f32x4){0.f, 0.f, 0.f, 0.f};
        const f32x4 a0 = *(const f32x4*)(AT + k * 8), a1 = *(const f32x4*)(AT + k * 8 + 4);
        const float av[8] = {a0.x, a0.y, a0.z, a0.w, a1.x, a1.y, a1.z, a1.w};
#pragma unroll
        for (int t = 0; t < 8; ++t) { acc[t][0] += av[t] * w.x; acc[t][1] += av[t] * w.y; acc[t][2] += av[t] * w.z; acc[t][3] += av[t] * w.w; }
    }
#pragma unroll
    for (int t = 0; t < 8; ++t) { f32x4 v = {acc[t][0], acc[t][1], acc[t][2], acc[t][3]}; *(f32x4*)(red + (kg * 8 + t) * CB + 4 * c4) = v; }
    __syncthreads();
    {
        const int o = tid % OUT, part = tid / OUT, t = o / CB, col = o % CB;
        float s = 0.f;
#pragma unroll 8
        for (int q = 0; q < 32; ++q) s += red[((part * 32 + q) * 8 + t) * CB + col];
        if (P > 1) {
            AT[part * OUT + o] = s;
            __syncthreads();
            if (tid < OUT) {
                s = 0.f;
#pragma unroll
                for (int q = 0; q < P; ++q) s += AT[q * OUT + o];
            }
        }
        if (tid < OUT && (n0 + col) < N) f(t, n0 + col, normw ? s * rs8[t] : s);
    }
}

__device__ __forceinline__ void late_weight_transposes(const Params& p, char* smem, int first) {
    const int t0 = otid(), lane = t0 & 63, wave = t0 >> 6;
    const int G = gridDim.x, gw = ((int)blockIdx.x - first) * 8 + wave, NGW = (G - first) * 8;
    float* scr = (float*)smem + wave * (64 * 33);
    constexpr int I_SQ = 32 * 64, I_WQ = 32 * 32, NIT = 3 * I_SQ + I_WQ;
    __syncthreads();
    for (int it = gw; it < NIT; it += NGW) {
        int r = it;
        if (r < I_SQ) { p0_transpose_item<false>(p.w_ret_o, D, D, p.WrT, scr, r, 64, lane); continue; } r -= I_SQ;
        if (r < I_SQ) { p0_transpose_item<false>(p.w_att_o, D, D, p.WaT, scr, r, 64, lane); continue; } r -= I_SQ;
        if (r < I_SQ) { p0_transpose_item<false>(p.w_out, D, D, p.WoT, scr, r, 64, lane); continue; } r -= I_SQ;
        p0_transpose_item<false>(p.peer_wq, D, 1024, p.WqT, scr, r, 32, lane, p.norm2_w);
    }
    __syncthreads();
}

__device__ __forceinline__ void phase1(const Params& p, char* smem) {
    const int tid = otid();
    for (int i = 0;; ++i) {
        int pm, pn; if (!unit_next(i, TP / 256, NWP / 256, pm, pn)) break;
        f32x4 acc[2][2][4][2] = {};
        gemm_core(p.XN, p.WinT, pm * 256, pn * 256, D, acc, (h16*)smem);
        epilogue_full(acc, smem, [&](int ai, int bj, int r, int part, float* x1, float* x2) {
            RopeRegs rr;
            rope_load(rr, p.ROPE + (size_t)((pm * 256 + ai * 128 + r) & (SEQ - 1)) * 64, part);
            inproj_block(p, pn * 2 + bj, pm * 256 + ai * 128 + r, part, x1, x2, rr);
        });
    }
    {
        const int G = gridDim.x, first = (G > 160) ? 160 : 0, nw = G - first;
        if ((int)blockIdx.x >= first) {
            for (int it = blockIdx.x - first; it < (NW0 + 63) / 64; it += nw) {
                float* ZS = p.ZS;
                gemv8_item<64>(p.XNS, p.w_in, NW0, it * 64, smem, [=](int t, int n, float v) { ZS[(size_t)t * NW0 + n] = v; });
            }
            late_weight_transposes(p, smem, first);
        }
    }
}

__device__ __forceinline__ void indexer_item(const Params& p, int b, int g, char* smem) {
    const int tid = otid(), lane = tid & 63, wave = tid >> 6, r16 = lane & 15, kq = lane >> 4;
    float* SC = (float*)smem;
    const int t0 = 8 * g, nkeys = 8 * g + 8, ntile = (nkeys + 15) >> 4;
    const size_t tb = (size_t)b * SEQ;
    {
        h16x8 af[2][4][4];
        float* WL = (float*)(smem + 8 * SCS * 4);
        if (tid < 128) WL[tid] = p.IW[(tb + t0) * 16 + tid];
#pragma unroll
        for (int Qg = 0; Qg < 2; ++Qg)
#pragma unroll
            for (int hg = 0; hg < 4; ++hg) {
                const h16* qp = p.IQ + (tb + t0 + Qg * 4 + (r16 >> 2)) * 2048 + (hg * 4 + (r16 & 3)) * 128 + kq * 8;
#pragma unroll
                for (int kk = 0; kk < 4; ++kk) af[Qg][hg][kk] = *(const h16x8*)(qp + kk * 32);
            }
        __syncthreads();
        f32x4 wv[2][4];
#pragma unroll
        for (int Qg = 0; Qg < 2; ++Qg)
#pragma unroll
            for (int hg = 0; hg < 4; ++hg) wv[Qg][hg] = *(const f32x4*)(WL + (Qg * 4 + kq) * 16 + hg * 4);
        const h16* kbase = p.IK + tb * 128 + kq * 128 + r16 * 8;
        const int last = ntile - 1;
        h16x8 b0[4], b1[4], b2[4];
#define IDX_LOAD(dst, tl) { const int _t = (tl) < last ? (tl) : last; const h16* _kp = kbase + (size_t)_t * 16 * 128; \
    asm volatile("global_load_dwordx4 %0, %4, off\n\tglobal_load_dwordx4 %1, %4, off offset:1024\n\tglobal_load_dwordx4 %2, %4, off offset:2048\n\tglobal_load_dwordx4 %3, %4, off offset:3072" \
                 : "=&v"(dst[0]), "=&v"(dst[1]), "=&v"(dst[2]), "=&v"(dst[3]) : "v"(_kp) : "memory"); }
#define IDX_WAIT8(bfr) asm volatile("s_waitcnt vmcnt(8)" : "+v"(bfr[0]), "+v"(bfr[1]), "+v"(bfr[2]), "+v"(bfr[3]) :: "memory")
#define IDX_TILE(bfr, tl) { const int _t = (tl) < last ? (tl) : last; \
    _Pragma("unroll") for (int Qg = 0; Qg < 2; ++Qg) { float sc = 0.f; \
        _Pragma("unroll") for (int hg = 0; hg < 4; ++hg) { f32x4 a = {0.f, 0.f, 0.f, 0.f}; \
            _Pragma("unroll") for (int kk = 0; kk < 4; ++kk) a = __builtin_amdgcn_mfma_f32_16x16x32_f16(af[Qg][hg][kk], bfr[kk], a, 0, 0, 0); \
            sc += wv[Qg][hg].x * fmaxf(a.x, 0.f) + wv[Qg][hg].y * fmaxf(a.y, 0.f) + wv[Qg][hg].z * fmaxf(a.z, 0.f) + wv[Qg][hg].w * fmaxf(a.w, 0.f); } \
        SC[(Qg * 4 + kq) * SCS + _t * 16 + r16] = sc; } }
#pragma unroll
        for (int Qg = 0; Qg < 2; ++Qg)
#pragma unroll
            for (int hg = 0; hg < 4; ++hg) asm volatile("" : "+v"(af[Qg][hg][0]), "+v"(af[Qg][hg][1]), "+v"(af[Qg][hg][2]), "+v"(af[Qg][hg][3]));
#pragma unroll
        for (int Qg = 0; Qg < 2; ++Qg) asm volatile("" : "+v"(wv[Qg][0]), "+v"(wv[Qg][1]), "+v"(wv[Qg][2]), "+v"(wv[Qg][3]));
        IDX_LOAD(b0, wave) IDX_LOAD(b1, wave + 8) IDX_LOAD(b2, wave + 16)
        for (int tile = wave; tile < ntile; tile += 24) {
            IDX_WAIT8(b0); IDX_TILE(b0, tile) IDX_LOAD(b0, tile + 24)
            IDX_WAIT8(b1); IDX_TILE(b1, tile + 8) IDX_LOAD(b1, tile + 32)
            IDX_WAIT8(b2); IDX_TILE(b2, tile + 16) IDX_LOAD(b2, tile + 40)
        }
        asm volatile("s_waitcnt vmcnt(0)" ::: "memory");
#undef IDX_WAIT8
#undef IDX_LOAD
#undef IDX_TILE
    }
    __syncthreads();
    {
        const int t = t0 + wave, nvalid = t + 1;
        int* outp = p.TOPI + (tb + t) * 256;
        if (nvalid <= 256) {
#pragma unroll
            for (int i = 0; i < 4; ++i) { const int j = lane + 64 * i; outp[j] = (j < nvalid) ? j : -1; }
        } else {
            unsigned u[64];
#pragma unroll
            for (int i = 0; i < 64; ++i) { const int s = i * 64 + lane; const unsigned o = f2ord(SC[wave * SCS + s]); u[i] = (s <= t) ? o : 0u; }
            unsigned tau; int need_eq;
            const int nreg = __builtin_amdgcn_readfirstlane((t >> 6) + 1);
            wave_kth_dyn<64>(u, (nreg + 7) >> 3, 256, tau, need_eq);
            const u64 lt = (1ull << lane) - 1ull;
            int base = 0, eqt = 0;
            unsigned tau2 = tau; asm volatile("" : "+v"(tau2));
            static_for<0, 16>([&](auto G4) {
                constexpr int g4 = decltype(G4)::value;
                if (g4 * 4 < nreg) {
#pragma unroll
                    for (int ii = 0; ii < 4; ++ii) {
                        constexpr int dummy = 0; (void)dummy;
                        const int i = g4 * 4 + ii;
                        const bool gt = u[i] > tau2, eq = u[i] == tau2;
                        const u64 meq = __ballot(eq);
                        const bool sel = gt || (eq && (eqt + __popcll(meq & lt)) < need_eq);
                        const u64 ms = __ballot(sel);
                        if (sel) outp[base + __popcll(ms & lt)] = i * 64 + lane;
                        base += __popcll(ms); eqt += __popcll(meq);
                    }
                    __builtin_amdgcn_sched_barrier(0);
                }
            });
        }
    }
    __syncthreads();
}

__device__ __forceinline__ void kv_item(const Params& p, int b, int h, int c, char* smem) {
    const int tid = otid(), lane = tid & 63, wave = tid >> 6;
    char* Kimg = smem;
    char* Vimg = smem + 32768;
    const size_t tok0 = (size_t)b * SEQ + c * 128;
    const float lg = ret_log_g(h);
#pragma unroll
    for (int i = 0; i < 4; ++i) {
        const int q = tid + 512 * i, tt = q >> 4, ch = q & 15;
        const u32x4 raw = *(const u32x4*)(p.RK + (tok0 + tt) * 1024 + h * 128 + ch * 8);
        float v[8]; unpk8(raw, v);
        const float dec = __expf((float)(127 - tt) * lg);
#pragma unroll
        for (int e = 0; e < 8; ++e) v[e] *= dec;
        *(u32x4*)(Kimg + (tt >> 5) * 8192 + off_b(tt & 31, ch)) = pk8(v);
    }
#pragma unroll
    for (int i = 0; i < 8; ++i) {
        const int q = tid + 512 * i, tt = q >> 5, c32 = q & 31;
        const u32x4 raw = *(const u32x4*)(p.RV + (tok0 + tt) * 2048 + h * 256 + c32 * 8);
        *(u32x4*)(Vimg + ((tt >> 5) * 2 + (c32 >> 4)) * 8192 + off_b(tt & 31, c32 & 15)) = raw;
    }
    __syncthreads();
    f32x4 acc[16];
#pragma unroll
    for (int nt = 0; nt < 16; ++nt) acc[nt] = (f32x4){0.f, 0.f, 0.f, 0.f};
    const unsigned z0 = lds_u32(smem) + tr_addr16(lane, 0, 0), z1 = lds_u32(smem) + tr_addr16(lane, 0, 1);
    static_for<0, 4>([&](auto KS) {
        constexpr int ks = decltype(KS)::value;
        const h16x8 af = tr_read8o<ks * 8192>(z0 ^ (32u * wave), z1 ^ (32u * wave));
        static_for<0, 16>([&](auto NT) {
            constexpr int nt = decltype(NT)::value;
            const h16x8 bf = tr_read8o<(ks * 2 + (nt >> 3)) * 8192>((z0 + 32768u) ^ (32u * (nt & 7)), (z1 + 32768u) ^ (32u * (nt & 7)));
            acc[nt] = __builtin_amdgcn_mfma_f32_16x16x32_f16(bf, af, acc[nt], 0, 0, 0);
        });
    });
    float* dst = p.KV + ((size_t)((b * 8 + h) * 32 + c) * 128) * 256;
#pragma unroll
    for (int nt = 0; nt < 16; ++nt) *(f32x4*)(dst + (size_t)(16 * wave + (lane & 15)) * 256 + 16 * nt + 4 * (lane >> 4)) = acc[nt];
    __syncthreads();
}

__device__ __forceinline__ void sample_post_item(const Params& p) {
    const int tid = otid();
    const float2* rp = p.ROPE + (size_t)4096 * 64;
    for (int q = tid; q < 8 * 122 * 4; q += 512) {
        const int part = q & 3, cb = (q >> 2) % 122, t = (q >> 2) / 122;
        const int col0 = (cb < 89) ? cb * 128 : (cb < 105) ? C_GR + (cb - 89) * 128 : (cb < 121) ? C_GA + (cb - 105) * 128 : C_IW;
        const float* z = p.ZS + (size_t)t * NW0 + col0;
        float x1[16], x2[16];
        if (cb < 121) {
#pragma unroll
            for (int i = 0; i < 16; ++i) { x1[i] = z[16 * part + i]; x2[i] = z[64 + 16 * part + i]; }
        } else {
#pragma unroll
            for (int i = 0; i < 16; ++i) { x1[i] = z[i]; x2[i] = 0.f; }
        }
        if (cb < 8) { rope32(x1, x2, rp, part); store_f32_32(p.SRQ + t * 1024 + cb * 128, part, x1, x2); }
        else if (cb < 16) {
            rope32(x1, x2, rp, part);
#pragma unroll
            for (int i = 0; i < 16; ++i) { x1[i] *= 0.08838834764831845f; x2[i] *= 0.08838834764831845f; }
            store_f32_32(p.SRK + t * 1024 + (cb - 8) * 128, part, x1, x2);
        } else if (cb < 32) store_f32_32(p.SRV + t * 2048 + (cb - 16) * 128, part, x1, x2);
        else if (cb < 48) {
#pragma unroll
            for (int i = 0; i < 16; ++i) { x1[i] = siluf_(x1[i]); x2[i] = siluf_(x2[i]); }
            store_f32_32(p.SRG + t * 2048 + (cb - 32) * 128, part, x1, x2);
        } else if (cb < 68) {
            const bool isq = cb < 64;
            float ss = 0.f;
#pragma unroll
            for (int i = 0; i < 16; ++i) ss += x1[i] * x1[i] + x2[i] * x2[i];
            ss = quad_sum(ss);
            const float rs = rsqrtf(ss * (1.f / 128.f) + EPS);
            const float* nw = isq ? p.q_norm_w : p.k_norm_w;
#pragma unroll
            for (int i = 0; i < 16; ++i) { x1[i] *= rs * nw[16 * part + i]; x2[i] *= rs * nw[64 + 16 * part + i]; }
            rope32(x1, x2, rp, part);
            if (isq) {
#pragma unroll
                for (int i = 0; i < 16; ++i) { x1[i] *= 0.08838834764831845f; x2[i] *= 0.08838834764831845f; }
                store_f32_32(p.SAQ + t * 2048 + (cb - 48) * 128, part, x1, x2);
            } else {
                store_f32_32(p.SAK + t * 512 + (cb - 64) * 128, part, x1, x2);
                store_f32_32(p.out + O_KS + t * 512 + (cb - 64) * 128, part, x1, x2);
            }
        } else if (cb < 72) {
            store_f32_32(p.SAV + t * 512 + (cb - 68) * 128, part, x1, x2);
            store_f32_32(p.out + O_VS + t * 512 + (cb - 68) * 128, part, x1, x2);
        } else if (cb < 88) {
        } else if (cb == 88) {
            rope32(x1, x2, rp, part);
            store_f32_32(p.SIK + t * 128, part, x1, x2);
            store_f32_32(p.out + O_IKS + t * 128, part, x1, x2);
        } else if (cb < 121) {
#pragma unroll
            for (int i = 0; i < 16; ++i) { x1[i] = sigmoidf_(x1[i]); x2[i] = sigmoidf_(x2[i]); }
            float* dst = (cb < 105) ? p.SGR + t * 2048 + (cb - 89) * 128 : p.SGA + t * 2048 + (cb - 105) * 128;
            store_f32_32(dst, part, x1, x2);
        }
    }
}

__device__ __forceinline__ void sample_indexer_item(const Params& p, int t, int kr, char* smem) {
    const int tid = otid();
    float* qs = (float*)smem;
    float* ws = qs + 2048;
    float* kself = ws + 16;
    float* tmp = kself + 128;
    const float2* rp = p.ROPE + (size_t)4096 * 64;
    const float* z = p.ZS + (size_t)t * NW0;
    __syncthreads();
#pragma unroll
    for (int i = 0; i < 2; ++i) {
        const int pr = tid + 512 * i, hh = pr >> 6, d = pr & 63;
        const float a = z[C_IQ + hh * 128 + d], b = z[C_IQ + hh * 128 + 64 + d];
        const float2 cs = rp[d];
        qs[hh * 128 + d] = (a * cs.x - b * cs.y) * 0.08838834764831845f;
        qs[hh * 128 + 64 + d] = (b * cs.x + a * cs.y) * 0.08838834764831845f;
    }
    if (tid < 16) ws[tid] = z[C_IW + tid] * 0.25f;
    if (tid < 64) { const float a = z[C_IK + tid], b = z[C_IK + 64 + tid]; const float2 cs = rp[tid]; kself[tid] = a * cs.x - b * cs.y; kself[64 + tid] = b * cs.x + a * cs.y; }
    __syncthreads();
    {
        const int lane = tid & 63, wave = tid >> 6, r16 = lane & 15, g = lane >> 4;
        h16x8 qhi[4], qlo[4];
#pragma unroll
        for (int kk = 0; kk < 4; ++kk) {
            const float* qp = qs + r16 * 128 + kk * 32 + g * 8;
            const f32x4 a = *(const f32x4*)qp, b = *(const f32x4*)(qp + 4);
            const float v[8] = {a.x, a.y, a.z, a.w, b.x, b.y, b.z, b.w};
#pragma unroll
            for (int e = 0; e < 8; ++e) { const h16 hv = (h16)v[e]; qhi[kk][e] = hv; qlo[kk][e] = (h16)(v[e] - (float)hv); }
        }
        f32x4 wv4 = *(const f32x4*)(ws + 4 * g);
        f32x4 kraw[4][4][2];
#pragma unroll
        for (int tl = 0; tl < 4; ++tl) {
            const int s = kr * 512 + (wave * 4 + tl) * 16 + r16;
            const int page = p.page_table[t * NPAGES + (s >> 7)];
            const float* kp = p.cache_kidx + ((size_t)page * PAGE + (s & 127)) * 128 + g * 8;
#pragma unroll
            for (int kk = 0; kk < 4; ++kk) { kraw[tl][kk][0] = *(const f32x4*)(kp + kk * 32); kraw[tl][kk][1] = *(const f32x4*)(kp + kk * 32 + 4); }
        }
#pragma unroll
        for (int tl = 0; tl < 4; ++tl) {
            f32x4 acc = {0.f, 0.f, 0.f, 0.f};
#pragma unroll
            for (int kk = 0; kk < 4; ++kk) {
                const f32x4 a = kraw[tl][kk][0], b = kraw[tl][kk][1];
                const float v[8] = {a.x, a.y, a.z, a.w, b.x, b.y, b.z, b.w};
                h16x8 khi, klo;
#pragma unroll
                for (int e = 0; e < 8; ++e) { const h16 hv = (h16)v[e]; khi[e] = hv; klo[e] = (h16)(v[e] - (float)hv); }
                acc = __builtin_amdgcn_mfma_f32_16x16x32_f16(qlo[kk], khi, acc, 0, 0, 0);
                acc = __builtin_amdgcn_mfma_f32_16x16x32_f16(qhi[kk], klo, acc, 0, 0, 0);
                acc = __builtin_amdgcn_mfma_f32_16x16x32_f16(qhi[kk], khi, acc, 0, 0, 0);
            }
            float sc = wv4.x * fmaxf(acc.x, 0.f) + wv4.y * fmaxf(acc.y, 0.f) + wv4.z * fmaxf(acc.z, 0.f) + wv4.w * fmaxf(acc.w, 0.f);
            sc += __shfl_xor(sc, 16); sc += __shfl_xor(sc, 32);
            if (g == 0) p.SSC[(size_t)t * SSCS + kr * 512 + (wave * 4 + tl) * 16 + r16] = sc;
        }
    }
    if (kr == 31) {
        if (tid < 16) { float d = 0.f;
#pragma unroll 4
            for (int i = 0; i < 128; ++i) d += qs[tid * 128 + i] * kself[i]; tmp[tid] = ws[tid] * fmaxf(d, 0.f); }
        __syncthreads();
        if (tid == 0) { float sc = 0.f; for (int i = 0; i < 16; ++i) sc += tmp[i]; p.SSC[(size_t)t * SSCS + PAST] = sc; }
    }
    __syncthreads();
}

__device__ __forceinline__ void phase2(const Params& p, char* smem) {
    const int c = blockIdx.x, G = gridDim.x;
    for (int k = 0;; ++k) {
        const int rr = (k >> 1) * 2 * G, r = (k & 1) ? rr + 2 * G - 1 - c : rr + c;
        if (rr >= 1024) break;
        if (r < 1024) indexer_item(p, r & 1, 511 - (r >> 1), smem);
    }
    for (int it = c; it < 512; it += G) kv_item(p, it >> 8, (it >> 5) & 7, it & 31, smem);
    for (int it = c; it < 256; it += G) sample_indexer_item(p, it >> 5, it & 31, smem);
    if (c == G - 1) sample_post_item(p);
}

__device__ __forceinline__ void scan_item(const Params& p, int item) {
    const int idx = item * 512 + otid();
    const int dv = idx & 255, dkb = (idx >> 8) & 15, h = (idx >> 12) & 7, b = idx >> 15;
    const float gC = __expf(128.f * ret_log_g(h));
    float S[8];
#pragma unroll
    for (int i = 0; i < 8; ++i) S[i] = 0.f;
    const size_t bh = (size_t)(b * 8 + h);
#pragma unroll 4
    for (int c = 0; c < 32; ++c) {
        *(u32x4*)(p.SPT + (((bh * 32 + c) * 256 + dv) * 128) + dkb * 8) = pk8(S);
        const float* kv = p.KV + ((bh * 32 + c) * 128 + dkb * 8) * 256 + dv;
#pragma unroll
        for (int i = 0; i < 8; ++i) S[i] = gC * S[i] + kv[(size_t)i * 256];
    }
#pragma unroll
    for (int i = 0; i < 8; ++i) p.out[O_SP + (bh * 128 + dkb * 8 + i) * 256 + dv] = S[i];
}

__device__ __forceinline__ void attn_item(const Params& p, int b, int n, int tt, char* smem) {
    const int tid = otid(), lane = tid & 63, wave = tid >> 6, r16 = lane & 15, g = lane >> 4;
    const int t = b * SEQ + tt;
    const int cnt = (tt + 1 < 256) ? tt + 1 : 256;
    int* lidx = (int*)(smem + wave * 9216);
    char* img = smem + wave * 9216 + 1024;
    const unsigned az0 = lds_u32(img) + tr_addr16(lane, 0, 0), az1 = lds_u32(img) + tr_addr16(lane, 0, 1);
    const size_t tb = (size_t)b * SEQ;
#pragma unroll
    for (int i = 0; i < 4; ++i) { const int v = p.TOPI[(size_t)t * 256 + lane + 64 * i]; lidx[lane + 64 * i] = v < 0 ? 0 : v; }
    long qf[4];
    {
        const unsigned char* qp = p.AQ8 + (size_t)t * 2048 + (n * 4 + (r16 & 3)) * 128 + 16 * g;
        u32x4 c0 = *(const u32x4*)qp, c1 = *(const u32x4*)(qp + 64);
        if (r16 >= 4) { c0 = (u32x4){0u, 0u, 0u, 0u}; c1 = c0; }
        qf[0] = (long)(((u64)c0.y << 32) | c0.x); qf[1] = (long)(((u64)c0.w << 32) | c0.z);
        qf[2] = (long)(((u64)c1.y << 32) | c1.x); qf[3] = (long)(((u64)c1.w << 32) | c1.z);
    }
    const unsigned char* kbase = p.AK8 + tb * 512 + n * 128 + 16 * g;
    const h16* vbase = p.AV + tb * 512 + n * 128;
    f32x4 sacc[16];
    {
        u32x4 kf[16][2];
#pragma unroll
        for (int i = 0; i < 16; ++i) {
            const unsigned char* kp = kbase + (size_t)lidx[16 * i + r16] * 512;
            kf[i][0] = *(const u32x4*)kp; kf[i][1] = *(const u32x4*)(kp + 64);
        }
#pragma unroll
        for (int i = 0; i < 16; ++i) {
            const u32x4 k0 = kf[i][0], k1 = kf[i][1];
            f32x4 a = {0.f, 0.f, 0.f, 0.f};
            a = __builtin_amdgcn_mfma_f32_16x16x32_fp8_fp8((long)(((u64)k0.y << 32) | k0.x), qf[0], a, 0, 0, 0);
            a = __builtin_amdgcn_mfma_f32_16x16x32_fp8_fp8((long)(((u64)k0.w << 32) | k0.z), qf[1], a, 0, 0, 0);
            a = __builtin_amdgcn_mfma_f32_16x16x32_fp8_fp8((long)(((u64)k1.y << 32) | k1.x), qf[2], a, 0, 0, 0);
            a = __builtin_amdgcn_mfma_f32_16x16x32_fp8_fp8((long)(((u64)k1.w << 32) | k1.z), qf[3], a, 0, 0, 0);
#pragma unroll
            for (int j = 0; j < 4; ++j) sacc[i][j] = ((16 * i + 4 * g + j) < cnt) ? a[j] * (1.f / 16.f) : -3.0e38f;
        }
    }
    u32x4 vr[3][8];
#pragma unroll
    for (int b0 = 0; b0 < 3; ++b0)
#pragma unroll
        for (int i2 = 0; i2 < 8; ++i2) {
            const int q = lane + 64 * i2, s = q >> 4, ch = q & 15;
            const int slot = (2 * b0 + ((s >> 2) & 1)) * 16 + 4 * (s >> 3) + (s & 3);
            vr[b0][i2] = *(const u32x4*)(vbase + (size_t)lidx[slot] * 512 + ch * 8);
        }
    float mx = -3.0e38f;
#pragma unroll
    for (int i = 0; i < 16; ++i)
#pragma unroll
        for (int j = 0; j < 4; ++j) mx = fmaxf(mx, sacc[i][j]);
    mx = fmaxf(mx, __shfl_xor(mx, 16)); mx = fmaxf(mx, __shfl_xor(mx, 32));
    float sum = 0.f;
#pragma unroll
    for (int i = 0; i < 16; ++i)
#pragma unroll
        for (int j = 0; j < 4; ++j) { const float e = __expf(sacc[i][j] - mx); sacc[i][j] = e; sum += e; }
    sum += __shfl_xor(sum, 16); sum += __shfl_xor(sum, 32);
    f32x4 oacc[8];
#pragma unroll
    for (int c = 0; c < 8; ++c) oacc[c] = (f32x4){0.f, 0.f, 0.f, 0.f};
#pragma unroll
    for (int bI = 0; bI < 8; ++bI) {
#pragma unroll
        for (int i2 = 0; i2 < 8; ++i2) { const int q = lane + 64 * i2; *(u32x4*)(img + off_b(q >> 4, q & 15)) = vr[bI % 3][i2]; }
        if (bI + 3 < 8) {
#pragma unroll
            for (int i2 = 0; i2 < 8; ++i2) {
                const int q = lane + 64 * i2, s = q >> 4, ch = q & 15;
                const int slot = (2 * (bI + 3) + ((s >> 2) & 1)) * 16 + 4 * (s >> 3) + (s & 3);
                vr[bI % 3][i2] = *(const u32x4*)(vbase + (size_t)lidx[slot] * 512 + ch * 8);
            }
        }
        h16x8 pf;
        {
            const f32x4 a0 = sacc[2 * bI], a1 = sacc[2 * bI + 1];
            pf[0] = (h16)a0.x; pf[1] = (h16)a0.y; pf[2] = (h16)a0.z; pf[3] = (h16)a0.w;
            pf[4] = (h16)a1.x; pf[5] = (h16)a1.y; pf[6] = (h16)a1.z; pf[7] = (h16)a1.w;
        }
#pragma unroll
        for (int c0 = 0; c0 < 8; c0 += 4) {
            h16x8 vf[4];
            tr_read8x4(az0, az1, c0, vf);
#pragma unroll
            for (int c = 0; c < 4; ++c) oacc[c0 + c] = __builtin_amdgcn_mfma_f32_16x16x32_f16(pf, vf[c], oacc[c0 + c], 0, 0, 0);
        }
    }
    float inv[4];
#pragma unroll
    for (int j = 0; j < 4; ++j) inv[j] = 1.f / __shfl(sum, j);
    h16* ost = (h16*)img;
    if (g == 0) {
#pragma unroll
        for (int c = 0; c < 8; ++c)
#pragma unroll
            for (int j = 0; j < 4; ++j) ost[j * 128 + 16 * c + r16] = (h16)(oacc[c][j] * inv[j]);
    }
    asm volatile("s_waitcnt lgkmcnt(0)" ::: "memory");
    *(u32x4*)(p.ATT + (size_t)t * 2048 + n * 512 + lane * 8) = *(const u32x4*)(ost + lane * 8);
    asm volatile("s_waitcnt lgkmcnt(0)" ::: "memory");
}

__device__ __forceinline__ void sample_topk_item(const Params& p, int t, char* smem) {
    const int tid = otid(), lane = tid & 63, wave = tid >> 6;
    int* red = (int*)smem;
    int* cnts = red + 16;
    __syncthreads();
    unsigned u[33];
#pragma unroll
    for (int i = 0; i < 33; ++i) { const int s = i * 512 + tid; u[i] = (s < LS) ? f2ord(p.SSC[(size_t)t * SSCS + s]) : 0u; }
    unsigned tau = 0u;
    for (int bit = 31; bit >= 0; --bit) {
        const unsigned cand = tau | (1u << bit);
        int c = 0;
#pragma unroll
        for (int i = 0; i < 33; ++i) c += (u[i] >= cand) ? 1 : 0;
#pragma unroll
        for (int o = 32; o > 0; o >>= 1) c += __shfl_xor(c, o);
        if (lane == 0) red[wave] = c;
        __syncthreads();
        int tot = 0;
#pragma unroll
        for (int w = 0; w < 8; ++w) tot += red[w];
        __syncthreads();
        if (tot >= 256) tau = cand;
    }
    const u64 lt = (1ull << lane) - 1ull;
#pragma unroll
    for (int i = 0; i < 33; ++i) {
        const u64 mg = __ballot(u[i] > tau), me = __ballot(u[i] == tau);
        if (lane == 0) { cnts[i * 8 + wave] = __popcll(mg); cnts[264 + i * 8 + wave] = __popcll(me); }
        if ((i & 3) == 3) __builtin_amdgcn_sched_barrier(0);
    }
    __syncthreads();
    int cg_tot = 0;
#pragma unroll 8
    for (int i = 0; i < 264; ++i) cg_tot += cnts[i];
    const int need_eq = 256 - cg_tot;
    int eq_before = 0, sel_before = 0;
    int* outp = p.STOP + t * 256;
    unsigned tau2 = tau; asm volatile("" : "+v"(tau2));
#pragma unroll
    for (int i = 0; i < 33; ++i) {
        int eb = eq_before, sb = sel_before;
        for (int w = 0; w < wave; ++w) {
            const int ng = cnts[i * 8 + w], ne = cnts[264 + i * 8 + w];
            int take_e = need_eq - eb; take_e = take_e < 0 ? 0 : (take_e > ne ? ne : take_e);
            eb += ne; sb += ng + take_e;
        }
        const bool gt = u[i] > tau2, eq = u[i] == tau2;
        const u64 me = __ballot(eq);
        const bool sel = gt || (eq && (eb + __popcll(me & lt)) < need_eq);
        const u64 ms = __ballot(sel);
        if (sel) outp[sb + __popcll(ms & lt)] = i * 512 + tid;
        for (int w = 0; w < 8; ++w) {
            const int ng = cnts[i * 8 + w], ne = cnts[264 + i * 8 + w];
            int take_e = need_eq - eq_before; take_e = take_e < 0 ? 0 : (take_e > ne ? ne : take_e);
            eq_before += ne; sel_before += ng + take_e;
        }
        __builtin_amdgcn_sched_barrier(0);
    }
    __syncthreads();
}

__device__ __forceinline__ void sample_ret_item(const Params& p, int t, int h, char* smem);
__device__ __forceinline__ void sample_attn_item(const Params& p, int t, int n, char* smem);
__device__ __forceinline__ void phase3(const Params& p, char* smem, int rep) {
    const int c = blockIdx.x, G = gridDim.x;
    for (int it = c; it < 200; it += G) {
        if (it < 128) scan_item(p, it);
        else if (it < 136) {
            sample_topk_item(p, it - 128, smem);
            __threadfence(); __syncthreads();
            for (int n = 0; n < 4; ++n) sample_attn_item(p, it - 128, n, smem);
        } else sample_ret_item(p, (it - 136) >> 3, (it - 136) & 7, smem);
    }
    __syncthreads();
    {
        const int lane = otid() & 63;
        const unsigned home = xb_xcc_id() & 7u;
        int dead = 0, it = -1;
        for (; dead < 8; ++dead) {
            int v = 0;
            if (lane == 0) v = (int)atomicAdd(&p.ctl[4096 + 512 * rep + 64 * ((home + (unsigned)dead) & 7u)], 1u);
            v = __builtin_amdgcn_readfirstlane(v);
            if (v < 4096) { it = (int)((home + (unsigned)dead) & 7u) * 4096 + v; break; }
        }
        while (it >= 0) {
            const unsigned q0 = (home + (unsigned)dead) & 7u;
            int v0 = 0;
            if (lane == 0) v0 = (int)atomicAdd(&p.ctl[4096 + 512 * rep + 64 * q0], 1u);
            const int q = it >> 12;
            attn_item(p, q >> 2, q & 3, it & 4095, smem);
            v0 = __builtin_amdgcn_readfirstlane(v0);
            if (v0 < 4096) it = (int)q0 * 4096 + v0;
            else {
                it = -1;
                for (++dead; dead < 8; ++dead) {
                    int v = 0;
                    if (lane == 0) v = (int)atomicAdd(&p.ctl[4096 + 512 * rep + 64 * ((home + (unsigned)dead) & 7u)], 1u);
                    v = __builtin_amdgcn_readfirstlane(v);
                    if (v < 4096) { it = (int)((home + (unsigned)dead) & 7u) * 4096 + v; break; }
                }
            }
        }
    }
    __syncthreads();
}

__device__ __forceinline__ void retout_item(const Params& p, int b, int h, int c, char* smem) {
    const int tid = otid(), lane = tid & 63, wave = tid >> 6, r16 = lane & 15, g = lane >> 4;
    char* Vimg = smem;
    const size_t tok0 = (size_t)b * SEQ + c * 128;
    const float lg = ret_log_g(h);
#pragma unroll
    for (int i = 0; i < 8; ++i) {
        const int q = tid + 512 * i, sg = q >> 5, c32 = q & 31, bI = sg >> 5, s = sg & 31;
        const int tokl = bI * 32 + ((s >> 2) & 1) * 16 + 4 * (s >> 3) + (s & 3);
        const u32x4 raw = *(const u32x4*)(p.RV + (tok0 + tokl) * 2048 + h * 256 + c32 * 8);
        *(u32x4*)(Vimg + (bI * 2 + (c32 >> 4)) * 8192 + off_b(s, c32 & 15)) = raw;
    }
    __syncthreads();
    const int il = 16 * wave + r16;
    h16x8 qf[4], qd[4];
    {
        const h16* qp = p.RQ + (tok0 + il) * 1024 + h * 128 + g * 8;
        const float dq = __expf((float)(il + 1) * lg);
#pragma unroll
        for (int kk = 0; kk < 4; ++kk) {
            const u32x4 raw = *(const u32x4*)(qp + kk * 32);
            qf[kk] = __builtin_bit_cast(h16x8, raw);
            float v[8]; unpk8(raw, v);
#pragma unroll
            for (int e = 0; e < 8; ++e) v[e] *= dq;
            qd[kk] = __builtin_bit_cast(h16x8, pk8(v));
        }
    }
    f32x4 sacc[8];
#pragma unroll
    for (int jr = 0; jr < 2; ++jr) {
        h16x8 kf[4][4];
        if (4 * jr <= wave) {
#pragma unroll
            for (int q = 0; q < 4; ++q) {
                const int jt = 4 * jr + q, jc = jt <= wave ? jt : wave;
                const h16* kp = p.RK + (tok0 + 16 * jc + r16) * 1024 + h * 128 + g * 8;
#pragma unroll
                for (int kk = 0; kk < 4; ++kk) kf[q][kk] = *(const h16x8*)(kp + kk * 32);
            }
        }
#pragma unroll
        for (int q = 0; q < 4; ++q) {
            const int jt = 4 * jr + q;
            sacc[jt] = (f32x4){0.f, 0.f, 0.f, 0.f};
            if (jt <= wave) {
#pragma unroll
                for (int kk = 0; kk < 4; ++kk) sacc[jt] = __builtin_amdgcn_mfma_f32_16x16x32_f16(kf[q][kk], qf[kk], sacc[jt], 0, 0, 0);
#pragma unroll
                for (int j = 0; j < 4; ++j) { const int jl = 16 * jt + 4 * g + j; sacc[jt][j] = (il >= jl) ? sacc[jt][j] * __expf((float)(il - jl) * lg) : 0.f; }
            }
        }
        __builtin_amdgcn_sched_barrier(0);
    }
    f32x4 oacc[16];
    const h16* sp = p.SPT + ((size_t)((b * 8 + h) * 32 + c) * 256) * 128;
#pragma unroll
    for (int er = 0; er < 4; ++er) {
        h16x8 sf[4][4];
#pragma unroll
        for (int q = 0; q < 4; ++q) {
            const h16* sr = sp + (size_t)(16 * (4 * er + q) + r16) * 128 + g * 8;
#pragma unroll
            for (int kk = 0; kk < 4; ++kk) sf[q][kk] = *(const h16x8*)(sr + kk * 32);
        }
#pragma unroll
        for (int q = 0; q < 4; ++q) {
            const int et = 4 * er + q;
            oacc[et] = (f32x4){0.f, 0.f, 0.f, 0.f};
#pragma unroll
            for (int kk = 0; kk < 4; ++kk) oacc[et] = __builtin_amdgcn_mfma_f32_16x16x32_f16(sf[q][kk], qd[kk], oacc[et], 0, 0, 0);
        }
        __builtin_amdgcn_sched_barrier(0);
    }
    const unsigned rz0 = lds_u32(Vimg) + tr_addr16(lane, 0, 0), rz1 = lds_u32(Vimg) + tr_addr16(lane, 0, 1);
    static_for<0, 4>([&](auto BI) {
        constexpr int bI = decltype(BI)::value;
        if (2 * bI <= wave) {
            h16x8 pf;
            const f32x4 a0 = sacc[2 * bI], a1 = sacc[2 * bI + 1];
            pf[0] = (h16)a0.x; pf[1] = (h16)a0.y; pf[2] = (h16)a0.z; pf[3] = (h16)a0.w;
            pf[4] = (h16)a1.x; pf[5] = (h16)a1.y; pf[6] = (h16)a1.z; pf[7] = (h16)a1.w;
            static_for<0, 16>([&](auto ET) {
                constexpr int et = decltype(ET)::value;
                const h16x8 vf = tr_read8o<(bI * 2 + (et >> 3)) * 8192>(rz0 ^ (32u * (et & 7)), rz1 ^ (32u * (et & 7)));
                oacc[et] = __builtin_amdgcn_mfma_f32_16x16x32_f16(vf, pf, oacc[et], 0, 0, 0);
            });
        }
    });
    float s1 = 0.f;
#pragma unroll
    for (int et = 0; et < 16; ++et) s1 += oacc[et].x + oacc[et].y + oacc[et].z + oacc[et].w;
    s1 += __shfl_xor(s1, 16); s1 += __shfl_xor(s1, 32);
    const float mu = s1 * (1.f / 256.f);
    float s2 = 0.f;
#pragma unroll
    for (int et = 0; et < 16; ++et)
#pragma unroll
        for (int j = 0; j < 4; ++j) { const float d = oacc[et][j] - mu; s2 += d * d; }
    s2 += __shfl_xor(s2, 16); s2 += __shfl_xor(s2, 32);
    const float rs = rsqrtf(s2 * (1.f / 256.f) + EPS);
    const size_t tok = tok0 + il;
#pragma unroll
    for (int et = 0; et < 16; ++et) {
        const int e0 = h * 256 + 16 * et + 4 * g;
        const f32x4 gw = *(const f32x4*)(p.ret_gn_w + e0);
        const f32x2 rgraw = *(const f32x2*)(p.RG + tok * 2048 + e0);
        const float rgx = rgraw.x, rgy = rgraw.y;
        const h16x2 r0 = __builtin_bit_cast(h16x2, rgx), r1 = __builtin_bit_cast(h16x2, rgy);
        const float o0 = (oacc[et].x - mu) * rs * gw.x * (float)r0.x, o1 = (oacc[et].y - mu) * rs * gw.y * (float)r0.y;
        const float o2 = (oacc[et].z - mu) * rs * gw.z * (float)r1.x, o3 = (oacc[et].w - mu) * rs * gw.w * (float)r1.y;
        f32x2 o; o.x = __uint_as_float(pkh(o0, o1)); o.y = __uint_as_float(pkh(o2, o3));
        *(f32x2*)(p.RN + tok * 2048 + e0) = o;
    }
    __syncthreads();
}

__device__ __forceinline__ void sample_ret_item(const Params& p, int t, int h, char* smem) {
    const int tid = otid(), dv = tid & 255, half = tid >> 8;
    float* qs = (float*)smem;
    float* ks = qs + 128;
    float* part = ks + 128;
    float* red = part + 512;
    __syncthreads();
    if (tid < 128) { qs[tid] = p.SRQ[t * 1024 + h * 128 + tid]; ks[tid] = p.SRK[t * 1024 + h * 128 + tid]; }
    __syncthreads();
    const float gm = 1.f - exp2f(-5.f - (float)h);
    float qk = 0.f;
#pragma unroll 4
    for (int i = 0; i < 128; ++i) qk += qs[i] * ks[i];
    const float v = p.SRV[t * 2048 + h * 256 + dv];
    const float* Sin = p.state_ret + ((size_t)(t * 8 + h) * 128) * 256;
    float* Sout = p.out + O_SS + ((size_t)(t * 8 + h) * 128) * 256;
    float cross = 0.f;
#pragma unroll 8
    for (int i = 0; i < 64; ++i) {
        const int dk = half * 64 + i;
        const float s = Sin[(size_t)dk * 256 + dv];
        cross += qs[dk] * s;
        Sout[(size_t)dk * 256 + dv] = gm * s + ks[dk] * v;
    }
    part[half * 256 + dv] = cross;
    __syncthreads();
    float o = 0.f;
    if (tid < 256) o = qk * v + gm * (part[dv] + part[256 + dv]);
    float s1 = (tid < 256) ? o : 0.f;
    s1 = wave_sum(s1);
    if ((tid & 63) == 0) red[tid >> 6] = s1;
    __syncthreads();
    const float mu = (red[0] + red[1] + red[2] + red[3]) * (1.f / 256.f);
    float d = (tid < 256) ? (o - mu) : 0.f;
    float s2 = wave_sum(d * d);
    if ((tid & 63) == 0) red[8 + (tid >> 6)] = s2;
    __syncthreads();
    const float rs = rsqrtf((red[8] + red[9] + red[10] + red[11]) * (1.f / 256.f) + EPS);
    if (tid < 256) p.SRN[t * 2048 + h * 256 + dv] = d * rs * p.ret_gn_w[h * 256 + dv] * p.SRG[t * 2048 + h * 256 + dv];
    __syncthreads();
}

__device__ __forceinline__ void sample_attn_item(const Params& p, int t, int n, char* smem) {
    const int tid = otid(), lane = tid & 63, wave = tid >> 6;
    float* qs = (float*)smem;
    int* rowk = (int*)(smem + 2048);
    float* lg = (float*)(smem + 3072);
    float* part = (float*)(smem + 7168);
    float* sums = (float*)(smem + 23552);
    __syncthreads();
    qs[tid] = p.SAQ[t * 2048 + n * 512 + tid];
    if (tid < 256) { const int idx = p.STOP[t * 256 + tid]; rowk[tid] = (idx < PAST) ? p.page_table[t * NPAGES + (idx >> 7)] * PAGE + (idx & 127) : -1; }
    __syncthreads();
    {
        const int key = wave * 32 + (lane >> 1), dh = lane & 1, row = rowk[key];
        const float* kp = (row >= 0) ? p.cache_k + ((size_t)row * 4 + n) * 128 + dh * 64 : p.SAK + t * 512 + n * 128 + dh * 64;
        f32x4 kv[16];
#pragma unroll
        for (int i = 0; i < 16; ++i) kv[i] = *(const f32x4*)(kp + 4 * i);
#pragma unroll
        for (int h = 0; h < 4; ++h) {
            float d = 0.f;
#pragma unroll
            for (int i = 0; i < 16; ++i) { const f32x4 q = *(const f32x4*)(qs + h * 128 + dh * 64 + 4 * i); d += kv[i].x * q.x + kv[i].y * q.y + kv[i].z * q.z + kv[i].w * q.w; }
            d += __shfl_xor(d, 1);
            if (dh == 0) lg[h * 256 + key] = d;
        }
    }
    __syncthreads();
    if (wave < 4) {
        float v[4];
#pragma unroll
        for (int i = 0; i < 4; ++i) v[i] = lg[wave * 256 + lane + 64 * i];
        const float mx = wave_max(fmaxf(fmaxf(v[0], v[1]), fmaxf(v[2], v[3])));
        float s = 0.f;
#pragma unroll
        for (int i = 0; i < 4; ++i) { v[i] = __expf(v[i] - mx); s += v[i]; lg[wave * 256 + lane + 64 * i] = v[i]; }
        s = wave_sum(s);
        if (lane == 0) sums[wave] = s;
    }
    __syncthreads();
    {
        const int sub = lane >> 4, dc = lane & 15;
        float acc[4][8];
#pragma unroll
        for (int h = 0; h < 4; ++h)
#pragma unroll
            for (int e = 0; e < 8; ++e) acc[h][e] = 0.f;
        f32x4 va[8], vb[8];
#pragma unroll
        for (int j = 0; j < 8; ++j) {
            const int row = rowk[wave * 32 + sub * 8 + j];
            const float* vp = (row >= 0) ? p.cache_v + ((size_t)row * 4 + n) * 128 + dc * 8 : p.SAV + t * 512 + n * 128 + dc * 8;
            va[j] = *(const f32x4*)vp; vb[j] = *(const f32x4*)(vp + 4);
        }
#pragma unroll
        for (int j = 0; j < 8; ++j) {
            const int key = wave * 32 + sub * 8 + j;
#pragma unroll
            for (int h = 0; h < 4; ++h) {
                const float pk = lg[h * 256 + key];
                acc[h][0] += pk * va[j].x; acc[h][1] += pk * va[j].y; acc[h][2] += pk * va[j].z; acc[h][3] += pk * va[j].w;
                acc[h][4] += pk * vb[j].x; acc[h][5] += pk * vb[j].y; acc[h][6] += pk * vb[j].z; acc[h][7] += pk * vb[j].w;
            }
        }
#pragma unroll
        for (int h = 0; h < 4; ++h)
#pragma unroll
            for (int e = 0; e < 8; ++e) { float v = acc[h][e]; v += __shfl_xor(v, 16); v += __shfl_xor(v, 32); if (sub == 0) part[(wave * 4 + h) * 128 + dc * 8 + e] = v; }
    }
    __syncthreads();
    {
        const int h = tid >> 7, d = tid & 127;
        float o = 0.f;
#pragma unroll
        for (int w = 0; w < 8; ++w) o += part[(w * 4 + h) * 128 + d];
        p.SATT[t * 2048 + (n * 4 + h) * 128 + d] = o / sums[h];
    }
    __syncthreads();
}

__device__ __forceinline__ void phase4(const Params& p, char* smem) {
    const int c = blockIdx.x, G = gridDim.x;
    for (int it = c; it < 512; it += G) retout_item(p, it >> 8, (it >> 5) & 7, it & 31, smem);
}

__device__ __forceinline__ void phase5(const Params& p, char* smem) {
    const int tid = otid();
    for (int i = 0;; ++i) {
        int pm, pn; if (!unit_next(i, TP / 256, D / 256, pm, pn)) break;
        f32x4 acc[2][2][4][2] = {};
        gemm_core(p.RN, p.WrT, pm * 256, pn * 256, D, acc, (h16*)smem);
        {
            const int tz = otid(), wid = tz >> 6, lane = tz & 63, wr = wid >> 2, wc = wid & 3, fr = lane & 15, fq = lane >> 4;
            h16* R16 = (h16*)smem;
            __syncthreads();
#pragma unroll 4
            for (int i = 0; i < 16; ++i) {
                const int q = tz + 512 * i, row = q >> 5, ch = q & 31;
                const size_t off = (size_t)(pm * 256 + row) * D + pn * 256 + ch * 8;
                float gr[8], ga[8];
                unpk8(*(const u32x4*)(p.GR + off), gr); unpk8(*(const u32x4*)(p.GA + off), ga);
#pragma unroll
                for (int e = 0; e < 8; ++e) gr[e] *= __builtin_amdgcn_rcpf(fmaxf(ga[e], 1e-4f));
                *(u32x4*)(R16 + row * ES16 + ch * 8) = pk8(gr);
            }
            __syncthreads();
#pragma unroll
            for (int ai = 0; ai < 2; ++ai)
#pragma unroll
                for (int bj = 0; bj < 2; ++bj)
#pragma unroll
                    for (int m = 0; m < 4; ++m)
#pragma unroll
                        for (int n = 0; n < 2; ++n) {
                            const f32x2 rr = *(const f32x2*)(R16 + (ai * 128 + wr * 64 + m * 16 + fr) * ES16 + bj * 128 + wc * 32 + n * 16 + fq * 4);
                            const float rx = rr.x, ry = rr.y;
                            const h16x2 r0 = __builtin_bit_cast(h16x2, rx), r1 = __builtin_bit_cast(h16x2, ry);
                            acc[ai][bj][m][n].x *= (float)r0.x; acc[ai][bj][m][n].y *= (float)r0.y; acc[ai][bj][m][n].z *= (float)r1.x; acc[ai][bj][m][n].w *= (float)r1.y;
                        }
        }
        __syncthreads();
        gemm_core(p.ATT, p.WaT, pm * 256, pn * 256, D, acc, (h16*)smem);
        epilogue_full(acc, smem, [&](int ai, int bj, int r, int part, float* x1, float* x2) {
            const size_t rowoff = (size_t)(pm * 256 + ai * 128 + r) * D + pn * 256 + bj * 128;
            const h16* gp = p.GA + rowoff;
            float g1[16], g2[16];
            unpk8(*(const u32x4*)(gp + 16 * part), g1); unpk8(*(const u32x4*)(gp + 16 * part + 8), g1 + 8);
            unpk8(*(const u32x4*)(gp + 64 + 16 * part), g2); unpk8(*(const u32x4*)(gp + 64 + 16 * part + 8), g2 + 8);
#pragma unroll
            for (int e = 0; e < 16; ++e) { x1[e] *= fmaxf(g1[e], 1e-4f); x2[e] *= fmaxf(g2[e], 1e-4f); }
            store_h16_32(p.MIX + rowoff, part, x1, x2);
        });
    }
    for (int it = blockIdx.x; it < 256; it += gridDim.x) {
        float* SMIX = p.SMIX; const float* SGR = p.SGR; const float* SGA = p.SGA;
        gemv8_item<8>(p.SRN, p.w_ret_o, D, it * 8, smem, [=](int t, int n, float v) { SMIX[t * D + n] = SGR[t * D + n] * v; });
        gemv8_item<8>(p.SATT, p.w_att_o, D, it * 8, smem, [=](int t, int n, float v) { SMIX[t * D + n] += SGA[t * D + n] * v; });
    }
}

__device__ __forceinline__ void phase6(const Params& p, char* smem) {
    const int tid = otid();
    for (int i = 0;; ++i) {
        int pm, pn; if (!unit_next(i, TP / 256, D / 256, pm, pn)) break;
        f32x4 acc[2][2][4][2] = {};
#ifdef GEMM_TWICE
        gemm_core(p.MIX, p.WoT, pm * 256, pn * 256, D, acc, (h16*)smem);
        __syncthreads();
        for (int a = 0; a < 2; ++a) for (int b = 0; b < 2; ++b) for (int m = 0; m < 4; ++m) for (int n = 0; n < 2; ++n) acc[a][b][m][n] = acc[a][b][m][n] * 0.0f;
#endif
        gemm_core(p.MIX, p.WoT, pm * 256, pn * 256, D, acc, (h16*)smem);
        epilogue_full(acc, smem, [&](int ai, int bj, int r, int part, float* x1, float* x2) {
            const size_t rowoff = (size_t)(pm * 256 + ai * 128 + r) * D + pn * 256 + bj * 128;
            const float* xp = p.x_prompt + rowoff;
#pragma unroll
            for (int q = 0; q < 4; ++q) {
                const f32x4 a = *(const f32x4*)(xp + 16 * part + 4 * q), bq = *(const f32x4*)(xp + 64 + 16 * part + 4 * q);
                x1[4 * q] += a.x; x1[4 * q + 1] += a.y; x1[4 * q + 2] += a.z; x1[4 * q + 3] += a.w;
                x2[4 * q] += bq.x; x2[4 * q + 1] += bq.y; x2[4 * q + 2] += bq.z; x2[4 * q + 3] += bq.w;
            }
            store_h16_32(p.HN + rowoff, part, x1, x2);
            float ss = 0.f;
#pragma unroll
            for (int e = 0; e < 16; ++e) ss += x1[e] * x1[e] + x2[e] * x2[e];
            ss = quad_sum(ss);
            if (part == 0) atomicAdd(p.ROWSS + pm * 256 + ai * 128 + r, ss);
        });
    }
    for (int it = blockIdx.x; it < 256; it += gridDim.x) {
        float* out = p.out; const float* xs = p.x_sample;
        gemv8_item<8>(p.SMIX, p.w_out, D, it * 8, smem, [=](int t, int n, float v) { out[O_YS + t * D + n] = xs[t * D + n] + v; });
    }
}

__device__ __forceinline__ void phase7(const Params& p) {
    const int t0 = otid(), lane = t0 & 63, gw = blockIdx.x * 8 + (t0 >> 6), NGW = gridDim.x * 8;
    for (int r = gw; r < TT; r += NGW) {
        const float* x = (r < TP) ? p.out + O_YP + (size_t)r * D : p.out + O_YS + (size_t)(r - TP) * D;
        f32x4 v[8]; float ss = 0.f;
#pragma unroll
        for (int j = 0; j < 8; ++j) { v[j] = *(const f32x4*)(x + 4 * (lane + 64 * j)); ss += v[j].x * v[j].x + v[j].y * v[j].y + v[j].z * v[j].z + v[j].w * v[j].w; }
        ss = wave_sum(ss);
        const float rs = rsqrtf(ss * (1.f / D) + EPS);
#pragma unroll
        for (int j = 0; j < 8; ++j) {
            const f32x4 w = *(const f32x4*)(p.norm2_w + 4 * (lane + 64 * j));
            const float a = v[j].x * rs * w.x, b = v[j].y * rs * w.y, c = v[j].z * rs * w.z, d = v[j].w * rs * w.w;
            if (r < TP) { f32x2 o; o.x = __uint_as_float(pkh(a, b)); o.y = __uint_as_float(pkh(c, d)); *(f32x2*)(p.HN + (size_t)r * D + 4 * (lane + 64 * j)) = o; }
            else { f32x4 o = {a, b, c, d}; *(f32x4*)(p.SHN + (size_t)(r - TP) * D + 4 * (lane + 64 * j)) = o; }
        }
    }
}

constexpr int PCV_ITER = 4;
constexpr int PCV_UCH = (int)(((size_t)NEXP * D / 32) / (512 * PCV_ITER));
constexpr int PCV_VCH = PCV_UCH;
constexpr int PCV_CHUNKS = PCV_UCH + PCV_VCH;
__device__ __forceinline__ void peer_convert_chunk(const Params& p, int chunk) {
    const int tid = otid();
    const bool isu = chunk < PCV_UCH;
    const size_t base = (size_t)(isu ? chunk : chunk - PCV_UCH) * (512 * PCV_ITER) + tid;
    const float* tab = isu ? p.peer_u : p.peer_v;
    unsigned char* outp = (unsigned char*)(isu ? p.PU : p.PV);
    const float sc = isu ? 64.f : 16.f;
#pragma unroll 2
    for (int r = 0; r < PCV_ITER; ++r) {
        const float* src = tab + (base + (size_t)r * 512) * 32;
        f32x4 a[8];
#pragma unroll
        for (int q = 0; q < 8; ++q) a[q] = *(const f32x4*)(src + 4 * q);
        if (isu) {
            const float* wk = p.norm2_w + (int)(((base + (size_t)r * 512) & 63) * 32);
#pragma unroll
            for (int q = 0; q < 8; ++q) { const f32x4 w4 = *(const f32x4*)(wk + 4 * q); a[q].x *= w4.x; a[q].y *= w4.y; a[q].z *= w4.z; a[q].w *= w4.w; }
        }
        u32x4 o;
#pragma unroll
        for (int q = 0; q < 4; ++q) {
            unsigned w = 0u;
            w = __builtin_amdgcn_cvt_scalef32_pk_fp4_f32(w, a[2 * q].x * sc, a[2 * q].y * sc, 1.0f, 0);
            w = __builtin_amdgcn_cvt_scalef32_pk_fp4_f32(w, a[2 * q].z * sc, a[2 * q].w * sc, 1.0f, 1);
            w = __builtin_amdgcn_cvt_scalef32_pk_fp4_f32(w, a[2 * q + 1].x * sc, a[2 * q + 1].y * sc, 1.0f, 2);
            w = __builtin_amdgcn_cvt_scalef32_pk_fp4_f32(w, a[2 * q + 1].z * sc, a[2 * q + 1].w * sc, 1.0f, 3);
            o[q] = w;
        }
        *(u32x4*)(outp + (base + (size_t)r * 512) * 16) = o;
    }
}
__device__ __forceinline__ void peer_convert_pull(const Params& p, char* smem, int rep) {
    volatile int* s_next = (volatile int*)(smem + LDS_BYTES - 64);
    for (;;) {
        __syncthreads();
        if (threadIdx.x == 0) s_next[0] = (int)atomicAdd(&p.ctl[6144 + 64 * rep], 1u);
        __syncthreads();
        const int ch = s_next[0];
        if (ch >= PCV_CHUNKS) break;
        peer_convert_chunk(p, ch);
    }
}

__device__ __forceinline__ void phase8(const Params& p, char* smem, int rep) {
    const int tid = otid();
    for (int i = 0;; ++i) {
        int pm, pn; if (!unit_next(i, TP / 256, 1024 / 256, pm, pn)) break;
        f32x4 acc[2][2][4][2] = {};
        gemm_core(p.HN, p.WqT, pm * 256, pn * 256, D, acc, (h16*)smem);
        epilogue_full(acc, smem, [&](int ai, int bj, int r, int part, float* x1, float* x2) {
            const float rs = rsqrtf(p.ROWSS[pm * 256 + ai * 128 + r] * (1.f / D) + EPS);
#pragma unroll
            for (int e = 0; e < 16; ++e) { x1[e] *= rs; x2[e] *= rs; }
            store_h16_32((h16*)p.PQ + (size_t)(pm * 256 + ai * 128 + r) * 1024 + pn * 256 + bj * 128, part, x1, x2);
        });
    }
    {
        const int G = gridDim.x, first = (G > 144) ? 128 : 0;
        if ((int)blockIdx.x >= first)
            for (int it = blockIdx.x - first; it < 128; it += G - first) {
                float* SPQ = p.SPQ;
                gemv8_item<8>(p.out + O_YS, p.peer_wq, 1024, it * 8, smem, [=](int t, int n, float v) { SPQ[t * 1024 + n] = v; }, p.norm2_w, it == 0 ? p.SHN : nullptr);
            }
    }
    peer_convert_pull(p, smem, rep);
}

template <int NV, class EMIT>
__device__ __forceinline__ void wave_select(const unsigned (&u)[NV], int K, int lane, EMIT emit) {
    unsigned tau; int need_eq;
    if constexpr (NV < 8) wave_kth_r4<NV>(u, K, tau, need_eq); else wave_kth<NV>(u, K, tau, need_eq);
    const u64 lt = (1ull << lane) - 1ull;
    int base = 0, eqt = 0;
    unsigned tau2 = tau; asm volatile("" : "+v"(tau2));
#pragma unroll
    for (int i = 0; i < NV; ++i) {
        const bool gt = u[i] > tau2, eq = u[i] == tau2;
        const u64 meq = __ballot(eq);
        const bool sel = gt || (eq && (eqt + __popcll(meq & lt)) < need_eq);
        const u64 ms = __ballot(sel);
        if (sel) emit(i, base + __popcll(ms & lt));
        base += __popcll(ms); eqt += __popcll(meq);
    }
}

template <bool SAMPLE>
__device__ __forceinline__ void load_row8(const void* base, size_t row, int chunk, float* v) {
    if (SAMPLE) {
        const float* r = (const float*)base + row * D + chunk * 8;
        const f32x4 a = *(const f32x4*)r, b = *(const f32x4*)(r + 4);
        v[0] = a.x; v[1] = a.y; v[2] = a.z; v[3] = a.w; v[4] = b.x; v[5] = b.y; v[6] = b.z; v[7] = b.w;
    } else {
        unpk8(*(const u32x4*)((const h16*)base + row * D + chunk * 8), v);
    }
}

template <bool SAMPLE>
__device__ __forceinline__ void peer_item(const Params& p, int tk, char* smem) {
    const int tid = otid(), lane = tid & 63, h = tid >> 6;
    float* qsh = (float*)smem;
    int* route_e = (int*)(smem + 4096);
    float* route_g = (float*)(smem + 4608);
    float* l1v = (float*)(smem + 5120);
    int* l1i = (int*)(smem + 5632);
    float* l2v = (float*)(smem + 6144);
    int* l2i = (int*)(smem + 6656);
    float* parts = (float*)(smem + 8192);
    const int ts = tk - TP;
    __syncthreads();
    { const float* q = SAMPLE ? p.SPQ + (size_t)ts * 1024 : p.PQ + (size_t)tk * 1024; qsh[tid] = q[tid]; qsh[tid + 512] = q[tid + 512]; }
    __syncthreads();
    {
        float s1[2], s2[2];
#pragma unroll
        for (int i = 0; i < 2; ++i) {
            const int key = lane + 64 * i;
            float a = 0.f, b = 0.f;
            if constexpr (SAMPLE) {
                const float* k1 = p.peer_k1 + ((size_t)(h * 128 + key)) * 64;
                const float* k2 = p.peer_k2 + ((size_t)(h * 128 + key)) * 64;
#pragma unroll 4
                for (int c4 = 0; c4 < 16; ++c4) {
                    const f32x4 x = *(const f32x4*)(k1 + 4 * c4), y = *(const f32x4*)(k2 + 4 * c4);
                    const f32x4 q1 = *(const f32x4*)(qsh + h * 128 + 4 * c4), q2 = *(const f32x4*)(qsh + h * 128 + 64 + 4 * c4);
                    a += x.x * q1.x + x.y * q1.y + x.z * q1.z + x.w * q1.w;
                    b += y.x * q2.x + y.y * q2.y + y.z * q2.z + y.w * q2.w;
                }
            } else {
                const h16* k1 = p.K1H + ((size_t)(h * 128 + key)) * 64;
                const h16* k2 = p.K2H + ((size_t)(h * 128 + key)) * 64;
#pragma unroll 2
                for (int c8 = 0; c8 < 8; ++c8) {
                    float x[8], y[8]; unpk8(*(const u32x4*)(k1 + 8 * c8), x); unpk8(*(const u32x4*)(k2 + 8 * c8), y);
                    const f32x4 q1a = *(const f32x4*)(qsh + h * 128 + 8 * c8), q1b = *(const f32x4*)(qsh + h * 128 + 8 * c8 + 4);
                    const f32x4 q2a = *(const f32x4*)(qsh + h * 128 + 64 + 8 * c8), q2b = *(const f32x4*)(qsh + h * 128 + 64 + 8 * c8 + 4);
                    a += x[0] * q1a.x + x[1] * q1a.y + x[2] * q1a.z + x[3] * q1a.w + x[4] * q1b.x + x[5] * q1b.y + x[6] * q1b.z + x[7] * q1b.w;
                    b += y[0] * q2a.x + y[1] * q2a.y + y[2] * q2a.z + y[3] * q2a.w + y[4] * q2b.x + y[5] * q2b.y + y[6] * q2b.z + y[7] * q2b.w;
                }
            }
            s1[i] = a; s2[i] = b;
        }
        unsigned u[2];
        u[0] = f2ord(s1[0]); u[1] = f2ord(s1[1]);
        wave_select<2>(u, 16, lane, [&](int i, int pos) { l1v[h * 16 + pos] = s1[i]; l1i[h * 16 + pos] = lane + 64 * i; });
        u[0] = f2ord(s2[0]); u[1] = f2ord(s2[1]);
        wave_select<2>(u, 16, lane, [&](int i, int pos) { l2v[h * 16 + pos] = s2[i]; l2i[h * 16 + pos] = lane + 64 * i; });
        asm volatile("s_waitcnt lgkmcnt(0)" ::: "memory");
        float cv[4]; unsigned cu[4];
        const int a = lane >> 2;
#pragma unroll
        for (int i = 0; i < 4; ++i) { cv[i] = l1v[h * 16 + a] + l2v[h * 16 + (lane & 3) * 4 + i]; cu[i] = f2ord(cv[i]); }
        wave_select<4>(cu, 16, lane, [&](int i, int pos) { route_g[h * 16 + pos] = cv[i]; route_e[h * 16 + pos] = l1i[h * 16 + a] * 128 + l2i[h * 16 + (lane & 3) * 4 + i]; });
        asm volatile("s_waitcnt lgkmcnt(0)" ::: "memory");
        float sc = (lane < 16) ? route_g[h * 16 + lane] : -3.0e38f;
        const float mx = wave_max(sc);
        const float ex = (lane < 16) ? __expf(sc - mx) : 0.f;
        const float sm = wave_sum(ex);
        asm volatile("s_waitcnt lgkmcnt(0)" ::: "memory");
        if (lane < 16) route_g[h * 16 + lane] = ex / sm;
        asm volatile("s_waitcnt lgkmcnt(0)" ::: "memory");
    }
    {
        const void* hnb = SAMPLE ? (const void*)p.SHN : (const void*)p.HN;
        const void* ub = SAMPLE ? (const void*)p.peer_u : (const void*)p.PU;
        const void* vb = SAMPLE ? (const void*)p.peer_v : (const void*)p.PV;
        const size_t hrow = SAMPLE ? (size_t)ts : (size_t)tk;
        float hv[SAMPLE ? 32 : 1], facc[32];
        u32x4 hp[SAMPLE ? 1 : 4];
        if constexpr (SAMPLE) {
#pragma unroll
            for (int jj = 0; jj < 2; ++jj) { load_row8<true>(hnb, hrow, 2 * (lane + 64 * jj), hv + 16 * jj); load_row8<true>(hnb, hrow, 2 * (lane + 64 * jj) + 1, hv + 16 * jj + 8); }
        } else {
#pragma unroll
            for (int jj = 0; jj < 2; ++jj) { hp[2 * jj] = *(const u32x4*)((const h16*)hnb + hrow * D + (lane + 64 * jj) * 16); hp[2 * jj + 1] = *(const u32x4*)((const h16*)hnb + hrow * D + (lane + 64 * jj) * 16 + 8); }
        }
#pragma unroll
        for (int i = 0; i < 32; ++i) facc[i] = 0.f;
        if constexpr (SAMPLE) {
#pragma unroll 1
            for (int k = 0; k < 16; ++k) {
                const size_t e = (size_t)route_e[h * 16 + k];
                const float* up = (const float*)ub + e * D; const float* vp = (const float*)vb + e * D;
                f32x4 ur[8], vr[8];
#pragma unroll
                for (int jj = 0; jj < 2; ++jj)
#pragma unroll
                    for (int q = 0; q < 4; ++q) { ur[4 * jj + q] = *(const f32x4*)(up + (lane + 64 * jj) * 16 + 4 * q); vr[4 * jj + q] = *(const f32x4*)(vp + (lane + 64 * jj) * 16 + 4 * q); }
                float d = 0.f;
#pragma unroll
                for (int i = 0; i < 8; ++i) d += hv[4 * i] * ur[i].x + hv[4 * i + 1] * ur[i].y + hv[4 * i + 2] * ur[i].z + hv[4 * i + 3] * ur[i].w;
                d = wave_sum(d);
                const float cw = route_g[h * 16 + k] * gelu_exact(d);
#pragma unroll
                for (int i = 0; i < 8; ++i) { facc[4 * i] += cw * vr[i].x; facc[4 * i + 1] += cw * vr[i].y; facc[4 * i + 2] += cw * vr[i].z; facc[4 * i + 3] += cw * vr[i].w; }
            }
        } else {
            const unsigned char* u8 = (const unsigned char*)ub; const unsigned char* v8 = (const unsigned char*)vb;
#pragma unroll 1
            for (int k = 0; k < 16; k += 8) {
                u32x4 ur[8][2], vr[8][2];
#pragma unroll
                for (int x = 0; x < 8; ++x) {
                    const size_t e = (size_t)route_e[h * 16 + k + x];
#pragma unroll
                    for (int jj = 0; jj < 2; ++jj) { ur[x][jj] = *(const u32x4*)(u8 + e * D + (lane + 64 * jj) * 16); vr[x][jj] = *(const u32x4*)(v8 + e * D + (lane + 64 * jj) * 16); }
                }
#pragma unroll
                for (int x = 0; x < 8; ++x) {
                    float d = 0.f;
#pragma unroll
                    for (int jj = 0; jj < 2; ++jj)
#pragma unroll
                        for (int q = 0; q < 4; ++q) {
                            const int w = (int)ur[x][jj][q];
                            const f32x2 lo = __builtin_amdgcn_cvt_pk_f32_fp8(w, false), hi = __builtin_amdgcn_cvt_pk_f32_fp8(w, true);
                            const unsigned h0 = hp[2 * jj + (q >> 1)][2 * (q & 1)], h1 = hp[2 * jj + (q >> 1)][2 * (q & 1) + 1];
                            const h16x2 p0 = __builtin_bit_cast(h16x2, h0), p1 = __builtin_bit_cast(h16x2, h1);
                            d += (float)p0.x * lo.x + (float)p0.y * lo.y + (float)p1.x * hi.x + (float)p1.y * hi.y;
                        }
                    d = wave_sum(d) * (1.f / 64.f);
                    const float cw = route_g[h * 16 + k + x] * gelu_exact(d) * (1.f / 16.f);
#pragma unroll
                    for (int jj = 0; jj < 2; ++jj)
#pragma unroll
                        for (int q = 0; q < 4; ++q) {
                            const int w = (int)vr[x][jj][q];
                            const f32x2 lo = __builtin_amdgcn_cvt_pk_f32_fp8(w, false), hi = __builtin_amdgcn_cvt_pk_f32_fp8(w, true);
                            facc[16 * jj + 4 * q] += cw * lo.x; facc[16 * jj + 4 * q + 1] += cw * lo.y; facc[16 * jj + 4 * q + 2] += cw * hi.x; facc[16 * jj + 4 * q + 3] += cw * hi.y;
                        }
                }
            }
        }
#pragma unroll
        for (int jj = 0; jj < 2; ++jj) {
            float* dst = parts + h * 2048 + (lane + 64 * jj) * 16;
#pragma unroll
            for (int q = 0; q < 4; ++q) { f32x4 a = {facc[16 * jj + 4 * q], facc[16 * jj + 4 * q + 1], facc[16 * jj + 4 * q + 2], facc[16 * jj + 4 * q + 3]}; *(f32x4*)(dst + 4 * q) = a; }
        }
    }
    __syncthreads();
    {
        f32x4 f = {0.f, 0.f, 0.f, 0.f};
#pragma unroll
        for (int w = 0; w < 8; ++w) { const f32x4 a = *(const f32x4*)(parts + w * 2048 + tid * 4); f.x += a.x; f.y += a.y; f.z += a.z; f.w += a.w; }
        float* y = SAMPLE ? p.out + O_YS + (size_t)ts * D + tid * 4 : p.out + O_YP + (size_t)tk * D + tid * 4;
        f32x4 hh = *(const f32x4*)y;
        hh.x += f.x; hh.y += f.y; hh.z += f.z; hh.w += f.w;
        *(f32x4*)y = hh;
    }
}

static __device__ const unsigned char PAIR_LUT[64] = {0,1,2,3,4,5,6,7,8,9,10,11,12,13,14,15,16,17,18,19,20,21,22,23,32,33,34,35,36,48,49,50,51,64,65,66,80,81,96,97,112,113,128,144,160,176,192,208,224,240,0,0,0,0,0,0,0,0,0,0,0,0,0,0};
template <int J>
__device__ __forceinline__ unsigned bt_fetch(unsigned v) {
    if constexpr (J == 1) return (unsigned)__builtin_amdgcn_update_dpp(0, (int)v, 0xB1, 0xF, 0xF, true);
    else if constexpr (J == 2) return (unsigned)__builtin_amdgcn_update_dpp(0, (int)v, 0x4E, 0xF, 0xF, true);
    else if constexpr (J == 8) return (unsigned)__builtin_amdgcn_update_dpp(0, (int)v, 0x128, 0xF, 0xF, true);
    else if constexpr (J == 4) return (unsigned)__builtin_amdgcn_ds_swizzle((int)v, 0x101F);
    else if constexpr (J == 16) return (unsigned)__builtin_amdgcn_ds_swizzle((int)v, 0x401F);
    else return (unsigned)__shfl_xor((int)v, 32);
}
template <int J, u64 M>
__device__ __forceinline__ unsigned bt_cmpx(unsigned x) {
    const unsigned q = bt_fetch<J>(x);
    const unsigned mn = x < q ? x : q, mx = x < q ? q : x;
    unsigned r;
    asm("v_cndmask_b32 %0, %1, %2, %3\n\ts_nop 1" : "=v"(r) : "v"(mn), "v"(mx), "s"(M));
    return r;
}
template <int J, u64 M>
__device__ __forceinline__ unsigned bt_cmpx_n(unsigned x) {
    const unsigned q = bt_fetch<J>(x);
    const unsigned mn = x < q ? x : q, mx = x < q ? q : x;
    unsigned r;
    asm("v_cndmask_b32 %0, %1, %2, %3\n\ts_nop 1" : "=v"(r) : "v"(mn), "v"(mx), "s"(M));
    return r;
}
__device__ __forceinline__ unsigned bitonic_top16_x1(unsigned a) {
#define BT1(J, M0) a = bt_cmpx_n<J, M0>(a);
    BT1(1, 0x9999999999999999ull) BT1(2, 0xc3c3c3c3c3c3c3c3ull) BT1(1, 0xa5a5a5a5a5a5a5a5ull)
    BT1(4, 0xf00ff00ff00ff00full) BT1(2, 0xcc33cc33cc33cc33ull) BT1(1, 0xaa55aa55aa55aa55ull)
    BT1(8, 0xff0000ffff0000ffull) BT1(4, 0xf0f00f0ff0f00f0full) BT1(2, 0xcccc3333cccc3333ull) BT1(1, 0xaaaa5555aaaa5555ull)
    { const unsigned q = bt_fetch<16>(a); a = a > q ? a : q; }
    BT1(8, 0xff00ff0000ff00ffull) BT1(4, 0xf0f0f0f00f0f0f0full) BT1(2, 0xcccccccc33333333ull) BT1(1, 0xaaaaaaaa55555555ull)
    { const unsigned q = bt_fetch<32>(a); a = a > q ? a : q; }
    BT1(8, 0x00ff00ff00ff00ffull) BT1(4, 0x0f0f0f0f0f0f0f0full) BT1(2, 0x3333333333333333ull) BT1(1, 0x5555555555555555ull)
#undef BT1
    return a;
}
__device__ __forceinline__ void bitonic_top16_x2(unsigned& a0, unsigned& a1, unsigned& b0, unsigned& b1) {
#define BT4(J, M0, M1) a0 = bt_cmpx<J, M0>(a0); b0 = bt_cmpx<J, M0>(b0); a1 = bt_cmpx<J, M1>(a1); b1 = bt_cmpx<J, M1>(b1);
#define BT2(J, M0) a0 = bt_cmpx<J, M0>(a0); b0 = bt_cmpx<J, M0>(b0);
    BT4(1, 0x9999999999999999ull, 0x9999999999999999ull)
    BT4(2, 0xc3c3c3c3c3c3c3c3ull, 0xc3c3c3c3c3c3c3c3ull)
    BT4(1, 0xa5a5a5a5a5a5a5a5ull, 0xa5a5a5a5a5a5a5a5ull)
    BT4(4, 0xf00ff00ff00ff00full, 0xf00ff00ff00ff00full)
    BT4(2, 0xcc33cc33cc33cc33ull, 0xcc33cc33cc33cc33ull)
    BT4(1, 0xaa55aa55aa55aa55ull, 0xaa55aa55aa55aa55ull)
    BT4(8, 0xff0000ffff0000ffull, 0x00ffff0000ffff00ull)
    BT4(4, 0xf0f00f0ff0f00f0full, 0x0f0ff0f00f0ff0f0ull)
    BT4(2, 0xcccc3333cccc3333ull, 0x3333cccc3333ccccull)
    BT4(1, 0xaaaa5555aaaa5555ull, 0x5555aaaa5555aaaaull)
    a0 = a0 > a1 ? a0 : a1; b0 = b0 > b1 ? b0 : b1;
    BT2(8, 0xff0000ffff0000ffull) BT2(4, 0xf0f00f0ff0f00f0full) BT2(2, 0xcccc3333cccc3333ull) BT2(1, 0xaaaa5555aaaa5555ull)
    { const unsigned qa = bt_fetch<16>(a0), qb = bt_fetch<16>(b0); a0 = a0 > qa ? a0 : qa; b0 = b0 > qb ? b0 : qb; }
    BT2(8, 0xff00ff0000ff00ffull) BT2(4, 0xf0f0f0f00f0f0f0full) BT2(2, 0xcccccccc33333333ull) BT2(1, 0xaaaaaaaa55555555ull)
    { const unsigned qa = bt_fetch<32>(a0), qb = bt_fetch<32>(b0); a0 = a0 > qa ? a0 : qa; b0 = b0 > qb ? b0 : qb; }
    BT2(8, 0x00ff00ff00ff00ffull) BT2(4, 0x0f0f0f0f0f0f0f0full) BT2(2, 0x3333333333333333ull) BT2(1, 0x5555555555555555ull)
#undef BT4
#undef BT2
}

__device__ __forceinline__ void peer_route_wg(const Params& p, char* smem) {
    const int tid = otid(), lane = tid & 63, wave = tid >> 6;
    const int c = blockIdx.x, G = gridDim.x, h = c & 7;
    constexpr int KS = 144;
    char* K1 = smem; char* K2 = smem + 128 * KS;
    float* qw = (float*)(smem + 2 * 128 * KS) + wave * 128;
    float* lst = (float*)(smem + 2 * 128 * KS + 8 * 512) + wave * 160;
    float* l1v = lst; int* l1i = (int*)(lst + 16); float* l2v = lst + 32; int* l2i = (int*)(lst + 48); float* scv = lst + 64; int* eid = (int*)(lst + 80);
    __syncthreads();
    for (int i = tid; i < 2 * 128 * 8; i += 512) {
        const int tbl = i >> 10, r = (i >> 3) & 127, ch = i & 7;
        const h16* src = (tbl ? p.K2H : p.K1H) + ((size_t)(h * 128 + r)) * 64 + ch * 8;
        *(u32x4*)((tbl ? K2 : K1) + r * KS + ch * 16) = *(const u32x4*)src;
    }
    __syncthreads();
    const int nblk = TP / 64;
    volatile int* s_next = (volatile int*)(smem + LDS_BYTES - 64);
    for (;;) {
        __syncthreads();
        if (threadIdx.x == 0) s_next[0] = (int)atomicAdd(&p.ctl[6400 + 64 * h], 1u);
        __syncthreads();
        const int tb = s_next[0];
        if (tb >= nblk) break;
        float* SW = (float*)(smem + 65536) + wave * 2048;
        {
            const int r16 = lane & 15, g = lane >> 4;
            const h16* qrow = (const h16*)p.PQ + (size_t)(64 * tb + wave * 8 + (r16 & 7)) * 1024 + h * 128 + g * 8;
            h16x8 qa[2][2];
#pragma unroll
            for (int tb2 = 0; tb2 < 2; ++tb2)
#pragma unroll
                for (int kk = 0; kk < 2; ++kk) qa[tb2][kk] = *(const h16x8*)(qrow + tb2 * 64 + kk * 32);
#pragma unroll
            for (int tb2 = 0; tb2 < 2; ++tb2) {
                const char* KT = tb2 ? K2 : K1;
#pragma unroll
                for (int nt = 0; nt < 8; ++nt) {
                    f32x4 a = {0.f, 0.f, 0.f, 0.f};
#pragma unroll
                    for (int kk = 0; kk < 2; ++kk) {
                        const h16x8 kb = *(const h16x8*)(KT + (16 * nt + r16) * KS + (kk * 4 + g) * 16);
                        a = __builtin_amdgcn_mfma_f32_16x16x32_f16(qa[tb2][kk], kb, a, 0, 0, 0);
                    }
                    if (g < 2) {
#pragma unroll
                        for (int j = 0; j < 4; ++j) SW[(tb2 * 8 + 4 * g + j) * 128 + 16 * nt + r16] = a[j];
                    }
                }
            }
            asm volatile("s_waitcnt lgkmcnt(0)" ::: "memory");
        }
        for (int j = 0; j < 8; ++j) {
            const int tk = 64 * tb + wave * 8 + j;
            const float* sw1 = SW + j * 128; const float* sw2 = SW + (8 + j) * 128;
            unsigned ka0 = (f2ord(sw1[lane]) & ~127u) | (unsigned)(127 - lane), ka1 = (f2ord(sw1[64 + lane]) & ~127u) | (unsigned)(63 - lane);
            unsigned kb0 = (f2ord(sw2[lane]) & ~127u) | (unsigned)(127 - lane), kb1 = (f2ord(sw2[64 + lane]) & ~127u) | (unsigned)(63 - lane);
            bitonic_top16_x2(ka0, ka1, kb0, kb1);
            {
                const bool second = (lane & 16) != 0;
                const unsigned key = second ? kb0 : ka0;
                const int idx = 127 - (int)(key & 127u);
                const float val = (second ? sw2 : sw1)[idx];
                float* sv = lst + 96 + (second ? 32 : 0); int* si = (int*)sv + 16;
                if (lane < 32) { sv[lane & 15] = val; si[lane & 15] = idx; }
            }
            asm volatile("s_waitcnt lgkmcnt(0)" ::: "memory");
            float cv1; int e1;
            {
                const int ab = PAIR_LUT[lane], a = ab >> 4, b = ab & 15;
                const float* s1v = lst + 96; const int* s1i = (const int*)(lst + 112); const float* s2v = lst + 128; const int* s2i = (const int*)(lst + 144);
                cv1 = s1v[a] + s2v[b]; e1 = s1i[a] * 128 + s2i[b];
            }
            unsigned kc = (lane < 50) ? ((f2ord(cv1) & ~63u) | (unsigned)(63 - lane)) : 0u;
            kc = bitonic_top16_x1(kc);
            const int cl = 63 - (int)(kc & 63u);
            const float sc = __shfl(cv1, cl); const int ee = __shfl(e1, cl);
            const float mx = __int_as_float(__builtin_amdgcn_readfirstlane(__float_as_int(sc)));
            const float ex = __expf(sc - mx);
            float sm = ex;
            sm += __int_as_float(__builtin_amdgcn_update_dpp(0, __float_as_int(sm), 0x128, 0xF, 0xF, true));
            sm += __int_as_float(__builtin_amdgcn_update_dpp(0, __float_as_int(sm), 0x124, 0xF, 0xF, true));
            sm += __int_as_float(__builtin_amdgcn_update_dpp(0, __float_as_int(sm), 0x122, 0xF, 0xF, true));
            sm += __int_as_float(__builtin_amdgcn_update_dpp(0, __float_as_int(sm), 0x121, 0xF, 0xF, true));
            if (lane < 16) { int2 o; o.x = ee; o.y = __float_as_int(ex / sm); p.ROUTE[((size_t)tk * 8 + h) * 16 + lane] = o; }
            asm volatile("s_waitcnt lgkmcnt(0)" ::: "memory");
        }
    }
}

__device__ __forceinline__ void peer_gather_wave(const Params& p, int tk, char* smem) {
    const int lane = otid() & 63;
    const int2 r0 = p.ROUTE[(size_t)tk * 128 + lane], r1 = p.ROUTE[(size_t)tk * 128 + 64 + lane];
    f32x2 hv[16];
#pragma unroll
    for (int k = 0; k < 4; ++k) {
        float t8[8]; unpk8(*(const u32x4*)(p.HN + (size_t)tk * D + 32 * lane + 8 * k), t8);
#pragma unroll
        for (int e = 0; e < 4; ++e) hv[4 * k + e] = (f32x2){t8[2 * e], t8[2 * e + 1]};
    }
    f32x2 facc[16];
#pragma unroll
    for (int i = 0; i < 16; ++i) facc[i] = (f32x2){0.f, 0.f};
    const float rs64 = rsqrtf(p.ROWSS[tk] * (1.f / D) + EPS) * (1.f / 64.f);
    const unsigned char* u8 = (const unsigned char*)p.PU; const unsigned char* v8 = (const unsigned char*)p.PV;
    const int xl = ((lane >> 5) & 1) * 4 + ((lane >> 4) & 1) * 2 + ((lane >> 3) & 1);
    u32x4 uA[8], uB[8], vv[8];
#define PG_ISSUE_U(b, uu) { const int _es = ((b) < 8) ? r0.x : r1.x; \
    _Pragma("unroll") for (int x = 0; x < 8; ++x) { const size_t e = (size_t)(unsigned)__builtin_amdgcn_readlane(_es, 8 * ((b) & 7) + x); \
        uu[x] = *(const u32x4*)(u8 + e * (D / 2) + lane * 16); } }
#define PG_APPLY(b, uu) { const int _es = ((b) < 8) ? r0.x : r1.x; const int _gs = ((b) < 8) ? r0.y : r1.y; \
    _Pragma("unroll") for (int x = 0; x < 8; ++x) { const size_t e = (size_t)(unsigned)__builtin_amdgcn_readlane(_es, 8 * ((b) & 7) + x); \
        vv[x] = *(const u32x4*)(v8 + e * (D / 2) + lane * 16); } \
    const float gl = __int_as_float(__shfl(_gs, 8 * ((b) & 7) + xl)); \
    float d[8]; \
    _Pragma("unroll") for (int x = 0; x < 8; ++x) { f32x2 a2 = {0.f, 0.f}; \
        _Pragma("unroll") for (int q = 0; q < 4; ++q) { const unsigned w = uu[x][q]; \
            a2 += hv[4 * q] * __builtin_amdgcn_cvt_scalef32_pk_f32_fp4(w, 1.0f, 0); a2 += hv[4 * q + 1] * __builtin_amdgcn_cvt_scalef32_pk_f32_fp4(w, 1.0f, 1); \
            a2 += hv[4 * q + 2] * __builtin_amdgcn_cvt_scalef32_pk_f32_fp4(w, 1.0f, 2); a2 += hv[4 * q + 3] * __builtin_amdgcn_cvt_scalef32_pk_f32_fp4(w, 1.0f, 3); } \
        d[x] = a2.x + a2.y; } \
    float r4[4], r2[2], r1v; \
    { const bool hi = (lane & 32) != 0; \
      _Pragma("unroll") for (int k = 0; k < 4; ++k) { const float keep = hi ? d[k + 4] : d[k], send = hi ? d[k] : d[k + 4]; r4[k] = keep + __shfl_xor(send, 32); } } \
    { const bool hi = (lane & 16) != 0; \
      _Pragma("unroll") for (int k = 0; k < 2; ++k) { const float keep = hi ? r4[k + 2] : r4[k], send = hi ? r4[k] : r4[k + 2]; r2[k] = keep + __shfl_xor(send, 16); } } \
    { const bool hi = (lane & 8) != 0; const float keep = hi ? r2[1] : r2[0], send = hi ? r2[0] : r2[1]; r1v = keep + __shfl_xor(send, 8); } \
    r1v += __shfl_xor(r1v, 4); r1v += __shfl_xor(r1v, 2); r1v += __shfl_xor(r1v, 1); \
    const float cwv = gl * gelu_exact(r1v * rs64) * (1.f / 16.f); \
    _Pragma("unroll") for (int x = 0; x < 8; ++x) { const float cw = __int_as_float(__builtin_amdgcn_readlane(__float_as_int(cwv), 8 * x)); const f32x2 cw2 = {cw, cw}; \
        _Pragma("unroll") for (int q = 0; q < 4; ++q) { const unsigned w = vv[x][q]; \
            facc[4 * q] += cw2 * __builtin_amdgcn_cvt_scalef32_pk_f32_fp4(w, 1.0f, 0); facc[4 * q + 1] += cw2 * __builtin_amdgcn_cvt_scalef32_pk_f32_fp4(w, 1.0f, 1); \
            facc[4 * q + 2] += cw2 * __builtin_amdgcn_cvt_scalef32_pk_f32_fp4(w, 1.0f, 2); facc[4 * q + 3] += cw2 * __builtin_amdgcn_cvt_scalef32_pk_f32_fp4(w, 1.0f, 3); } } }
    PG_ISSUE_U(0, uA)
#pragma unroll 1
    for (int b = 0; b < 16; b += 2) {
        PG_ISSUE_U(b + 1, uB)
        __builtin_amdgcn_sched_barrier(0);
        PG_APPLY(b, uA)
        __builtin_amdgcn_sched_barrier(0);
        if (b + 2 < 16) PG_ISSUE_U(b + 2, uA)
        __builtin_amdgcn_sched_barrier(0);
        PG_APPLY(b + 1, uB)
        __builtin_amdgcn_sched_barrier(0);
    }
#undef PG_ISSUE_U
#undef PG_APPLY
    float* y = p.out + O_YP + (size_t)tk * D + 32 * lane;
#pragma unroll
    for (int q = 0; q < 8; ++q) {
        f32x4 hh = {hv[2 * q].x + facc[2 * q].x, hv[2 * q].y + facc[2 * q].y, hv[2 * q + 1].x + facc[2 * q + 1].x, hv[2 * q + 1].y + facc[2 * q + 1].y};
        *(f32x4*)(y + 4 * q) = hh;
    }
}

__device__ __forceinline__ void phase9(const Params& p, char* smem) {
    const int c = blockIdx.x, G = gridDim.x;
    for (int tk = TP + (G - 1 - c); tk < TT; tk += G) peer_item<true>(p, tk, smem);
    peer_route_wg(p, smem);
}
__device__ __forceinline__ void phase10(const Params& p, char* smem) {
    const int gw = blockIdx.x * 8 + (otid() >> 6), NGW = gridDim.x * 8;
    for (int tk = gw; tk < TP; tk += NGW) peer_gather_wave(p, tk, smem);
}

__global__ __launch_bounds__(512, 2) void fwd_kernel(KArgs ka) {
    extern __shared__ __attribute__((aligned(16))) char smem[];
    const Params p = make_params(ka);
    volatile LAS unsigned* st = (volatile LAS unsigned*)(smem + LDS_BYTES - 16);
    if (threadIdx.x == 0) { st[0] = 0u; st[1] = 0u; }
    __syncthreads();
    XcdBarrier bar = xcd_barrier_post(p.ctl, st);
#ifndef PHASE_MASK
#define PHASE_MASK 0x7ff
#endif
#ifndef REP_MASK
  #define REP_MASK 0
#endif
#define PH(k, call) if (((PHASE_MASK >> (k)) & 1) && ka.ph_lo <= (k) && (k) < ka.ph_hi) { \
    for (int rep = 0; rep < 1 + ((REP_MASK >> (k)) & 1); ++rep) { call; if (rep + 1 < 1 + ((REP_MASK >> (k)) & 1)) xcd_barrier(bar); } \
    if ((k) + 1 < ka.ph_hi) xcd_barrier(bar); }
    PH(0, phase0(p, smem))
    PH(1, phase1(p, smem))
    PH(2, phase2(p, smem))
    PH(3, phase3(p, smem, rep))
    PH(4, phase4(p, smem))
    PH(5, phase5(p, smem))
    PH(6, phase6(p, smem))
    PH(8, phase8(p, smem, rep))
    PH(9, phase9(p, smem))
    PH(10, phase10(p, smem))
#undef PH
}


#ifdef DBG_RET_NAIVE
__global__ void dbg_ret_naive(KArgs ka) {
    const Params p = make_params(ka);
    const int idx = blockIdx.x * blockDim.x + threadIdx.x;
    const int dv = idx & 255, dk = (idx >> 8) & 127, h = (idx >> 15) & 7, b = idx >> 18;
    const float g = 1.f - exp2f(-5.f - (float)h);
    float S = 0.f;
    for (int t = 0; t < SEQ; ++t) {
        const size_t tok = (size_t)b * SEQ + t;
        S = g * S + (float)p.RK[tok * 1024 + h * 128 + dk] * (float)p.RV[tok * 2048 + h * 256 + dv];
    }
    p.out[O_SP + ((size_t)((b * 8 + h) * 128 + dk)) * 256 + dv] = S;
}
#endif
#ifdef DBG_SCALES
__global__ void dbg_scale_kernel(float* out) {
    const float sc[10] = {DBG_SCALES};
    const size_t offs[11] = {O_YP, O_YS, O_KP, O_VP, O_IKP, O_SP, O_KS, O_VS, O_IKS, O_SS, 28861440};
    for (size_t i = (size_t)blockIdx.x * blockDim.x + threadIdx.x; i < 28861440; i += (size_t)gridDim.x * blockDim.x) {
        float s = 0.f;
#pragma unroll
        for (int k = 0; k < 10; ++k) if (i >= offs[k] && i < offs[k + 1]) s = sc[k];
        out[i] = (s == 0.f) ? 0.f : out[i] * s;
    }
}
#endif
#ifndef MK_MULTI
#define MK_MULTI 0
#endif
extern "C" void kernel_launch(void* const* d_in, const int* in_sizes, int n_in, void* d_out, int out_size, void* d_ws, size_t ws_size, hipStream_t stream) {
    static int grid = 0;
    if (grid == 0) {
        int dev = 0, cus = 0;
        (void)hipGetDevice(&dev); (void)hipDeviceGetAttribute(&cus, hipDeviceAttributeMultiprocessorCount, dev);
        (void)hipFuncSetAttribute((const void*)fwd_kernel, hipFuncAttributeMaxDynamicSharedMemorySize, LDS_BYTES);
        int per_cu = 0;
        (void)hipOccupancyMaxActiveBlocksPerMultiprocessor(&per_cu, (const void*)fwd_kernel, 512, LDS_BYTES);
        (void)hipGetLastError();
        grid = (cus > 0 ? cus : 256) * 1;
        if (per_cu < 1) fprintf(stderr, "kernel_launch: occupancy query reports %d blocks per CU\n", per_cu);
    }
    KArgs p;
    memset(&p, 0, sizeof(p));
    if (n_in < 21) { fprintf(stderr, "kernel_launch: expected 21 inputs, got %d\n", n_in); return; }
    for (int i = 0; i < 21; ++i) p.in[i] = d_in[i];
    p.out = (float*)d_out;
    p.ws = (char*)d_ws;
    if (WS_END > ws_size) { fprintf(stderr, "kernel_launch: workspace too small (%zu > %zu)\n", (size_t)WS_END, ws_size); return; }
    (void)hipMemsetAsync(d_ws, 0, 65536, stream);
#if MK_MULTI
    for (int k = 0; k < 11; ++k) {
        p.ph_lo = k; p.ph_hi = k + 1;
        hipLaunchKernelGGL(fwd_kernel, dim3(grid), dim3(512), LDS_BYTES, stream, p);
    }
#else
    p.ph_lo = 0; p.ph_hi = 11;
    hipLaunchKernelGGL(fwd_kernel, dim3(grid), dim3(512), LDS_BYTES, stream, p);
#endif
#ifdef DBG_RET_NAIVE
    hipLaunchKernelGGL(dbg_ret_naive, dim3(2 * 8 * 128 * 256 / 256), dim3(256), 0, stream, p);
#endif
#ifdef DBG_SCALES
    hipLaunchKernelGGL(dbg_scale_kernel, dim3(1024), dim3(256), 0, stream, (float*)d_out);
#endif
}
```
